# Optimizing an MI355X kernel written in HIP

```python
import math
import jax, jax.numpy as jnp
from jax import lax
import numpy as np

D_MODEL = 1024
BATCH = 2
SEQ = 8192
DEPTH = 1

CTX_LEN = 256
GRID_W = 64
HEAD_DIM = 64
GQA_HEADS = 8
GQA_KV_HEADS = 2
GQA_GROUP = GQA_HEADS // GQA_KV_HEADS
DIFF_HEADS = 4
DIFF_V_DIM = 2 * HEAD_DIM
MIX_WIDTH = GQA_HEADS * HEAD_DIM + DIFF_HEADS * DIFF_V_DIM
A_Q_COLS = GQA_HEADS * HEAD_DIM
A_KV_COLS = GQA_KV_HEADS * HEAD_DIM
B_QK_COLS = DIFF_HEADS * 2 * HEAD_DIM
B_V_COLS = DIFF_HEADS * DIFF_V_DIM
QKV_COLS = A_Q_COLS + 2 * A_KV_COLS + 2 * B_QK_COLS + B_V_COLS
Q_BLOCK = 128
ROPE_THETA = 10000.0
N_EXPERTS = 32
TOP_K = 4
D_FF = D_MODEL
SWIGLU_ALPHA = 1.702
SWIGLU_LIMIT = 7.0
EXPERT_BLOCK = 128
N_MOD = 6
EPS = 1e-6

kernel_name = 'hybrid_gqa_diffattn_moe_dit_layer'


def rms_norm(x, g):
    xf = x.astype(jnp.float32)
    y = xf * lax.rsqrt(jnp.mean(xf * xf, axis=-1, keepdims=True) + EPS)
    return (y * g.astype(jnp.float32)).astype(x.dtype)


def modulate(h, shift, scale):
    return h * (1 + scale) + shift


def axial_rope_tables(n_tokens):
    rows = n_tokens // GRID_W
    row = jnp.broadcast_to(jnp.arange(rows, dtype=jnp.float32)[:, None], (rows, GRID_W)).reshape(-1)
    col = jnp.broadcast_to(jnp.arange(GRID_W, dtype=jnp.float32)[None, :], (rows, GRID_W)).reshape(-1)
    n_freq = HEAD_DIM // 4
    inv_freq = ROPE_THETA ** (-jnp.arange(n_freq, dtype=jnp.float32) / n_freq)
    ang = jnp.stack([row[:, None] * inv_freq, col[:, None] * inv_freq], axis=1)
    return jnp.cos(ang), jnp.sin(ang)


def apply_axial_rope(x, cos, sin):
    b, t, h, _ = x.shape
    xr = x.reshape(b, t, h, 2, 2, HEAD_DIM // 4)
    x1, x2 = xr[..., 0, :], xr[..., 1, :]
    cs = cos[None, :, None]
    sn = sin[None, :, None]
    out = jnp.stack([x1 * cs - x2 * sn, x2 * cs + x1 * sn], axis=-2)
    return out.reshape(x.shape).astype(x.dtype)


def split_projection(p):
    b, t, _ = p.shape
    offs = [A_Q_COLS, A_Q_COLS + A_KV_COLS, A_Q_COLS + 2 * A_KV_COLS,
            A_Q_COLS + 2 * A_KV_COLS + B_QK_COLS, A_Q_COLS + 2 * A_KV_COLS + 2 * B_QK_COLS]
    qa, ka, va, qb, kb, vb = jnp.split(p, offs, axis=-1)
    qa = qa.reshape(b, t, GQA_HEADS, HEAD_DIM)
    ka = ka.reshape(b, t, GQA_KV_HEADS, HEAD_DIM)
    va = va.reshape(b, t, GQA_KV_HEADS, HEAD_DIM)
    qb = qb.reshape(b, t, DIFF_HEADS, 2, HEAD_DIM)
    kb = kb.reshape(b, t, DIFF_HEADS, 2, HEAD_DIM)
    vb = vb.reshape(b, t, DIFF_HEADS, DIFF_V_DIM)
    return qa, ka, va, qb, kb, vb


def rope_diff(x, cos, sin):
    b, t, h, two, d = x.shape
    return apply_axial_rope(x.reshape(b, t, h * two, d), cos, sin).reshape(x.shape)


def gqa_attention(q, k, v, q_block):
    b, t, _, d = q.shape
    nb = t // q_block
    qb = q.reshape(b, nb, q_block, GQA_KV_HEADS, GQA_GROUP, d).transpose(1, 0, 3, 4, 2, 5)
    scale = d ** -0.5

    def block(qi):
        s = jnp.einsum('bhgqd,bkhd->bhgqk', qi, k, preferred_element_type=jnp.float32) * scale
        p = jax.nn.softmax(s, axis=-1)
        return jnp.einsum('bhgqk,bkhd->bqhgd', p.astype(v.dtype), v)

    o = lax.map(block, qb)
    return o.transpose(1, 0, 2, 3, 4, 5).reshape(b, t, GQA_HEADS * d)


def diff_attention(q, k, v, lam, sub_g, lambda_init, q_block):
    b, t, h, _, d = q.shape
    nb = t // q_block
    qb = q.reshape(b, nb, q_block, h, 2, d).transpose(1, 0, 3, 4, 2, 5)
    scale = d ** -0.5

    def block(qi):
        s = jnp.einsum('bhcqd,bkhcd->bhcqk', qi, k, preferred_element_type=jnp.float32) * scale
        p = jax.nn.softmax(s, axis=-1)
        a = p[:, :, 0] - lam * p[:, :, 1]
        return jnp.einsum('bhqk,bkhe->bqhe', a.astype(v.dtype), v)

    o = lax.map(block, qb).transpose(1, 0, 2, 3, 4).reshape(b, t, h, DIFF_V_DIM)
    o = rms_norm(o, sub_g) * (1.0 - lambda_init)
    return o.reshape(b, t, h * DIFF_V_DIM)


def moe_ffn(h, w_router, b_router, w_in, b_in, w_out, b_out):
    b, t, dm = h.shape
    n = b * t
    xt = h.reshape(n, dm)
    logits = (xt @ w_router + b_router).astype(jnp.float32)
    top_val, top_idx = lax.top_k(logits, TOP_K)
    gates = jax.nn.softmax(top_val, axis=-1)
    n_assign = n * TOP_K
    exp_flat = top_idx.reshape(-1).astype(jnp.int32)
    tok_flat = jnp.repeat(jnp.arange(n, dtype=jnp.int32), TOP_K)
    gate_flat = gates.reshape(-1)
    order = jnp.argsort(exp_flat)
    exp_sorted = exp_flat[order]
    counts = jax.ops.segment_sum(jnp.ones_like(exp_flat), exp_flat, num_segments=N_EXPERTS)
    starts = jnp.cumsum(counts) - counts
    padded = (counts + EXPERT_BLOCK - 1) // EXPERT_BLOCK * EXPERT_BLOCK
    pad_ends = jnp.cumsum(padded)
    pad_starts = pad_ends - padded
    dest = pad_starts[exp_sorted] + (jnp.arange(n_assign, dtype=jnp.int32) - starts[exp_sorted])
    n_blocks = -(-n_assign // EXPERT_BLOCK) + N_EXPERTS
    n_rows = n_blocks * EXPERT_BLOCK
    row_tok = jnp.full((n_rows,), n, jnp.int32).at[dest].set(tok_flat[order])
    row_gate = jnp.zeros((n_rows,), jnp.float32).at[dest].set(gate_flat[order])
    block_start = jnp.arange(n_blocks, dtype=jnp.int32) * EXPERT_BLOCK
    block_exp = jnp.minimum(jnp.searchsorted(pad_ends, block_start, side='right'), N_EXPERTS - 1)
    x_pad = jnp.concatenate([xt, jnp.zeros((1, dm), xt.dtype)], axis=0)
    xs = x_pad[row_tok].reshape(n_blocks, EXPERT_BLOCK, dm)

    def expert_block(args):
        xb, e = args
        hcat = xb @ w_in[e] + b_in[e]
        x_glu = jnp.minimum(hcat[:, :D_FF], SWIGLU_LIMIT)
        x_lin = jnp.clip(hcat[:, D_FF:], -SWIGLU_LIMIT, SWIGLU_LIMIT)
        act = x_glu * jax.nn.sigmoid(SWIGLU_ALPHA * x_glu) * (x_lin + 1)
        return act @ w_out[e] + b_out[e]

    ys = lax.map(expert_block, (xs, block_exp)).reshape(n_rows, dm)
    y = jax.ops.segment_sum(ys * row_gate[:, None].astype(ys.dtype), row_tok, num_segments=n + 1)[:n]
    return y.reshape(b, t, dm)


def setup_inputs(seed: int = 0) -> dict:
    key = jax.random.key(seed)
    ks = jax.random.split(key, 21)
    f32 = jnp.float32
    nrm = lambda k, shape, s: jax.random.normal(k, shape, f32) * s
    return {
        'x': nrm(ks[0], (BATCH, SEQ, D_MODEL), 1.0),
        'c': nrm(ks[1], (BATCH, D_MODEL), 1.0),
        'ctx': nrm(ks[2], (BATCH, CTX_LEN, D_MODEL), 1.0),
        'c_ctx': nrm(ks[3], (D_MODEL,), 1.0),
        'w_ada': nrm(ks[4], (DEPTH, D_MODEL, N_MOD * D_MODEL), 0.5 * D_MODEL ** -0.5),
        'b_ada': nrm(ks[5], (DEPTH, N_MOD * D_MODEL), 0.02),
        'g_attn': 1.0 + nrm(ks[6], (DEPTH, D_MODEL), 0.05),
        'w_qkv': nrm(ks[7], (DEPTH, D_MODEL, QKV_COLS), D_MODEL ** -0.5),
        'gqa_q_norm': 1.0 + nrm(ks[8], (DEPTH, HEAD_DIM), 0.05),
        'gqa_k_norm': 1.0 + nrm(ks[9], (DEPTH, HEAD_DIM), 0.05),
        'diff_lambda': nrm(ks[10], (DEPTH, 4, HEAD_DIM), 0.1),
        'diff_subln': 1.0 + nrm(ks[11], (DEPTH, DIFF_V_DIM), 0.05),
        'w_o': nrm(ks[12], (DEPTH, MIX_WIDTH, D_MODEL), MIX_WIDTH ** -0.5),
        'g_ffn': 1.0 + nrm(ks[13], (DEPTH, D_MODEL), 0.05),
        'w_router': nrm(ks[14], (DEPTH, D_MODEL, N_EXPERTS), D_MODEL ** -0.5),
        'b_router': nrm(ks[15], (DEPTH, N_EXPERTS), 0.01),
        'w_in': nrm(ks[16], (DEPTH, N_EXPERTS, D_MODEL, 2 * D_FF), D_MODEL ** -0.5),
        'b_in': nrm(ks[17], (DEPTH, N_EXPERTS, 2 * D_FF), 0.02),
        'w_out': nrm(ks[18], (DEPTH, N_EXPERTS, D_FF, D_MODEL), D_FF ** -0.5),
        'b_out': nrm(ks[19], (DEPTH, N_EXPERTS, D_MODEL), 0.02),
        'g_final': 1.0 + nrm(ks[20], (D_MODEL,), 0.05),
    }


def reference(x, c, ctx, c_ctx, w_ada, b_ada, g_attn, w_qkv, gqa_q_norm, gqa_k_norm, diff_lambda,
              diff_subln, w_o, g_ffn, w_router, b_router, w_in, b_in, w_out, b_out, g_final):
    n_tok = x.shape[1]
    cos, sin = axial_rope_tables(n_tok)
    for l in range(DEPTH):
        lambda_init = 0.8 - 0.6 * math.exp(-0.3 * l)
        mod_x = (jax.nn.silu(c) @ w_ada[l] + b_ada[l])[:, None, :]
        mod_c = (jax.nn.silu(c_ctx) @ w_ada[l] + b_ada[l])[None, None, :]
        sh1, sc1, gt1, sh2, sc2, gt2 = jnp.split(mod_x, N_MOD, axis=-1)
        csh1, csc1, cgt1, csh2, csc2, cgt2 = jnp.split(mod_c, N_MOD, axis=-1)

        h = modulate(rms_norm(x, g_attn[l]), sh1, sc1)
        hc = modulate(rms_norm(ctx, g_attn[l]), csh1, csc1)
        qa, ka, va, qb, kb, vb = split_projection(h @ w_qkv[l])
        qa_c, ka_c, va_c, qb_c, kb_c, vb_c = split_projection(hc @ w_qkv[l])
        qa = apply_axial_rope(rms_norm(qa, gqa_q_norm[l]), cos, sin)
        ka = apply_axial_rope(rms_norm(ka, gqa_k_norm[l]), cos, sin)
        ka_c = rms_norm(ka_c, gqa_k_norm[l])
        qb = rope_diff(qb, cos, sin)
        kb = rope_diff(kb, cos, sin)
        lamf = diff_lambda[l].astype(jnp.float32)
        lam = jnp.exp(jnp.sum(lamf[0] * lamf[1])) - jnp.exp(jnp.sum(lamf[2] * lamf[3])) + lambda_init
        ka_all = jnp.concatenate([ka_c, ka], axis=1)
        va_all = jnp.concatenate([va_c, va], axis=1)
        kb_all = jnp.concatenate([kb_c, kb], axis=1)
        vb_all = jnp.concatenate([vb_c, vb], axis=1)
        lat_mix = jnp.concatenate([
            gqa_attention(qa, ka_all, va_all, Q_BLOCK),
            diff_attention(qb, kb_all, vb_all, lam, diff_subln[l], lambda_init, Q_BLOCK),
        ], axis=-1)
        x = x + gt1 * (lat_mix @ w_o[l])
        x = x + gt2 * moe_ffn(modulate(rms_norm(x, g_ffn[l]), sh2, sc2),
                              w_router[l], b_router[l], w_in[l], b_in[l], w_out[l], b_out[l])

        if l < DEPTH - 1:
            qa_c = rms_norm(qa_c, gqa_q_norm[l])
            ctx_len = ctx.shape[1]
            ctx_mix = jnp.concatenate([
                gqa_attention(qa_c, ka_c, va_c, ctx_len),
                diff_attention(qb_c, kb_c, vb_c, lam, diff_subln[l], lambda_init, ctx_len),
            ], axis=-1)
            ctx = ctx + cgt1 * (ctx_mix @ w_o[l])
            ctx = ctx + cgt2 * moe_ffn(modulate(rms_norm(ctx, g_ffn[l]), csh2, csc2),
                                       w_router[l], b_router[l], w_in[l], b_in[l], w_out[l], b_out[l])
    return rms_norm(x, g_final)
```

```cpp
#include <hip/hip_runtime.h>
#include <math.h>
#include <stdint.h>

namespace nv {
constexpr int D = 1024, NB = 2, T = 8192, CTX = 256, KEYS = CTX + T, MROWS = NB * KEYS, NTOK = NB * T;
constexpr int QKVC = 2304, NE = 32, TOPK = 4, DFF = 1024, NMOD = 6 * D;
constexpr float EPS = 1e-6f;

constexpr size_t WS_MOD = 0;
constexpr size_t WS_ROPE = WS_MOD + 3 * NMOD;
constexpr size_t WS_CNT = WS_ROPE + 2 * 128 * 16;
constexpr size_t WS_GATE = WS_CNT + 128;
constexpr size_t WS_LTOK = WS_GATE + (size_t)NTOK * 4;
constexpr size_t WS_LSLOT = WS_LTOK + (size_t)NE * NTOK;
constexpr size_t WS_H = WS_LSLOT + (size_t)NE * NTOK;
constexpr size_t WS_QKV = WS_H + (size_t)MROWS * D;
constexpr size_t WS_DT = WS_QKV + (size_t)MROWS * QKVC;
constexpr size_t WS_MIX = WS_DT + (size_t)2 * NTOK * 512;
constexpr size_t WS_X1 = WS_MIX + (size_t)NTOK * D;
constexpr size_t WS_ACT = WS_X1 + (size_t)NTOK * D;
constexpr size_t WS_Y = WS_ACT + (size_t)NTOK * 4 * D;
constexpr size_t WS_END = WS_Y + (size_t)NTOK * 4 * D;

__device__ __forceinline__ float block_sum(float v, float* red) {
    for (int o = 32; o > 0; o >>= 1) v += __shfl_xor(v, o);
    const int w = threadIdx.x >> 6;
    __syncthreads();
    if ((threadIdx.x & 63) == 0) red[w] = v;
    __syncthreads();
    return (red[0] + red[1]) + (red[2] + red[3]);
}

__global__ void k_mod(const float* c, const float* cctx, const float* w_ada, const float* b_ada, float* mod) {
    const int col = blockIdx.x * 256 + threadIdx.x, v = blockIdx.y;
    const float* src = v < 2 ? c + v * D : cctx;
    float acc = 0.f;
    for (int k = 0; k < D; ++k) { const float s = src[k]; acc += (s / (1.f + expf(-s))) * w_ada[(size_t)k * NMOD + col]; }
    mod[v * NMOD + col] = acc + b_ada[col];
}
__global__ void k_rope(float* tab) {
    const int i = blockIdx.x * 256 + threadIdx.x; if (i >= 128 * 16) return;
    const int p = i / 16, f = i % 16;
    const float invf = (float)pow(10000.0, -(double)f / 16.0);
    const float ang = (float)p * invf;
    tab[i] = (float)cos((double)ang); tab[128 * 16 + i] = (float)sin((double)ang);
}
__global__ void k_norm1(const float* x, const float* ctx, const float* g, const float* mod, float* h) {
    __shared__ float red[4];
    const int m = blockIdx.x, b = m / KEYS, i = m % KEYS;
    const float* src; const float* md;
    if (i < CTX) { src = ctx + ((size_t)b * CTX + i) * D; md = mod + 2 * NMOD; } else { src = x + ((size_t)b * T + (i - CTX)) * D; md = mod + b * NMOD; }
    const float4 v = ((const float4*)src)[threadIdx.x];
    const float ss = block_sum(v.x * v.x + v.y * v.y + v.z * v.z + v.w * v.w, red);
    const float rstd = 1.0f / sqrtf(ss * (1.f / D) + EPS);
    const int c0 = threadIdx.x * 4; float o[4] = {v.x, v.y, v.z, v.w};
    for (int j = 0; j < 4; ++j) o[j] = o[j] * rstd * g[c0 + j] * (1.f + md[D + c0 + j]) + md[c0 + j];
    ((float4*)(h + (size_t)m * D))[threadIdx.x] = make_float4(o[0], o[1], o[2], o[3]);
}

template <class P, bool DUAL>
__global__ void __launch_bounds__(256) k_sgemm(P p) {
    __shared__ float As[16][68], Bs[16][68], Bs2[DUAL ? 16 : 1][68];
    const float* A; const float* Bm; const float* B2 = nullptr; int lda, ldb, M, K;
    const int z = blockIdx.z, m0 = blockIdx.y * 64, n0 = blockIdx.x * 64;
    if (!p.setup(z, A, lda, Bm, B2, ldb, M, K)) return;
    if (m0 >= M) return;
    const int tid = threadIdx.x, tx = tid & 15, ty = tid >> 4;
    const int ar = tid >> 2, ak = (tid & 3) * 4;
    const int bk = tid >> 4, bn = (tid & 15) * 4;
    const int arow = m0 + ar; const bool avalid = arow < M;
    const float* ap = A + (size_t)p.arow(z, avalid ? arow : m0) * lda + ak;
    float acc[4][4] = {}, acc2[4][4] = {};
    for (int k0 = 0; k0 < K; k0 += 16) {
        const float4 av = *(const float4*)(ap + k0);
        const float4 bv = *(const float4*)(Bm + (size_t)(k0 + bk) * ldb + n0 + bn);
        float4 bv2 = bv; if (DUAL) bv2 = *(const float4*)(B2 + (size_t)(k0 + bk) * ldb + n0 + bn);
        __syncthreads();
        As[ak + 0][ar] = av.x; As[ak + 1][ar] = av.y; As[ak + 2][ar] = av.z; As[ak + 3][ar] = av.w;
        *(float4*)&Bs[bk][bn] = bv; if (DUAL) *(float4*)&Bs2[bk][bn] = bv2;
        __syncthreads();
#pragma unroll
        for (int k = 0; k < 16; ++k) {
            const float4 a = *(const float4*)&As[k][ty * 4]; const float4 b = *(const float4*)&Bs[k][tx * 4];
            const float aa[4] = {a.x, a.y, a.z, a.w}, bb[4] = {b.x, b.y, b.z, b.w};
#pragma unroll
            for (int i = 0; i < 4; ++i)
#pragma unroll
                for (int j = 0; j < 4; ++j) acc[i][j] += aa[i] * bb[j];
            if (DUAL) { const float4 b2 = *(const float4*)&Bs2[k][tx * 4]; const float b2b[4] = {b2.x, b2.y, b2.z, b2.w};
#pragma unroll
                for (int i = 0; i < 4; ++i)
#pragma unroll
                    for (int j = 0; j < 4; ++j) acc2[i][j] += aa[i] * b2b[j]; }
        }
    }
#pragma unroll
    for (int i = 0; i < 4; ++i) { const int m = m0 + ty * 4 + i; if (m >= M) continue;
#pragma unroll
        for (int j = 0; j < 4; ++j) p.store(z, m, n0 + tx * 4 + j, acc[i][j], acc2[i][j]); }
}
struct PQkv { const float* h; const float* w; float* out;
    __device__ bool setup(int, const float*& A, int& lda, const float*& Bm, const float*&, int& ldb, int& M, int& K) const { A = h; lda = D; Bm = w; ldb = QKVC; M = MROWS; K = D; return true; }
    __device__ int arow(int, int m) const { return m; }
    __device__ void store(int, int m, int n, float v, float) const { out[(size_t)m * QKVC + n] = v; } };
struct PWo { const float* mix; const float* w; const float* x; const float* mod; float* x1;
    __device__ bool setup(int, const float*& A, int& lda, const float*& Bm, const float*&, int& ldb, int& M, int& K) const { A = mix; lda = D; Bm = w; ldb = D; M = NTOK; K = D; return true; }
    __device__ int arow(int, int m) const { return m; }
    __device__ void store(int, int m, int n, float v, float) const { const int b = m / T; x1[(size_t)m * D + n] = x[(size_t)m * D + n] + mod[b * NMOD + 2 * D + n] * v; } };
struct PIn { const float* h2; const float* w_in; const float* b_in; const int* cnt; const int* off; const int* ltok; float* act;
    __device__ bool setup(int e, const float*& A, int& lda, const float*& Bm, const float*& B2, int& ldb, int& M, int& K) const { A = h2; lda = D; Bm = w_in + (size_t)e * D * 2 * DFF; B2 = Bm + DFF; ldb = 2 * DFF; M = cnt[e]; K = D; return M > 0; }
    __device__ int arow(int e, int m) const { return ltok[(size_t)e * NTOK + m]; }
    __device__ void store(int e, int m, int n, float v, float v2) const {
        float g = fminf(v + b_in[e * 2 * DFF + n], 7.f), l = fminf(fmaxf(v2 + b_in[e * 2 * DFF + DFF + n], -7.f), 7.f);
        act[(size_t)(off[e] + m) * DFF + n] = g * (1.f / (1.f + expf(-1.702f * g))) * (l + 1.f); } };
struct POut { const float* act; const float* w_out; const float* b_out; const int* cnt; const int* off; const int* lslot; const float* gate; float* y;
    __device__ bool setup(int e, const float*& A, int& lda, const float*& Bm, const float*&, int& ldb, int& M, int& K) const { A = act + (size_t)off[e] * DFF; lda = DFF; Bm = w_out + (size_t)e * DFF * D; ldb = D; M = cnt[e]; K = DFF; return M > 0; }
    __device__ int arow(int, int m) const { return m; }
    __device__ void store(int e, int m, int n, float v, float) const { const int s = lslot[(size_t)e * NTOK + m]; y[(size_t)s * D + n] = gate[s] * (v + b_out[e * D + n]); } };

__global__ void k_qkpost(float* qkv, const float* qn, const float* kn, const float* rope) {
    const int idx = blockIdx.x * 256 + threadIdx.x; if (idx >= MROWS * 26) return;
    const int m = idx / 26, s = idx % 26, i = m % KEYS;
    int col; const float* g = nullptr;
    if (s < 8) { col = s * 64; g = qn; } else if (s < 10) { col = 512 + (s - 8) * 64; g = kn; } else if (s < 18) col = 768 + (s - 10) * 64; else col = 1280 + (s - 18) * 64;
    float* p = qkv + (size_t)m * QKVC + col; float v[64];
#pragma unroll
    for (int d = 0; d < 64; ++d) v[d] = p[d];
    if (g) { float ss = 0.f;
#pragma unroll
        for (int d = 0; d < 64; ++d) ss += v[d] * v[d];
        const float r = 1.0f / sqrtf(ss * (1.f / 64.f) + EPS);
#pragma unroll
        for (int d = 0; d < 64; ++d) v[d] = v[d] * r * g[d]; }
    if (i >= CTX) { const int t = i - CTX, pr = t / 64, pc = t % 64;
#pragma unroll
        for (int ax = 0; ax < 2; ++ax) { const int pos = ax ? pc : pr;
#pragma unroll
            for (int f = 0; f < 16; ++f) { const float cs = rope[pos * 16 + f], sn = rope[2048 + pos * 16 + f]; const float a = v[ax * 32 + f], b2 = v[ax * 32 + 16 + f];
                v[ax * 32 + f] = a * cs - b2 * sn; v[ax * 32 + 16 + f] = b2 * cs + a * sn; } } }
#pragma unroll
    for (int d = 0; d < 64; ++d) p[d] = v[d];
}

__global__ void __launch_bounds__(64) k_attn(const float* qkv, float* mix, float* dt) {
    __shared__ float Ks[16][64], Vs[16][64];
    const int run = blockIdx.y, lane = threadIdx.x;
    int b, qcol, kcol, vcol; float* outp; int ostride;
    if (run < 16) { b = run / 8; const int h = run % 8; qcol = h * 64; kcol = 512 + (h / 4) * 64; vcol = 640 + (h / 4) * 64; outp = mix + (size_t)b * T * D + h * 64; ostride = D; }
    else { const int r = run - 16; b = r / 16; const int h = (r / 4) % 4, c = (r / 2) % 2, vh = r % 2; qcol = 768 + h * 128 + c * 64; kcol = 1280 + h * 128 + c * 64; vcol = 1792 + h * 128 + vh * 64;
        outp = dt + (size_t)c * NTOK * 512 + (size_t)b * T * 512 + h * 128 + vh * 64; ostride = 512; }
    const int t = blockIdx.x * 64 + lane;
    const float* qp = qkv + ((size_t)b * KEYS + CTX + t) * QKVC + qcol;
    float q[64], o[64];
#pragma unroll
    for (int d = 0; d < 64; ++d) { q[d] = qp[d] * 0.125f; o[d] = 0.f; }
    float mrun = -INFINITY, lrun = 0.f;
    const float* kb = qkv + (size_t)b * KEYS * QKVC;
    for (int j0 = 0; j0 < KEYS; j0 += 16) {
        __syncthreads();
#pragma unroll
        for (int i = 0; i < 4; ++i) { const int idx = i * 64 + lane, r = idx / 16, c4 = (idx % 16) * 4;
            *(float4*)&Ks[r][c4] = *(const float4*)(kb + (size_t)(j0 + r) * QKVC + kcol + c4);
            *(float4*)&Vs[r][c4] = *(const float4*)(kb + (size_t)(j0 + r) * QKVC + vcol + c4); }
        __syncthreads();
        float s[16]; float tmax = -INFINITY;
#pragma unroll
        for (int j = 0; j < 16; ++j) { float a = 0.f;
#pragma unroll
            for (int d = 0; d < 64; d += 4) { const float4 kv = *(const float4*)&Ks[j][d]; a += q[d] * kv.x + q[d + 1] * kv.y + q[d + 2] * kv.z + q[d + 3] * kv.w; }
            s[j] = a; tmax = fmaxf(tmax, a); }
        const float mnew = fmaxf(mrun, tmax), alpha = expf(mrun - mnew);
        lrun *= alpha;
#pragma unroll
        for (int d = 0; d < 64; ++d) o[d] *= alpha;
#pragma unroll
        for (int j = 0; j < 16; ++j) { const float pj = expf(s[j] - mnew); lrun += pj;
#pragma unroll
            for (int d = 0; d < 64; d += 4) { const float4 vv = *(const float4*)&Vs[j][d]; o[d] += pj * vv.x; o[d + 1] += pj * vv.y; o[d + 2] += pj * vv.z; o[d + 3] += pj * vv.w; } }
        mrun = mnew;
    }
    const float il = 1.f / lrun; float* op = outp + (size_t)t * ostride;
#pragma unroll
    for (int d = 0; d < 64; ++d) op[d] = o[d] * il;
}
__global__ void k_diffcomb(const float* dt, const float* lamp, const float* subg, float* mix) {
    const int idx = blockIdx.x * 256 + threadIdx.x; if (idx >= NTOK * 4) return;
    const int tok = idx / 4, h = idx % 4;
    float s01 = 0.f, s23 = 0.f;
    for (int d = 0; d < 64; ++d) { s01 += lamp[d] * lamp[64 + d]; s23 += lamp[128 + d] * lamp[192 + d]; }
    const float lam = expf(s01) - expf(s23) + 0.2f;
    const float* p0 = dt + (size_t)tok * 512 + h * 128; const float* p1 = p0 + (size_t)NTOK * 512;
    float ss = 0.f;
    for (int e = 0; e < 128; ++e) { const float v = p0[e] - lam * p1[e]; ss += v * v; }
    const float r = 1.0f / sqrtf(ss * (1.f / 128.f) + EPS);
    float* o = mix + (size_t)tok * D + 512 + h * 128;
    for (int e = 0; e < 128; ++e) o[e] = (p0[e] - lam * p1[e]) * r * subg[e] * 0.8f;
}
__global__ void k_router(const float* x1, const float* g, const float* mod, const float* wr, const float* br, float* h2, float* gate, int* cnt, int* ltok, int* lslot) {
    __shared__ float red[4], hs[D], part[8][32], lg[32];
    const int tok = blockIdx.x, b = tok / T, tid = threadIdx.x; const float* md = mod + b * NMOD;
    const float4 v = ((const float4*)(x1 + (size_t)tok * D))[tid];
    const float ss = block_sum(v.x * v.x + v.y * v.y + v.z * v.z + v.w * v.w, red);
    const float rstd = 1.0f / sqrtf(ss * (1.f / D) + EPS);
    const int c0 = tid * 4; float o[4] = {v.x, v.y, v.z, v.w};
    for (int j = 0; j < 4; ++j) { o[j] = o[j] * rstd * g[c0 + j] * (1.f + md[4 * D + c0 + j]) + md[3 * D + c0 + j]; hs[c0 + j] = o[j]; }
    ((float4*)(h2 + (size_t)tok * D))[tid] = make_float4(o[0], o[1], o[2], o[3]);
    __syncthreads();
    const int e = tid & 31, sub = tid >> 5; float a = 0.f;
    for (int k = sub; k < D; k += 8) a += hs[k] * wr[k * NE + e];
    part[sub][e] = a;
    __syncthreads();
    if (tid < 32) { float s = 0.f; for (int i = 0; i < 8; ++i) s += part[i][tid]; lg[tid] = s + br[tid]; }
    __syncthreads();
    if (tid == 0) {
        int idx[4]; float val[4]; unsigned used = 0u;
        for (int k = 0; k < 4; ++k) { int bi = -1; float bv = -INFINITY; for (int i = 0; i < NE; ++i) if (!((used >> i) & 1u) && lg[i] > bv) { bv = lg[i]; bi = i; } used |= 1u << bi; idx[k] = bi; val[k] = bv; }
        float den = 0.f, ex[4]; for (int k = 0; k < 4; ++k) { ex[k] = expf(val[k] - val[0]); den += ex[k]; }
        for (int k = 0; k < 4; ++k) { const int pos = atomicAdd(&cnt[idx[k]], 1); ltok[(size_t)idx[k] * NTOK + pos] = tok; lslot[(size_t)idx[k] * NTOK + pos] = tok * 4 + k; gate[tok * 4 + k] = ex[k] / den; }
    }
}
__global__ void k_offsets(const int* cnt, int* off) { if (threadIdx.x == 0) { int s = 0; for (int e = 0; e < NE; ++e) { off[e] = s; s += cnt[e]; } } }
__global__ void k_final(const float* x1, const float* y, const float* mod, const float* g, float* out) {
    __shared__ float red[4];
    const int tok = blockIdx.x, b = tok / T, tid = threadIdx.x, c0 = tid * 4; const float* gt2 = mod + b * NMOD + 5 * D;
    const float4 xv = ((const float4*)(x1 + (size_t)tok * D))[tid]; float o[4] = {xv.x, xv.y, xv.z, xv.w}; float ys[4] = {0.f, 0.f, 0.f, 0.f};
    for (int k = 0; k < 4; ++k) { const float4 yv = ((const float4*)(y + ((size_t)tok * 4 + k) * D))[tid]; ys[0] += yv.x; ys[1] += yv.y; ys[2] += yv.z; ys[3] += yv.w; }
    float ss = 0.f; for (int j = 0; j < 4; ++j) { o[j] += gt2[c0 + j] * ys[j]; ss += o[j] * o[j]; }
    ss = block_sum(ss, red);
    const float rstd = 1.0f / sqrtf(ss * (1.f / D) + EPS);
    ((float4*)(out + (size_t)tok * D))[tid] = make_float4(o[0] * rstd * g[c0], o[1] * rstd * g[c0 + 1], o[2] * rstd * g[c0 + 2], o[3] * rstd * g[c0 + 3]);
}
}

extern "C" void kernel_launch(void* const* d_in, const int* in_sizes, int n_in, void* d_out, int out_size, void* d_ws, size_t ws_size, hipStream_t stream) {
    using namespace nv;
    const float* x = (const float*)d_in[0]; const float* c = (const float*)d_in[1]; const float* ctx = (const float*)d_in[2]; const float* cctx = (const float*)d_in[3];
    const float* w_ada = (const float*)d_in[4]; const float* b_ada = (const float*)d_in[5]; const float* g_attn = (const float*)d_in[6]; const float* w_qkv = (const float*)d_in[7];
    const float* qn = (const float*)d_in[8]; const float* kn = (const float*)d_in[9]; const float* dlam = (const float*)d_in[10]; const float* subln = (const float*)d_in[11];
    const float* w_o = (const float*)d_in[12]; const float* g_ffn = (const float*)d_in[13]; const float* w_router = (const float*)d_in[14]; const float* b_router = (const float*)d_in[15];
    const float* w_in = (const float*)d_in[16]; const float* b_in = (const float*)d_in[17]; const float* w_out = (const float*)d_in[18]; const float* b_out = (const float*)d_in[19];
    const float* g_final = (const float*)d_in[20];
    float* ws = (float*)d_ws; float* out = (float*)d_out;
    if (ws_size < WS_END * 4) return;
    float* mod = ws + WS_MOD; float* rope = ws + WS_ROPE; int* cnt = (int*)(ws + WS_CNT); int* off = cnt + 32; float* gate = ws + WS_GATE;
    int* ltok = (int*)(ws + WS_LTOK); int* lslot = (int*)(ws + WS_LSLOT); float* h = ws + WS_H; float* qkv = ws + WS_QKV; float* dt = ws + WS_DT;
    float* mix = ws + WS_MIX; float* x1 = ws + WS_X1; float* act = ws + WS_ACT; float* y = ws + WS_Y;
    hipMemsetAsync(cnt, 0, 128 * 4, stream);
    k_mod<<<dim3(NMOD / 256, 3), 256, 0, stream>>>(c, cctx, w_ada, b_ada, mod);
    k_rope<<<8, 256, 0, stream>>>(rope);
    k_norm1<<<MROWS, 256, 0, stream>>>(x, ctx, g_attn, mod, h);
    k_sgemm<PQkv, false><<<dim3(QKVC / 64, MROWS / 64, 1), 256, 0, stream>>>(PQkv{h, w_qkv, qkv});
    k_qkpost<<<(MROWS * 26 + 255) / 256, 256, 0, stream>>>(qkv, qn, kn, rope);
    k_attn<<<dim3(T / 64, 48), 64, 0, stream>>>(qkv, mix, dt);
    k_diffcomb<<<NTOK * 4 / 256, 256, 0, stream>>>(dt, dlam, subln, mix);
    k_sgemm<PWo, false><<<dim3(D / 64, NTOK / 64, 1), 256, 0, stream>>>(PWo{mix, w_o, x, mod, x1});
    float* h2 = h;
    k_router<<<NTOK, 256, 0, stream>>>(x1, g_ffn, mod, w_router, b_router, h2, gate, cnt, ltok, lslot);
    k_offsets<<<1, 64, 0, stream>>>(cnt, off);
    k_sgemm<PIn, true><<<dim3(DFF / 64, NTOK / 64, NE), 256, 0, stream>>>(PIn{h2, w_in, b_in, cnt, off, ltok, act});
    k_sgemm<POut, false><<<dim3(D / 64, NTOK / 64, NE), 256, 0, stream>>>(POut{act, w_out, b_out, cnt, off, lslot, gate, y});
    k_final<<<NTOK, 256, 0, stream>>>(x1, y, mod, g_final, out);
}
```

```cpp
#include <hip/hip_runtime.h>
#include <hip/hip_bf16.h>
#include <cstdio>
#include <cstdint>
#include <cmath>
__device__ __forceinline__ int lane_id_asm() { int l; asm volatile("v_mbcnt_lo_u32_b32 %0, -1, 0\n\tv_mbcnt_hi_u32_b32 %0, -1, %0" : "=v"(l)); return l; }
namespace pg8 {
#define PG8_LAS __attribute__((address_space(3)))
typedef unsigned short bf16_t;
typedef short bf16x8 __attribute__((ext_vector_type(8)));
typedef float f32x4 __attribute__((ext_vector_type(4)));
typedef unsigned u32x4 __attribute__((ext_vector_type(4)));
constexpr int BM = 256, BK = 64, HALF = 128, HTB = HALF * BK * 2  , STAGE_BYTES = 8 * HTB, NXCD = 8, WGM = 8;

__host__ __device__ __forceinline__ int lds_byte(int r, int c) { const int st = (r >> 4) * 2 + (c >> 5), rr = r & 15, cc = c & 31, ob = rr * 64 + cc * 2; return st * 1024 + (ob ^ (((ob >> 9) & 1) << 5)); }
__host__ __device__ __forceinline__ void stage_rc(int b, int& R, int& C) { const int st = b / 1024, sb = b % 1024, swz = sb ^ (((sb >> 9) & 1) << 5); R = (st >> 1) * 16 + swz / 64; C = (st & 1) * 32 + (swz % 64) / 2; }
__host__ __device__ __forceinline__ int perm32(int rho) { const int n = rho >> 4, i = rho & 15; return 8 * (i >> 2) + 4 * n + (i & 3); }

struct Unit { int pm, pn, e, mt, pnl, pad_; };
struct Gemm { const bf16_t* A; const bf16_t* Bt; int M, N, K; };

struct StaticOrder {
    int nM, nN, nwg, G, c;
    __host__ __device__ void init(int M, int N, int G_, int c_) { nM = M / BM; nN = N / BM; nwg = nM * nN; G = G_; c = c_; }
    __host__ __device__ bool next(int i, Unit& u) const {
        const long L = (long)i * G + c; if (L >= nwg) return false;
        int wgid = (int)L; { const int q = nwg / NXCD, r = nwg % NXCD, xcd = wgid % NXCD, off = wgid / NXCD; wgid = (xcd < r ? xcd * (q + 1) : r * (q + 1) + (xcd - r) * q) + off; }
        const int nig = WGM * nN, gid = wgid / nig, fm = gid * WGM, gsz = (nM - fm) < WGM ? (nM - fm) : WGM;
        u.pm = fm + ((wgid % nig) % gsz); u.pn = (wgid % nig) / gsz; return true;
    }
    __device__ __forceinline__ void a_ready(const Unit&) const {}
    __device__ __forceinline__ void done(const Unit&) const {}
};

__device__ __forceinline__ unsigned cvt_pk_bf16(float lo, float hi) { unsigned r; asm volatile("v_cvt_pk_bf16_f32 %0, %1, %2" : "=v"(r) : "v"(lo), "v"(hi)); return r; }
typedef float f32x2 __attribute__((ext_vector_type(2)));
typedef unsigned u32x2 __attribute__((ext_vector_type(2)));
typedef int v8i32 __attribute__((ext_vector_type(8)));
typedef int v4i32 __attribute__((ext_vector_type(4)));
__device__ __forceinline__ v8i32 cat8(bf16x8 lo, bf16x8 hi) { const v4i32 a = __builtin_bit_cast(v4i32, lo), b = __builtin_bit_cast(v4i32, hi); return __builtin_shufflevector(a, b, 0, 1, 2, 3, 4, 5, 6, 7); }
__device__ __forceinline__ unsigned pk4_fp8(float a, float b, float c, float d) { int r = __builtin_amdgcn_cvt_pk_fp8_f32(a, b, 0, false); r = __builtin_amdgcn_cvt_pk_fp8_f32(c, d, r, true); return (unsigned)r; }
constexpr float W8_SCALE = 16.0f, W8_INV = 1.0f / 16.0f;
constexpr int QKV_PITCH = 2304;
constexpr float ATT_C2 = 0.125f * 1.4426950408889634f;
constexpr float RMS_EPS = 1e-6f;

struct EpiQkv {
    static constexpr bool PERM = false, AFTER_DRAIN = false;
    bf16_t* O; const float* qn; const float* kn; const float* rope;
    const float* cb;
    unsigned char* qk8;
    unsigned char* v8;
    unsigned* nmax;
    __device__ __forceinline__ void operator()(const f32x4 (&acc)[2][2][4][2], const Unit& u, int wr, int wc, int fr_in, int fq_in) const {
        int fr = fr_in, fq = fq_in; asm volatile("" : "+v"(fr), "+v"(fq));
        const int s = u.pnl * 4 + wc;
        const bool isq = (s < 8) || (s >= 12 && s < 20), isk = (s >= 8 && s < 10) || (s >= 20 && s < 28);
        const bool donorm = s < 10; const float* gp = s < 8 ? qn : kn;
        const int tb = u.pm % 33;
        const int ax = fq >> 1, hc0 = 32 * ax + 8 * (fq & 1);
        const float* cbp = cb + (tb == 0 ? 2 : u.pm / 33) * QKV_PITCH + s * 64 + hc0;
        const bool dorope = (isq || isk) && tb != 0;
        const float sc = isq ? ATT_C2 * 4.0f : (isk ? 0.25f : 1.0f);
        const bool dobound = (s >= 12 && s < 28); float nmx = 0.f;
        f32x4 gv[2][2], cbv[2][2];
#pragma unroll
        for (int h = 0; h < 2; ++h)
#pragma unroll
            for (int n = 0; n < 2; ++n) { gv[h][n] = donorm ? *(const f32x4*)(gp + hc0 + 16 * h + 4 * n) : (f32x4){1.f, 1.f, 1.f, 1.f}; cbv[h][n] = (f32x4){0.f, 0.f, 0.f, 0.f}; }
        const int s26 = s < 10 ? s : s - 2;
#pragma unroll
        for (int ai = 0; ai < 2; ++ai)
#pragma unroll
            for (int m = 0; m < 4; ++m) {
                const int rl = ai * HALF + wr * 64 + m * 16 + fr;
                f32x4 v[2][2];
#pragma unroll
                for (int h = 0; h < 2; ++h)
#pragma unroll
                    for (int n = 0; n < 2; ++n) v[h][n] = acc[ai][h][m][n] * W8_INV + cbv[h][n];
                if (dobound || donorm) { float ss = 0.f;
#pragma unroll
                    for (int h = 0; h < 2; ++h)
#pragma unroll
                        for (int n = 0; n < 2; ++n) { const f32x4 x = v[h][n]; ss += (x[0] * x[0] + x[1] * x[1]) + (x[2] * x[2] + x[3] * x[3]); }
                    ss += __shfl_xor(ss, 16); ss += __shfl_xor(ss, 32);
                    if (dobound) nmx = fmaxf(nmx, ss);
                    if (donorm) { const float r = 1.0f / sqrtf(ss * (1.0f / 64.0f) + RMS_EPS);
#pragma unroll
                        for (int h = 0; h < 2; ++h)
#pragma unroll
                            for (int n = 0; n < 2; ++n) v[h][n] = v[h][n] * r * gv[h][n]; } }
                if (dorope) {
                    const int pos = ax ? (rl & 63) : ((tb - 1) * 4 + (rl >> 6));
#pragma unroll
                    for (int n = 0; n < 2; ++n) { const f32x4 cs = *(const f32x4*)(rope + pos * 16 + 8 * (fq & 1) + 4 * n), sn = *(const f32x4*)(rope + 2048 + pos * 16 + 8 * (fq & 1) + 4 * n);
                        const f32x4 x1 = v[0][n], x2 = v[1][n]; v[0][n] = x1 * cs - x2 * sn; v[1][n] = x2 * cs + x1 * sn; }
                }
                const size_t row = (size_t)(u.pm * BM + rl);
                if (isq || isk) { unsigned char* p8 = qk8 + row * 1664 + s26 * 64 + hc0;
#pragma unroll
                    for (int h = 0; h < 2; ++h) { const f32x4 x0 = v[h][0] * sc, x1 = v[h][1] * sc; u32x2 w; w.x = pk4_fp8(x0[0], x0[1], x0[2], x0[3]); w.y = pk4_fp8(x1[0], x1[1], x1[2], x1[3]); *(u32x2*)(p8 + 16 * h) = w; } }
                else { bf16_t* rowp = O + row * QKV_PITCH + s * 64 + hc0;
                    { unsigned char* p8 = v8 + row * 640 + (s >= 28 ? 128 + (s - 28) * 64 : (s - 10) * 64) + hc0;
#pragma unroll
                        for (int h = 0; h < 2; ++h) { const f32x4 x0 = v[h][0], x1 = v[h][1]; u32x2 w; w.x = pk4_fp8(x0[0], x0[1], x0[2], x0[3]); w.y = pk4_fp8(x1[0], x1[1], x1[2], x1[3]); *(u32x2*)(p8 + 16 * h) = w; } }
#pragma unroll
                    for (int h = 0; h < 2; ++h) { const f32x4 x0 = v[h][0], x1 = v[h][1]; u32x4 w; w.x = cvt_pk_bf16(x0[0], x0[1]); w.y = cvt_pk_bf16(x0[2], x0[3]); w.z = cvt_pk_bf16(x1[0], x1[1]); w.w = cvt_pk_bf16(x1[2], x1[3]); *(u32x4*)(rowp + 16 * h) = w; } }
            }
        if (dobound) {
#pragma unroll
            for (int o_ = 1; o_ < 16; o_ <<= 1) nmx = fmaxf(nmx, __shfl_xor(nmx, o_));
            if (fr == 0 && fq == 0) __hip_atomic_fetch_max(nmax + s, __float_as_uint(nmx), __ATOMIC_RELAXED, __HIP_MEMORY_SCOPE_AGENT); }
    }
};
struct EpiWo {
    static constexpr bool PERM = true, AFTER_DRAIN = false;
    const float* x; const float* mod; bf16_t* x1;
    __device__ __forceinline__ void operator()(const f32x4 (&acc)[2][2][4][2], const Unit& u, int wr, int wc, int fr_in, int fq_in) const {
        int fr = fr_in, fq = fq_in; asm volatile("" : "+v"(fr), "+v"(fq));
        const int b = u.pm >> 5; const float* gt = mod + b * 6144 + 2048;
        const int col0 = u.pn * BM + wc * 32 + 8 * fq, row0 = u.pm * BM + wr * 64 + fr;
        f32x4 g[2][2];
#pragma unroll
        for (int bj = 0; bj < 2; ++bj)
#pragma unroll
            for (int n = 0; n < 2; ++n) g[bj][n] = *(const f32x4*)(gt + col0 + bj * HALF + 4 * n);
#pragma unroll
        for (int ai = 0; ai < 2; ++ai)
#pragma unroll
            for (int m = 0; m < 4; ++m) { const size_t off = (size_t)(row0 + ai * HALF + m * 16) * 1024 + col0;
#pragma unroll
                for (int bj = 0; bj < 2; ++bj) { const f32x4 x0 = *(const f32x4*)(x + off + bj * HALF), x4 = *(const f32x4*)(x + off + bj * HALF + 4);
                    const f32x4 v0 = x0 + g[bj][0] * acc[ai][bj][m][0], v1 = x4 + g[bj][1] * acc[ai][bj][m][1];
                    u32x4 w; w.x = cvt_pk_bf16(v0[0], v0[1]); w.y = cvt_pk_bf16(v0[2], v0[3]); w.z = cvt_pk_bf16(v1[0], v1[1]); w.w = cvt_pk_bf16(v1[2], v1[3]);
                    *(u32x4*)(x1 + off + bj * HALF) = w; } }
    }
};
struct EpiSwiglu {
    static constexpr bool PERM = true, AFTER_DRAIN = false;
    bf16_t* act; const float* b_in;
    __device__ __forceinline__ void operator()(const f32x4 (&acc)[2][2][4][2], const Unit& u, int wr, int wc, int fr_in, int fq_in) const {
        int fr = fr_in, fq = fq_in; asm volatile("" : "+v"(fr), "+v"(fq));
        const int c0 = u.pnl * 128 + wc * 32 + 8 * fq; const float* bg = b_in + u.e * 2048 + c0; const float* bl = bg + 1024;
        constexpr float KP = 1.702f * 1.4426950408889634f, KI = 1.0f / KP;
        const f32x4 bgv[2] = {*(const f32x4*)bg * KP, *(const f32x4*)(bg + 4) * KP}, blv[2] = {(*(const f32x4*)bl + 1.0f) * KI, (*(const f32x4*)(bl + 4) + 1.0f) * KI};
#pragma unroll
        for (int ai = 0; ai < 2; ++ai)
#pragma unroll
            for (int m = 0; m < 4; ++m) { const size_t row = (size_t)u.pm * BM + ai * HALF + wr * 64 + m * 16 + fr; f32x4 a[2];
#pragma unroll
                for (int n = 0; n < 2; ++n) { f32x4 g2 = acc[ai][0][m][n] * (W8_INV * KP) + bgv[n], l2 = acc[ai][1][m][n] * (W8_INV * KI) + blv[n], d;
#pragma unroll
                    for (int i = 0; i < 4; ++i) { g2[i] = fminf(g2[i], 7.0f * KP); l2[i] = __builtin_amdgcn_fmed3f(l2[i], -6.0f * KI, 8.0f * KI); d[i] = __builtin_amdgcn_exp2f(-g2[i]); }
                    d = d + 1.0f;
#pragma unroll
                    for (int i = 0; i < 4; ++i) d[i] = __builtin_amdgcn_rcpf(d[i]);
                    a[n] = g2 * d * l2; }
                u32x2 w; w.x = pk4_fp8(a[0][0], a[0][1], a[0][2], a[0][3]); w.y = pk4_fp8(a[1][0], a[1][1], a[1][2], a[1][3]);
                *(u32x2*)((unsigned char*)act + row * 1024 + c0) = w; }
    }
};
struct EpiMoeOut {
    static constexpr bool PERM = true, AFTER_DRAIN = false;
    bf16_t* y; const float* b_out; const float* lgate;
    __device__ __forceinline__ void operator()(const f32x4 (&acc)[2][2][4][2], const Unit& u, int wr, int wc, int fr_in, int fq_in) const {
        int fr = fr_in, fq = fq_in; asm volatile("" : "+v"(fr), "+v"(fq));
        const int c0 = u.pnl * BM + wc * 32 + 8 * fq; const float* bp = b_out + u.e * 1024 + c0;
        f32x4 bv[2][2];
#pragma unroll
        for (int bj = 0; bj < 2; ++bj)
#pragma unroll
            for (int n = 0; n < 2; ++n) bv[bj][n] = *(const f32x4*)(bp + bj * HALF + 4 * n);
#pragma unroll
        for (int ai = 0; ai < 2; ++ai)
#pragma unroll
            for (int m = 0; m < 4; ++m) { const int rl = ai * HALF + wr * 64 + m * 16 + fr; const float gate = lgate[(size_t)u.e * 16384 + u.mt * BM + rl];
                unsigned char* rowp = (unsigned char*)y + ((size_t)u.pm * BM + rl) * 1024 + c0;
#pragma unroll
                for (int bj = 0; bj < 2; ++bj) { const f32x4 v0 = (acc[ai][bj][m][0] * W8_INV + bv[bj][0]) * gate, v1 = (acc[ai][bj][m][1] * W8_INV + bv[bj][1]) * gate;
                    u32x2 w; w.x = pk4_fp8(v0[0], v0[1], v0[2], v0[3]); w.y = pk4_fp8(v1[0], v1[1], v1[2], v1[3]);
                    *(u32x2*)(rowp + bj * HALF) = w; } }
    }
};
struct QkvOrder : StaticOrder {
    __device__ __forceinline__ bool next(int i, Unit& u) const { if (!StaticOrder::next(i, u)) return false; u.pnl = u.pn;     u.e = 0; u.mt = 0; u.pad_ = 0; return true; }
};
struct MoeOrder {
    const PG8_LAS int* tp; const PG8_LAS unsigned char* te; int npn, G, c;
    __device__ __forceinline__ bool next(int i, Unit& u) const {
        const long L = (long)i * G + c; const int g = (int)(L / npn);
        if (g >= __builtin_amdgcn_readfirstlane(tp[32])) return false;
        const int e = __builtin_amdgcn_readfirstlane((int)te[g]);
        u.e = e; u.mt = g - __builtin_amdgcn_readfirstlane(tp[e]); u.pnl = (int)(L % npn); u.pm = g; u.pn = e * npn + u.pnl; u.pad_ = 0; return true;
    }
    __device__ __forceinline__ void a_ready(const Unit&) const {}
    __device__ __forceinline__ void done(const Unit&) const {}
};
template <class Epi, class Sched, bool ALIGN_EPI = false, bool SP2 = false, bool GATHER = false, bool F8 = false>
__device__ __forceinline__ void gemm_phase(PG8_LAS unsigned char* lds, const Gemm g, const Sched& S, const Epi& E, int wid_in, const int* glist = nullptr, PG8_LAS unsigned* idbuf = nullptr) {
    static_assert(!GATHER || SP2, "GATHER is written for the SP2 loop only");
    const int lane = lane_id_asm(), wid = wid_in, tid = wid * 64 + lane, wr = wid >> 2, wc = wid & 3, fr = lane & 15, fq = lane >> 4;
    constexpr int ES = F8 ? 1 : 2;
    const int K = g.K, nt = (K * ES) / (BK * 2);
    unsigned voffA[2], voffB[2]; int Rl[2]; unsigned Cb[2];
#pragma unroll
    for (int i = 0; i < 2; ++i) { int R, C; stage_rc(tid * 16 + i * 8192, R, C); const int Rb = Epi::PERM ? ((R & ~31) + perm32(R & 31)) : R;
        voffA[i] = (unsigned)(R * K * ES + C * 2); voffB[i] = (unsigned)(Rb * K * ES + C * 2); Rl[i] = R; Cb[i] = (unsigned)C * 2u; }
    unsigned cv[2][2] = {{0u, 0u}, {0u, 0u}}, nv[2][2] = {{0u, 0u}, {0u, 0u}};
    constexpr int GL_STRIDE = 16384;
    PG8_LAS unsigned* myid = idbuf + wid * 256;
#define PG8_FETCH_IDS(U) do { _Pragma("unroll") for (int h_ = 0; h_ < 2; ++h_) _Pragma("unroll") for (int i_ = 0; i_ < 2; ++i_) \
        __builtin_amdgcn_global_load_lds((const unsigned*)(glist + (size_t)(U).e * GL_STRIDE + (U).mt * BM + h_ * HALF + Rl[i_]), (PG8_LAS unsigned*)(myid + (h_ * 2 + i_) * 64), 4, 0, 0); } while (0)
#define PG8_READ_IDS(dst) do { _Pragma("unroll") for (int h_ = 0; h_ < 2; ++h_) _Pragma("unroll") for (int i_ = 0; i_ < 2; ++i_) dst[h_][i_] = myid[(h_ * 2 + i_) * 64 + lane] * (unsigned)(K * ES) + Cb[i_]; } while (0)
#define PG8_STAGE_A(bufoff, kbase, H, NX) do { if constexpr (GATHER) { unsigned v_[2]; v_[0] = (NX) ? nv[H][0] : cv[H][0]; v_[1] = (NX) ? nv[H][1] : cv[H][1]; PG8_STAGE(bufoff, kbase, v_); } \
        else { PG8_STAGE(bufoff, (kbase) + ((H) ? hstep : (size_t)0), voffA); } } while (0)
    const size_t kstep = (size_t)(BK * 2);
    const size_t hstep = (size_t)HALF * K * ES;
    const size_t tstep = 2 * hstep;
    const unsigned ldsw = (unsigned)wid * 1024u;
    const int aoff = lds_byte(wr * 64 + fr, fq * 8), boff = lds_byte(wc * 32 + fr, fq * 8);
#define PG8_SA(b, h) (((b) * 2 + (h)) * HTB)
#define PG8_SB(b, h) ((4 + (b) * 2 + (h)) * HTB)
#define PG8_STAGE(bufoff, gbase, voff) do { _Pragma("unroll") for (int _i = 0; _i < 2; ++_i) \
        __builtin_amdgcn_global_load_lds((const unsigned*)((const char*)(gbase) + (voff)[_i]), (PG8_LAS unsigned*)(lds + (bufoff) + ldsw + _i * 8192), 16, 0, 0); } while (0)
#define PG8_LDA(dst, b, h) do { if constexpr (F8) { _Pragma("unroll") for (int m = 0; m < 4; ++m) dst##8[m] = cat8(*(const PG8_LAS bf16x8*)(lds + PG8_SA(b, h) + aoff + m * 2048), *(const PG8_LAS bf16x8*)(lds + PG8_SA(b, h) + aoff + m * 2048 + 1024)); } \
        else { _Pragma("unroll") for (int m = 0; m < 4; ++m) _Pragma("unroll") for (int k = 0; k < 2; ++k) dst[m][k] = *(const PG8_LAS bf16x8*)(lds + PG8_SA(b, h) + aoff + m * 2048 + k * 1024); } } while (0)
#define PG8_LDB(dst, b, h) do { if constexpr (F8) { _Pragma("unroll") for (int n = 0; n < 2; ++n) dst##8[n] = cat8(*(const PG8_LAS bf16x8*)(lds + PG8_SB(b, h) + boff + n * 2048), *(const PG8_LAS bf16x8*)(lds + PG8_SB(b, h) + boff + n * 2048 + 1024)); } \
        else { _Pragma("unroll") for (int n = 0; n < 2; ++n) _Pragma("unroll") for (int k = 0; k < 2; ++k) dst[n][k] = *(const PG8_LAS bf16x8*)(lds + PG8_SB(b, h) + boff + n * 2048 + k * 1024); } } while (0)
#define PG8_MMA(ai, bj, At, Bt) do { __builtin_amdgcn_s_setprio(1); if constexpr (F8) { _Pragma("unroll") for (int m = 0; m < 4; ++m) _Pragma("unroll") for (int n = 0; n < 2; ++n) \
        asm volatile("s_nop 1\n\tv_mfma_f32_16x16x128_f8f6f4 %0, %1, %2, %0" : "+v"(acc[ai][bj][m][n]) : "v"(Bt##8[n]), "v"(At##8[m])); }     \
        else { _Pragma("unroll") for (int m = 0; m < 4; ++m) _Pragma("unroll") for (int n = 0; n < 2; ++n) _Pragma("unroll") for (int k = 0; k < 2; ++k) \
        acc[ai][bj][m][n] = __builtin_amdgcn_mfma_f32_16x16x32_bf16(Bt[n][k], At[m][k], acc[ai][bj][m][n], 0, 0, 0); } __builtin_amdgcn_s_setprio(0); } while (0)
#define PG8_WAIT_V(n) asm volatile("s_waitcnt vmcnt(" #n ")" ::: "memory")
#define PG8_WAIT_L(n) asm volatile("s_waitcnt lgkmcnt(" #n ")" ::: "memory")
#define PG8_BAR __builtin_amdgcn_s_barrier()
#define PG8_SCHED __builtin_amdgcn_sched_barrier(0)
    Unit cur, nxt; int ui = 0;
    if (!S.next(0, cur)) return;
    f32x4 acc[2][2][4][2];
#pragma unroll
    for (int a = 0; a < 2; ++a)
#pragma unroll
        for (int b = 0; b < 2; ++b)
#pragma unroll
            for (int m = 0; m < 4; ++m)
#pragma unroll
                for (int n = 0; n < 2; ++n) acc[a][b][m][n] = (f32x4){0.f, 0.f, 0.f, 0.f};
    bf16x8 At[4][2], B0[2][2], B1[2][2]; v8i32 At8[4], B08[2], B18[2];
    const char* cA = (const char*)g.A + (GATHER ? (size_t)0 : (size_t)cur.pm * tstep); const char* cB = (const char*)g.Bt + (size_t)cur.pn * tstep;
    S.a_ready(cur);
    if constexpr (GATHER) { PG8_FETCH_IDS(cur); asm volatile("s_waitcnt vmcnt(0)" ::: "memory"); PG8_READ_IDS(cv); }
    if constexpr (SP2) {
        PG8_STAGE(PG8_SB(0, 0), cB, voffB); PG8_STAGE(PG8_SB(0, 1), cB + hstep, voffB); PG8_STAGE_A(PG8_SA(0, 0), cA, 0, false); PG8_STAGE_A(PG8_SA(0, 1), cA, 1, false);
        if (wr == 1) PG8_BAR;
        PG8_WAIT_V(2); PG8_BAR;
        PG8_STAGE(PG8_SB(1, 0), cB + kstep, voffB); PG8_STAGE_A(PG8_SA(1, 0), cA + kstep, 0, false); PG8_STAGE(PG8_SB(1, 1), cB + hstep + kstep, voffB);
        PG8_WAIT_V(6); PG8_BAR;
    } else {
        PG8_STAGE(PG8_SB(0, 0), cB, voffB); PG8_STAGE(PG8_SA(0, 0), cA, voffA); PG8_STAGE(PG8_SB(0, 1), cB + hstep, voffB); PG8_STAGE(PG8_SA(0, 1), cA + hstep, voffA);
        if (wr == 1) PG8_BAR;
        PG8_WAIT_V(4); PG8_BAR;
        PG8_STAGE(PG8_SB(1, 0), cB + kstep, voffB); PG8_STAGE(PG8_SA(1, 0), cA + kstep, voffA); PG8_STAGE(PG8_SB(1, 1), cB + hstep + kstep, voffB);
        PG8_WAIT_V(6); PG8_BAR;
    }
    for (;;) {
        const bool has_next = S.next(ui + 1, nxt);
        const char* nA = (has_next && !GATHER) ? (const char*)g.A + (size_t)nxt.pm * tstep : cA; const char* nB = has_next ? (const char*)g.Bt + (size_t)nxt.pn * tstep : cB;
        if constexpr (GATHER) { if (has_next) PG8_FETCH_IDS(nxt); }
        for (int t = 0; t < nt; t += 2) {
            const bool last = (t == nt - 2);
            if constexpr (GATHER) { if (last) { if (has_next) { PG8_READ_IDS(nv); } else { _Pragma("unroll") for (int h_ = 0; h_ < 2; ++h_) { nv[h_][0] = cv[h_][0]; nv[h_][1] = cv[h_][1]; } } } }
            const char* a1 = cA + (size_t)(t + 1) * kstep;
            const char* a2 = last ? nA : cA + (size_t)(t + 2) * kstep; const char* b2 = last ? nB : cB + (size_t)(t + 2) * kstep;
            const char* a3 = a2 + kstep; const char* b3 = b2 + kstep;
            if (last && has_next) S.a_ready(nxt);
            if constexpr (SP2) {
            PG8_LDB(B0, 0, 0); PG8_LDB(B1, 0, 1); PG8_SCHED; PG8_LDA(At, 0, 0); PG8_STAGE_A(PG8_SA(1, 1), a1, 1, false);
            PG8_WAIT_V(8); PG8_WAIT_L(0); PG8_BAR; PG8_MMA(0, 0, At, B0); PG8_MMA(0, 1, At, B1); PG8_BAR; PG8_SCHED;
            PG8_LDA(At, 0, 1); PG8_STAGE(PG8_SB(0, 0), b2, voffB); PG8_STAGE(PG8_SB(0, 1), b2 + hstep, voffB); PG8_STAGE_A(PG8_SA(0, 0), a2, 0, last);
            PG8_WAIT_V(8); PG8_WAIT_L(0); PG8_BAR; PG8_MMA(1, 0, At, B0); PG8_MMA(1, 1, At, B1); PG8_BAR; PG8_SCHED;
            PG8_LDB(B0, 1, 0); PG8_LDB(B1, 1, 1); PG8_SCHED; PG8_LDA(At, 1, 0); PG8_STAGE_A(PG8_SA(0, 1), a2, 1, last);
            PG8_WAIT_V(8); PG8_WAIT_L(0); PG8_BAR; PG8_MMA(0, 0, At, B0); PG8_MMA(0, 1, At, B1); PG8_BAR; PG8_SCHED;
            PG8_LDA(At, 1, 1); PG8_STAGE(PG8_SB(1, 0), b3, voffB); PG8_STAGE(PG8_SB(1, 1), b3 + hstep, voffB); PG8_STAGE_A(PG8_SA(1, 0), a3, 0, last);
            PG8_WAIT_V(8); PG8_WAIT_L(0); PG8_BAR; PG8_MMA(1, 0, At, B0); PG8_MMA(1, 1, At, B1); PG8_BAR; PG8_SCHED;
            } else {
            PG8_LDB(B0, 0, 0); PG8_SCHED; PG8_LDA(At, 0, 0); PG8_STAGE(PG8_SA(1, 1), a1 + hstep, voffA);
            PG8_WAIT_L(8); PG8_BAR; PG8_WAIT_L(0); PG8_MMA(0, 0, At, B0); PG8_BAR; PG8_SCHED;
            PG8_LDB(B1, 0, 1); PG8_STAGE(PG8_SB(0, 0), b2, voffB);
            PG8_BAR; PG8_WAIT_L(0); PG8_MMA(0, 1, At, B1); PG8_BAR;
            PG8_LDA(At, 0, 1); PG8_STAGE(PG8_SA(0, 0), a2, voffA);
            PG8_BAR; PG8_WAIT_L(0); PG8_MMA(1, 0, At, B0); PG8_BAR; PG8_SCHED;
            PG8_STAGE(PG8_SB(0, 1), b2 + hstep, voffB);
            PG8_WAIT_V(6); PG8_BAR; PG8_MMA(1, 1, At, B1); PG8_BAR;
            PG8_LDB(B0, 1, 0); PG8_SCHED; PG8_LDA(At, 1, 0); PG8_STAGE(PG8_SA(0, 1), a2 + hstep, voffA);
            PG8_WAIT_L(8); PG8_BAR; PG8_WAIT_L(0); PG8_MMA(0, 0, At, B0); PG8_BAR; PG8_SCHED;
            PG8_LDB(B1, 1, 1); PG8_STAGE(PG8_SB(1, 0), b3, voffB);
            PG8_BAR; PG8_WAIT_L(0); PG8_MMA(0, 1, At, B1); PG8_BAR;
            PG8_LDA(At, 1, 1); PG8_STAGE(PG8_SA(1, 0), a3, voffA);
            PG8_BAR; PG8_WAIT_L(0); PG8_MMA(1, 0, At, B0); PG8_BAR; PG8_SCHED;
            PG8_STAGE(PG8_SB(1, 1), b3 + hstep, voffB);
            PG8_WAIT_V(6); PG8_BAR; PG8_MMA(1, 1, At, B1); PG8_BAR;
            }
        }
        if constexpr (ALIGN_EPI) { if (wr == 0) PG8_BAR; }
        if constexpr (F8) { asm volatile("s_nop 15\n\ts_nop 15" ::: "memory"); }
        if constexpr (!Epi::AFTER_DRAIN) { E(acc, cur, wr, wc, fr, fq); S.done(cur); }
        if (!has_next) break;
#pragma unroll
        for (int a = 0; a < 2; ++a)
#pragma unroll
            for (int b = 0; b < 2; ++b)
#pragma unroll
                for (int m = 0; m < 4; ++m)
#pragma unroll
                    for (int n = 0; n < 2; ++n) acc[a][b][m][n] = (f32x4){0.f, 0.f, 0.f, 0.f};
        cur = nxt; cA = nA; cB = nB; ++ui;
        if constexpr (GATHER) { _Pragma("unroll") for (int h_ = 0; h_ < 2; ++h_) { cv[h_][0] = nv[h_][0]; cv[h_][1] = nv[h_][1]; } }
        if constexpr (ALIGN_EPI) { if (wr == 1) PG8_BAR; }
    }
    PG8_WAIT_V(0);
    if constexpr (!ALIGN_EPI) { if (wr == 0) PG8_BAR; }
    PG8_BAR;
    if constexpr (Epi::AFTER_DRAIN) { E.fused(acc, cur, wr, wc, fr, fq, lds, wid, lane); S.done(cur); }
#undef PG8_SA
#undef PG8_FETCH_IDS
#undef PG8_READ_IDS
#undef PG8_STAGE_A
#undef PG8_SB
#undef PG8_STAGE
#undef PG8_LDA
#undef PG8_LDB
#undef PG8_MMA
#undef PG8_WAIT_V
#undef PG8_WAIT_L
#undef PG8_BAR
#undef PG8_SCHED
}
}
#ifndef PG8_SP2
#define PG8_SP2 true
#endif
#ifndef PG8_ALIGN
#define PG8_ALIGN true
#endif
namespace attn_body {
using bf16=__hip_bfloat16;
using bf16x8=__attribute__((ext_vector_type(8)))short;
using s16x4=__attribute__((ext_vector_type(4)))short;
using f32x16=__attribute__((ext_vector_type(16)))float;
using u32x4=__attribute__((ext_vector_type(4)))unsigned;
constexpr int D=64,DM=2304;
constexpr int NW=8,QBLK=32,QB=QBLK*NW,KVBLK=64,NKEYS=8448,NT=NKEYS/KVBLK;
static_assert(NT%2==0&&NT>=6,"the 2-step loop needs an even tile count");
constexpr int ATTN_PITCH=DM, ATTN_UNIT_ROWS=QB;
__device__ __forceinline__ int crow(int r,int hi){return (r&3)+8*(r>>2)+4*hi;}
#define SBAR() __builtin_amdgcn_sched_barrier(0)
__device__ __forceinline__ void cmask(f32x16&p0,f32x16&p1,int jb,int qrel,int hi){
  const float NEG=-INFINITY; int kb=64*jb+4*hi;
  #pragma unroll
  for(int r=0;r<16;++r){int kv=kb+(r&3)+8*(r>>2); if(kv>qrel)p0[r]=NEG; if(kv+32>qrel)p1[r]=NEG;}
}

constexpr int NSLOT=3, SLOTB=8192;
constexpr int LDS_K=0, LDS_V=NSLOT*SLOTB, LDS_WS=2*NSLOT*SLOTB, LDS_OST=LDS_WS+NW*64*4, LDS_BYTES=LDS_OST+NW*4096;
constexpr float C2=0.125f*1.4426950408889634f;
__device__ __forceinline__ void glds16(const void*gsrc,unsigned lds_dst){unsigned keep;
  asm volatile("s_mov_b32 %0, m0\n\ts_mov_b32 m0, %2\n\ts_nop 0\n\tglobal_load_lds_dwordx4 %1, off\n\ts_mov_b32 m0, %0":"=&s"(keep):"v"(gsrc),"s"(lds_dst):"memory");}
__device__ __forceinline__ float max3f(float a,float b,float c){float r;asm("v_max3_f32 %0, %1, %2, %3":"=v"(r):"v"(a),"v"(b),"v"(c));return r;}
__device__ __forceinline__ float max2f(float a,float b){float r;asm("v_max_f32_e32 %0, %1, %2":"=v"(r):"v"(a),"v"(b));return r;}
__device__ __forceinline__ float fadd_s(float a,float b){float r;asm("v_add_f32_e32 %0, %1, %2":"=v"(r):"v"(a),"v"(b));return r;}
__device__ __forceinline__ float fsub_s(float a,float b){float r;asm("v_sub_f32_e32 %0, %1, %2":"=v"(r):"v"(a),"v"(b));return r;}
typedef float f32x2_t __attribute__((ext_vector_type(2))); typedef __bf16 bf16x2_t __attribute__((ext_vector_type(2)));
__device__ __forceinline__ unsigned cvtpk_s(float lo,float hi){f32x2_t v={lo,hi};bf16x2_t b=__builtin_convertvector(v,bf16x2_t);return __builtin_bit_cast(unsigned,b);}
#define WAIT_BAR(N) asm volatile("s_waitcnt vmcnt(" #N ") lgkmcnt(0)\n\ts_barrier":::"memory")

__device__ __forceinline__ void qkt(f32x16&p0,f32x16&p1,const char*Kslot,const bf16x8*qr,const f32x16&negm,int r32,int hi){
  const char*kb=Kslot+hi*1024+r32*16;
  #pragma unroll
  for(int d0=0;d0<4;++d0){
    const bf16x8 b0=*reinterpret_cast<const bf16x8*>(kb+d0*2048);
    const bf16x8 b1=*reinterpret_cast<const bf16x8*>(kb+d0*2048+512);
    if(d0==0){p0=__builtin_amdgcn_mfma_f32_32x32x16_bf16(b0,qr[0],negm,0,0,0);p1=__builtin_amdgcn_mfma_f32_32x32x16_bf16(b1,qr[0],negm,0,0,0);}
    else{p0=__builtin_amdgcn_mfma_f32_32x32x16_bf16(b0,qr[d0],p0,0,0,0);p1=__builtin_amdgcn_mfma_f32_32x32x16_bf16(b1,qr[d0],p1,0,0,0);}}
}
typedef __attribute__((address_space(3))) const char* lds_cptr;
typedef short v4i16_t __attribute__((ext_vector_type(4)));
__device__ __forceinline__ void kload8(bf16x8*kf,lds_cptr kp){
  kf[0]=*(const __attribute__((address_space(3))) bf16x8*)(kp);      kf[1]=*(const __attribute__((address_space(3))) bf16x8*)(kp+512);
  kf[2]=*(const __attribute__((address_space(3))) bf16x8*)(kp+2048); kf[3]=*(const __attribute__((address_space(3))) bf16x8*)(kp+2560);
  kf[4]=*(const __attribute__((address_space(3))) bf16x8*)(kp+4096); kf[5]=*(const __attribute__((address_space(3))) bf16x8*)(kp+4608);
  kf[6]=*(const __attribute__((address_space(3))) bf16x8*)(kp+6144); kf[7]=*(const __attribute__((address_space(3))) bf16x8*)(kp+6656);
}
__device__ __forceinline__ void kload2(bf16x8*kf,lds_cptr kp,int j){ kf[2*j]=*(const __attribute__((address_space(3))) bf16x8*)(kp+j*2048); kf[2*j+1]=*(const __attribute__((address_space(3))) bf16x8*)(kp+j*2048+512); }
__device__ __forceinline__ s16x4 vtr(lds_cptr p){ return __builtin_bit_cast(s16x4,__builtin_amdgcn_ds_read_tr16_b64_v4i16((__attribute__((address_space(3))) v4i16_t*)p)); }
__device__ __forceinline__ float rowmax(const f32x16&p0,const f32x16&p1){
  float a=max3f(p0[0],p0[1],p1[0]),b=max3f(p0[2],p0[3],p1[1]);a=max3f(a,p1[2],p1[3]);
  #pragma unroll
  for(int r=4;r<16;r+=4){a=max3f(a,p0[r],p0[r+1]);b=max3f(b,p0[r+2],p0[r+3]);a=max3f(a,p1[r],p1[r+1]);b=max3f(b,p1[r+2],p1[r+3]);}
  const float m=max2f(a,b);
  auto rr=__builtin_amdgcn_permlane32_swap(__float_as_uint(m),__float_as_uint(m),false,false);
  return max2f(__uint_as_float(rr[0]),__uint_as_float(rr[1]));
}
__device__ __forceinline__ void pv(f32x16*o,int vb,bf16x8 pa0,bf16x8 pa1,bf16x8 pa2,bf16x8 pa3){
  #pragma unroll
  for(int d0=0;d0<2;++d0){s16x4 lo[4],hi[4];
    #pragma unroll
    for(int ks=0;ks<4;++ks){
      asm volatile("ds_read_b64_tr_b16 %0,%1 offset:%c2":"=&v"(lo[ks]):"v"(vb),"i"(d0*4096+ks*1024):"memory");
      asm volatile("ds_read_b64_tr_b16 %0,%1 offset:%c2":"=&v"(hi[ks]):"v"(vb),"i"(d0*4096+ks*1024+512):"memory");}
    asm volatile("s_waitcnt lgkmcnt(0)":::"memory");SBAR();
    #define PK(k) (bf16x8){lo[k][0],lo[k][1],lo[k][2],lo[k][3],hi[k][0],hi[k][1],hi[k][2],hi[k][3]}
    o[d0]=__builtin_amdgcn_mfma_f32_32x32x16_bf16(pa0,PK(0),o[d0],0,0,0);
    o[d0]=__builtin_amdgcn_mfma_f32_32x32x16_bf16(pa1,PK(1),o[d0],0,0,0);
    o[d0]=__builtin_amdgcn_mfma_f32_32x32x16_bf16(pa2,PK(2),o[d0],0,0,0);
    o[d0]=__builtin_amdgcn_mfma_f32_32x32x16_bf16(pa3,PK(3),o[d0],0,0,0);
    #undef PK
  }
}

#ifndef ATTN_STORE16
#define ATTN_STORE16(p,v) (*(u32x4*)(p)=(v))
#endif
template<int THRL,bool FIXREF=false> __device__ __forceinline__ void attn_unit(const bf16*Qu,const bf16*__restrict__ Kb,const bf16*__restrict__ Vb,bf16*Ou,int opitch,char*shm,int wid){
  const int lane=lane_id_asm(),r32=lane&31,hi=lane>>5;
  const bf16*Qw=Qu+(long)(wid*QBLK)*DM;
  const bf16*Kh=Kb,*Vh=Vb;
  const unsigned lds0=(unsigned)(uintptr_t)shm;
  float*wsf=(float*)(shm+LDS_WS)+wid*64;
  const bf16*ksrc=Kh+(long)lane*DM+wid*8;
  const bf16*vsrc=Vh+(long)(16*(wid&3)+(lane>>2))*DM+(wid>>2)*32+(lane&3)*8;
  const unsigned kdst=lds0+LDS_K+wid*1024, vdst=lds0+LDS_V+wid*1024;
  #define DMA_K(t,slot) glds16(ksrc+(long)(t)*KVBLK*DM,(unsigned)__builtin_amdgcn_readfirstlane(kdst+(slot)))
  #define DMA_V(t,slot) glds16(vsrc+(long)(t)*KVBLK*DM,(unsigned)__builtin_amdgcn_readfirstlane(vdst+(slot)))
  const int vb0=(int)(lds0+LDS_V)+((lane>>4)&1)*32+(lane&3)*8+(4*hi+((lane&15)>>2))*64;
  const char*Kbase=shm+LDS_K; bf16x8 kf[8];
  const lds_cptr shm3=(lds_cptr)shm; const lds_cptr kp0=shm3+LDS_K+hi*1024+r32*16; const lds_cptr vp0=shm3+LDS_V+((lane>>4)&1)*32+(lane&3)*8+(4*hi+((lane&15)>>2))*64;
  DMA_K(0,0);DMA_V(0,0);DMA_K(1,SLOTB);
  bf16x8 qr[4];
  #pragma unroll
  for(int d0=0;d0<4;++d0)qr[d0]=*reinterpret_cast<const bf16x8*>(&Qw[(long)r32*DM+d0*16+hi*8]);
  float mhat=0.f,l_reg=0.f;f32x16 o[2];o[0]=f32x16{};o[1]=f32x16{};f32x16 negm=f32x16{};asm volatile("":"+v"(negm));
  #define CMASK(P0,P1,t) do{}while(0)
  bool resc=false;
  #define START(P0,P1) do{ resc=false; if constexpr(!FIXREF){ const float rm=rowmax(P0,P1); \
    { const float dl=rm; mhat=fadd_s(mhat,dl); \
      _Pragma("unroll") for(int r=0;r<16;++r){P0[r]=fsub_s(P0[r],dl);P1[r]=fsub_s(P1[r],dl);} \
      _Pragma("unroll") for(int r=0;r<16;++r)negm[r]=-mhat; asm volatile("":"+v"(negm)); } } \
    _Pragma("unroll") for(int r=0;r<16;++r)P0[r]=__builtin_amdgcn_exp2f(P0[r]); }while(0)
  #define RESC() do{ if(resc){ asm volatile("s_waitcnt lgkmcnt(0)":::"memory"); \
      _Pragma("unroll") for(int d_=0;d_<2;++d_) _Pragma("unroll") for(int r=0;r<16;++r)o[d_][r]*=wsf[crow(r,hi)]; } }while(0)
  f32x16 pA0,pA1,pB0,pB1;
  int sl_prev=0,sl_cur=0,sl_next=SLOTB;
  #define ROT() do{sl_prev=sl_cur;sl_cur=sl_next;sl_next=(sl_next==(NSLOT-1)*SLOTB)?0:sl_next+SLOTB;}while(0)
  DMA_K(2,2*SLOTB);
  WAIT_BAR(3);
  qkt(pA0,pA1,Kbase,qr,negm,r32,hi);asm volatile("s_nop 15\n\ts_nop 7":"+v"(pA0),"+v"(pA1));CMASK(pA0,pA1,0);
  START(pA0,pA1);
  _Pragma("unroll") for(int r=0;r<16;++r)pA1[r]=__builtin_amdgcn_exp2f(pA1[r]);
  WAIT_BAR(0);
  DMA_K(3,0);DMA_V(1,SLOTB);
  ROT();
  kload8(kf,kp0+sl_cur);
  WAIT_BAR(2);
  s16x4 vlo[8],vhi[8]; u32x4 pw0,pw1,pw2,pw3;
  #define PKW(P,B) cvtpk_s(P[B],P[B+1])
  #define PAF(k) __builtin_bit_cast(bf16x8,pw##k)
  #define VFR(i) (bf16x8){vlo[i][0],vlo[i][1],vlo[i][2],vlo[i][3],vhi[i][0],vhi[i][1],vhi[i][2],vhi[i][3]}
  #define PIN(x) asm volatile("":"+v"(x))
  #define MX3(a,b,c) __builtin_fmaxf(__builtin_fmaxf((a),(b)),(c))
  #define GAPA(MF,A0,A1,A2,A3,W0,W1,PW) do{ MF; sacc+=A0; sacc+=A1; sacc+=A2; sacc+=A3; PIN(sacc); W0; W1; PIN(PW); SBAR(); }while(0)
  #define EX(v) __builtin_amdgcn_exp2f(v)
  #define GAPB(MF,X,B) do{ MF; X[B]=EX(X[B]); X[B+1]=EX(X[B+1]); X[B+2]=EX(X[B+2]); X[B+3]=EX(X[B+3]); PIN(X); SBAR(); }while(0)
  #define VRD(i) do{ vlo[i]=vtr(vp_+(((i)>>2)*4096+((i)&3)*1024)); vhi[i]=vtr(vp_+(((i)>>2)*4096+((i)&3)*1024+512)); }while(0)
  #define KRD(G,j) do{ if(G){ kload2(kf,kp0+sl_next,j); SBAR(); } }while(0)
  #define STEP(C0,C1,P0,P1,t,GK,GV,GL) do{ SBAR(); \
    const lds_cptr vp_=vp0+sl_prev; \
    VRD(0); SBAR(); float sacc=(P0[0]+P0[1]); \
    GAPA(C0=__builtin_amdgcn_mfma_f32_32x32x16_bf16(kf[0],qr[0],negm,0,0,0), P0[2],P0[3],P0[4],P0[5],     pw0[0]=PKW(P0,0), pw0[1]=PKW(P0,2), pw0); \
    VRD(4); SBAR(); GAPA(C1=__builtin_amdgcn_mfma_f32_32x32x16_bf16(kf[1],qr[0],negm,0,0,0), P0[6],P0[7],P0[8],P0[9],     pw0[2]=PKW(P0,4), pw0[3]=PKW(P0,6), pw0); \
    VRD(1); SBAR(); GAPA(C0=__builtin_amdgcn_mfma_f32_32x32x16_bf16(kf[2],qr[1],C0,0,0,0),   P0[10],P0[11],P0[12],P0[13], pw1[0]=PKW(P0,8), pw1[1]=PKW(P0,10), pw1); \
    VRD(5); SBAR(); GAPA(C1=__builtin_amdgcn_mfma_f32_32x32x16_bf16(kf[3],qr[1],C1,0,0,0),   P0[14],P0[15],P1[0],P1[1],   pw1[2]=PKW(P0,12),pw1[3]=PKW(P0,14), pw1); \
    VRD(2); SBAR(); GAPA(C0=__builtin_amdgcn_mfma_f32_32x32x16_bf16(kf[4],qr[2],C0,0,0,0),   P1[2],P1[3],P1[4],P1[5],     pw2[0]=PKW(P1,0), pw2[1]=PKW(P1,2), pw2); \
    VRD(6); SBAR(); GAPA(C1=__builtin_amdgcn_mfma_f32_32x32x16_bf16(kf[5],qr[2],C1,0,0,0),   P1[6],P1[7],P1[8],P1[9],     pw2[2]=PKW(P1,4), pw2[3]=PKW(P1,6), pw2); \
    VRD(3); SBAR(); GAPA(C0=__builtin_amdgcn_mfma_f32_32x32x16_bf16(kf[6],qr[3],C0,0,0,0),   P1[10],P1[11],P1[12],P1[13], pw3[0]=PKW(P1,8), pw3[1]=PKW(P1,10), pw3); \
    VRD(7); SBAR(); GAPA(C1=__builtin_amdgcn_mfma_f32_32x32x16_bf16(kf[7],qr[3],C1,0,0,0),   P1[14],P1[15],0.f,0.f,       pw3[2]=PKW(P1,12),pw3[3]=PKW(P1,14), pw3); \
    l_reg+=sacc; \
    if(GK){DMA_K((t)+3,sl_cur);} if(GV){DMA_V((t)+1,sl_next);} \
    CMASK(C0,C1,t); \
    if constexpr(!FIXREF){ float a=MX3(C0[0],C0[1],C1[0]),b=MX3(C0[2],C0[3],C1[1]); a=MX3(a,C1[2],C1[3]); \
      _Pragma("unroll") for(int r=4;r<16;r+=4){a=MX3(a,C0[r],C0[r+1]);b=MX3(b,C0[r+2],C0[r+3]);a=MX3(a,C1[r],C1[r+1]);b=MX3(b,C1[r+2],C1[r+3]);} \
      float rm=__builtin_fmaxf(a,b); { auto rr=__builtin_amdgcn_permlane32_swap(__float_as_uint(rm),__float_as_uint(rm),false,false); rm=__builtin_fmaxf(__uint_as_float(rr[0]),__uint_as_float(rr[1])); } \
      resc=false; \
      if(__builtin_expect(__any(rm>(float)THRL),0)){ const float dl=__builtin_fmaxf(rm,0.f); mhat+=dl; \
        _Pragma("unroll") for(int r=0;r<16;++r){C0[r]-=dl;C1[r]-=dl;} \
        _Pragma("unroll") for(int r=0;r<16;++r)negm[r]=-mhat; asm volatile("":"+v"(negm)); \
        const float f=__builtin_amdgcn_exp2f(-dl); l_reg*=f; if(hi==0)wsf[r32]=f; resc=true; } } \
    SBAR(); \
    GAPB(o[0]=__builtin_amdgcn_mfma_f32_32x32x16_bf16(PAF(0),VFR(0),o[0],0,0,0), C0,0); \
    GAPB(o[1]=__builtin_amdgcn_mfma_f32_32x32x16_bf16(PAF(0),VFR(4),o[1],0,0,0), C0,4); \
    KRD(GL,0); GAPB(o[0]=__builtin_amdgcn_mfma_f32_32x32x16_bf16(PAF(1),VFR(1),o[0],0,0,0), C0,8); \
    KRD(GL,1); GAPB(o[1]=__builtin_amdgcn_mfma_f32_32x32x16_bf16(PAF(1),VFR(5),o[1],0,0,0), C0,12); \
    KRD(GL,2); GAPB(o[0]=__builtin_amdgcn_mfma_f32_32x32x16_bf16(PAF(2),VFR(2),o[0],0,0,0), C1,0); \
    KRD(GL,3); GAPB(o[1]=__builtin_amdgcn_mfma_f32_32x32x16_bf16(PAF(2),VFR(6),o[1],0,0,0), C1,4); \
    GAPB(o[0]=__builtin_amdgcn_mfma_f32_32x32x16_bf16(PAF(3),VFR(3),o[0],0,0,0), C1,8); \
    GAPB(o[1]=__builtin_amdgcn_mfma_f32_32x32x16_bf16(PAF(3),VFR(7),o[1],0,0,0), C1,12); \
    }while(0)
  int t=1;
  for(;t+5<NT;t+=2){
    STEP(pB0,pB1,pA0,pA1,t,true,true,true);     WAIT_BAR(2); RESC(); ROT();
    STEP(pA0,pA1,pB0,pB1,t+1,true,true,true);   WAIT_BAR(2); RESC(); ROT();
  }
  #define ENDW(tt) do{ if((tt)+3<NT){WAIT_BAR(2);} else if((tt)+2<NT){WAIT_BAR(1);} else {WAIT_BAR(0);} }while(0)
  for(;t+1<NT;t+=2){
    STEP(pB0,pB1,pA0,pA1,t,(t+3<NT),(t+1<NT),(t+1<NT));       ENDW(t);   RESC(); ROT();
    STEP(pA0,pA1,pB0,pB1,t+1,(t+4<NT),(t+2<NT),(t+2<NT));     ENDW(t+1); RESC(); ROT();
  }
  STEP(pB0,pB1,pA0,pA1,NT-1,false,false,false); RESC();
  { float sacc=pB0[0]+pB0[1]; _Pragma("unroll") for(int r=2;r<16;++r)sacc+=pB0[r]; _Pragma("unroll") for(int r=0;r<16;++r)sacc+=pB1[r]; l_reg+=sacc;
    pw0=(u32x4){PKW(pB0,0),PKW(pB0,2),PKW(pB0,4),PKW(pB0,6)};pw1=(u32x4){PKW(pB0,8),PKW(pB0,10),PKW(pB0,12),PKW(pB0,14)};pw2=(u32x4){PKW(pB1,0),PKW(pB1,2),PKW(pB1,4),PKW(pB1,6)};pw3=(u32x4){PKW(pB1,8),PKW(pB1,10),PKW(pB1,12),PKW(pB1,14)};
    SBAR(); pv(o,vb0+sl_cur,PAF(0),PAF(1),PAF(2),PAF(3)); }
  #undef PKW
  #undef PAF
  #undef VFR
  #undef PIN
  #undef MX3
  #undef GAPA
  #undef GAPB
  #undef EX
  #undef VRD
  #undef KRD
  #undef STEP
  #undef ENDW
  {auto rr=__builtin_amdgcn_permlane32_swap(__float_as_uint(l_reg),__float_as_uint(l_reg),false,false);l_reg=__uint_as_float(rr[0])+__uint_as_float(rr[1]);}
  if(hi==0)wsf[32+r32]=l_reg;asm volatile("s_waitcnt lgkmcnt(0)":::"memory");
  float rli[16];
  #pragma unroll
  for(int r=0;r<16;++r)rli[r]=__builtin_amdgcn_rcpf(wsf[32+crow(r,hi)]);
  bf16*Ow=Ou+(long)(wid*QBLK)*opitch;
  { bf16*stg=(bf16*)(shm+LDS_OST)+wid*2048;
    #pragma unroll
    for(int r=0;r<16;++r){const int orow=crow(r,hi);
      #pragma unroll
      for(int d0=0;d0<2;++d0)stg[orow*64+d0*32+r32]=__float2bfloat16(o[d0][r]*rli[r]);}
    asm volatile("s_waitcnt lgkmcnt(0)":::"memory");
    #pragma unroll
    for(int i=0;i<4;++i){const int row=i*8+(lane>>3),ch=lane&7; const u32x4 v=*(const u32x4*)(stg+row*64+ch*8); ATTN_STORE16(Ow+(long)row*opitch+ch*8,v);} }
  asm volatile("s_waitcnt lgkmcnt(0)\n\ts_barrier":::"memory");
  #undef DMA_K
  #undef DMA_V
  #undef CMASK
  #undef START
  #undef RESC
  #undef ROT
}
constexpr int SLOTV2=16384, LDS2_K=0, LDS2_V=NSLOT*SLOTB, LDS2_WS=LDS2_V+NSLOT*SLOTV2, LDS2_BYTES=LDS2_WS+NW*64*4;
__device__ __forceinline__ void pv128(f32x16*o,int vb,bf16x8 pa0,bf16x8 pa1,bf16x8 pa2,bf16x8 pa3){
  #pragma unroll
  for(int d0=0;d0<4;++d0){s16x4 lo[4],hi[4];
    #pragma unroll
    for(int ks=0;ks<4;++ks){
      asm volatile("ds_read_b64_tr_b16 %0,%1 offset:%c2":"=&v"(lo[ks]):"v"(vb),"i"(d0*4096+ks*1024):"memory");
      asm volatile("ds_read_b64_tr_b16 %0,%1 offset:%c2":"=&v"(hi[ks]):"v"(vb),"i"(d0*4096+ks*1024+512):"memory");}
    asm volatile("s_waitcnt lgkmcnt(0)":::"memory");SBAR();
    #define PK(k) (bf16x8){lo[k][0],lo[k][1],lo[k][2],lo[k][3],hi[k][0],hi[k][1],hi[k][2],hi[k][3]}
    o[d0]=__builtin_amdgcn_mfma_f32_32x32x16_bf16(pa0,PK(0),o[d0],0,0,0);
    o[d0]=__builtin_amdgcn_mfma_f32_32x32x16_bf16(pa1,PK(1),o[d0],0,0,0);
    o[d0]=__builtin_amdgcn_mfma_f32_32x32x16_bf16(pa2,PK(2),o[d0],0,0,0);
    o[d0]=__builtin_amdgcn_mfma_f32_32x32x16_bf16(pa3,PK(3),o[d0],0,0,0);
    #undef PK
  }
}
template<int THRL,bool FIXREF=false> __device__ __forceinline__ void attn_unit128(const bf16*Qu,const bf16*__restrict__ Kb,const bf16*__restrict__ Vb,bf16*Ou,int opitch,char*shm,int wid,float*stash,float lam,const float*subg){
  const int lane=lane_id_asm(),r32=lane&31,hi=lane>>5;
  const bf16*Vh=Vb;
 for(int cpass=0;cpass<2;++cpass){
  const int lane_p=lane_id_asm(),r32p=lane_p&31,hip=lane_p>>5;
  const bf16*Qw=Qu+(long)(wid*QBLK)*DM+cpass*64;
  const bf16*Kh=Kb+cpass*64;
  const unsigned lds0=(unsigned)(uintptr_t)shm;
  float*wsf=(float*)(shm+LDS2_WS)+wid*64;
  const bf16*ksrc=Kh+(long)lane_p*DM+wid*8;
  const bf16*vsrc=Vh+(long)(16*(wid&3)+(lane_p>>2))*DM+(wid>>2)*32+(lane_p&3)*8;
  const unsigned kdst=lds0+LDS2_K+wid*1024, vdst=lds0+LDS2_V+wid*1024;
  #define DMA_K(t,slot) glds16(ksrc+(long)(t)*KVBLK*DM,(unsigned)__builtin_amdgcn_readfirstlane(kdst+(slot)))
  #define DMA_V(t,slot) do{ glds16(vsrc+(long)(t)*KVBLK*DM,(unsigned)__builtin_amdgcn_readfirstlane(vdst+2*(slot))); glds16(vsrc+(long)(t)*KVBLK*DM+64,(unsigned)__builtin_amdgcn_readfirstlane(vdst+2*(slot)+8192)); }while(0)
  const int vb0=(int)(lds0+LDS2_V)+((lane_p>>4)&1)*32+(lane_p&3)*8+(4*hip+((lane_p&15)>>2))*64;
  const char*Kbase=shm+LDS2_K; bf16x8 kf[8];
  const lds_cptr shm3=(lds_cptr)shm; const lds_cptr kp0=shm3+LDS2_K+hip*1024+r32p*16; const lds_cptr vp0=shm3+LDS2_V+((lane_p>>4)&1)*32+(lane_p&3)*8+(4*hip+((lane_p&15)>>2))*64;
  DMA_K(0,0);DMA_V(0,0);DMA_K(1,SLOTB);
  bf16x8 qr[4];
  #pragma unroll
  for(int d0=0;d0<4;++d0)qr[d0]=*reinterpret_cast<const bf16x8*>(&Qw[(long)r32p*DM+d0*16+hip*8]);
  float zf_; asm volatile("v_mov_b32 %0, 0":"=v"(zf_));
  float mhat=0.f,l_reg=0.f;f32x16 o[4];
  #pragma unroll
  for(int r=0;r<16;++r){o[0][r]=zf_;o[1][r]=zf_;o[2][r]=zf_;o[3][r]=zf_;}
  f32x16 negm;
  #pragma unroll
  for(int r=0;r<16;++r)negm[r]=zf_;
  asm volatile("":"+v"(negm));
  #define CMASK(P0,P1,t) do{}while(0)
  bool resc=false;
  #define START(P0,P1) do{ resc=false; if constexpr(!FIXREF){ const float rm=rowmax(P0,P1); \
    { const float dl=rm; mhat=fadd_s(mhat,dl); \
      _Pragma("unroll") for(int r=0;r<16;++r){P0[r]=fsub_s(P0[r],dl);P1[r]=fsub_s(P1[r],dl);} \
      _Pragma("unroll") for(int r=0;r<16;++r)negm[r]=-mhat; asm volatile("":"+v"(negm)); } } \
    _Pragma("unroll") for(int r=0;r<16;++r)P0[r]=__builtin_amdgcn_exp2f(P0[r]); }while(0)
  #define RESC() do{ if(resc){ asm volatile("s_waitcnt lgkmcnt(0)":::"memory"); \
      _Pragma("unroll") for(int d_=0;d_<4;++d_) _Pragma("unroll") for(int r=0;r<16;++r)o[d_][r]*=wsf[crow(r,hi)]; } }while(0)
  f32x16 pA0,pA1,pB0,pB1;
  int sl_prev=0,sl_cur=0,sl_next=SLOTB;
  #define ROT() do{sl_prev=sl_cur;sl_cur=sl_next;sl_next=(sl_next==(NSLOT-1)*SLOTB)?0:sl_next+SLOTB;}while(0)
  DMA_K(2,2*SLOTB);
  WAIT_BAR(4);
  qkt(pA0,pA1,Kbase,qr,negm,r32,hi);asm volatile("s_nop 15\n\ts_nop 7":"+v"(pA0),"+v"(pA1));CMASK(pA0,pA1,0);
  START(pA0,pA1);
  _Pragma("unroll") for(int r=0;r<16;++r)pA1[r]=__builtin_amdgcn_exp2f(pA1[r]);
  WAIT_BAR(0);
  DMA_K(3,0);DMA_V(1,SLOTB);
  ROT();
  kload8(kf,kp0+sl_cur);
  WAIT_BAR(3);
  s16x4 vlo[9],vhi[9]; u32x4 pw0,pw1,pw2,pw3;
  #define PKW(P,B) cvtpk_s(P[B],P[B+1])
  #define PAF(k) __builtin_bit_cast(bf16x8,pw##k)
  #define VFR(i) (bf16x8){vlo[i][0],vlo[i][1],vlo[i][2],vlo[i][3],vhi[i][0],vhi[i][1],vhi[i][2],vhi[i][3]}
  #define PIN(x) asm volatile("":"+v"(x))
  #define MX3(a,b,c) __builtin_fmaxf(__builtin_fmaxf((a),(b)),(c))
  #define GAPA(MF,A0,A1,A2,A3,W0,W1,PW) do{ MF; sacc+=A0; sacc+=A1; sacc+=A2; sacc+=A3; PIN(sacc); W0; W1; PIN(PW); SBAR(); }while(0)
  #define EX(v) __builtin_amdgcn_exp2f(v)
  #define GAPB(MF,X,B) do{ MF; X[B]=EX(X[B]); X[B+1]=EX(X[B+1]); PIN(X); SBAR(); }while(0)
  #define VRD2(i,s) do{ vlo[s]=vtr(vp_+(8192+((i)>>2)*4096+((i)&3)*1024)); vhi[s]=vtr(vp_+(8192+((i)>>2)*4096+((i)&3)*1024+512)); }while(0)
  #define VRD(i) do{ vlo[i]=vtr(vp_+(((i)>>2)*4096+((i)&3)*1024)); vhi[i]=vtr(vp_+(((i)>>2)*4096+((i)&3)*1024+512)); }while(0)
  #define KRD(G,j) do{ if(G){ kload2(kf,kp0+sl_next,j); SBAR(); } }while(0)
  #define STEP(C0,C1,P0,P1,t,GK,GV,GL) do{ SBAR(); \
    const lds_cptr vp_=vp0+2*sl_prev; \
    VRD(0); SBAR(); float sacc=(P0[0]+P0[1]); \
    GAPA(C0=__builtin_amdgcn_mfma_f32_32x32x16_bf16(kf[0],qr[0],negm,0,0,0), P0[2],P0[3],P0[4],P0[5],     pw0[0]=PKW(P0,0), pw0[1]=PKW(P0,2), pw0); \
    VRD(4); SBAR(); GAPA(C1=__builtin_amdgcn_mfma_f32_32x32x16_bf16(kf[1],qr[0],negm,0,0,0), P0[6],P0[7],P0[8],P0[9],     pw0[2]=PKW(P0,4), pw0[3]=PKW(P0,6), pw0); \
    VRD(1); SBAR(); GAPA(C0=__builtin_amdgcn_mfma_f32_32x32x16_bf16(kf[2],qr[1],C0,0,0,0),   P0[10],P0[11],P0[12],P0[13], pw1[0]=PKW(P0,8), pw1[1]=PKW(P0,10), pw1); \
    VRD(5); SBAR(); GAPA(C1=__builtin_amdgcn_mfma_f32_32x32x16_bf16(kf[3],qr[1],C1,0,0,0),   P0[14],P0[15],P1[0],P1[1],   pw1[2]=PKW(P0,12),pw1[3]=PKW(P0,14), pw1); \
    VRD(2); SBAR(); GAPA(C0=__builtin_amdgcn_mfma_f32_32x32x16_bf16(kf[4],qr[2],C0,0,0,0),   P1[2],P1[3],P1[4],P1[5],     pw2[0]=PKW(P1,0), pw2[1]=PKW(P1,2), pw2); \
    VRD(6); SBAR(); GAPA(C1=__builtin_amdgcn_mfma_f32_32x32x16_bf16(kf[5],qr[2],C1,0,0,0),   P1[6],P1[7],P1[8],P1[9],     pw2[2]=PKW(P1,4), pw2[3]=PKW(P1,6), pw2); \
    VRD(3); SBAR(); GAPA(C0=__builtin_amdgcn_mfma_f32_32x32x16_bf16(kf[6],qr[3],C0,0,0,0),   P1[10],P1[11],P1[12],P1[13], pw3[0]=PKW(P1,8), pw3[1]=PKW(P1,10), pw3); \
    VRD(7); SBAR(); GAPA(C1=__builtin_amdgcn_mfma_f32_32x32x16_bf16(kf[7],qr[3],C1,0,0,0),   P1[14],P1[15],0.f,0.f,       pw3[2]=PKW(P1,12),pw3[3]=PKW(P1,14), pw3); \
    l_reg+=sacc; \
    if(GK){DMA_K((t)+3,sl_cur);} if(GV){DMA_V((t)+1,sl_next);} \
    CMASK(C0,C1,t); \
    if constexpr(!FIXREF){ float a=MX3(C0[0],C0[1],C1[0]),b=MX3(C0[2],C0[3],C1[1]); a=MX3(a,C1[2],C1[3]); \
      _Pragma("unroll") for(int r=4;r<16;r+=4){a=MX3(a,C0[r],C0[r+1]);b=MX3(b,C0[r+2],C0[r+3]);a=MX3(a,C1[r],C1[r+1]);b=MX3(b,C1[r+2],C1[r+3]);} \
      float rm=__builtin_fmaxf(a,b); { auto rr=__builtin_amdgcn_permlane32_swap(__float_as_uint(rm),__float_as_uint(rm),false,false); rm=__builtin_fmaxf(__uint_as_float(rr[0]),__uint_as_float(rr[1])); } \
      resc=false; \
      if(__builtin_expect(__any(rm>(float)THRL),0)){ const float dl=__builtin_fmaxf(rm,0.f); mhat+=dl; \
        _Pragma("unroll") for(int r=0;r<16;++r){C0[r]-=dl;C1[r]-=dl;} \
        _Pragma("unroll") for(int r=0;r<16;++r)negm[r]=-mhat; asm volatile("":"+v"(negm)); \
        const float f=__builtin_amdgcn_exp2f(-dl); l_reg*=f; { const int l2_=lane_id_asm(); if((l2_>>5)==0)wsf[l2_&31]=f; } resc=true; } } \
    SBAR(); \
    VRD2(0,8); SBAR(); GAPB(o[0]=__builtin_amdgcn_mfma_f32_32x32x16_bf16(PAF(0),VFR(0),o[0],0,0,0), C0,0); \
    VRD2(4,0); SBAR(); GAPB(o[1]=__builtin_amdgcn_mfma_f32_32x32x16_bf16(PAF(0),VFR(4),o[1],0,0,0), C0,2); \
    VRD2(1,4); SBAR(); GAPB(o[0]=__builtin_amdgcn_mfma_f32_32x32x16_bf16(PAF(1),VFR(1),o[0],0,0,0), C0,4); \
    VRD2(5,1); SBAR(); GAPB(o[1]=__builtin_amdgcn_mfma_f32_32x32x16_bf16(PAF(1),VFR(5),o[1],0,0,0), C0,6); \
    VRD2(2,5); SBAR(); GAPB(o[0]=__builtin_amdgcn_mfma_f32_32x32x16_bf16(PAF(2),VFR(2),o[0],0,0,0), C0,8); \
    VRD2(6,2); SBAR(); GAPB(o[1]=__builtin_amdgcn_mfma_f32_32x32x16_bf16(PAF(2),VFR(6),o[1],0,0,0), C0,10); \
    VRD2(3,6); SBAR(); GAPB(o[0]=__builtin_amdgcn_mfma_f32_32x32x16_bf16(PAF(3),VFR(3),o[0],0,0,0), C0,12); \
    VRD2(7,3); SBAR(); GAPB(o[1]=__builtin_amdgcn_mfma_f32_32x32x16_bf16(PAF(3),VFR(7),o[1],0,0,0), C0,14); \
    KRD(GL,0); GAPB(o[2]=__builtin_amdgcn_mfma_f32_32x32x16_bf16(PAF(0),VFR(8),o[2],0,0,0), C1,0); \
    KRD(GL,1); GAPB(o[3]=__builtin_amdgcn_mfma_f32_32x32x16_bf16(PAF(0),VFR(0),o[3],0,0,0), C1,2); \
    KRD(GL,2); GAPB(o[2]=__builtin_amdgcn_mfma_f32_32x32x16_bf16(PAF(1),VFR(4),o[2],0,0,0), C1,4); \
    KRD(GL,3); GAPB(o[3]=__builtin_amdgcn_mfma_f32_32x32x16_bf16(PAF(1),VFR(1),o[3],0,0,0), C1,6); \
    GAPB(o[2]=__builtin_amdgcn_mfma_f32_32x32x16_bf16(PAF(2),VFR(5),o[2],0,0,0), C1,8); \
    GAPB(o[3]=__builtin_amdgcn_mfma_f32_32x32x16_bf16(PAF(2),VFR(2),o[3],0,0,0), C1,10); \
    GAPB(o[2]=__builtin_amdgcn_mfma_f32_32x32x16_bf16(PAF(3),VFR(6),o[2],0,0,0), C1,12); \
    GAPB(o[3]=__builtin_amdgcn_mfma_f32_32x32x16_bf16(PAF(3),VFR(3),o[3],0,0,0), C1,14); \
    }while(0)
  int t=1;
  for(;t+5<NT;t+=2){
    STEP(pB0,pB1,pA0,pA1,t,true,true,true);     WAIT_BAR(3); RESC(); ROT();
    STEP(pA0,pA1,pB0,pB1,t+1,true,true,true);   WAIT_BAR(3); RESC(); ROT();
  }
  #define ENDW(tt) do{ if((tt)+3<NT){WAIT_BAR(3);} else if((tt)+2<NT){WAIT_BAR(2);} else {WAIT_BAR(0);} }while(0)
  for(;t+1<NT;t+=2){
    STEP(pB0,pB1,pA0,pA1,t,(t+3<NT),(t+1<NT),(t+1<NT));       ENDW(t);   RESC(); ROT();
    STEP(pA0,pA1,pB0,pB1,t+1,(t+4<NT),(t+2<NT),(t+2<NT));     ENDW(t+1); RESC(); ROT();
  }
  STEP(pB0,pB1,pA0,pA1,NT-1,false,false,false); RESC();
  { float sacc=pB0[0]+pB0[1]; _Pragma("unroll") for(int r=2;r<16;++r)sacc+=pB0[r]; _Pragma("unroll") for(int r=0;r<16;++r)sacc+=pB1[r]; l_reg+=sacc;
    pw0=(u32x4){PKW(pB0,0),PKW(pB0,2),PKW(pB0,4),PKW(pB0,6)};pw1=(u32x4){PKW(pB0,8),PKW(pB0,10),PKW(pB0,12),PKW(pB0,14)};pw2=(u32x4){PKW(pB1,0),PKW(pB1,2),PKW(pB1,4),PKW(pB1,6)};pw3=(u32x4){PKW(pB1,8),PKW(pB1,10),PKW(pB1,12),PKW(pB1,14)};
    SBAR(); pv128(o,vb0+2*sl_cur,PAF(0),PAF(1),PAF(2),PAF(3)); }
  #undef PKW
  #undef PAF
  #undef VFR
  #undef VRD2
  #undef PIN
  #undef MX3
  #undef GAPA
  #undef GAPB
  #undef EX
  #undef VRD
  #undef KRD
  #undef STEP
  #undef ENDW
  {auto rr=__builtin_amdgcn_permlane32_swap(__float_as_uint(l_reg),__float_as_uint(l_reg),false,false);l_reg=__uint_as_float(rr[0])+__uint_as_float(rr[1]);}
  const int lane_e=lane_id_asm(),r32e=lane_e&31,hie=lane_e>>5;
  if(hie==0)wsf[32+r32e]=l_reg;asm volatile("s_waitcnt lgkmcnt(0)":::"memory");
  float rli[16];
  #pragma unroll
  for(int r=0;r<16;++r)rli[r]=__builtin_amdgcn_rcpf(wsf[32+crow(r,hie)]);
  float*st=stash+(size_t)wid*4096+lane_e*4;
  if(cpass==0){
    #pragma unroll
    for(int d0=0;d0<4;++d0)
      #pragma unroll
      for(int q4=0;q4<4;++q4){ typedef float f32x4_t __attribute__((ext_vector_type(4)));
        const f32x4_t v={o[d0][4*q4]*rli[4*q4],o[d0][4*q4+1]*rli[4*q4+1],o[d0][4*q4+2]*rli[4*q4+2],o[d0][4*q4+3]*rli[4*q4+3]};
        *(f32x4_t*)(st+(d0*4+q4)*256)=v; }
  } else {
    typedef float f32x4_t __attribute__((ext_vector_type(4)));
    float ss[16];
    #pragma unroll
    for(int r=0;r<16;++r)ss[r]=0.f;
    #pragma unroll
    for(int d0=0;d0<4;++d0)
      #pragma unroll
      for(int q4=0;q4<4;++q4){ const f32x4_t a=*(const f32x4_t*)(st+(d0*4+q4)*256);
        #pragma unroll
        for(int i=0;i<4;++i){ const int r=4*q4+i; const float v=a[i]-lam*(o[d0][r]*rli[r]); o[d0][r]=v; ss[r]+=v*v; } if(q4==3)asm volatile("":::"memory"); }
    #pragma unroll
    for(int r=0;r<16;++r){ float s=ss[r]; s+=__shfl_xor(s,1); s+=__shfl_xor(s,2); s+=__shfl_xor(s,4); s+=__shfl_xor(s,8); s+=__shfl_xor(s,16); ss[r]=0.8f/sqrtf(s*(1.0f/128.0f)+1e-6f); }
    float gsub[4];
    #pragma unroll
    for(int d0=0;d0<4;++d0)gsub[d0]=subg[d0*32+r32e];
    asm volatile("s_waitcnt lgkmcnt(0)\n\ts_barrier":::"memory");
    bf16*Ow=Ou+(long)(wid*QBLK)*opitch;
    bf16*stg=(bf16*)shm+wid*4096;
    #pragma unroll
    for(int r=0;r<16;++r){const int orow=crow(r,hie);
      #pragma unroll
      for(int d0=0;d0<4;++d0)stg[orow*128+d0*32+r32e]=__float2bfloat16(o[d0][r]*ss[r]*gsub[d0]);}
    asm volatile("s_waitcnt lgkmcnt(0)":::"memory");
    #pragma unroll
    for(int i=0;i<8;++i){const int row=i*4+(lane_e>>4),ch=lane_e&15; const u32x4 v=*(const u32x4*)(stg+row*128+ch*8); ATTN_STORE16(Ow+(long)row*opitch+ch*8,v);}
  }
  asm volatile("s_waitcnt lgkmcnt(0)\n\ts_barrier":::"memory");
 }
  #undef DMA_K
  #undef DMA_V
  #undef CMASK
  #undef START
  #undef RESC
  #undef ROT
}

typedef int v8i32_t __attribute__((ext_vector_type(8))); typedef int v4i32_t __attribute__((ext_vector_type(4)));
constexpr int P8=1664;
#define MFMA8(a,b,c) __builtin_amdgcn_mfma_scale_f32_32x32x64_f8f6f4(a,b,c,0,0,0,0,0,0)
__device__ __forceinline__ v8i32_t cat8v(v4i32_t a,v4i32_t b){ return __builtin_shufflevector(a,b,0,1,2,3,4,5,6,7); }
__device__ __forceinline__ v8i32_t kfrag8(lds_cptr kp){ return cat8v(*(const __attribute__((address_space(3))) v4i32_t*)(kp),*(const __attribute__((address_space(3))) v4i32_t*)(kp+1024)); }
__device__ __forceinline__ void qkt8(f32x16&p0,f32x16&p1,lds_cptr kp,v8i32_t q8,const f32x16&negm){ const v8i32_t a=kfrag8(kp),b=kfrag8(kp+512); p0=MFMA8(a,q8,negm); p1=MFMA8(b,q8,negm); }
constexpr int SLOTK8=4096;
constexpr int L8A_K=0, L8A_V=NSLOT*SLOTK8, L8A_WS=L8A_V+NSLOT*8192, L8A_OST=L8A_WS+NW*64*4, L8A_BYTES=L8A_OST+NW*4096;
constexpr int L8B_K=0, L8B_V=NSLOT*SLOTK8, L8B_WS=65536, L8B_BYTES=L8B_WS+NW*64*4;
template<int THRL,bool FIXREF=false> __device__ __forceinline__ void attn_unit_q8(const unsigned char*Qu8,const unsigned char*__restrict__ Kb8,const bf16*__restrict__ Vb,bf16*Ou,int opitch,char*shm,int wid){
  const int lane=lane_id_asm(),r32=lane&31,hi=lane>>5;
  const unsigned char*Qw8=Qu8+(long)(wid*QBLK)*P8;
  const unsigned char*Kh8=Kb8; const bf16*Vh=Vb;
  const unsigned lds0=(unsigned)(uintptr_t)shm;
  float*wsf=(float*)(shm+L8A_WS)+wid*64;
  const unsigned char*ksrc=Kh8+(long)lane*P8+(wid&3)*16;
  const bf16*vsrc=Vh+(long)(16*(wid&3)+(lane>>2))*DM+(wid>>2)*32+(lane&3)*8;
  const unsigned kdst=lds0+L8A_K+(wid&3)*1024, vdst=lds0+L8A_V+wid*1024;
  #define DMA_K(t,slot) glds16(ksrc+(long)(t)*KVBLK*P8,(unsigned)__builtin_amdgcn_readfirstlane(kdst+(slot)))
  #define DMA_V(t,slot) glds16(vsrc+(long)(t)*KVBLK*DM,(unsigned)__builtin_amdgcn_readfirstlane(vdst+2*(slot)))
  const int vb0=(int)(lds0+L8A_V)+((lane>>4)&1)*32+(lane&3)*8+(4*hi+((lane&15)>>2))*64;
  v8i32_t kf8[2];
  const lds_cptr shm3=(lds_cptr)shm; const lds_cptr kp0=shm3+L8A_K+hi*2048+r32*16; const lds_cptr vp0=shm3+L8A_V+((lane>>4)&1)*32+(lane&3)*8+(4*hi+((lane&15)>>2))*64;
  DMA_K(0,0);DMA_V(0,0);DMA_K(1,SLOTK8);
  const v8i32_t q8=*reinterpret_cast<const v8i32_t*>(Qw8+(long)r32*P8+hi*32);
  float mhat=0.f,l_reg=0.f;f32x16 o[2];o[0]=f32x16{};o[1]=f32x16{};f32x16 negm=f32x16{};asm volatile("":"+v"(negm));
  #define CMASK(P0,P1,t) do{}while(0)
  bool resc=false;
  #define START(P0,P1) do{ resc=false; if constexpr(!FIXREF){ const float rm=rowmax(P0,P1); \
    { const float dl=rm; mhat=fadd_s(mhat,dl); \
      _Pragma("unroll") for(int r=0;r<16;++r){P0[r]=fsub_s(P0[r],dl);P1[r]=fsub_s(P1[r],dl);} \
      _Pragma("unroll") for(int r=0;r<16;++r)negm[r]=-mhat; asm volatile("":"+v"(negm)); } } \
    _Pragma("unroll") for(int r=0;r<16;++r)P0[r]=__builtin_amdgcn_exp2f(P0[r]); }while(0)
  #define RESC() do{ if(resc){ asm volatile("s_waitcnt lgkmcnt(0)":::"memory"); \
      _Pragma("unroll") for(int d_=0;d_<2;++d_) _Pragma("unroll") for(int r=0;r<16;++r)o[d_][r]*=wsf[crow(r,hi)]; } }while(0)
  f32x16 pA0,pA1,pB0,pB1;
  int sl_prev=0,sl_cur=0,sl_next=SLOTK8;
  #define ROT() do{sl_prev=sl_cur;sl_cur=sl_next;sl_next=(sl_next==(NSLOT-1)*SLOTK8)?0:sl_next+SLOTK8;}while(0)
  DMA_K(2,2*SLOTK8);
  WAIT_BAR(3);
  qkt8(pA0,pA1,kp0,q8,negm);asm volatile("s_nop 15\n\ts_nop 7":"+v"(pA0),"+v"(pA1));CMASK(pA0,pA1,0);
  START(pA0,pA1);
  _Pragma("unroll") for(int r=0;r<16;++r)pA1[r]=__builtin_amdgcn_exp2f(pA1[r]);
  WAIT_BAR(0);
  DMA_K(3,0);DMA_V(1,SLOTK8);
  ROT();
  kf8[0]=kfrag8(kp0+sl_cur); kf8[1]=kfrag8(kp0+sl_cur+512);
  WAIT_BAR(2);
  s16x4 vlo[8],vhi[8]; u32x4 pw0,pw1,pw2,pw3;
  #define PKW(P,B) cvtpk_s(P[B],P[B+1])
  #define PAF(k) __builtin_bit_cast(bf16x8,pw##k)
  #define VFR(i) (bf16x8){vlo[i][0],vlo[i][1],vlo[i][2],vlo[i][3],vhi[i][0],vhi[i][1],vhi[i][2],vhi[i][3]}
  #define PIN(x) asm volatile("":"+v"(x))
  #define MX3(a,b,c) __builtin_fmaxf(__builtin_fmaxf((a),(b)),(c))
  #define GAPA(MF,A0,A1,A2,A3,W0,W1,PW) do{ MF; sacc+=A0; sacc+=A1; sacc+=A2; sacc+=A3; PIN(sacc); W0; W1; PIN(PW); SBAR(); }while(0)
  #define EX(v) __builtin_amdgcn_exp2f(v)
  #define GAPB(MF,X,B) do{ MF; X[B]=EX(X[B]); X[B+1]=EX(X[B+1]); X[B+2]=EX(X[B+2]); X[B+3]=EX(X[B+3]); PIN(X); SBAR(); }while(0)
  #define VRD(i) do{ vlo[i]=vtr(vp_+(((i)>>2)*4096+((i)&3)*1024)); vhi[i]=vtr(vp_+(((i)>>2)*4096+((i)&3)*1024+512)); }while(0)
  #define KRD(G,j) do{ if(G){ kf8[j]=kfrag8(kp0+sl_next+(j)*512); SBAR(); } }while(0)
  #define STEP(C0,C1,P0,P1,t,GK,GV,GL) do{ SBAR(); \
    const lds_cptr vp_=vp0+2*sl_prev; \
    VRD(0); SBAR(); float sacc=(P0[0]+P0[1]); \
    C0=MFMA8(kf8[0],q8,negm); \
    sacc+=P0[2];sacc+=P0[3];sacc+=P0[4];sacc+=P0[5];sacc+=P0[6];sacc+=P0[7]; PIN(sacc); pw0[0]=PKW(P0,0); pw0[1]=PKW(P0,2); pw0[2]=PKW(P0,4); pw0[3]=PKW(P0,6); PIN(pw0); SBAR(); \
    VRD(4); SBAR(); \
    sacc+=P0[8];sacc+=P0[9];sacc+=P0[10];sacc+=P0[11];sacc+=P0[12];sacc+=P0[13];sacc+=P0[14];sacc+=P0[15]; PIN(sacc); pw1[0]=PKW(P0,8); pw1[1]=PKW(P0,10); pw1[2]=PKW(P0,12); pw1[3]=PKW(P0,14); PIN(pw1); SBAR(); \
    VRD(1); VRD(5); SBAR(); \
    C1=MFMA8(kf8[1],q8,negm); \
    sacc+=P1[0];sacc+=P1[1];sacc+=P1[2];sacc+=P1[3];sacc+=P1[4];sacc+=P1[5];sacc+=P1[6];sacc+=P1[7]; PIN(sacc); pw2[0]=PKW(P1,0); pw2[1]=PKW(P1,2); pw2[2]=PKW(P1,4); pw2[3]=PKW(P1,6); PIN(pw2); SBAR(); \
    VRD(2); VRD(6); SBAR(); \
    sacc+=P1[8];sacc+=P1[9];sacc+=P1[10];sacc+=P1[11];sacc+=P1[12];sacc+=P1[13];sacc+=P1[14];sacc+=P1[15]; PIN(sacc); pw3[0]=PKW(P1,8); pw3[1]=PKW(P1,10); pw3[2]=PKW(P1,12); pw3[3]=PKW(P1,14); PIN(pw3); SBAR(); \
    VRD(3); VRD(7); SBAR(); \
    l_reg+=sacc; \
    if(GK){DMA_K((t)+3,sl_cur);} if(GV){DMA_V((t)+1,sl_next);} \
    CMASK(C0,C1,t); \
    if constexpr(!FIXREF){ float a=MX3(C0[0],C0[1],C1[0]),b=MX3(C0[2],C0[3],C1[1]); a=MX3(a,C1[2],C1[3]); \
      _Pragma("unroll") for(int r=4;r<16;r+=4){a=MX3(a,C0[r],C0[r+1]);b=MX3(b,C0[r+2],C0[r+3]);a=MX3(a,C1[r],C1[r+1]);b=MX3(b,C1[r+2],C1[r+3]);} \
      float rm=__builtin_fmaxf(a,b); { auto rr=__builtin_amdgcn_permlane32_swap(__float_as_uint(rm),__float_as_uint(rm),false,false); rm=__builtin_fmaxf(__uint_as_float(rr[0]),__uint_as_float(rr[1])); } \
      resc=false; \
      if(__builtin_expect(__any(rm>(float)THRL),0)){ const float dl=__builtin_fmaxf(rm,0.f); mhat+=dl; \
        _Pragma("unroll") for(int r=0;r<16;++r){C0[r]-=dl;C1[r]-=dl;} \
        _Pragma("unroll") for(int r=0;r<16;++r)negm[r]=-mhat; asm volatile("":"+v"(negm)); \
        const float f=__builtin_amdgcn_exp2f(-dl); l_reg*=f; if(hi==0)wsf[r32]=f; resc=true; } } \
    SBAR(); \
    GAPB(o[0]=__builtin_amdgcn_mfma_f32_32x32x16_bf16(PAF(0),VFR(0),o[0],0,0,0), C0,0); \
    GAPB(o[1]=__builtin_amdgcn_mfma_f32_32x32x16_bf16(PAF(0),VFR(4),o[1],0,0,0), C0,4); \
    KRD(GL,0); GAPB(o[0]=__builtin_amdgcn_mfma_f32_32x32x16_bf16(PAF(1),VFR(1),o[0],0,0,0), C0,8); \
    KRD(GL,1); GAPB(o[1]=__builtin_amdgcn_mfma_f32_32x32x16_bf16(PAF(1),VFR(5),o[1],0,0,0), C0,12); \
    GAPB(o[0]=__builtin_amdgcn_mfma_f32_32x32x16_bf16(PAF(2),VFR(2),o[0],0,0,0), C1,0); \
    GAPB(o[1]=__builtin_amdgcn_mfma_f32_32x32x16_bf16(PAF(2),VFR(6),o[1],0,0,0), C1,4); \
    GAPB(o[0]=__builtin_amdgcn_mfma_f32_32x32x16_bf16(PAF(3),VFR(3),o[0],0,0,0), C1,8); \
    GAPB(o[1]=__builtin_amdgcn_mfma_f32_32x32x16_bf16(PAF(3),VFR(7),o[1],0,0,0), C1,12); \
    }while(0)
  int t=1;
  for(;t+5<NT;t+=2){
    STEP(pB0,pB1,pA0,pA1,t,true,true,true);     WAIT_BAR(2); RESC(); ROT();
    STEP(pA0,pA1,pB0,pB1,t+1,true,true,true);   WAIT_BAR(2); RESC(); ROT();
  }
  #define ENDW(tt) do{ if((tt)+3<NT){WAIT_BAR(2);} else if((tt)+2<NT){WAIT_BAR(1);} else {WAIT_BAR(0);} }while(0)
  for(;t+1<NT;t+=2){
    STEP(pB0,pB1,pA0,pA1,t,(t+3<NT),(t+1<NT),(t+1<NT));       ENDW(t);   RESC(); ROT();
    STEP(pA0,pA1,pB0,pB1,t+1,(t+4<NT),(t+2<NT),(t+2<NT));     ENDW(t+1); RESC(); ROT();
  }
  STEP(pB0,pB1,pA0,pA1,NT-1,false,false,false); RESC();
  { float sacc=pB0[0]+pB0[1]; _Pragma("unroll") for(int r=2;r<16;++r)sacc+=pB0[r]; _Pragma("unroll") for(int r=0;r<16;++r)sacc+=pB1[r]; l_reg+=sacc;
    pw0=(u32x4){PKW(pB0,0),PKW(pB0,2),PKW(pB0,4),PKW(pB0,6)};pw1=(u32x4){PKW(pB0,8),PKW(pB0,10),PKW(pB0,12),PKW(pB0,14)};pw2=(u32x4){PKW(pB1,0),PKW(pB1,2),PKW(pB1,4),PKW(pB1,6)};pw3=(u32x4){PKW(pB1,8),PKW(pB1,10),PKW(pB1,12),PKW(pB1,14)};
    SBAR(); pv(o,vb0+2*sl_cur,PAF(0),PAF(1),PAF(2),PAF(3)); }
  #undef PKW
  #undef PAF
  #undef VFR
  #undef PIN
  #undef MX3
  #undef GAPA
  #undef GAPB
  #undef EX
  #undef VRD
  #undef KRD
  #undef STEP
  #undef ENDW
  {auto rr=__builtin_amdgcn_permlane32_swap(__float_as_uint(l_reg),__float_as_uint(l_reg),false,false);l_reg=__uint_as_float(rr[0])+__uint_as_float(rr[1]);}
  if(hi==0)wsf[32+r32]=l_reg;asm volatile("s_waitcnt lgkmcnt(0)":::"memory");
  float rli[16];
  #pragma unroll
  for(int r=0;r<16;++r)rli[r]=__builtin_amdgcn_rcpf(wsf[32+crow(r,hi)]);
  bf16*Ow=Ou+(long)(wid*QBLK)*opitch;
  { bf16*stg=(bf16*)(shm+L8A_OST)+wid*2048;
    #pragma unroll
    for(int r=0;r<16;++r){const int orow=crow(r,hi);
      #pragma unroll
      for(int d0=0;d0<2;++d0)stg[orow*64+d0*32+r32]=__float2bfloat16(o[d0][r]*rli[r]);}
    asm volatile("s_waitcnt lgkmcnt(0)":::"memory");
    #pragma unroll
    for(int i=0;i<4;++i){const int row=i*8+(lane>>3),ch=lane&7; const u32x4 v=*(const u32x4*)(stg+row*64+ch*8); ATTN_STORE16(Ow+(long)row*opitch+ch*8,v);} }
  asm volatile("s_waitcnt lgkmcnt(0)\n\ts_barrier":::"memory");
  #undef DMA_K
  #undef DMA_V
  #undef CMASK
  #undef START
  #undef RESC
  #undef ROT
}
typedef int v2i32_t __attribute__((ext_vector_type(2)));
constexpr int PV8=640;
constexpr int L9A_K=0, L9A_V=4*SLOTK8, L9A_WS=7*SLOTK8, L9A_OST=L9A_WS+NW*64*4, L9A_BYTES=L9A_OST+NW*4096;
template<int THRL,bool FIXREF=false> __device__ __forceinline__ void attn_unit_q8v(const unsigned char*Qu8,const unsigned char*__restrict__ Kb8,const unsigned char*__restrict__ Vb8,bf16*Ou,int opitch,char*shm,int wid){
  const int lane=lane_id_asm(),r32=lane&31,hi=lane>>5;
  const unsigned char*Qw8=Qu8+(long)(wid*QBLK)*P8;
  const unsigned char*Kh8=Kb8; const bool kw=wid<4;
  const unsigned lds0=(unsigned)(uintptr_t)shm;
  float*wsf=(float*)(shm+L9A_WS)+wid*64;
  const unsigned char*ksrc=Kh8+(long)lane*P8+(wid&3)*16;
  const int vkey_=16*(wid&3)+(lane>>2), vc_=(lane&3)^(((vkey_>>3)&1)<<1);
  const unsigned char*vsrc=Vb8+(long)vkey_*PV8+vc_*16;
  const unsigned kdst=lds0+L9A_K+(wid&3)*1024, vdst=lds0+L9A_V+(wid&3)*1024;
  #define DMA_K(t,slot) glds16(ksrc+(long)(t)*KVBLK*P8,(unsigned)__builtin_amdgcn_readfirstlane(kdst+(slot)))
  #define DMA_V(t,slot) glds16(vsrc+(long)(t)*KVBLK*PV8,(unsigned)__builtin_amdgcn_readfirstlane(vdst+(slot)))
  v8i32_t kf8[2];
  const lds_cptr shm3=(lds_cptr)shm; const lds_cptr kp0=shm3+L9A_K+hi*2048+r32*16;
  const int vq_=(lane&15)>>1, vkey0_=(vq_&3)+8*(vq_>>2)+4*hi, vsw_=(vq_>>2)<<1;
  const lds_cptr vpA=shm3+L9A_V+vkey0_*64+((((lane>>4)&1))^vsw_)*16+(lane&1)*8, vpB=shm3+L9A_V+vkey0_*64+((2+((lane>>4)&1))^vsw_)*16+(lane&1)*8;
  if(kw){DMA_K(0,0);DMA_K(1,SLOTK8);}else{DMA_V(0,0);}
  const v8i32_t q8=*reinterpret_cast<const v8i32_t*>(Qw8+(long)r32*P8+hi*32);
  float mhat=0.f,l_reg=0.f;f32x16 o[2];o[0]=f32x16{};o[1]=f32x16{};f32x16 negm=f32x16{};asm volatile("":"+v"(negm));
  #define CMASK(P0,P1,t) do{}while(0)
  bool resc=false;
  #define START(P0,P1) do{ resc=false; if constexpr(!FIXREF){ const float rm=rowmax(P0,P1); \
    { const float dl=rm; mhat=fadd_s(mhat,dl); \
      _Pragma("unroll") for(int r=0;r<16;++r){P0[r]=fsub_s(P0[r],dl);P1[r]=fsub_s(P1[r],dl);} \
      _Pragma("unroll") for(int r=0;r<16;++r)negm[r]=-mhat; asm volatile("":"+v"(negm)); } } \
    _Pragma("unroll") for(int r=0;r<16;++r)P0[r]=__builtin_amdgcn_exp2f(P0[r]); }while(0)
  #define RESC() do{ if(resc){ asm volatile("s_waitcnt lgkmcnt(0)":::"memory"); \
      _Pragma("unroll") for(int d_=0;d_<2;++d_) _Pragma("unroll") for(int r=0;r<16;++r)o[d_][r]*=wsf[crow(r,hi)]; } }while(0)
  f32x16 pA0,pA1,pB0,pB1;
  int sl_prev=0,sl_cur=0,sl_next=SLOTK8;
  int kq_prev=0,kq_cur=0,kq_next=SLOTK8;
  #define ROT() do{sl_prev=sl_cur;sl_cur=sl_next;sl_next=(sl_next==(NSLOT-1)*SLOTK8)?0:sl_next+SLOTK8; kq_prev=kq_cur;kq_cur=kq_next;kq_next=(kq_next==3*SLOTK8)?0:kq_next+SLOTK8;}while(0)
  if(kw){DMA_K(2,2*SLOTK8);}
  WAIT_BAR(2);
  qkt8(pA0,pA1,kp0,q8,negm);asm volatile("s_nop 15\n\ts_nop 7":"+v"(pA0),"+v"(pA1));CMASK(pA0,pA1,0);
  START(pA0,pA1);
  _Pragma("unroll") for(int r=0;r<16;++r)pA1[r]=__builtin_amdgcn_exp2f(pA1[r]);
  WAIT_BAR(0);
  if(kw){DMA_K(3,3*SLOTK8);}else{DMA_V(1,SLOTK8);}
  ROT();
  kf8[0]=kfrag8(kp0+kq_cur); kf8[1]=kfrag8(kp0+kq_cur+512);
  WAIT_BAR(1);
  v2i32_t vA0,vA1,vA2,vA3,vB0,vB1,vB2,vB3; v8i32_t pw8=v8i32_t{}; static_assert(FIXREF,"constant reference only (the row sums are not rescaled)");
  v8i32_t ones8; { int o1_; asm volatile("v_mov_b32 %0, 0x38383838":"=v"(o1_)); ones8=(v8i32_t){o1_,o1_,o1_,o1_,o1_,o1_,o1_,o1_}; } f32x16 ls=f32x16{};
  #define PK4(P,B) (int)pg8::pk4_fp8(P[B],P[B+1],P[B+2],P[B+3])
  #define PK4I(D,P,B) do{ D=__builtin_amdgcn_cvt_pk_fp8_f32(P[B],P[B+1],D,false); D=__builtin_amdgcn_cvt_pk_fp8_f32(P[B+2],P[B+3],D,true); }while(0)
  #define VT8(p) __builtin_amdgcn_ds_read_tr8_b64_v2i32((__attribute__((address_space(3))) v2i32_t*)(p))
  #define V8A() (v8i32_t){vA0[0],vA0[1],vA1[0],vA1[1],vA2[0],vA2[1],vA3[0],vA3[1]}
  #define V8B() (v8i32_t){vB0[0],vB0[1],vB1[0],vB1[1],vB2[0],vB2[1],vB3[0],vB3[1]}
  #define PIN(x) asm volatile("":"+v"(x))
  #define MX3(a,b,c) __builtin_fmaxf(__builtin_fmaxf((a),(b)),(c))
  #define EX(v) __builtin_amdgcn_exp2f(v)
  #define EX4(X,B) do{ X[B]=EX(X[B]); X[B+1]=EX(X[B+1]); X[B+2]=EX(X[B+2]); X[B+3]=EX(X[B+3]); PIN(X); SBAR(); }while(0)
  #define KRD(G,j,KS) do{ if(G){ kf8[j]=kfrag8(kp0+(KS)+(j)*512); SBAR(); } }while(0)
  #define STEPA(C0,C1,P0,P1) do{ SBAR(); \
    const lds_cptr va_=vpA+sl_prev, vb_=vpB+sl_prev; \
    vA0=VT8(va_); vA1=VT8(va_+1024); SBAR(); \
    C0=MFMA8(kf8[0],q8,negm); \
    PK4I(pw8[0],P0,0); PK4I(pw8[1],P0,4); PIN(pw8); SBAR(); \
    vA2=VT8(va_+2048); vA3=VT8(va_+3072); SBAR(); \
    PK4I(pw8[2],P0,8); PK4I(pw8[3],P0,12); PIN(pw8); SBAR(); \
    vB0=VT8(vb_); vB1=VT8(vb_+1024); SBAR(); \
    C1=MFMA8(kf8[1],q8,negm); \
    PK4I(pw8[4],P1,0); PK4I(pw8[5],P1,4); PIN(pw8); SBAR(); \
    vB2=VT8(vb_+2048); vB3=VT8(vb_+3072); SBAR(); \
    PK4I(pw8[6],P1,8); PK4I(pw8[7],P1,12); PIN(pw8); SBAR(); \
    }while(0)
  #define STEPB(C0,C1,GL,KS) do{ SBAR(); \
    ls=MFMA8(pw8,ones8,ls); o[0]=MFMA8(pw8,V8A(),o[0]); SBAR(); \
    EX4(C0,0); EX4(C0,4); KRD(GL,0,KS); EX4(C0,8); EX4(C0,12); \
    o[1]=MFMA8(pw8,V8B(),o[1]); SBAR(); \
    EX4(C1,0); KRD(GL,1,KS); EX4(C1,4); EX4(C1,8); EX4(C1,12); \
    }while(0)
  #define ENDW(tt) do{ if((tt)+3<NT){WAIT_BAR(1);} else {WAIT_BAR(0);} }while(0)
  if(kw){
    int t=1;
    for(;t+1<NT;t+=2){
      STEPA(pB0,pB1,pA0,pA1); if(t+3<NT){DMA_K(t+3,kq_prev);} STEPB(pB0,pB1,true,kq_next); ENDW(t); ROT();
      STEPA(pA0,pA1,pB0,pB1); if(t+4<NT){DMA_K(t+4,kq_prev);} STEPB(pA0,pA1,(t+2<NT),kq_next); ENDW(t+1); ROT();
    }
    STEPA(pB0,pB1,pA0,pA1); STEPB(pB0,pB1,false,0);
  } else {
    int t=1;
    DMA_V(2,sl_next); STEPA(pB0,pB1,pA0,pA1); ENDW(1); ROT(); t=2;
    for(;t+3<NT;t+=2){
      DMA_V(t+1,sl_next); STEPB(pB0,pB1,true,kq_cur); STEPA(pA0,pA1,pB0,pB1); ENDW(t); ROT();
      DMA_V(t+2,sl_next); STEPB(pA0,pA1,true,kq_cur); STEPA(pB0,pB1,pA0,pA1); ENDW(t+1); ROT();
    }
    DMA_V(t+1,sl_next); STEPB(pB0,pB1,true,kq_cur); STEPA(pA0,pA1,pB0,pB1); ENDW(t); ROT();
    STEPB(pA0,pA1,true,kq_cur); STEPA(pB0,pB1,pA0,pA1);
    STEPB(pB0,pB1,false,0);
  }
  {
    pw8=(v8i32_t){PK4(pB0,0),PK4(pB0,4),PK4(pB0,8),PK4(pB0,12),PK4(pB1,0),PK4(pB1,4),PK4(pB1,8),PK4(pB1,12)};
    const lds_cptr va_=vpA+sl_cur, vb_=vpB+sl_cur;
    vA0=VT8(va_); vA1=VT8(va_+1024); vA2=VT8(va_+2048); vA3=VT8(va_+3072); vB0=VT8(vb_); vB1=VT8(vb_+1024); vB2=VT8(vb_+2048); vB3=VT8(vb_+3072);
    SBAR(); ls=MFMA8(pw8,ones8,ls); o[0]=MFMA8(pw8,V8A(),o[0]); o[1]=MFMA8(pw8,V8B(),o[1]); }
  #undef PK4
  #undef PK4I
  #undef VT8
  #undef V8A
  #undef V8B
  #undef PIN
  #undef MX3
  #undef EX
  #undef EX4
  #undef KRD
  #undef STEPA
  #undef STEPB
  #undef STEP
  #undef ENDW
  {auto rr=__builtin_amdgcn_permlane32_swap(__float_as_uint(l_reg),__float_as_uint(l_reg),false,false);l_reg=__uint_as_float(rr[0])+__uint_as_float(rr[1]);}
  if(hi==0)wsf[32+r32]=l_reg;asm volatile("s_waitcnt lgkmcnt(0)":::"memory");
  float rli[16];
  #pragma unroll
  for(int r=0;r<16;++r)rli[r]=__builtin_amdgcn_rcpf(ls[r]);
  bf16*Ow=Ou+(long)(wid*QBLK)*opitch;
  { bf16*stg=(bf16*)(shm+L9A_OST)+wid*2048;
    #pragma unroll
    for(int r=0;r<16;++r){const int orow=crow(r,hi);
      #pragma unroll
      for(int d0=0;d0<2;++d0)stg[orow*64+d0*32+r32]=__float2bfloat16(o[d0][r]*rli[r]);}
    asm volatile("s_waitcnt lgkmcnt(0)":::"memory");
    #pragma unroll
    for(int i=0;i<4;++i){const int row=i*8+(lane>>3),ch=lane&7; const u32x4 v=*(const u32x4*)(stg+row*64+ch*8); ATTN_STORE16(Ow+(long)row*opitch+ch*8,v);} }
  asm volatile("s_waitcnt lgkmcnt(0)\n\ts_barrier":::"memory");
  #undef DMA_K
  #undef DMA_V
  #undef CMASK
  #undef START
  #undef RESC
  #undef ROT
}
template<int THRL,bool FIXREF=false> __device__ __forceinline__ void attn_unit128_q8(const unsigned char*Qu8,const unsigned char*__restrict__ Kb8,const bf16*__restrict__ Vb,bf16*Ou,int opitch,char*shm,int wid,float*stash,float lam,const float*subg,int pass_lo,int pass_hi){
  const int lane=lane_id_asm(),r32=lane&31,hi=lane>>5;
  const bf16*Vh=Vb;
 for(int cpass=pass_lo;cpass<pass_hi;++cpass){
  const int lane_p=lane_id_asm(),r32p=lane_p&31,hip=lane_p>>5;
  const unsigned char*Qw8=Qu8+(long)(wid*QBLK)*P8+cpass*64;
  const unsigned char*Kh8=Kb8+cpass*64;
  const unsigned lds0=(unsigned)(uintptr_t)shm;
  float*wsf=(float*)(shm+L8B_WS)+wid*64;
  const unsigned char*ksrc=Kh8+(long)lane_p*P8+(wid&3)*16;
  const bf16*vsrc=Vh+(long)(16*(wid&3)+(lane_p>>2))*DM+(wid>>2)*32+(lane_p&3)*8;
  const unsigned kdst=lds0+L8B_K+(wid&3)*1024, vdst=lds0+L8B_V+wid*1024;
  #define DMA_K(t,slot) glds16(ksrc+(long)(t)*KVBLK*P8,(unsigned)__builtin_amdgcn_readfirstlane(kdst+(slot)))
  #define DMA_V(t,slot) do{ glds16(vsrc+(long)(t)*KVBLK*DM,(unsigned)__builtin_amdgcn_readfirstlane(vdst+4*(slot))); glds16(vsrc+(long)(t)*KVBLK*DM+64,(unsigned)__builtin_amdgcn_readfirstlane(vdst+4*(slot)+8192)); }while(0)
  const int vb0=(int)(lds0+L8B_V)+((lane_p>>4)&1)*32+(lane_p&3)*8+(4*hip+((lane_p&15)>>2))*64;
  v8i32_t kf8[2];
  const lds_cptr shm3=(lds_cptr)shm; const lds_cptr kp0=shm3+L8B_K+hip*2048+r32p*16; const lds_cptr vp0=shm3+L8B_V+((lane_p>>4)&1)*32+(lane_p&3)*8+(4*hip+((lane_p&15)>>2))*64;
  DMA_K(0,0);DMA_V(0,0);DMA_K(1,SLOTK8);
  const v8i32_t q8=*reinterpret_cast<const v8i32_t*>(Qw8+(long)r32p*P8+hip*32);
  float zf_; asm volatile("v_mov_b32 %0, 0":"=v"(zf_));
  float mhat=0.f,l_reg=0.f;f32x16 o[4];
  #pragma unroll
  for(int r=0;r<16;++r){o[0][r]=zf_;o[1][r]=zf_;o[2][r]=zf_;o[3][r]=zf_;}
  f32x16 negm;
  #pragma unroll
  for(int r=0;r<16;++r)negm[r]=zf_;
  asm volatile("":"+v"(negm));
  #define CMASK(P0,P1,t) do{}while(0)
  bool resc=false;
  #define START(P0,P1) do{ resc=false; if constexpr(!FIXREF){ const float rm=rowmax(P0,P1); \
    { const float dl=rm; mhat=fadd_s(mhat,dl); \
      _Pragma("unroll") for(int r=0;r<16;++r){P0[r]=fsub_s(P0[r],dl);P1[r]=fsub_s(P1[r],dl);} \
      _Pragma("unroll") for(int r=0;r<16;++r)negm[r]=-mhat; asm volatile("":"+v"(negm)); } } \
    _Pragma("unroll") for(int r=0;r<16;++r)P0[r]=__builtin_amdgcn_exp2f(P0[r]); }while(0)
  #define RESC() do{ if(resc){ asm volatile("s_waitcnt lgkmcnt(0)":::"memory"); \
      _Pragma("unroll") for(int d_=0;d_<4;++d_) _Pragma("unroll") for(int r=0;r<16;++r)o[d_][r]*=wsf[crow(r,hi)]; } }while(0)
  f32x16 pA0,pA1,pB0,pB1;
  int sl_prev=0,sl_cur=0,sl_next=SLOTK8;
  #define ROT() do{sl_prev=sl_cur;sl_cur=sl_next;sl_next=(sl_next==(NSLOT-1)*SLOTK8)?0:sl_next+SLOTK8;}while(0)
  DMA_K(2,2*SLOTK8);
  WAIT_BAR(4);
  qkt8(pA0,pA1,kp0,q8,negm);asm volatile("s_nop 15\n\ts_nop 7":"+v"(pA0),"+v"(pA1));CMASK(pA0,pA1,0);
  START(pA0,pA1);
  _Pragma("unroll") for(int r=0;r<16;++r)pA1[r]=__builtin_amdgcn_exp2f(pA1[r]);
  WAIT_BAR(0);
  DMA_K(3,0);DMA_V(1,SLOTK8);
  ROT();
  kf8[0]=kfrag8(kp0+sl_cur); kf8[1]=kfrag8(kp0+sl_cur+512);
  WAIT_BAR(3);
  s16x4 vlo[9],vhi[9]; u32x4 pw0,pw1,pw2,pw3;
  #define PKW(P,B) cvtpk_s(P[B],P[B+1])
  #define PAF(k) __builtin_bit_cast(bf16x8,pw##k)
  #define VFR(i) (bf16x8){vlo[i][0],vlo[i][1],vlo[i][2],vlo[i][3],vhi[i][0],vhi[i][1],vhi[i][2],vhi[i][3]}
  #define PIN(x) asm volatile("":"+v"(x))
  #define MX3(a,b,c) __builtin_fmaxf(__builtin_fmaxf((a),(b)),(c))
  #define GAPA(MF,A0,A1,A2,A3,W0,W1,PW) do{ MF; sacc+=A0; sacc+=A1; sacc+=A2; sacc+=A3; PIN(sacc); W0; W1; PIN(PW); SBAR(); }while(0)
  #define EX(v) __builtin_amdgcn_exp2f(v)
  #define GAPB(MF,X,B) do{ MF; X[B]=EX(X[B]); X[B+1]=EX(X[B+1]); PIN(X); SBAR(); }while(0)
  #define VRD2(i,s) do{ vlo[s]=vtr(vp_+(8192+((i)>>2)*4096+((i)&3)*1024)); vhi[s]=vtr(vp_+(8192+((i)>>2)*4096+((i)&3)*1024+512)); }while(0)
  #define VRD(i) do{ vlo[i]=vtr(vp_+(((i)>>2)*4096+((i)&3)*1024)); vhi[i]=vtr(vp_+(((i)>>2)*4096+((i)&3)*1024+512)); }while(0)
  #define KRD(G,j) do{ if(G){ kf8[j]=kfrag8(kp0+sl_next+(j)*512); SBAR(); } }while(0)
  #define STEP(C0,C1,P0,P1,t,GK,GV,GL) do{ SBAR(); \
    const lds_cptr vp_=vp0+4*sl_prev; \
    VRD(0); SBAR(); float sacc=(P0[0]+P0[1]); \
    C0=MFMA8(kf8[0],q8,negm); \
    sacc+=P0[2];sacc+=P0[3];sacc+=P0[4];sacc+=P0[5];sacc+=P0[6];sacc+=P0[7]; PIN(sacc); pw0[0]=PKW(P0,0); pw0[1]=PKW(P0,2); pw0[2]=PKW(P0,4); pw0[3]=PKW(P0,6); PIN(pw0); SBAR(); \
    VRD(4); SBAR(); \
    sacc+=P0[8];sacc+=P0[9];sacc+=P0[10];sacc+=P0[11];sacc+=P0[12];sacc+=P0[13];sacc+=P0[14];sacc+=P0[15]; PIN(sacc); pw1[0]=PKW(P0,8); pw1[1]=PKW(P0,10); pw1[2]=PKW(P0,12); pw1[3]=PKW(P0,14); PIN(pw1); SBAR(); \
    VRD(1); VRD(5); SBAR(); \
    C1=MFMA8(kf8[1],q8,negm); \
    sacc+=P1[0];sacc+=P1[1];sacc+=P1[2];sacc+=P1[3];sacc+=P1[4];sacc+=P1[5];sacc+=P1[6];sacc+=P1[7]; PIN(sacc); pw2[0]=PKW(P1,0); pw2[1]=PKW(P1,2); pw2[2]=PKW(P1,4); pw2[3]=PKW(P1,6); PIN(pw2); SBAR(); \
    VRD(2); VRD(6); SBAR(); \
    sacc+=P1[8];sacc+=P1[9];sacc+=P1[10];sacc+=P1[11];sacc+=P1[12];sacc+=P1[13];sacc+=P1[14];sacc+=P1[15]; PIN(sacc); pw3[0]=PKW(P1,8); pw3[1]=PKW(P1,10); pw3[2]=PKW(P1,12); pw3[3]=PKW(P1,14); PIN(pw3); SBAR(); \
    VRD(3); VRD(7); SBAR(); \
    l_reg+=sacc; \
    if(GK){DMA_K((t)+3,sl_cur);} if(GV){DMA_V((t)+1,sl_next);} \
    CMASK(C0,C1,t); \
    if constexpr(!FIXREF){ float a=MX3(C0[0],C0[1],C1[0]),b=MX3(C0[2],C0[3],C1[1]); a=MX3(a,C1[2],C1[3]); \
      _Pragma("unroll") for(int r=4;r<16;r+=4){a=MX3(a,C0[r],C0[r+1]);b=MX3(b,C0[r+2],C0[r+3]);a=MX3(a,C1[r],C1[r+1]);b=MX3(b,C1[r+2],C1[r+3]);} \
      float rm=__builtin_fmaxf(a,b); { auto rr=__builtin_amdgcn_permlane32_swap(__float_as_uint(rm),__float_as_uint(rm),false,false); rm=__builtin_fmaxf(__uint_as_float(rr[0]),__uint_as_float(rr[1])); } \
      resc=false; \
      if(__builtin_expect(__any(rm>(float)THRL),0)){ const float dl=__builtin_fmaxf(rm,0.f); mhat+=dl; \
        _Pragma("unroll") for(int r=0;r<16;++r){C0[r]-=dl;C1[r]-=dl;} \
        _Pragma("unroll") for(int r=0;r<16;++r)negm[r]=-mhat; asm volatile("":"+v"(negm)); \
        const float f=__builtin_amdgcn_exp2f(-dl); l_reg*=f; { const int l2_=lane_id_asm(); if((l2_>>5)==0)wsf[l2_&31]=f; } resc=true; } } \
    SBAR(); \
    VRD2(0,8); SBAR(); GAPB(o[0]=__builtin_amdgcn_mfma_f32_32x32x16_bf16(PAF(0),VFR(0),o[0],0,0,0), C0,0); \
    VRD2(4,0); SBAR(); GAPB(o[1]=__builtin_amdgcn_mfma_f32_32x32x16_bf16(PAF(0),VFR(4),o[1],0,0,0), C0,2); \
    VRD2(1,4); SBAR(); GAPB(o[0]=__builtin_amdgcn_mfma_f32_32x32x16_bf16(PAF(1),VFR(1),o[0],0,0,0), C0,4); \
    VRD2(5,1); SBAR(); GAPB(o[1]=__builtin_amdgcn_mfma_f32_32x32x16_bf16(PAF(1),VFR(5),o[1],0,0,0), C0,6); \
    VRD2(2,5); SBAR(); GAPB(o[0]=__builtin_amdgcn_mfma_f32_32x32x16_bf16(PAF(2),VFR(2),o[0],0,0,0), C0,8); \
    VRD2(6,2); SBAR(); GAPB(o[1]=__builtin_amdgcn_mfma_f32_32x32x16_bf16(PAF(2),VFR(6),o[1],0,0,0), C0,10); \
    VRD2(3,6); SBAR(); GAPB(o[0]=__builtin_amdgcn_mfma_f32_32x32x16_bf16(PAF(3),VFR(3),o[0],0,0,0), C0,12); \
    VRD2(7,3); SBAR(); GAPB(o[1]=__builtin_amdgcn_mfma_f32_32x32x16_bf16(PAF(3),VFR(7),o[1],0,0,0), C0,14); \
    KRD(GL,0); GAPB(o[2]=__builtin_amdgcn_mfma_f32_32x32x16_bf16(PAF(0),VFR(8),o[2],0,0,0), C1,0); \
    KRD(GL,1); GAPB(o[3]=__builtin_amdgcn_mfma_f32_32x32x16_bf16(PAF(0),VFR(0),o[3],0,0,0), C1,2); \
    GAPB(o[2]=__builtin_amdgcn_mfma_f32_32x32x16_bf16(PAF(1),VFR(4),o[2],0,0,0), C1,4); \
    GAPB(o[3]=__builtin_amdgcn_mfma_f32_32x32x16_bf16(PAF(1),VFR(1),o[3],0,0,0), C1,6); \
    GAPB(o[2]=__builtin_amdgcn_mfma_f32_32x32x16_bf16(PAF(2),VFR(5),o[2],0,0,0), C1,8); \
    GAPB(o[3]=__builtin_amdgcn_mfma_f32_32x32x16_bf16(PAF(2),VFR(2),o[3],0,0,0), C1,10); \
    GAPB(o[2]=__builtin_amdgcn_mfma_f32_32x32x16_bf16(PAF(3),VFR(6),o[2],0,0,0), C1,12); \
    GAPB(o[3]=__builtin_amdgcn_mfma_f32_32x32x16_bf16(PAF(3),VFR(3),o[3],0,0,0), C1,14); \
    }while(0)
  int t=1;
  for(;t+5<NT;t+=2){
    STEP(pB0,pB1,pA0,pA1,t,true,true,true);     WAIT_BAR(3); RESC(); ROT();
    STEP(pA0,pA1,pB0,pB1,t+1,true,true,true);   WAIT_BAR(3); RESC(); ROT();
  }
  #define ENDW(tt) do{ if((tt)+3<NT){WAIT_BAR(3);} else if((tt)+2<NT){WAIT_BAR(2);} else {WAIT_BAR(0);} }while(0)
  for(;t+1<NT;t+=2){
    STEP(pB0,pB1,pA0,pA1,t,(t+3<NT),(t+1<NT),(t+1<NT));       ENDW(t);   RESC(); ROT();
    STEP(pA0,pA1,pB0,pB1,t+1,(t+4<NT),(t+2<NT),(t+2<NT));     ENDW(t+1); RESC(); ROT();
  }
  STEP(pB0,pB1,pA0,pA1,NT-1,false,false,false); RESC();
  { float sacc=pB0[0]+pB0[1]; _Pragma("unroll") for(int r=2;r<16;++r)sacc+=pB0[r]; _Pragma("unroll") for(int r=0;r<16;++r)sacc+=pB1[r]; l_reg+=sacc;
    pw0=(u32x4){PKW(pB0,0),PKW(pB0,2),PKW(pB0,4),PKW(pB0,6)};pw1=(u32x4){PKW(pB0,8),PKW(pB0,10),PKW(pB0,12),PKW(pB0,14)};pw2=(u32x4){PKW(pB1,0),PKW(pB1,2),PKW(pB1,4),PKW(pB1,6)};pw3=(u32x4){PKW(pB1,8),PKW(pB1,10),PKW(pB1,12),PKW(pB1,14)};
    SBAR(); pv128(o,vb0+4*sl_cur,PAF(0),PAF(1),PAF(2),PAF(3)); }
  #undef PKW
  #undef PAF
  #undef VFR
  #undef VRD2
  #undef PIN
  #undef MX3
  #undef GAPA
  #undef GAPB
  #undef EX
  #undef VRD
  #undef KRD
  #undef STEP
  #undef ENDW
  {auto rr=__builtin_amdgcn_permlane32_swap(__float_as_uint(l_reg),__float_as_uint(l_reg),false,false);l_reg=__uint_as_float(rr[0])+__uint_as_float(rr[1]);}
  const int lane_e=lane_id_asm(),r32e=lane_e&31,hie=lane_e>>5;
  if(hie==0)wsf[32+r32e]=l_reg;asm volatile("s_waitcnt lgkmcnt(0)":::"memory");
  float rli[16];
  #pragma unroll
  for(int r=0;r<16;++r)rli[r]=__builtin_amdgcn_rcpf(wsf[32+crow(r,hie)]);
  float*st=stash+(size_t)wid*4096+lane_e*4;
  if(cpass==0){
    #pragma unroll
    for(int d0=0;d0<4;++d0)
      #pragma unroll
      for(int q4=0;q4<4;++q4){ typedef float f32x4_t __attribute__((ext_vector_type(4)));
        const f32x4_t v={o[d0][4*q4]*rli[4*q4],o[d0][4*q4+1]*rli[4*q4+1],o[d0][4*q4+2]*rli[4*q4+2],o[d0][4*q4+3]*rli[4*q4+3]};
        *(f32x4_t*)(st+(d0*4+q4)*256)=v; }
  } else {
    typedef float f32x4_t __attribute__((ext_vector_type(4)));
    float ss[16];
    #pragma unroll
    for(int r=0;r<16;++r)ss[r]=0.f;
    #pragma unroll
    for(int d0=0;d0<4;++d0)
      #pragma unroll
      for(int q4=0;q4<4;++q4){ const f32x4_t a=*(const f32x4_t*)(st+(d0*4+q4)*256);
        #pragma unroll
        for(int i=0;i<4;++i){ const int r=4*q4+i; const float v=a[i]-lam*(o[d0][r]*rli[r]); o[d0][r]=v; ss[r]+=v*v; } if(q4==3)asm volatile("":::"memory"); }
    #pragma unroll
    for(int r=0;r<16;++r){ float s=ss[r]; s+=__shfl_xor(s,1); s+=__shfl_xor(s,2); s+=__shfl_xor(s,4); s+=__shfl_xor(s,8); s+=__shfl_xor(s,16); ss[r]=0.8f/sqrtf(s*(1.0f/128.0f)+1e-6f); }
    float gsub[4];
    #pragma unroll
    for(int d0=0;d0<4;++d0)gsub[d0]=subg[d0*32+r32e];
    asm volatile("s_waitcnt lgkmcnt(0)\n\ts_barrier":::"memory");
    bf16*Ow=Ou+(long)(wid*QBLK)*opitch;
    bf16*stg=(bf16*)shm+wid*4096;
    #pragma unroll
    for(int r=0;r<16;++r){const int orow=crow(r,hie);
      #pragma unroll
      for(int d0=0;d0<4;++d0)stg[orow*128+d0*32+r32e]=__float2bfloat16(o[d0][r]*ss[r]*gsub[d0]);}
    asm volatile("s_waitcnt lgkmcnt(0)":::"memory");
    #pragma unroll
    for(int i=0;i<8;++i){const int row=i*4+(lane_e>>4),ch=lane_e&15; const u32x4 v=*(const u32x4*)(stg+row*128+ch*8); ATTN_STORE16(Ow+(long)row*opitch+ch*8,v);}
  }
  asm volatile("s_waitcnt lgkmcnt(0)\n\ts_barrier":::"memory");
 }
  #undef DMA_K
  #undef DMA_V
  #undef CMASK
  #undef START
  #undef RESC
  #undef ROT
}
constexpr float REFOFF=3.0f, LMIN=8.0f; constexpr int L9B_K=0, L9B_V=NSLOT*SLOTK8, L9B_WS=65536, L9B_FLAG=L9B_WS+NW*64*4, L9B_BYTES=L9B_FLAG+64;
template<int THRL,bool FIXREF=false> __device__ __forceinline__ bool attn_unit128_q8v(const unsigned char*Qu8,const unsigned char*__restrict__ Kb8,const unsigned char*__restrict__ Vb8,bf16*Ou,int opitch,char*shm,int wid,float*stash,float lam,const float*subg,int pass_lo,int pass_hi,float ref){
  static_assert(FIXREF,"constant reference only"); bool bad_any=false;
  const int lane=lane_id_asm(),r32=lane&31,hi=lane>>5;
  const bool kw=wid<4;
 for(int cpass=pass_lo;cpass<pass_hi;++cpass){
  const int lane_p=lane_id_asm(),r32p=lane_p&31,hip=lane_p>>5;
  const unsigned char*Qw8=Qu8+(long)(wid*QBLK)*P8+cpass*64;
  const unsigned char*Kh8=Kb8+cpass*64;
  const unsigned lds0=(unsigned)(uintptr_t)shm;
  float*wsf=(float*)(shm+L9B_WS)+wid*64;
  const unsigned char*ksrc=Kh8+(long)lane_p*P8+(wid&3)*16;
  const int vkey_=8*wid+(lane_p>>3), vc_=(lane_p&7)^((((vkey_>>1)&1)<<1)|(((vkey_>>3)&1)<<2));
  const unsigned char*vsrc=Vb8+(long)vkey_*PV8+vc_*16;
  const unsigned kdst=lds0+L9B_K+(wid&3)*1024, vdst=lds0+L9B_V+wid*1024;
  #define DMA_K(t,slot) glds16(ksrc+(long)(t)*KVBLK*P8,(unsigned)__builtin_amdgcn_readfirstlane(kdst+(slot)))
  #define DMA_V(t,slot) glds16(vsrc+(long)(t)*KVBLK*PV8,(unsigned)__builtin_amdgcn_readfirstlane(vdst+2*(slot)))
  #define WAITB(nk,nv) do{ if(kw){WAIT_BAR(nk);}else{WAIT_BAR(nv);} }while(0)
  v8i32_t kf8[2];
  const lds_cptr shm3=(lds_cptr)shm; const lds_cptr kp0=shm3+L9B_K+hip*2048+r32p*16;
  const int vq_=(lane_p&15)>>1, vkey0_=(vq_&3)+8*(vq_>>2)+4*hip, vsw_=(((vq_>>1)&1)<<1)|(((vq_>>2)&1)<<2), vg_=(lane_p>>4)&1;
  const lds_cptr vq0=shm3+L9B_V+vkey0_*128+(lane_p&1)*8;
  const lds_cptr vp0_=vq0+((0+vg_)^vsw_)*16, vp1_=vq0+((2+vg_)^vsw_)*16, vp2_=vq0+((4+vg_)^vsw_)*16, vp3_=vq0+((6+vg_)^vsw_)*16;
  if(kw){DMA_K(0,0);} DMA_V(0,0); if(kw){DMA_K(1,SLOTK8);}
  const v8i32_t q8=*reinterpret_cast<const v8i32_t*>(Qw8+(long)r32p*P8+hip*32);
  float zf_; asm volatile("v_mov_b32 %0, 0":"=v"(zf_));
  float mhat=0.f,l_reg=0.f,smax=0.f;f32x16 o[4];
  #pragma unroll
  for(int r=0;r<16;++r){o[0][r]=zf_;o[1][r]=zf_;o[2][r]=zf_;o[3][r]=zf_;}
  f32x16 negm;
  #pragma unroll
  for(int r=0;r<16;++r)negm[r]=zf_-ref;
  asm volatile("":"+v"(negm));
  #define CMASK(P0,P1,t) do{}while(0)
  bool resc=false;
  #define START(P0,P1) do{ resc=false; if constexpr(!FIXREF){ const float rm=rowmax(P0,P1); \
    { const float dl=rm-REFOFF; mhat=fadd_s(mhat,dl);     \
      _Pragma("unroll") for(int r=0;r<16;++r){P0[r]=fsub_s(P0[r],dl);P1[r]=fsub_s(P1[r],dl);} \
      _Pragma("unroll") for(int r=0;r<16;++r)negm[r]=-mhat; asm volatile("":"+v"(negm)); } } \
    _Pragma("unroll") for(int r=0;r<16;++r)P0[r]=__builtin_amdgcn_exp2f(P0[r]); }while(0)
  #define RESC() do{ if(resc){ asm volatile("s_waitcnt lgkmcnt(0)":::"memory"); \
      _Pragma("unroll") for(int d_=0;d_<4;++d_) _Pragma("unroll") for(int r=0;r<16;++r)o[d_][r]*=wsf[crow(r,hi)]; } }while(0)
  f32x16 pA0,pA1,pB0,pB1;
  int sl_prev=0,sl_cur=0,sl_next=SLOTK8;
  #define ROT() do{sl_prev=sl_cur;sl_cur=sl_next;sl_next=(sl_next==(NSLOT-1)*SLOTK8)?0:sl_next+SLOTK8;}while(0)
  if(kw){DMA_K(2,2*SLOTK8);}
  WAITB(3,2);
  qkt8(pA0,pA1,kp0,q8,negm);asm volatile("s_nop 15\n\ts_nop 7":"+v"(pA0),"+v"(pA1));CMASK(pA0,pA1,0);
  START(pA0,pA1);
  _Pragma("unroll") for(int r=0;r<16;++r)pA1[r]=__builtin_amdgcn_exp2f(pA1[r]);
  WAIT_BAR(0);
  if(kw){DMA_K(3,0);} DMA_V(1,SLOTK8);
  ROT();
  kf8[0]=kfrag8(kp0+sl_cur); kf8[1]=kfrag8(kp0+sl_cur+512);
  WAITB(2,1);
  v2i32_t vA0,vA1,vA2,vA3,vB0,vB1,vB2,vB3; v8i32_t pw8=v8i32_t{};
  v8i32_t ones8; { int o1_; asm volatile("v_mov_b32 %0, 0x38383838":"=v"(o1_)); ones8=(v8i32_t){o1_,o1_,o1_,o1_,o1_,o1_,o1_,o1_}; } f32x16 ls; _Pragma("unroll") for(int r=0;r<16;++r)ls[r]=zf_;
  #define PK4(P,B) __builtin_amdgcn_cvt_pk_bf8_f32(P[B+2],P[B+3],__builtin_amdgcn_cvt_pk_bf8_f32(P[B],P[B+1],0,false),true)
  #define PK4I(D,P,B) do{ D=__builtin_amdgcn_cvt_pk_bf8_f32(P[B],P[B+1],D,false); D=__builtin_amdgcn_cvt_pk_bf8_f32(P[B+2],P[B+3],D,true); }while(0)
  #define MFMAP(a,b,c) __builtin_amdgcn_mfma_scale_f32_32x32x64_f8f6f4(a,b,c,1,0,0,0,0,0)
  #define VT8(p) __builtin_amdgcn_ds_read_tr8_b64_v2i32((__attribute__((address_space(3))) v2i32_t*)(p))
  #define V8A() (v8i32_t){vA0[0],vA0[1],vA1[0],vA1[1],vA2[0],vA2[1],vA3[0],vA3[1]}
  #define V8B() (v8i32_t){vB0[0],vB0[1],vB1[0],vB1[1],vB2[0],vB2[1],vB3[0],vB3[1]}
  #define RDA(vp) do{ const lds_cptr p_=(vp)+2*sl_prev; vA0=VT8(p_); vA1=VT8(p_+2048); vA2=VT8(p_+4096); vA3=VT8(p_+6144); }while(0)
  #define RDB(vp) do{ const lds_cptr p_=(vp)+2*sl_prev; vB0=VT8(p_); vB1=VT8(p_+2048); vB2=VT8(p_+4096); vB3=VT8(p_+6144); }while(0)
  #define PIN(x) asm volatile("":"+v"(x))
  #define MX3(a,b,c) __builtin_fmaxf(__builtin_fmaxf((a),(b)),(c))
  #define EX(v) __builtin_amdgcn_exp2f(v)
  #define EX4(X,B) do{ X[B]=EX(X[B]); X[B+1]=EX(X[B+1]); X[B+2]=EX(X[B+2]); X[B+3]=EX(X[B+3]); PIN(X); SBAR(); }while(0)
  #define KRD(G,j) do{ if(G){ kf8[j]=kfrag8(kp0+sl_next+(j)*512); SBAR(); } }while(0)
  #define STEP(C0,C1,P0,P1,t,GK,GV,GL) do{ SBAR(); \
    { const lds_cptr p_=vp0_+2*sl_prev; vA0=VT8(p_); vA1=VT8(p_+2048); } SBAR(); \
    C0=MFMA8(kf8[0],q8,negm); \
    PK4I(pw8[0],P0,0); PK4I(pw8[1],P0,4); PIN(pw8); SBAR(); \
    { const lds_cptr p_=vp0_+2*sl_prev; vA2=VT8(p_+4096); vA3=VT8(p_+6144); } SBAR(); \
    PK4I(pw8[2],P0,8); PK4I(pw8[3],P0,12); PIN(pw8); SBAR(); \
    { const lds_cptr p_=vp1_+2*sl_prev; vB0=VT8(p_); vB1=VT8(p_+2048); } SBAR(); \
    C1=MFMA8(kf8[1],q8,negm); \
    PK4I(pw8[4],P1,0); PK4I(pw8[5],P1,4); PIN(pw8); SBAR(); \
    { const lds_cptr p_=vp1_+2*sl_prev; vB2=VT8(p_+4096); vB3=VT8(p_+6144); } SBAR(); \
    PK4I(pw8[6],P1,8); PK4I(pw8[7],P1,12); PIN(pw8); SBAR(); \
    if(GK){ if(kw){DMA_K((t)+3,sl_cur);} } if(GV){DMA_V((t)+1,sl_next);} \
    CMASK(C0,C1,t); \
    SBAR(); \
    ls=MFMAP(pw8,ones8,ls); o[0]=MFMAP(pw8,V8A(),o[0]); SBAR(); RDA(vp2_); SBAR(); EX4(C0,0); EX4(C0,4); \
    o[1]=MFMAP(pw8,V8B(),o[1]); SBAR(); RDB(vp3_); SBAR(); EX4(C0,8); EX4(C0,12); \
    KRD(GL,0); \
    o[2]=MFMAP(pw8,V8A(),o[2]); SBAR(); EX4(C1,0); EX4(C1,4); \
    KRD(GL,1); \
    o[3]=MFMAP(pw8,V8B(),o[3]); SBAR(); EX4(C1,8); EX4(C1,12); \
    }while(0)
  int t=1;
  for(;t+5<NT;t+=2){
    STEP(pB0,pB1,pA0,pA1,t,true,true,true);     WAITB(2,1); RESC(); ROT();
    STEP(pA0,pA1,pB0,pB1,t+1,true,true,true);   WAITB(2,1); RESC(); ROT();
  }
  #define ENDW(tt) do{ if((tt)+3<NT){WAITB(2,1);} else if((tt)+2<NT){WAIT_BAR(1);} else {WAIT_BAR(0);} }while(0)
  for(;t+1<NT;t+=2){
    STEP(pB0,pB1,pA0,pA1,t,(t+3<NT),(t+1<NT),(t+1<NT));       ENDW(t);   RESC(); ROT();
    STEP(pA0,pA1,pB0,pB1,t+1,(t+4<NT),(t+2<NT),(t+2<NT));     ENDW(t+1); RESC(); ROT();
  }
  STEP(pB0,pB1,pA0,pA1,NT-1,false,false,false); RESC();
  {
    pw8=(v8i32_t){PK4(pB0,0),PK4(pB0,4),PK4(pB0,8),PK4(pB0,12),PK4(pB1,0),PK4(pB1,4),PK4(pB1,8),PK4(pB1,12)};
    const int sl_keep=sl_prev; sl_prev=sl_cur;
    RDA(vp0_); RDB(vp1_); SBAR(); ls=MFMAP(pw8,ones8,ls); o[0]=MFMAP(pw8,V8A(),o[0]); o[1]=MFMAP(pw8,V8B(),o[1]); SBAR();
    RDA(vp2_); RDB(vp3_); SBAR(); o[2]=MFMAP(pw8,V8A(),o[2]); o[3]=MFMAP(pw8,V8B(),o[3]); sl_prev=sl_keep; }
  #undef PK4
  #undef PK4I
  #undef MFMAP
  #undef VT8
  #undef V8A
  #undef V8B
  #undef RDA
  #undef RDB
  #undef PIN
  #undef MX3
  #undef EX
  #undef EX4
  #undef KRD
  #undef STEP
  #undef ENDW
  {auto rr=__builtin_amdgcn_permlane32_swap(__float_as_uint(l_reg),__float_as_uint(l_reg),false,false);l_reg=__uint_as_float(rr[0])+__uint_as_float(rr[1]);}
  const int lane_e=lane_id_asm(),r32e=lane_e&31,hie=lane_e>>5;
  { float nz_=0.f; _Pragma("unroll") for(int d_=0;d_<4;++d_) _Pragma("unroll") for(int r=0;r<16;++r)nz_=__builtin_fmaf(o[d_][r],0.0f,nz_);     float lmin_=ls[0]; _Pragma("unroll") for(int r=1;r<16;++r)lmin_=__builtin_fminf(lmin_,ls[r]); const bool badl=!(nz_==0.0f)||!(lmin_>=LMIN); const int lf_=lane_id_asm(); if(__any(badl)&&lf_==0)((volatile float*)(shm+L9B_FLAG))[wid]=1.0f; else if(lf_==0)((volatile float*)(shm+L9B_FLAG))[wid]=0.0f; }
  if(hie==0)wsf[32+r32e]=l_reg;asm volatile("s_waitcnt lgkmcnt(0)":::"memory");
  float rli[16];
  #pragma unroll
  for(int r=0;r<16;++r)rli[r]=__builtin_amdgcn_rcpf(ls[r]);
  float*st=stash+(size_t)wid*4096+lane_e*4;
  if(cpass==0){
    #pragma unroll
    for(int d0=0;d0<4;++d0)
      #pragma unroll
      for(int q4=0;q4<4;++q4){ typedef float f32x4_t __attribute__((ext_vector_type(4)));
        const f32x4_t v={o[d0][4*q4]*rli[4*q4],o[d0][4*q4+1]*rli[4*q4+1],o[d0][4*q4+2]*rli[4*q4+2],o[d0][4*q4+3]*rli[4*q4+3]};
        *(f32x4_t*)(st+(d0*4+q4)*256)=v; }
  } else {
    typedef float f32x4_t __attribute__((ext_vector_type(4)));
    float ss[16];
    #pragma unroll
    for(int r=0;r<16;++r)ss[r]=0.f;
    #pragma unroll
    for(int d0=0;d0<4;++d0)
      #pragma unroll
      for(int q4=0;q4<4;++q4){ const f32x4_t a=*(const f32x4_t*)(st+(d0*4+q4)*256);
        #pragma unroll
        for(int i=0;i<4;++i){ const int r=4*q4+i; const float v=a[i]-lam*(o[d0][r]*rli[r]); o[d0][r]=v; ss[r]+=v*v; } if(q4==3)asm volatile("":::"memory"); }
    #pragma unroll
    for(int r=0;r<16;++r){ float s=ss[r]; s+=__shfl_xor(s,1); s+=__shfl_xor(s,2); s+=__shfl_xor(s,4); s+=__shfl_xor(s,8); s+=__shfl_xor(s,16); ss[r]=0.8f/sqrtf(s*(1.0f/128.0f)+1e-6f); }
    float gsub[4];
    #pragma unroll
    for(int d0=0;d0<4;++d0)gsub[d0]=subg[d0*32+r32e];
    asm volatile("s_waitcnt lgkmcnt(0)\n\ts_barrier":::"memory");
    bf16*Ow=Ou+(long)(wid*QBLK)*opitch;
    bf16*stg=(bf16*)shm+wid*4096;
    #pragma unroll
    for(int r=0;r<16;++r){const int orow=crow(r,hie);
      #pragma unroll
      for(int d0=0;d0<4;++d0)stg[orow*128+d0*32+r32e]=__float2bfloat16(o[d0][r]*ss[r]*gsub[d0]);}
    asm volatile("s_waitcnt lgkmcnt(0)":::"memory");
    #pragma unroll
    for(int i=0;i<8;++i){const int row=i*4+(lane_e>>4),ch=lane_e&15; const u32x4 v=*(const u32x4*)(stg+row*128+ch*8); ATTN_STORE16(Ow+(long)row*opitch+ch*8,v);}
  }
  asm volatile("s_waitcnt lgkmcnt(0)\n\ts_barrier":::"memory");
  { const float*fl_=(const float*)(shm+L9B_FLAG); float fs_=0.f; _Pragma("unroll") for(int w_=0;w_<NW;++w_)fs_+=fl_[w_]; bad_any=bad_any||(__builtin_amdgcn_readfirstlane(__float_as_uint(fs_))!=0u); }
 }
  return bad_any;
  #undef DMA_K
  #undef DMA_V
  #undef WAITB
  #undef CMASK
  #undef START
  #undef RESC
  #undef ROT
}
constexpr int ATTN_LDS_BYTES=LDS_BYTES;
#undef SBAR
#undef WAIT_BAR
}
#define GAS __attribute__((address_space(1)))
#define LAS __attribute__((address_space(3)))
typedef unsigned short bf16;
typedef unsigned v4u __attribute__((ext_vector_type(4)));
typedef float f32x4 __attribute__((ext_vector_type(4)));
typedef short bf16x8 __attribute__((ext_vector_type(8)));
typedef GAS unsigned gu32;
typedef GAS unsigned long long gu64;
#define RLX_AGENT __ATOMIC_RELAXED, __HIP_MEMORY_SCOPE_AGENT
#define LDS_WAIT() asm volatile("s_waitcnt lgkmcnt(0)" ::: "memory")
#define VM_WAIT() asm volatile("s_waitcnt vmcnt(0)" ::: "memory")
__device__ __forceinline__ unsigned long long rt() { return __builtin_amdgcn_s_memrealtime(); }
__device__ __forceinline__ unsigned f2bf(float f) { unsigned u = __builtin_bit_cast(unsigned, f); return (u + 0x7fffu + ((u >> 16) & 1u)) >> 16; }
__device__ __forceinline__ unsigned pk2(float lo, float hi) { return f2bf(lo) | (f2bf(hi) << 16); }

#define XB_TMO      128
#define XB_XCNT(j)  (256  + 64 * (j))
#define XB_XSUB(j)  (1280 + 64 * (j))
#define XB_XGEN(j)  (2304 + 64 * (j))
#define XB_TOP      3328
#define XB_TOPGEN   3392
#define XCD_BAR_WORDS 3456
#define XB_SPIN_CAP (1u << 18)

__device__ __forceinline__ unsigned xb_ld(unsigned* p)              { return __hip_atomic_load(p, __ATOMIC_RELAXED, __HIP_MEMORY_SCOPE_AGENT); }
__device__ __forceinline__ unsigned xb_add(unsigned* p, unsigned v) { return __hip_atomic_fetch_add(p, v, __ATOMIC_RELAXED, __HIP_MEMORY_SCOPE_AGENT); }
__device__ __forceinline__ unsigned xb_xcc_id() { return (unsigned)__builtin_amdgcn_s_getreg((3 << 11) | 20) & 0xFu; }
#define XB_SPIN(cond, bar) do { unsigned _sp = 0; while (cond) { __builtin_amdgcn_s_sleep(1); \
    if ((++_sp & 255u) == 0u) { if (xb_ld(&(bar)[XB_TMO])) break; if (_sp > XB_SPIN_CAP) { atomicAdd(&(bar)[XB_TMO], 1u); break; } } } } while (0)

struct XcdBarrier {
    unsigned* bar; unsigned x;
    int wv;
    volatile LAS unsigned* st;
};

__device__ __forceinline__ XcdBarrier xcd_barrier_post(unsigned* bar, volatile LAS unsigned* st) {
    XcdBarrier b; b.bar = bar; b.x = xb_xcc_id(); b.st = st; b.wv = __builtin_amdgcn_readfirstlane(threadIdx.x >> 6);
    if (threadIdx.x == 0) (void)xb_add(&bar[XB_XCNT(b.x)], 1u);
    return b;
}
__device__ __forceinline__ void xcd_barrier_complete(unsigned* bar, unsigned x, unsigned& nloc, unsigned& nx) {
    const unsigned G = gridDim.x * gridDim.y * gridDim.z;
    unsigned sum, cnt, mine, sp = 0u;
    for (;;) {
        sum = 0u; cnt = 0u; mine = 0u;
#pragma unroll
        for (unsigned j = 0; j < 16; ++j) { const unsigned c = xb_ld(&bar[XB_XCNT(j)]); sum += c; cnt += (c > 0u) ? 1u : 0u; mine = (j == x) ? c : mine; }
        if (sum == G) break;
        __builtin_amdgcn_s_sleep(1);
        if ((++sp & 255u) == 0u) { if (xb_ld(&bar[XB_TMO])) break; if (sp > XB_SPIN_CAP) { atomicAdd(&bar[XB_TMO], 1u); break; } }
    }
    nloc = mine > 0u ? mine : 1u; nx = cnt > 0u ? cnt : 1u;
}

__device__ __forceinline__ void xcd_barrier(const XcdBarrier& b) {
    asm volatile("s_waitcnt vmcnt(0)" ::: "memory");
    __syncthreads();
    if (b.wv == 0 && lane_id_asm() == 0) {
        unsigned* bar = b.bar;
        __builtin_amdgcn_s_waitcnt(0);
        unsigned nloc = b.st[0], nx = b.st[1];
        if (nloc == 0u) { xcd_barrier_complete(bar, b.x, nloc, nx); b.st[0] = nloc; b.st[1] = nx; }
        const unsigned old = xb_add(&bar[XB_XSUB(b.x)], 1u);
        const unsigned gen = old / nloc;
        if (old + 1u == (gen + 1u) * nloc) {
            __builtin_amdgcn_fence(__ATOMIC_RELEASE, "agent");
            asm volatile("s_waitcnt vmcnt(0)" ::: "memory");
            const unsigned og = xb_add(&bar[XB_TOP], 1u);
            const unsigned tg = og / nx;
            if (og + 1u == (tg + 1u) * nx) xb_add(&bar[XB_TOPGEN], 1u);
            else XB_SPIN(xb_ld(&bar[XB_TOPGEN]) == tg, bar);
            __builtin_amdgcn_fence(__ATOMIC_ACQUIRE, "agent");
            xb_add(&bar[XB_XGEN(b.x)], 1u);
            asm volatile("s_waitcnt vmcnt(0)" ::: "memory");
        } else {
            XB_SPIN(xb_ld(&bar[XB_XGEN(b.x)]) == gen, bar);
            __builtin_amdgcn_fence(__ATOMIC_ACQUIRE, "agent");
            asm volatile("s_waitcnt vmcnt(0)" ::: "memory");
        }
    }
    __syncthreads();
}
__device__ __forceinline__ float wave_sum(float v) {
#pragma unroll
    for (int o = 1; o < 64; o <<= 1) v += __shfl_xor(v, o);
    return v;
}
constexpr int NWAVES = 8;
#ifndef MK_PER_PHASE
#define MK_PER_PHASE 0
#endif
constexpr int NPH = 10;
constexpr int DM_ = 1024, NB_ = 2, T_ = 8192, CTXL = 256, KEYS = CTXL + T_  , MROWS = NB_ * KEYS  , NTOK = NB_ * T_, QKVC = 2304, NE = 32, NMOD = 6 * DM_;
constexpr int SORT_ROWS = NTOK * 4 + NE * 256;
constexpr size_t MiB = 1u << 20;
constexpr size_t WS_CTL = 0, CTL_ZERO_BYTES = 64 * 1024;
constexpr size_t WS_MOD = 1 * MiB;
constexpr size_t WS_ROPE = WS_MOD + 3 * NMOD * 4;
constexpr size_t WS_SE = 2 * MiB;
constexpr size_t WS_SP = WS_SE + (size_t)NTOK * 4 * 4;
constexpr size_t WS_LTOK = 3 * MiB;
constexpr size_t WS_LGATE = 5 * MiB;
constexpr size_t WS_WQKV = 8 * MiB;
constexpr size_t WS_CB = 1 * MiB + 128 * 1024;
constexpr size_t WS_WO = 669 * MiB;
constexpr size_t WS_WIN = 16 * MiB;
constexpr size_t WS_WOUT = 144 * MiB;
constexpr size_t WS_XN = 208 * MiB;
constexpr size_t WS_QKV = 242 * MiB;
constexpr size_t WS_DT = 317 * MiB;
constexpr size_t WS_MIX = 349 * MiB;
constexpr size_t WS_ACT = 381 * MiB;
constexpr size_t WS_Y = 525 * MiB;
constexpr size_t WS_QK8 = 671 * MiB;
constexpr size_t WS_V8 = 96 * MiB;
constexpr size_t WS_END = 699 * MiB;
static_assert(WS_XN + (size_t)MROWS * 1024 * 2 <= WS_QKV && WS_QKV + (size_t)MROWS * QKVC * 2 <= WS_DT && WS_ACT + (size_t)SORT_ROWS * 1024 * 2 <= WS_Y && WS_Y + (size_t)SORT_ROWS * 1024 * 2 <= WS_END, "d_ws map");
constexpr int CW_CNT = 64;
constexpr int CW_NMAX = 128;
static_assert(true, ""); constexpr int CW_BAR = 4096;
constexpr int RING_OFF = 0, RING_BYTES = 131072;
constexpr int LDSCTL_OFF = RING_BYTES, MISC_OFF = LDSCTL_OFF + 320;
constexpr int IDBUF_OFF = RING_BYTES + 1024;
constexpr int TP_OFF = RING_BYTES + 9216;
constexpr int TE_OFF = TP_OFF + 256;
constexpr int XSCR_OFF = RING_BYTES + 10240;
constexpr int LDS_BYTES = 147456;
static_assert(XSCR_OFF + 4096 <= LDS_BYTES, "LDS map");

struct Frame {
    LAS unsigned char* lds; volatile LAS unsigned* MISC; gu32* ctl;
    int wave, vcu, G;
    const float* in[21]; float* out; unsigned char* ws;
};
__device__ __forceinline__ void build_tp(Frame& F) {
    LAS int* tp = (LAS int*)(F.lds + TP_OFF); const int lane = lane_id_asm();
    __syncthreads();
    if (F.wave == 0) {
        const int t = lane < NE ? (((int)__hip_atomic_load(F.ctl + CW_CNT + lane, RLX_AGENT) + 255) >> 8) : 0; int s = t;
#pragma unroll
        for (int o = 1; o < 32; o <<= 1) { const int u = __shfl_up(s, o); if (lane >= o) s += u; }
        if (lane < NE) { tp[lane] = s - t; LAS unsigned char* te = (LAS unsigned char*)(F.lds + TE_OFF); for (int g_ = s - t; g_ < s; ++g_) te[g_] = (unsigned char)lane; }
        if (lane == NE - 1) tp[NE] = s;
    }
    __syncthreads();
}
__device__ __forceinline__ void transpose_item(const float* W, int K, int N, bf16* WT, int k0, int n0, int wt_row0, LAS float* scr, int lane) {
    float t_[32];
#pragma unroll
    for (int i = 0; i < 32; ++i) t_[i] = W[(size_t)(k0 + 2 * i + (lane >> 5)) * N + n0 + (lane & 31)];
#pragma unroll
    for (int i = 0; i < 32; ++i) scr[(2 * i + (lane >> 5)) * 33 + (lane & 31)] = t_[i];
    LDS_WAIT(); asm volatile("" ::: "memory");
    const int c = lane & 7;
#pragma unroll
    for (int j = 0; j < 4; ++j) { const int n = (lane >> 3) + 8 * j; const LAS float* s = scr + (8 * c) * 33 + n;
        v4u o; o.x = pk2(s[0 * 33], s[1 * 33]); o.y = pk2(s[2 * 33], s[3 * 33]); o.z = pk2(s[4 * 33], s[5 * 33]); o.w = pk2(s[6 * 33], s[7 * 33]);
        *(GAS v4u*)(WT + (size_t)(wt_row0 + n) * K + k0 + 8 * c) = o; }
    LDS_WAIT(); asm volatile("" ::: "memory");
}
__device__ __forceinline__ void transpose_item_f8(const float* W, int K, int N, unsigned char* WT, int k0, int n0, int wt_row0, LAS float* scr, int lane, const float* kmul = nullptr, const float* kadd1 = nullptr, bool qmap = false) {
    float t_[32];
#pragma unroll
    for (int i = 0; i < 32; ++i) t_[i] = W[(size_t)(k0 + 2 * i + (lane >> 5)) * N + n0 + (lane & 31)];
    if (kmul) {
#pragma unroll
        for (int i = 0; i < 32; ++i) { const int k = k0 + 2 * i + (lane >> 5); t_[i] *= kmul[k] * (1.0f + kadd1[k]); } }
#pragma unroll
    for (int i = 0; i < 32; ++i) scr[(2 * i + (lane >> 5)) * 33 + (lane & 31)] = t_[i];
    LDS_WAIT(); asm volatile("" ::: "memory");
    const int c = lane & 3;
#pragma unroll
    for (int j = 0; j < 2; ++j) { const int n = (lane >> 2) + 16 * j; const LAS float* s = scr + (16 * c) * 33 + n;
        const int wrow = qmap ? wt_row0 + 128 * (n >> 4) + 16 * ((n & 7) >> 2) + 4 * ((n >> 3) & 1) + (n & 3) : wt_row0 + n;
        v4u o; o.x = pg8::pk4_fp8(s[0 * 33] * pg8::W8_SCALE, s[1 * 33] * pg8::W8_SCALE, s[2 * 33] * pg8::W8_SCALE, s[3 * 33] * pg8::W8_SCALE); o.y = pg8::pk4_fp8(s[4 * 33] * pg8::W8_SCALE, s[5 * 33] * pg8::W8_SCALE, s[6 * 33] * pg8::W8_SCALE, s[7 * 33] * pg8::W8_SCALE);
        o.z = pg8::pk4_fp8(s[8 * 33] * pg8::W8_SCALE, s[9 * 33] * pg8::W8_SCALE, s[10 * 33] * pg8::W8_SCALE, s[11 * 33] * pg8::W8_SCALE); o.w = pg8::pk4_fp8(s[12 * 33] * pg8::W8_SCALE, s[13 * 33] * pg8::W8_SCALE, s[14 * 33] * pg8::W8_SCALE, s[15 * 33] * pg8::W8_SCALE);
        *(GAS v4u*)(WT + (size_t)wrow * K + k0 + 16 * c) = o; }
    LDS_WAIT(); asm volatile("" ::: "memory");
}
constexpr int I_QKV = 16 * 72, I_WO = 16 * 32, I_IN = 16 * 64, I_OUT = 16 * 32;
constexpr int CONV_DENSE = I_WO, CONV_ALL = I_WO + NE * I_IN + NE * I_OUT;
__device__ __forceinline__ void conv_items(Frame& F, int first, int count, LAS float* scr, int lane) {
    const int gw = F.vcu * NWAVES + F.wave, NGW = F.G * NWAVES;
    for (int it = first + gw; it < first + count; it += NGW) {
        int r = it;
        if (r < I_WO) { const int kb = r / 32, nb = r % 32; transpose_item(F.in[12], DM_, DM_, (bf16*)(F.ws + WS_WO), 64 * kb, 32 * nb, 32 * nb, scr, lane); continue; } r -= I_WO;
        if (r < NE * I_IN) { const int e = r / I_IN, q = r % I_IN, kb = q / 64, nb = q % 64; const int grp = nb < 32 ? ((nb >> 2) * 8 + (nb & 3)) : (((nb - 32) >> 2) * 8 + 4 + ((nb - 32) & 3));
            transpose_item_f8(F.in[16] + (size_t)e * DM_ * 2048, DM_, 2048, F.ws + WS_WIN + (size_t)e * 2048 * DM_, 64 * kb, 32 * nb, 32 * grp, scr, lane); continue; } r -= NE * I_IN;
        { const int e = r / I_OUT, q = r % I_OUT, kb = q / 32, nb = q % 32;
            transpose_item_f8(F.in[18] + (size_t)e * DM_ * DM_, DM_, DM_, F.ws + WS_WOUT + (size_t)e * DM_ * DM_, 64 * kb, 32 * nb, 32 * nb, scr, lane); }
    }
}
__device__ __forceinline__ void cx_desc(const Frame& F, int it, const float*& src, int& N, unsigned char*& dst) {
    int r = it - I_WO;
    if (r < NE * I_IN) { const int e = r / I_IN, q = r % I_IN, kb = q / 64, nb = q % 64; const int grp = nb < 32 ? ((nb >> 2) * 8 + (nb & 3)) : (((nb - 32) >> 2) * 8 + 4 + ((nb - 32) & 3));
        N = 2048; src = F.in[16] + (size_t)e * DM_ * 2048 + (size_t)(64 * kb) * 2048 + 32 * nb; dst = F.ws + WS_WIN + (size_t)e * 2048 * DM_ + (size_t)(32 * grp) * DM_ + 64 * kb; }
    else { r -= NE * I_IN; const int e = r / I_OUT, q = r % I_OUT, kb = q / 32, nb = q % 32;
        N = DM_; src = F.in[18] + (size_t)e * DM_ * DM_ + (size_t)(64 * kb) * DM_ + 32 * nb; dst = F.ws + WS_WOUT + (size_t)e * DM_ * DM_ + (size_t)(32 * nb) * DM_ + 64 * kb; }
}
__device__ __forceinline__ void cx_ld(const Frame& F, int it, int lane, float (&t_)[32]) {
    const float* src; int N; unsigned char* dst; cx_desc(F, it, src, N, dst);
    const float* p = src + (size_t)(lane >> 5) * N + (lane & 31);
#pragma unroll
    for (int i = 0; i < 32; ++i) t_[i] = p[(size_t)(2 * i) * N];
}
__device__ __forceinline__ void cx_st(const Frame& F, int it, int lane, const float (&t_)[32], LAS float* scr) {
    const float* src; int N; unsigned char* dst; cx_desc(F, it, src, N, dst);
#pragma unroll
    for (int i = 0; i < 32; ++i) scr[(2 * i + (lane >> 5)) * 33 + (lane & 31)] = t_[i];
    LDS_WAIT(); asm volatile("" ::: "memory");
    const int c = lane & 3;
#pragma unroll
    for (int j = 0; j < 2; ++j) { const int n = (lane >> 2) + 16 * j; const LAS float* s = scr + (16 * c) * 33 + n;
        v4u o; o.x = pg8::pk4_fp8(s[0 * 33] * pg8::W8_SCALE, s[1 * 33] * pg8::W8_SCALE, s[2 * 33] * pg8::W8_SCALE, s[3 * 33] * pg8::W8_SCALE); o.y = pg8::pk4_fp8(s[4 * 33] * pg8::W8_SCALE, s[5 * 33] * pg8::W8_SCALE, s[6 * 33] * pg8::W8_SCALE, s[7 * 33] * pg8::W8_SCALE);
        o.z = pg8::pk4_fp8(s[8 * 33] * pg8::W8_SCALE, s[9 * 33] * pg8::W8_SCALE, s[10 * 33] * pg8::W8_SCALE, s[11 * 33] * pg8::W8_SCALE); o.w = pg8::pk4_fp8(s[12 * 33] * pg8::W8_SCALE, s[13 * 33] * pg8::W8_SCALE, s[14 * 33] * pg8::W8_SCALE, s[15 * 33] * pg8::W8_SCALE);
        *(GAS v4u*)(dst + (size_t)n * DM_ + 16 * c) = o; }
    LDS_WAIT(); asm volatile("" ::: "memory");
}
__device__ __forceinline__ void conv_experts(Frame& F, LAS float* scr, int lane) {
    const int cvu = (F.G % 8 == 0) ? ((F.vcu & ~7) | ((F.vcu + (F.vcu >> 3)) & 7)) : F.vcu;
    const int gw = cvu * NWAVES + F.wave, NGW = F.G * NWAVES, end = CONV_ALL;
    int it = CONV_DENSE + gw;
    float A_[32], B_[32], C_[32];
    if (it + 2 * NGW < end) {
        cx_ld(F, it, lane, A_); cx_ld(F, it + NGW, lane, B_);
        while (it + 4 * NGW < end) {
            cx_ld(F, it + 2 * NGW, lane, C_); cx_st(F, it, lane, A_, scr);
            cx_ld(F, it + 3 * NGW, lane, A_); cx_st(F, it + NGW, lane, B_, scr);
            cx_ld(F, it + 4 * NGW, lane, B_); cx_st(F, it + 2 * NGW, lane, C_, scr);
            it += 3 * NGW;
        }
        cx_st(F, it, lane, A_, scr); cx_st(F, it + NGW, lane, B_, scr); it += 2 * NGW;
    }
    for (; it < end; it += NGW) { cx_ld(F, it, lane, A_); cx_st(F, it, lane, A_, scr); }
}
__device__ __forceinline__ void p0_prologue(Frame& F) {
    const float* c = F.in[1]; const float* cctx = F.in[3]; const float* w_ada = F.in[4]; const float* b_ada = F.in[5];
    float* mod = (float*)(F.ws + WS_MOD); float* rope = (float*)(F.ws + WS_ROPE);
    LAS float* scr = (LAS float*)(F.lds + RING_OFF + F.wave * 16384);
    const int lane = lane_id_asm(), w = F.wave, tid = w * 64 + lane;
    for (int cg = F.vcu; cg < 192; cg += F.G) {
        for (int i = lane; i < 384; i += 64) { const int v = i >> 7, kk = i & 127; const float s = (v < 2 ? c[v * DM_ + 128 * w + kk] : cctx[128 * w + kk]); scr[i] = s / (1.0f + expf(-s)); }
        LDS_WAIT(); asm volatile("" ::: "memory");
        const int kh = lane >> 5, col = 32 * cg + (lane & 31); float a0 = 0.f, a1 = 0.f, a2 = 0.f;
        float wl_[64];
#pragma unroll
        for (int j = 0; j < 64; ++j) wl_[j] = w_ada[(size_t)(128 * w + 2 * j + kh) * NMOD + col];
#pragma unroll
        for (int j = 0; j < 64; ++j) { const int kk = 2 * j + kh; a0 += scr[kk] * wl_[j]; a1 += scr[128 + kk] * wl_[j]; a2 += scr[256 + kk] * wl_[j]; }
        a0 += __shfl_xor(a0, 32); a1 += __shfl_xor(a1, 32); a2 += __shfl_xor(a2, 32);
        LAS float* xs = (LAS float*)(F.lds + XSCR_OFF);
        if (lane < 32) { xs[w * 96 + lane] = a0; xs[w * 96 + 32 + lane] = a1; xs[w * 96 + 64 + lane] = a2; }
        __syncthreads();
        if (tid < 96) { float s = 0.f; for (int ww = 0; ww < 8; ++ww) s += xs[ww * 96 + tid]; const int v = tid >> 5, cc = 32 * cg + (tid & 31); mod[v * NMOD + cc] = s + b_ada[cc]; }
        __syncthreads();
    }
    for (int i = F.vcu * 8 + tid; i < 2048 && tid < 8; i += F.G * 8) { const int p = i >> 4, f = i & 15; const float invf = (float)pow(10000.0, -(double)f / 16.0); const float ang = (float)p * invf;
        rope[i] = (float)cos((double)ang); rope[2048 + i] = (float)sin((double)ang); }
    { GAS v4u* lt = (GAS v4u*)(F.ws + WS_LTOK); const int n16 = NE * 16384 * 4 / 16; for (int i = F.vcu * NWAVES * 64 + tid; i < n16; i += F.G * NWAVES * 64) lt[i] = (v4u){0u, 0u, 0u, 0u}; }
    conv_items(F, 0, CONV_DENSE, scr, lane);
}
__device__ __forceinline__ void p0_xhat(Frame& F) {
    const float* x = F.in[0]; const float* ctx = F.in[2]; bf16* XN = (bf16*)(F.ws + WS_XN); const float* g1 = F.in[6]; const float* mod = (const float*)(F.ws + WS_MOD);
    const int gw = F.vcu * NWAVES + F.wave, NGW = F.G * NWAVES, lane = lane_id_asm();
    for (int m0 = gw; m0 < MROWS; m0 += 2 * NGW) {
        f32x4 v[2][4]; int mm[2];
#pragma unroll
        for (int u = 0; u < 2; ++u) { const int m = (m0 + u * NGW < MROWS) ? m0 + u * NGW : m0; mm[u] = m; const int b = m / KEYS, i = m % KEYS;
            const float* src = (i < CTXL) ? ctx + ((size_t)b * CTXL + i) * DM_ : x + ((size_t)b * T_ + (i - CTXL)) * DM_;
            const GAS f32x4* xr = (const GAS f32x4*)src + lane;
#pragma unroll
            for (int j = 0; j < 4; ++j) v[u][j] = xr[64 * j]; }
#pragma unroll
        for (int u = 0; u < 2; ++u) { float s = 0.f;
#pragma unroll
            for (int j = 0; j < 4; ++j) s += (v[u][j].x * v[u][j].x + v[u][j].y * v[u][j].y) + (v[u][j].z * v[u][j].z + v[u][j].w * v[u][j].w);
            const float rstd = 1.0f / sqrtf(wave_sum(s) * (1.0f / DM_) + 1e-6f);
            GAS unsigned* o4 = (GAS unsigned*)((unsigned char*)XN + (size_t)mm[u] * DM_) + lane;
            const float* md = mod + (((mm[u] % KEYS) < CTXL) ? 2 : mm[u] / KEYS) * NMOD;
#pragma unroll
            for (int j = 0; j < 4; ++j) { const int cc = 4 * (lane + 64 * j); const f32x4 o = v[u][j] * rstd * (*(const f32x4*)(g1 + cc) * (*(const f32x4*)(md + DM_ + cc) + 1.0f)) + *(const f32x4*)(md + cc);
                o4[64 * j] = pg8::pk4_fp8(o.x, o.y, o.z, o.w); } }
    }
}
__device__ __forceinline__ void p1_wqkv(Frame& F) {
    const float* w = F.in[7];
    LAS float* scr = (LAS float*)(F.lds + RING_OFF + F.wave * 16384);
    const int lane = lane_id_asm(), wv = F.wave;
    const int gw = F.vcu * NWAVES + wv, NGW = F.G * NWAVES;
    for (int it = gw; it < I_QKV; it += NGW) { const int r = it, kb = r / 72, nb = r % 72, pn = nb >> 3, wc = (nb & 7) >> 1, ax = nb & 1;
        transpose_item_f8(w, DM_, QKVC, F.ws + WS_WQKV, 64 * kb, 32 * nb, 256 * pn + 32 * wc + 8 * ax, scr, lane, nullptr, nullptr, true); }
}
__device__ __forceinline__ float bf2f(unsigned short h) { return __builtin_bit_cast(float, (unsigned)h << 16); }
__device__ __forceinline__ void p3_attention(Frame& F, char* lds) {
    using abf = attn_body::bf16;
    const abf* QKV = (const abf*)(F.ws + WS_QKV); abf* MIX = (abf*)(F.ws + WS_MIX);
    const int ordB = (F.vcu >> 5) & 1; const int v8 = F.vcu & 7; const int cpos = v8 == 0 ? 0 : v8 < 3 ? 1 : v8 < 5 ? 2 : v8 < 7 ? 3 : 4; int pos = 0; bool cdone = false;
    bool fixref; { const int l_ = lane_id_asm(); float gq = fabsf(F.in[8][l_]), gk = fabsf(F.in[9][l_]);
#pragma unroll
        for (int o_ = 1; o_ < 64; o_ <<= 1) { gq = fmaxf(gq, __shfl_xor(gq, o_)); gk = fmaxf(gk, __shfl_xor(gk, o_)); }
        fixref = __builtin_amdgcn_readfirstlane((gq * gk <= 8.0f) ? 1 : 0) != 0; }
#define CONV_AT() do { if (!cdone && pos == cpos) { conv_experts(F, (LAS float*)(F.lds + RING_OFF + F.wave * 16384), lane_id_asm()); __syncthreads(); cdone = true; } ++pos; } while (0)
    CONV_AT();
    const float* lamp = F.in[10];
    float lam; { const int lane = lane_id_asm(); lam = expf(wave_sum(lamp[lane] * lamp[64 + lane])) - expf(wave_sum(lamp[128 + lane] * lamp[192 + lane])) + 0.2f; }
#pragma nounroll
    for (int seg = 0; seg < 2; ++seg) {
      if ((seg == 0) != (ordB != 0)) {
        for (int L = F.vcu; L < 16 * 32; L += F.G) {
            const int run = L >> 5, qb = L & 31, b = run >> 3, h = run & 7;
            const abf* kb = QKV + (size_t)b * KEYS * QKVC;
            const unsigned char* k8 = F.ws + WS_QK8 + (size_t)b * KEYS * 1664;
            if (fixref) attn_body::attn_unit_q8v<8, true>(k8 + (size_t)(CTXL + qb * 256) * 1664 + h * 64, k8 + (8 + (h >> 2)) * 64, F.ws + WS_V8 + (size_t)b * KEYS * 640 + (h >> 2) * 64, MIX + ((size_t)b * T_ + qb * 256) * DM_ + h * 64, DM_, lds, F.wave);
            else attn_body::attn_unit_q8<8, false>(k8 + (size_t)(CTXL + qb * 256) * 1664 + h * 64, k8 + (8 + (h >> 2)) * 64, kb + 640 + (h >> 2) * 64, MIX + ((size_t)b * T_ + qb * 256) * DM_ + h * 64, DM_, lds, F.wave);
            CONV_AT();
        }
      } else {
        for (int L = F.vcu; L < 8 * 32; L += F.G) {
            const int bh = L >> 5, qb = L & 31, b = bh >> 2, h = bh & 3;
            const abf* kb = QKV + (size_t)b * KEYS * QKVC;
            const float nq = fmaxf(__uint_as_float(__hip_atomic_load(F.ctl + CW_NMAX + 12 + 2 * h, RLX_AGENT)), __uint_as_float(__hip_atomic_load(F.ctl + CW_NMAX + 13 + 2 * h, RLX_AGENT)));
            const float nk = fmaxf(__uint_as_float(__hip_atomic_load(F.ctl + CW_NMAX + 20 + 2 * h, RLX_AGENT)), __uint_as_float(__hip_atomic_load(F.ctl + CW_NMAX + 21 + 2 * h, RLX_AGENT)));
            const float bound = sqrtf(nq * nk) * pg8::ATT_C2;
            const float ref8 = fmaxf(0.55f * bound - 15.0f, 0.0f);
            const unsigned char* k8 = F.ws + WS_QK8 + (size_t)b * KEYS * 1664;
#pragma nounroll
            for (int pp = 0; pp < 2; ++pp) {
                const bool redo = attn_body::attn_unit128_q8v<8, true>(k8 + (size_t)(CTXL + qb * 256) * 1664 + (10 + 2 * h) * 64, k8 + (18 + 2 * h) * 64, F.ws + WS_V8 + (size_t)b * KEYS * 640 + 128 + h * 128, MIX + ((size_t)b * T_ + qb * 256) * DM_ + 512 + h * 128, DM_, lds, F.wave,
                                           (float*)(F.ws + WS_DT) + (size_t)F.vcu * 32768, lam, F.in[11], pp, pp + 1, ref8);
                if (redo) attn_body::attn_unit128_q8<8, false>(k8 + (size_t)(CTXL + qb * 256) * 1664 + (10 + 2 * h) * 64, k8 + (18 + 2 * h) * 64, kb + 1792 + h * 128, MIX + ((size_t)b * T_ + qb * 256) * DM_ + 512 + h * 128, DM_, lds, F.wave,
                                           (float*)(F.ws + WS_DT) + (size_t)F.vcu * 32768, lam, F.in[11], pp, pp + 1);
                CONV_AT();
            }
        }
      }
    }
    if (!cdone) { conv_experts(F, (LAS float*)(F.lds + RING_OFF + F.wave * 16384), lane_id_asm()); __syncthreads(); }
#undef CONV_AT
}
__device__ __forceinline__ f32x4 bf4lo(v4u q); __device__ __forceinline__ f32x4 bf4hi(v4u q);
typedef short p6_bf16x8 __attribute__((ext_vector_type(8)));
typedef float p6_f32x16 __attribute__((ext_vector_type(16)));
__device__ __forceinline__ void p6_split8(const float (&v)[8], p6_bf16x8& hi, p6_bf16x8& lo) {
    unsigned h[4], l[4];
#pragma unroll
    for (int j = 0; j < 4; ++j) { h[j] = pg8::cvt_pk_bf16(v[2 * j], v[2 * j + 1]);
        const float r0 = v[2 * j] - __builtin_bit_cast(float, h[j] << 16), r1 = v[2 * j + 1] - __builtin_bit_cast(float, h[j] & 0xffff0000u); l[j] = pg8::cvt_pk_bf16(r0, r1); }
    hi = __builtin_bit_cast(p6_bf16x8, (v4u){h[0], h[1], h[2], h[3]}); lo = __builtin_bit_cast(p6_bf16x8, (v4u){l[0], l[1], l[2], l[3]});
}
__device__ __forceinline__ void p6_preload(Frame& F, p6_bf16x8 (&wh)[8], p6_bf16x8 (&wl)[8]) {
    const float* wr = F.in[14]; const int lane = lane_id_asm(), w = F.wave, e = lane & 31, hh = lane >> 5;
#pragma unroll
    for (int st = 0; st < 8; ++st) { float t[8];
#pragma unroll
        for (int j = 0; j < 8; ++j) t[j] = wr[(size_t)(128 * w + 16 * st + 8 * hh + j) * NE + e];
        p6_split8(t, wh[st], wl[st]); }
}
__device__ __forceinline__ void p6_router(Frame& F, p6_bf16x8 (&wh)[8], p6_bf16x8 (&wl)[8]) {
    const bf16* x1 = (const bf16*)(F.ws + WS_DT); const float* g = F.in[13]; const float* wr = F.in[14]; const float* br = F.in[15]; const float* mod = (const float*)(F.ws + WS_MOD);
    bf16* H2 = (bf16*)(F.ws + WS_XN); int* se = (int*)(F.ws + WS_SE); int* sp = (int*)(F.ws + WS_SP); int* ltok = (int*)(F.ws + WS_LTOK); float* lgate = (float*)(F.ws + WS_LGATE);
    LAS float* rstdb = (LAS float*)(F.lds + RING_OFF);
    LAS float* part = (LAS float*)(F.lds + RING_OFF + 1024);
    LAS float* lgb = (LAS float*)(F.lds + RING_OFF + 1024 + 65536);
    LAS float* selb = (LAS float*)(F.lds + RING_OFF + 1024 + 65536 + 8192);
    LAS unsigned* lcount = (LAS unsigned*)(F.lds + RING_OFF + 1024 + 65536 + 8192 + 1024);
    LAS unsigned* lbase = lcount + 32;
    LAS unsigned* recE = lbase + 32;
    LAS float* recG = (LAS float*)(recE + 256);
    const int lane = lane_id_asm(), w = F.wave, e = lane & 31, hh = lane >> 5, tid = w * 64 + lane;
    const float bre = br[e];
    for (int chunk = F.vcu; chunk < NTOK / 64; chunk += F.G) {
        const int tokc = chunk * 64, b = tokc / T_; const float* md = mod + b * NMOD;
        if (tid < 32) lcount[tid] = 0u;
        { f32x4 ga[4], sh[4];
#pragma unroll
            for (int j = 0; j < 4; ++j) { const int cc = 4 * (lane + 64 * j); ga[j] = *(const f32x4*)(g + cc) * (*(const f32x4*)(md + 4 * DM_ + cc) + 1.0f); sh[j] = *(const f32x4*)(md + 3 * DM_ + cc); }
#pragma unroll 1
            for (int hb = 0; hb < 2; ++hb) { const int tokw = tokc + 8 * w + 4 * hb;
                unsigned long long q_[4][4];
#pragma unroll
                for (int r = 0; r < 4; ++r) { const GAS unsigned long long* xr = (const GAS unsigned long long*)(x1 + (size_t)(tokw + r) * DM_) + lane;
#pragma unroll
                    for (int j = 0; j < 4; ++j) q_[r][j] = xr[64 * j]; }
                float rs_[4];
#pragma unroll
                for (int r = 0; r < 4; ++r) { float s = 0.f;
#pragma unroll
                    for (int j = 0; j < 4; ++j) { const unsigned lo = (unsigned)q_[r][j], hi = (unsigned)(q_[r][j] >> 32); const float a0 = bf2f(lo & 0xffff), a1 = bf2f(lo >> 16), a2 = bf2f(hi & 0xffff), a3 = bf2f(hi >> 16); s += (a0 * a0 + a1 * a1) + (a2 * a2 + a3 * a3); }
                    rs_[r] = 1.0f / sqrtf(wave_sum(s) * (1.0f / DM_) + 1e-6f); }
                if (lane == 0) {
#pragma unroll
                    for (int r = 0; r < 4; ++r) rstdb[8 * w + 4 * hb + r] = rs_[r]; }
#pragma unroll
                for (int r = 0; r < 4; ++r)
#pragma unroll
                    for (int j = 0; j < 4; ++j) { asm volatile("" : "+v"(q_[r][j])); const unsigned lo = (unsigned)q_[r][j], hi = (unsigned)(q_[r][j] >> 32); const f32x4 v = (f32x4){bf2f(lo & 0xffff), bf2f(lo >> 16), bf2f(hi & 0xffff), bf2f(hi >> 16)};
                        const f32x4 o = v * rs_[r] * ga[j] + sh[j];
                        *((GAS unsigned*)((unsigned char*)H2 + (size_t)(tokw + r) * DM_) + lane + 64 * j) = pg8::pk4_fp8(o.x, o.y, o.z, o.w); }
            }
        }
        __syncthreads();
        { p6_f32x16 acc[2]; acc[0] = p6_f32x16{}; acc[1] = p6_f32x16{};
            const float rs0 = rstdb[e], rs1 = rstdb[32 + e];
#pragma unroll
            for (int st = 0; st < 8; ++st) { const int k0 = 128 * w + 16 * st + 8 * hh;
                const f32x4 g0 = *(const f32x4*)(g + k0), g1 = *(const f32x4*)(g + k0 + 4), c0 = *(const f32x4*)(md + 4 * DM_ + k0), c1 = *(const f32x4*)(md + 4 * DM_ + k0 + 4), h0 = *(const f32x4*)(md + 3 * DM_ + k0), h1 = *(const f32x4*)(md + 3 * DM_ + k0 + 4);
                const f32x4 a0 = g0 * (c0 + 1.0f), a1 = g1 * (c1 + 1.0f);
#pragma unroll
                for (int rb = 0; rb < 2; ++rb) { const v4u q = *(const GAS v4u*)(x1 + (size_t)(tokc + 32 * rb + e) * DM_ + k0); const float rs = rb ? rs1 : rs0;
                    const f32x4 xl = bf4lo(q), xh = bf4hi(q); const f32x4 vl = xl * rs * a0 + h0, vh = xh * rs * a1 + h1;
                    const float vv[8] = {vl.x, vl.y, vl.z, vl.w, vh.x, vh.y, vh.z, vh.w}; p6_bf16x8 ahi, alo; p6_split8(vv, ahi, alo);
                    acc[rb] = __builtin_amdgcn_mfma_f32_32x32x16_bf16(ahi, wh[st], acc[rb], 0, 0, 0);
                    acc[rb] = __builtin_amdgcn_mfma_f32_32x32x16_bf16(ahi, wl[st], acc[rb], 0, 0, 0);
                    acc[rb] = __builtin_amdgcn_mfma_f32_32x32x16_bf16(alo, wh[st], acc[rb], 0, 0, 0); } }
#pragma unroll
            for (int rb = 0; rb < 2; ++rb)
#pragma unroll
                for (int r = 0; r < 16; ++r) part[(w * 64 + 32 * rb + (r & 3) + 8 * (r >> 2) + 4 * hh) * 32 + e] = acc[rb][r]; }
        __syncthreads();
        { const int row = tid >> 3, e4 = (tid & 7) * 4; f32x4 sacc = *(const f32x4*)(br + e4);
#pragma unroll
            for (int ww = 0; ww < 8; ++ww) sacc += *(const LAS f32x4*)(part + (ww * 64 + row) * 32 + e4);
            *(LAS f32x4*)(lgb + row * 32 + e4) = sacc; }
        __syncthreads();
#pragma unroll 2
        for (int r = 0; r < 8; ++r) { const int row = 8 * w + r; const float lg = lgb[row * 32 + e];
            int rank = 0;
#pragma unroll
            for (int q = 0; q < 32; ++q) { const float o = lgb[row * 32 + q]; rank += (o > lg || (o == lg && q < e)) ? 1 : 0; }
            if (lane < 32 && rank < 4) selb[row * 4 + rank] = lg;
            LDS_WAIT(); asm volatile("" ::: "memory");
            const float m0 = selb[row * 4], den = 1.0f + expf(selb[row * 4 + 1] - m0) + expf(selb[row * 4 + 2] - m0) + expf(selb[row * 4 + 3] - m0);
            if (lane < 32 && rank < 4) { const unsigned lpos = __hip_atomic_fetch_add(lcount + e, 1u, __ATOMIC_RELAXED, __HIP_MEMORY_SCOPE_WORKGROUP);
                recE[row * 4 + rank] = (unsigned)e | (lpos << 8); recG[row * 4 + rank] = expf(lg - m0) / den; }
        }
        (void)bre;
        __syncthreads();
        if (tid < 32) lbase[tid] = __hip_atomic_fetch_add(F.ctl + CW_CNT + tid, lcount[tid], RLX_AGENT);
        __syncthreads();
        if (tid < 256) { const unsigned rc = recE[tid]; const int ee = (int)(rc & 255u), pos = (int)(lbase[ee] + (rc >> 8)), tok = tokc + (tid >> 2);
            ltok[ee * 16384 + pos] = tok; lgate[ee * 16384 + pos] = recG[tid]; se[tok * 4 + (tid & 3)] = ee; sp[tok * 4 + (tid & 3)] = pos; }
        __syncthreads();
    }
}
__device__ __forceinline__ f32x4 bf4lo(v4u q) { return (f32x4){bf2f(q.x & 0xffff), bf2f(q.x >> 16), bf2f(q.y & 0xffff), bf2f(q.y >> 16)}; }
__device__ __forceinline__ f32x4 bf4hi(v4u q) { return (f32x4){bf2f(q.z & 0xffff), bf2f(q.z >> 16), bf2f(q.w & 0xffff), bf2f(q.w >> 16)}; }
__device__ __forceinline__ f32x4 f8x4(unsigned w) { return (f32x4){__builtin_amdgcn_cvt_f32_fp8((int)w, 0), __builtin_amdgcn_cvt_f32_fp8((int)w, 1), __builtin_amdgcn_cvt_f32_fp8((int)w, 2), __builtin_amdgcn_cvt_f32_fp8((int)w, 3)}; }
__device__ __forceinline__ void p9_final(Frame& F, float* dst) {
    const bf16* xo = (const bf16*)(F.ws + WS_DT); const float* gf = F.in[20]; const float* mod = (const float*)(F.ws + WS_MOD); const unsigned char* Y = F.ws + WS_Y;
    const int* se = (const int*)(F.ws + WS_SE); const int* sp = (const int*)(F.ws + WS_SP); const LAS int* tp = (const LAS int*)(F.lds + TP_OFF);
    const int gw = F.vcu * NWAVES + F.wave, NGW = F.G * NWAVES, lane = lane_id_asm();
    constexpr int NU = 2;
    for (int t0 = gw; t0 < NTOK; t0 += NU * NGW) {
        int tk[NU];
#pragma unroll
        for (int u = 0; u < NU; ++u) tk[u] = (t0 + u * NGW < NTOK) ? t0 + u * NGW : t0;
        int ee[NU][4], pp[NU][4];
#pragma unroll
        for (int u = 0; u < NU; ++u)
#pragma unroll
            for (int k = 0; k < 4; ++k) { ee[u][k] = se[tk[u] * 4 + k]; pp[u][k] = sp[tk[u] * 4 + k]; }
        v4u yq[NU][4]; v4u xq[NU][2];
#pragma unroll
        for (int u = 0; u < NU; ++u) {
#pragma unroll
            for (int k = 0; k < 4; ++k) yq[u][k] = *((const GAS v4u*)(Y + ((size_t)tp[ee[u][k]] * 256 + pp[u][k]) * DM_) + lane);
            const GAS v4u* xr = (const GAS v4u*)(xo + (size_t)tk[u] * DM_) + 2 * lane; xq[u][0] = xr[0]; xq[u][1] = xr[1];
        }
#pragma unroll
        for (int u = 0; u < NU; ++u) {
            const int b = tk[u] / T_; const GAS f32x4* gt2 = (const GAS f32x4*)(mod + b * NMOD + 5 * DM_) + 4 * lane; const GAS f32x4* gfp = (const GAS f32x4*)gf + 4 * lane;
            f32x4 ys[4] = {(f32x4){0.f, 0.f, 0.f, 0.f}, (f32x4){0.f, 0.f, 0.f, 0.f}, (f32x4){0.f, 0.f, 0.f, 0.f}, (f32x4){0.f, 0.f, 0.f, 0.f}};
#pragma unroll
            for (int k = 0; k < 4; ++k) { ys[0] += f8x4(yq[u][k].x); ys[1] += f8x4(yq[u][k].y); ys[2] += f8x4(yq[u][k].z); ys[3] += f8x4(yq[u][k].w); }
            f32x4 v[4]; float s = 0.f;
            v[0] = bf4lo(xq[u][0]) + gt2[0] * ys[0]; v[1] = bf4hi(xq[u][0]) + gt2[1] * ys[1]; v[2] = bf4lo(xq[u][1]) + gt2[2] * ys[2]; v[3] = bf4hi(xq[u][1]) + gt2[3] * ys[3];
#pragma unroll
            for (int j = 0; j < 4; ++j) s += (v[j].x * v[j].x + v[j].y * v[j].y) + (v[j].z * v[j].z + v[j].w * v[j].w);
            const float rstd = 1.0f / sqrtf(wave_sum(s) * (1.0f / DM_) + 1e-6f);
            GAS f32x4* xw = (GAS f32x4*)(dst + (size_t)tk[u] * DM_) + 4 * lane;
            xw[0] = v[0] * rstd * gfp[0]; xw[1] = v[1] * rstd * gfp[1]; xw[2] = v[2] * rstd * gfp[2]; xw[3] = v[3] * rstd * gfp[3];
        }
    }
}

struct Args { const float* in[21]; float* out; unsigned char* ws; int ph_lo, ph_hi; };
__global__ void __launch_bounds__(NWAVES * 64, 2) mk_fwd(Args args) {
    extern __shared__ __attribute__((aligned(16))) unsigned char lds[];
    Frame F;
    F.lds = (LAS unsigned char*)lds; F.MISC = (volatile LAS unsigned*)(F.lds + MISC_OFF);
    F.wave = __builtin_amdgcn_readfirstlane(threadIdx.x >> 6);
    F.G = gridDim.x; { const int bx = blockIdx.x; F.vcu = (F.G % 8 == 0) ? (bx % 8) * (F.G / 8) + bx / 8 : bx; }
#pragma unroll
    for (int i = 0; i < 21; ++i) F.in[i] = args.in[i];
    F.out = args.out; F.ws = args.ws; F.ctl = (gu32*)(args.ws + WS_CTL);
    for (int u = threadIdx.x; u < (LDS_BYTES - LDSCTL_OFF) / 4; u += NWAVES * 64) ((LAS unsigned*)(F.lds + LDSCTL_OFF))[u] = 0u;
    __syncthreads();
    XcdBarrier bar; bar.bar = (unsigned*)(F.ctl + CW_BAR); bar.x = 0; bar.st = nullptr; bar.wv = F.wave;
    if (!MK_PER_PHASE) bar = xcd_barrier_post((unsigned*)(F.ctl + CW_BAR), F.MISC + 8);
    const int lo = args.ph_lo, hi = args.ph_hi;
#define IN(k) (lo <= (k) && (k) < hi)
#define SEAM(k) do { if (IN(k) && IN((k) + 1)) xcd_barrier(bar); } while (0)
#ifndef PROBE_DUP
#define PROBE_DUP 0
#endif
#define REPS(k) for (int rep_ = 0; rep_ < (((PROBE_DUP >> (k)) & 1) ? 2 : 1); ++rep_)
#define DUPBAR(k) do { if (((PROBE_DUP >> (k)) & 1) && rep_ == 0 && !MK_PER_PHASE) xcd_barrier(bar); } while (0)
    bf16* XN = (bf16*)(F.ws + WS_XN);
    if (IN(0)) REPS(0) { p0_prologue(F); p1_wqkv(F); DUPBAR(0); } SEAM(0);
    if (IN(1)) REPS(1) { p0_xhat(F); DUPBAR(1); } SEAM(1);
    if (IN(2)) REPS(2) {
        pg8::Gemm g{XN, (const bf16*)(F.ws + WS_WQKV), MROWS, QKVC, DM_}; pg8::QkvOrder S; S.init(MROWS, QKVC, F.G, (int)blockIdx.x);
        pg8::EpiQkv E{(bf16*)(F.ws + WS_QKV), F.in[8], F.in[9], (const float*)(F.ws + WS_ROPE), (const float*)(F.ws + WS_CB), F.ws + WS_QK8, F.ws + WS_V8, (unsigned*)(F.ctl + CW_NMAX)};
        pg8::gemm_phase<pg8::EpiQkv, pg8::QkvOrder, PG8_ALIGN, PG8_SP2, false, true>(F.lds + RING_OFF, g, S, E, F.wave); DUPBAR(2);
    } SEAM(2);
    if (IN(3)) REPS(3) { p3_attention(F, (char*)lds + RING_OFF); DUPBAR(3); } if (IN(3) && IN(5)) xcd_barrier(bar);
    if (IN(5)) REPS(5) {
        pg8::Gemm g{(const bf16*)(F.ws + WS_MIX), (const bf16*)(F.ws + WS_WO), NTOK, DM_, DM_}; pg8::StaticOrder S; S.init(NTOK, DM_, F.G, (int)blockIdx.x);
        pg8::EpiWo E{F.in[0], (const float*)(F.ws + WS_MOD), (bf16*)(F.ws + WS_DT)};
        pg8::gemm_phase<pg8::EpiWo, pg8::StaticOrder, PG8_ALIGN, PG8_SP2>(F.lds + RING_OFF, g, S, E, F.wave); DUPBAR(5);
    }
    p6_bf16x8 wh6[8], wl6[8]; if (IN(6)) p6_preload(F, wh6, wl6);
    SEAM(5);
    if (IN(6)) REPS(6) { p6_router(F, wh6, wl6); if (((PROBE_DUP >> 6) & 1) && rep_ == 0) { xcd_barrier(bar); if (blockIdx.x == 0 && threadIdx.x < 32) F.ctl[CW_CNT + threadIdx.x] = 0u; xcd_barrier(bar); } } SEAM(6);
    if (IN(7)) REPS(7) {
        build_tp(F);
        pg8::Gemm g{XN, (const bf16*)(F.ws + WS_WIN), 0, 0, DM_}; pg8::MoeOrder S{(const LAS int*)(F.lds + TP_OFF), (const LAS unsigned char*)(F.lds + TE_OFF), 8, F.G, F.vcu};
        pg8::EpiSwiglu E{(bf16*)(F.ws + WS_ACT), F.in[17]};
        pg8::gemm_phase<pg8::EpiSwiglu, pg8::MoeOrder, PG8_ALIGN, PG8_SP2, true, true>(F.lds + RING_OFF, g, S, E, F.wave, (const int*)(F.ws + WS_LTOK), (LAS unsigned*)(F.lds + IDBUF_OFF)); DUPBAR(7);
    } SEAM(7);
    if (IN(8)) REPS(8) {
        build_tp(F);
        pg8::Gemm g{(const bf16*)(F.ws + WS_ACT), (const bf16*)(F.ws + WS_WOUT), 0, 0, DM_}; pg8::MoeOrder S{(const LAS int*)(F.lds + TP_OFF), (const LAS unsigned char*)(F.lds + TE_OFF), 4, F.G, F.vcu};
        pg8::EpiMoeOut E{(bf16*)(F.ws + WS_Y), F.in[19], (const float*)(F.ws + WS_LGATE)};
        pg8::gemm_phase<pg8::EpiMoeOut, pg8::MoeOrder, PG8_ALIGN, PG8_SP2, false, true>(F.lds + RING_OFF, g, S, E, F.wave); DUPBAR(8);
    } SEAM(8);
    if (IN(9)) REPS(9) { build_tp(F); p9_final(F, (((PROBE_DUP >> 9) & 1) && rep_ == 0) ? (float*)(F.ws + WS_ACT) : F.out); DUPBAR(9); }
#undef IN
#undef SEAM
}

extern "C" void kernel_launch(void* const* d_in, const int* in_sizes, int n_in, void* d_out, int out_size, void* d_ws, size_t ws_size, hipStream_t stream) {
    static int grid = 0;
    if (grid == 0) {
        if (n_in != 21 || out_size != NTOK * DM_ || ws_size < WS_END) { fprintf(stderr, "kernel_launch: unexpected shapes (n_in %d, out %d, ws %zu); nothing launched\n", n_in, out_size, ws_size); grid = -1; return; }
        int dev = 0, cus = 0, per_cu = 0;
        if (hipGetDevice(&dev) != hipSuccess || hipDeviceGetAttribute(&cus, hipDeviceAttributeMultiprocessorCount, dev) != hipSuccess) { grid = -1; return; }
        if (hipFuncSetAttribute((const void*)mk_fwd, hipFuncAttributeMaxDynamicSharedMemorySize, LDS_BYTES) != hipSuccess) { fprintf(stderr, "kernel_launch: hipFuncSetAttribute failed\n"); grid = -1; return; }
        if (hipOccupancyMaxActiveBlocksPerMultiprocessor(&per_cu, (const void*)mk_fwd, NWAVES * 64, LDS_BYTES) != hipSuccess || per_cu < 1) { fprintf(stderr, "kernel_launch: occupancy query says %d blocks per CU\n", per_cu); }
        (void)hipGetLastError();
        grid = cus;
    }
    if (grid < 0) return;
    if (hipMemsetAsync((char*)d_ws + WS_CTL, 0, CTL_ZERO_BYTES, stream) != hipSuccess) return;
    Args a{};
    for (int i = 0; i < 21; ++i) a.in[i] = (const float*)d_in[i];
    a.out = (float*)d_out; a.ws = (unsigned char*)d_ws;
#if MK_PER_PHASE
    for (int p = 0; p < NPH; ++p) { a.ph_lo = p; a.ph_hi = p + 1; hipLaunchKernelGGL(mk_fwd, dim3(grid), dim3(NWAVES * 64), LDS_BYTES, stream, a); }
#else
    a.ph_lo = 0; a.ph_hi = NPH; hipLaunchKernelGGL(mk_fwd, dim3(grid), dim3(NWAVES * 64), LDS_BYTES, stream, a);
#endif
}
```

```cpp
#include <hip/hip_runtime.h>
#include <hip/hip_bf16.h>
#include <cstdio>
#include <cstdint>
#include <cmath>
__device__ __forceinline__ int lane_id_asm() { int l; asm volatile("v_mbcnt_lo_u32_b32 %0, -1, 0\n\tv_mbcnt_hi_u32_b32 %0, -1, %0" : "=v"(l)); return l; }
namespace pg8 {
#define PG8_LAS __attribute__((address_space(3)))
typedef unsigned short bf16_t;
typedef short bf16x8 __attribute__((ext_vector_type(8)));
typedef float f32x4 __attribute__((ext_vector_type(4)));
typedef unsigned u32x4 __attribute__((ext_vector_type(4)));
constexpr int BM = 256, BK = 64, HALF = 128, HTB = HALF * BK * 2  , STAGE_BYTES = 8 * HTB, NXCD = 8, WGM = 8;

__host__ __device__ __forceinline__ int lds_byte(int r, int c) { const int st = (r >> 4) * 2 + (c >> 5), rr = r & 15, cc = c & 31, ob = rr * 64 + cc * 2; return st * 1024 + (ob ^ (((ob >> 9) & 1) << 5)); }
__host__ __device__ __forceinline__ void stage_rc(int b, int& R, int& C) { const int st = b / 1024, sb = b % 1024, swz = sb ^ (((sb >> 9) & 1) << 5); R = (st >> 1) * 16 + swz / 64; C = (st & 1) * 32 + (swz % 64) / 2; }
__host__ __device__ __forceinline__ int perm32(int rho) { const int n = rho >> 4, i = rho & 15; return 8 * (i >> 2) + 4 * n + (i & 3); }

struct Unit { int pm, pn, e, mt, pnl, pad_; };
struct Gemm { const bf16_t* A; const bf16_t* Bt; int M, N, K; };

struct StaticOrder {
    int nM, nN, nwg, G, c;
    __host__ __device__ void init(int M, int N, int G_, int c_) { nM = M / BM; nN = N / BM; nwg = nM * nN; G = G_; c = c_; }
    __host__ __device__ bool next(int i, Unit& u) const {
        const long L = (long)i * G + c; if (L >= nwg) return false;
        int wgid = (int)L; { const int q = nwg / NXCD, r = nwg % NXCD, xcd = wgid % NXCD, off = wgid / NXCD; wgid = (xcd < r ? xcd * (q + 1) : r * (q + 1) + (xcd - r) * q) + off; }
        const int nig = WGM * nN, gid = wgid / nig, fm = gid * WGM, gsz = (nM - fm) < WGM ? (nM - fm) : WGM;
        u.pm = fm + ((wgid % nig) % gsz); u.pn = (wgid % nig) / gsz; return true;
    }
    __device__ __forceinline__ void a_ready(const Unit&) const {}
    __device__ __forceinline__ void done(const Unit&) const {}
};

__device__ __forceinline__ unsigned cvt_pk_bf16(float lo, float hi) { unsigned r; asm volatile("v_cvt_pk_bf16_f32 %0, %1, %2" : "=v"(r) : "v"(lo), "v"(hi)); return r; }
typedef float f32x2 __attribute__((ext_vector_type(2)));
typedef unsigned u32x2 __attribute__((ext_vector_type(2)));
typedef int v8i32 __attribute__((ext_vector_type(8)));
typedef int v4i32 __attribute__((ext_vector_type(4)));
__device__ __forceinline__ v8i32 cat8(bf16x8 lo, bf16x8 hi) { const v4i32 a = __builtin_bit_cast(v4i32, lo), b = __builtin_bit_cast(v4i32, hi); return __builtin_shufflevector(a, b, 0, 1, 2, 3, 4, 5, 6, 7); }
__device__ __forceinline__ unsigned pk4_fp8(float a, float b, float c, float d) { int r = __builtin_amdgcn_cvt_pk_fp8_f32(a, b, 0, false); r = __builtin_amdgcn_cvt_pk_fp8_f32(c, d, r, true); return (unsigned)r; }
constexpr float W8_SCALE = 16.0f, W8_INV = 1.0f / 16.0f;
constexpr int QKV_PITCH = 2304;
constexpr float ATT_C2 = 0.125f * 1.4426950408889634f;
constexpr float RMS_EPS = 1e-6f;

struct EpiQkv {
    static constexpr bool PERM = false, AFTER_DRAIN = false;
    bf16_t* O; const float* qn; const float* kn; const float* rope;
    const float* cb;
    unsigned char* qk8;
    unsigned char* v8;
    unsigned* nmax;
    __device__ __forceinline__ void operator()(const f32x4 (&acc)[2][2][4][2], const Unit& u, int wr, int wc, int fr_in, int fq_in) const {
        int fr = fr_in, fq = fq_in; asm volatile("" : "+v"(fr), "+v"(fq));
        const int s = u.pnl * 4 + wc;
        const bool isq = (s < 8) || (s >= 12 && s < 20), isk = (s >= 8 && s < 10) || (s >= 20 && s < 28);
        const bool donorm = s < 10; const float* gp = s < 8 ? qn : kn;
        const int tb = u.pm % 33;
        const int ax = fq >> 1, hc0 = 32 * ax + 8 * (fq & 1);
        const float* cbp = cb + (tb == 0 ? 2 : u.pm / 33) * QKV_PITCH + s * 64 + hc0;
        const bool dorope = (isq || isk) && tb != 0;
        const float sc = isq ? ATT_C2 * 4.0f : (isk ? 0.25f : 1.0f);
        const bool dobound = (s >= 12 && s < 28); float nmx = 0.f;
        f32x4 gv[2][2], cbv[2][2];
#pragma unroll
        for (int h = 0; h < 2; ++h)
#pragma unroll
            for (int n = 0; n < 2; ++n) { gv[h][n] = donorm ? *(const f32x4*)(gp + hc0 + 16 * h + 4 * n) : (f32x4){1.f, 1.f, 1.f, 1.f}; cbv[h][n] = (f32x4){0.f, 0.f, 0.f, 0.f}; }
        const int s26 = s < 10 ? s : s - 2;
#pragma unroll
        for (int ai = 0; ai < 2; ++ai)
#pragma unroll
            for (int m = 0; m < 4; ++m) {
                const int rl = ai * HALF + wr * 64 + m * 16 + fr;
                f32x4 v[2][2];
#pragma unroll
                for (int h = 0; h < 2; ++h)
#pragma unroll
                    for (int n = 0; n < 2; ++n) v[h][n] = acc[ai][h][m][n] * W8_INV + cbv[h][n];
                if (dobound || donorm) { float ss = 0.f;
#pragma unroll
                    for (int h = 0; h < 2; ++h)
#pragma unroll
                        for (int n = 0; n < 2; ++n) { const f32x4 x = v[h][n]; ss += (x[0] * x[0] + x[1] * x[1]) + (x[2] * x[2] + x[3] * x[3]); }
                    ss += __shfl_xor(ss, 16); ss += __shfl_xor(ss, 32);
                    if (dobound) nmx = fmaxf(nmx, ss);
                    if (donorm) { const float r = 1.0f / sqrtf(ss * (1.0f / 64.0f) + RMS_EPS);
#pragma unroll
                        for (int h = 0; h < 2; ++h)
#pragma unroll
                            for (int n = 0; n < 2; ++n) v[h][n] = v[h][n] * r * gv[h][n]; } }
                if (dorope) {
                    const int pos = ax ? (rl & 63) : ((tb - 1) * 4 + (rl >> 6));
#pragma unroll
                    for (int n = 0; n < 2; ++n) { const f32x4 cs = *(const f32x4*)(rope + pos * 16 + 8 * (fq & 1) + 4 * n), sn = *(const f32x4*)(rope + 2048 + pos * 16 + 8 * (fq & 1) + 4 * n);
                        const f32x4 x1 = v[0][n], x2 = v[1][n]; v[0][n] = x1 * cs - x2 * sn; v[1][n] = x2 * cs + x1 * sn; }
                }
                const size_t row = (size_t)(u.pm * BM + rl);
                if (isq || isk) { unsigned char* p8 = qk8 + row * 1664 + s26 * 64 + hc0;
#pragma unroll
                    for (int h = 0; h < 2; ++h) { const f32x4 x0 = v[h][0] * sc, x1 = v[h][1] * sc; u32x2 w; w.x = pk4_fp8(x0[0], x0[1], x0[2], x0[3]); w.y = pk4_fp8(x1[0], x1[1], x1[2], x1[3]); *(u32x2*)(p8 + 16 * h) = w; } }
                else { bf16_t* rowp = O + row * QKV_PITCH + s * 64 + hc0;
                    { unsigned char* p8 = v8 + row * 640 + (s >= 28 ? 128 + (s - 28) * 64 : (s - 10) * 64) + hc0;
#pragma unroll
                        for (int h = 0; h < 2; ++h) { const f32x4 x0 = v[h][0], x1 = v[h][1]; u32x2 w; w.x = pk4_fp8(x0[0], x0[1], x0[2], x0[3]); w.y = pk4_fp8(x1[0], x1[1], x1[2], x1[3]); *(u32x2*)(p8 + 16 * h) = w; } }
#pragma unroll
                    for (int h = 0; h < 2; ++h) { const f32x4 x0 = v[h][0], x1 = v[h][1]; u32x4 w; w.x = cvt_pk_bf16(x0[0], x0[1]); w.y = cvt_pk_bf16(x0[2], x0[3]); w.z = cvt_pk_bf16(x1[0], x1[1]); w.w = cvt_pk_bf16(x1[2], x1[3]); *(u32x4*)(rowp + 16 * h) = w; } }
            }
        if (dobound) {
#pragma unroll
            for (int o_ = 1; o_ < 16; o_ <<= 1) nmx = fmaxf(nmx, __shfl_xor(nmx, o_));
            if (fr == 0 && fq == 0) __hip_atomic_fetch_max(nmax + s, __float_as_uint(nmx), __ATOMIC_RELAXED, __HIP_MEMORY_SCOPE_AGENT); }
    }
};
struct EpiWo {
    static constexpr bool PERM = true, AFTER_DRAIN = false;
    const float* x; const float* mod; bf16_t* x1;
    __device__ __forceinline__ void operator()(const f32x4 (&acc)[2][2][4][2], const Unit& u, int wr, int wc, int fr_in, int fq_in) const {
        int fr = fr_in, fq = fq_in; asm volatile("" : "+v"(fr), "+v"(fq));
        const int b = u.pm >> 5; const float* gt = mod + b * 6144 + 2048;
        const int col0 = u.pn * BM + wc * 32 + 8 * fq, row0 = u.pm * BM + wr * 64 + fr;
        f32x4 g[2][2];
#pragma unroll
        for (int bj = 0; bj < 2; ++bj)
#pragma unroll
            for (int n = 0; n < 2; ++n) g[bj][n] = *(const f32x4*)(gt + col0 + bj * HALF + 4 * n);
#pragma unroll
        for (int ai = 0; ai < 2; ++ai)
#pragma unroll
            for (int m = 0; m < 4; ++m) { const size_t off = (size_t)(row0 + ai * HALF + m * 16) * 1024 + col0;
#pragma unroll
                for (int bj = 0; bj < 2; ++bj) { const f32x4 x0 = *(const f32x4*)(x + off + bj * HALF), x4 = *(const f32x4*)(x + off + bj * HALF + 4);
                    const f32x4 v0 = x0 + g[bj][0] * acc[ai][bj][m][0], v1 = x4 + g[bj][1] * acc[ai][bj][m][1];
                    u32x4 w; w.x = cvt_pk_bf16(v0[0], v0[1]); w.y = cvt_pk_bf16(v0[2], v0[3]); w.z = cvt_pk_bf16(v1[0], v1[1]); w.w = cvt_pk_bf16(v1[2], v1[3]);
                    *(u32x4*)(x1 + off + bj * HALF) = w; } }
    }
};
struct EpiSwiglu {
    static constexpr bool PERM = true, AFTER_DRAIN = false;
    bf16_t* act; const float* b_in;
    __device__ __forceinline__ void operator()(const f32x4 (&acc)[2][2][4][2], const Unit& u, int wr, int wc, int fr_in, int fq_in) const {
        int fr = fr_in, fq = fq_in; asm volatile("" : "+v"(fr), "+v"(fq));
        const int c0 = u.pnl * 128 + wc * 32 + 8 * fq; const float* bg = b_in + u.e * 2048 + c0; const float* bl = bg + 1024;
        constexpr float KP = 1.702f * 1.4426950408889634f, KI = 1.0f / KP;
        const f32x4 bgv[2] = {*(const f32x4*)bg * KP, *(const f32x4*)(bg + 4) * KP}, blv[2] = {(*(const f32x4*)bl + 1.0f) * KI, (*(const f32x4*)(bl + 4) + 1.0f) * KI};
#pragma unroll
        for (int ai = 0; ai < 2; ++ai)
#pragma unroll
            for (int m = 0; m < 4; ++m) { const size_t row = (size_t)u.pm * BM + ai * HALF + wr * 64 + m * 16 + fr; f32x4 a[2];
#pragma unroll
                for (int n = 0; n < 2; ++n) { f32x4 g2 = acc[ai][0][m][n] * (W8_INV * KP) + bgv[n], l2 = acc[ai][1][m][n] * (W8_INV * KI) + blv[n], d;
#pragma unroll
                    for (int i = 0; i < 4; ++i) { g2[i] = fminf(g2[i], 7.0f * KP); l2[i] = __builtin_amdgcn_fmed3f(l2[i], -6.0f * KI, 8.0f * KI); d[i] = __builtin_amdgcn_exp2f(-g2[i]); }
                    d = d + 1.0f;
#pragma unroll
                    for (int i = 0; i < 4; ++i) d[i] = __builtin_amdgcn_rcpf(d[i]);
                    a[n] = g2 * d * l2; }
                u32x2 w; w.x = pk4_fp8(a[0][0], a[0][1], a[0][2], a[0][3]); w.y = pk4_fp8(a[1][0], a[1][1], a[1][2], a[1][3]);
                *(u32x2*)((unsigned char*)act + row * 1024 + c0) = w; }
    }
};
struct EpiMoeOut {
    static constexpr bool PERM = true, AFTER_DRAIN = false;
    bf16_t* y; const float* b_out; const float* lgate;
    __device__ __forceinline__ void operator()(const f32x4 (&acc)[2][2][4][2], const Unit& u, int wr, int wc, int fr_in, int fq_in) const {
        int fr = fr_in, fq = fq_in; asm volatile("" : "+v"(fr), "+v"(fq));
        const int c0 = u.pnl * BM + wc * 32 + 8 * fq; const float* bp = b_out + u.e * 1024 + c0;
        f32x4 bv[2][2];
#pragma unroll
        for (int bj = 0; bj < 2; ++bj)
#pragma unroll
            for (int n = 0; n < 2; ++n) bv[bj][n] = *(const f32x4*)(bp + bj * HALF + 4 * n);
#pragma unroll
        for (int ai = 0; ai < 2; ++ai)
#pragma unroll
            for (int m = 0; m < 4; ++m) { const int rl = ai * HALF + wr * 64 + m * 16 + fr; const float gate = lgate[(size_t)u.e * 16384 + u.mt * BM + rl];
                unsigned char* rowp = (unsigned char*)y + ((size_t)u.pm * BM + rl) * 1024 + c0;
#pragma unroll
                for (int bj = 0; bj < 2; ++bj) { const f32x4 v0 = (acc[ai][bj][m][0] * W8_INV + bv[bj][0]) * gate, v1 = (acc[ai][bj][m][1] * W8_INV + bv[bj][1]) * gate;
                    u32x2 w; w.x = pk4_fp8(v0[0], v0[1], v0[2], v0[3]); w.y = pk4_fp8(v1[0], v1[1], v1[2], v1[3]);
                    *(u32x2*)(rowp + bj * HALF) = w; } }
    }
};
struct QkvOrder : StaticOrder {
    __device__ __forceinline__ bool next(int i, Unit& u) const { if (!StaticOrder::next(i, u)) return false; u.pnl = u.pn;     u.e = 0; u.mt = 0; u.pad_ = 0; return true; }
};
struct MoeOrder {
    const PG8_LAS int* tp; const PG8_LAS unsigned char* te; int npn, G, c;
    unsigned* dep; int mode, joff;
    __device__ __forceinline__ bool next(int i, Unit& u) const {
        long L; int g;
        if (mode == 0) { L = (long)i * G + c; g = (int)(L / npn); }
        else { const int x = c >> 5, j = (c + joff) & 31; L = (long)i * 32 + j; const int T_ = __builtin_amdgcn_readfirstlane(tp[32]), per = (T_ + 7) >> 3, q = (int)(L / npn);
            if (q >= per) return false; g = x * per + q; }
        if (g >= __builtin_amdgcn_readfirstlane(tp[32])) return false;
        const int e = __builtin_amdgcn_readfirstlane((int)te[g]);
        u.e = e; u.mt = g - __builtin_amdgcn_readfirstlane(tp[e]); u.pnl = (int)(L % npn); u.pm = g; u.pn = e * npn + u.pnl; u.pad_ = 0; return true;
    }
    __device__ __forceinline__ void a_ready(const Unit& u) const { if (mode == 2) { while (__hip_atomic_load(dep + u.pm, __ATOMIC_RELAXED, __HIP_MEMORY_SCOPE_AGENT) < 64u) __builtin_amdgcn_s_sleep(4); asm volatile("" ::: "memory"); } }
    __device__ __forceinline__ void done(const Unit& u) const { if (mode == 1) { if (lane_id_asm() == 0) __hip_atomic_fetch_add(dep + u.pm, 1u, __ATOMIC_RELAXED, __HIP_MEMORY_SCOPE_AGENT); } }
};
template <class Epi, class Sched, bool ALIGN_EPI = false, bool SP2 = false, bool GATHER = false, bool F8 = false>
__device__ __forceinline__ void gemm_phase(PG8_LAS unsigned char* lds, const Gemm g, const Sched& S, const Epi& E, int wid_in, const int* glist = nullptr, PG8_LAS unsigned* idbuf = nullptr) {
    static_assert(!GATHER || SP2, "GATHER is written for the SP2 loop only");
    const int lane = lane_id_asm(), wid = wid_in, tid = wid * 64 + lane, wr = wid >> 2, wc = wid & 3, fr = lane & 15, fq = lane >> 4;
    constexpr int ES = F8 ? 1 : 2;
    const int K = g.K, nt = (K * ES) / (BK * 2);
    unsigned voffA[2], voffB[2]; int Rl[2]; unsigned Cb[2];
#pragma unroll
    for (int i = 0; i < 2; ++i) { int R, C; stage_rc(tid * 16 + i * 8192, R, C); const int Rb = Epi::PERM ? ((R & ~31) + perm32(R & 31)) : R;
        voffA[i] = (unsigned)(R * K * ES + C * 2); voffB[i] = (unsigned)(Rb * K * ES + C * 2); Rl[i] = R; Cb[i] = (unsigned)C * 2u; }
    unsigned cv[2][2] = {{0u, 0u}, {0u, 0u}}, nv[2][2] = {{0u, 0u}, {0u, 0u}};
    constexpr int GL_STRIDE = 16384;
    PG8_LAS unsigned* myid = idbuf + wid * 256;
#define PG8_FETCH_IDS(U) do { _Pragma("unroll") for (int h_ = 0; h_ < 2; ++h_) _Pragma("unroll") for (int i_ = 0; i_ < 2; ++i_) \
        __builtin_amdgcn_global_load_lds((const unsigned*)(glist + (size_t)(U).e * GL_STRIDE + (U).mt * BM + h_ * HALF + Rl[i_]), (PG8_LAS unsigned*)(myid + (h_ * 2 + i_) * 64), 4, 0, 0); } while (0)
#define PG8_READ_IDS(dst) do { _Pragma("unroll") for (int h_ = 0; h_ < 2; ++h_) _Pragma("unroll") for (int i_ = 0; i_ < 2; ++i_) dst[h_][i_] = myid[(h_ * 2 + i_) * 64 + lane] * (unsigned)(K * ES) + Cb[i_]; } while (0)
#define PG8_STAGE_A(bufoff, kbase, H, NX) do { if constexpr (GATHER) { unsigned v_[2]; v_[0] = (NX) ? nv[H][0] : cv[H][0]; v_[1] = (NX) ? nv[H][1] : cv[H][1]; PG8_STAGE(bufoff, kbase, v_); } \
        else { PG8_STAGE(bufoff, (kbase) + ((H) ? hstep : (size_t)0), voffA); } } while (0)
    const size_t kstep = (size_t)(BK * 2);
    const size_t hstep = (size_t)HALF * K * ES;
    const size_t tstep = 2 * hstep;
    const unsigned ldsw = (unsigned)wid * 1024u;
    const int aoff = lds_byte(wr * 64 + fr, fq * 8), boff = lds_byte(wc * 32 + fr, fq * 8);
#define PG8_SA(b, h) (((b) * 2 + (h)) * HTB)
#define PG8_SB(b, h) ((4 + (b) * 2 + (h)) * HTB)
#define PG8_STAGE(bufoff, gbase, voff) do { _Pragma("unroll") for (int _i = 0; _i < 2; ++_i) \
        __builtin_amdgcn_global_load_lds((const unsigned*)((const char*)(gbase) + (voff)[_i]), (PG8_LAS unsigned*)(lds + (bufoff) + ldsw + _i * 8192), 16, 0, 0); } while (0)
#define PG8_LDA(dst, b, h) do { if constexpr (F8) { _Pragma("unroll") for (int m = 0; m < 4; ++m) dst##8[m] = cat8(*(const PG8_LAS bf16x8*)(lds + PG8_SA(b, h) + aoff + m * 2048), *(const PG8_LAS bf16x8*)(lds + PG8_SA(b, h) + aoff + m * 2048 + 1024)); } \
        else { _Pragma("unroll") for (int m = 0; m < 4; ++m) _Pragma("unroll") for (int k = 0; k < 2; ++k) dst[m][k] = *(const PG8_LAS bf16x8*)(lds + PG8_SA(b, h) + aoff + m * 2048 + k * 1024); } } while (0)
#define PG8_LDB(dst, b, h) do { if constexpr (F8) { _Pragma("unroll") for (int n = 0; n < 2; ++n) dst##8[n] = cat8(*(const PG8_LAS bf16x8*)(lds + PG8_SB(b, h) + boff + n * 2048), *(const PG8_LAS bf16x8*)(lds + PG8_SB(b, h) + boff + n * 2048 + 1024)); } \
        else { _Pragma("unroll") for (int n = 0; n < 2; ++n) _Pragma("unroll") for (int k = 0; k < 2; ++k) dst[n][k] = *(const PG8_LAS bf16x8*)(lds + PG8_SB(b, h) + boff + n * 2048 + k * 1024); } } while (0)
#define PG8_MMA(ai, bj, At, Bt) do { __builtin_amdgcn_s_setprio(1); if constexpr (F8) { _Pragma("unroll") for (int m = 0; m < 4; ++m) _Pragma("unroll") for (int n = 0; n < 2; ++n) \
        asm volatile("s_nop 1\n\tv_mfma_f32_16x16x128_f8f6f4 %0, %1, %2, %0" : "+v"(acc[ai][bj][m][n]) : "v"(Bt##8[n]), "v"(At##8[m])); }     \
        else { _Pragma("unroll") for (int m = 0; m < 4; ++m) _Pragma("unroll") for (int n = 0; n < 2; ++n) _Pragma("unroll") for (int k = 0; k < 2; ++k) \
        acc[ai][bj][m][n] = __builtin_amdgcn_mfma_f32_16x16x32_bf16(Bt[n][k], At[m][k], acc[ai][bj][m][n], 0, 0, 0); } __builtin_amdgcn_s_setprio(0); } while (0)
#define PG8_WAIT_V(n) asm volatile("s_waitcnt vmcnt(" #n ")" ::: "memory")
#define PG8_WAIT_L(n) asm volatile("s_waitcnt lgkmcnt(" #n ")" ::: "memory")
#define PG8_BAR __builtin_amdgcn_s_barrier()
#define PG8_SCHED __builtin_amdgcn_sched_barrier(0)
    Unit cur, nxt, prv; int ui = 0; bool have_prv = false;
    if (!S.next(0, cur)) return;
    f32x4 acc[2][2][4][2];
#pragma unroll
    for (int a = 0; a < 2; ++a)
#pragma unroll
        for (int b = 0; b < 2; ++b)
#pragma unroll
            for (int m = 0; m < 4; ++m)
#pragma unroll
                for (int n = 0; n < 2; ++n) acc[a][b][m][n] = (f32x4){0.f, 0.f, 0.f, 0.f};
    bf16x8 At[4][2], B0[2][2], B1[2][2]; v8i32 At8[4], B08[2], B18[2];
    const char* cA = (const char*)g.A + (GATHER ? (size_t)0 : (size_t)cur.pm * tstep); const char* cB = (const char*)g.Bt + (size_t)cur.pn * tstep;
    S.a_ready(cur);
    if constexpr (GATHER) { PG8_FETCH_IDS(cur); asm volatile("s_waitcnt vmcnt(0)" ::: "memory"); PG8_READ_IDS(cv); }
    if constexpr (SP2) {
        PG8_STAGE(PG8_SB(0, 0), cB, voffB); PG8_STAGE(PG8_SB(0, 1), cB + hstep, voffB); PG8_STAGE_A(PG8_SA(0, 0), cA, 0, false); PG8_STAGE_A(PG8_SA(0, 1), cA, 1, false);
        if (wr == 1) PG8_BAR;
        PG8_WAIT_V(2); PG8_BAR;
        PG8_STAGE(PG8_SB(1, 0), cB + kstep, voffB); PG8_STAGE_A(PG8_SA(1, 0), cA + kstep, 0, false); PG8_STAGE(PG8_SB(1, 1), cB + hstep + kstep, voffB);
        PG8_WAIT_V(6); PG8_BAR;
    } else {
        PG8_STAGE(PG8_SB(0, 0), cB, voffB); PG8_STAGE(PG8_SA(0, 0), cA, voffA); PG8_STAGE(PG8_SB(0, 1), cB + hstep, voffB); PG8_STAGE(PG8_SA(0, 1), cA + hstep, voffA);
        if (wr == 1) PG8_BAR;
        PG8_WAIT_V(4); PG8_BAR;
        PG8_STAGE(PG8_SB(1, 0), cB + kstep, voffB); PG8_STAGE(PG8_SA(1, 0), cA + kstep, voffA); PG8_STAGE(PG8_SB(1, 1), cB + hstep + kstep, voffB);
        PG8_WAIT_V(6); PG8_BAR;
    }
    for (;;) {
        const bool has_next = S.next(ui + 1, nxt);
        const char* nA = (has_next && !GATHER) ? (const char*)g.A + (size_t)nxt.pm * tstep : cA; const char* nB = has_next ? (const char*)g.Bt + (size_t)nxt.pn * tstep : cB;
        if constexpr (GATHER) { if (has_next) PG8_FETCH_IDS(nxt); }
        for (int t = 0; t < nt; t += 2) {
            const bool last = (t == nt - 2);
            if constexpr (GATHER) { if (last) { if (has_next) { PG8_READ_IDS(nv); } else { _Pragma("unroll") for (int h_ = 0; h_ < 2; ++h_) { nv[h_][0] = cv[h_][0]; nv[h_][1] = cv[h_][1]; } } } }
            const char* a1 = cA + (size_t)(t + 1) * kstep;
            const char* a2 = last ? nA : cA + (size_t)(t + 2) * kstep; const char* b2 = last ? nB : cB + (size_t)(t + 2) * kstep;
            const char* a3 = a2 + kstep; const char* b3 = b2 + kstep;
            if (last && has_next) S.a_ready(nxt);
            if constexpr (SP2) {
            PG8_LDB(B0, 0, 0); PG8_LDB(B1, 0, 1); PG8_SCHED; PG8_LDA(At, 0, 0); PG8_STAGE_A(PG8_SA(1, 1), a1, 1, false);
            PG8_WAIT_V(8); PG8_WAIT_L(0); PG8_BAR; PG8_MMA(0, 0, At, B0); PG8_MMA(0, 1, At, B1); PG8_BAR; PG8_SCHED;
            PG8_LDA(At, 0, 1); PG8_STAGE(PG8_SB(0, 0), b2, voffB); PG8_STAGE(PG8_SB(0, 1), b2 + hstep, voffB); PG8_STAGE_A(PG8_SA(0, 0), a2, 0, last);
            PG8_WAIT_V(8); PG8_WAIT_L(0); PG8_BAR; PG8_MMA(1, 0, At, B0); PG8_MMA(1, 1, At, B1); PG8_BAR; PG8_SCHED;
            PG8_LDB(B0, 1, 0); PG8_LDB(B1, 1, 1); PG8_SCHED; PG8_LDA(At, 1, 0); PG8_STAGE_A(PG8_SA(0, 1), a2, 1, last);
            PG8_WAIT_V(8); PG8_WAIT_L(0); PG8_BAR; PG8_MMA(0, 0, At, B0); PG8_MMA(0, 1, At, B1); PG8_BAR; PG8_SCHED;
            PG8_LDA(At, 1, 1); PG8_STAGE(PG8_SB(1, 0), b3, voffB); PG8_STAGE(PG8_SB(1, 1), b3 + hstep, voffB); PG8_STAGE_A(PG8_SA(1, 0), a3, 0, last);
            PG8_WAIT_V(8); PG8_WAIT_L(0); PG8_BAR; PG8_MMA(1, 0, At, B0); PG8_MMA(1, 1, At, B1); PG8_BAR; PG8_SCHED;
            } else {
            PG8_LDB(B0, 0, 0); PG8_SCHED; PG8_LDA(At, 0, 0); PG8_STAGE(PG8_SA(1, 1), a1 + hstep, voffA);
            PG8_WAIT_L(8); PG8_BAR; PG8_WAIT_L(0); PG8_MMA(0, 0, At, B0); PG8_BAR; PG8_SCHED;
            PG8_LDB(B1, 0, 1); PG8_STAGE(PG8_SB(0, 0), b2, voffB);
            PG8_BAR; PG8_WAIT_L(0); PG8_MMA(0, 1, At, B1); PG8_BAR;
            PG8_LDA(At, 0, 1); PG8_STAGE(PG8_SA(0, 0), a2, voffA);
            PG8_BAR; PG8_WAIT_L(0); PG8_MMA(1, 0, At, B0); PG8_BAR; PG8_SCHED;
            PG8_STAGE(PG8_SB(0, 1), b2 + hstep, voffB);
            PG8_WAIT_V(6); PG8_BAR; PG8_MMA(1, 1, At, B1); PG8_BAR;
            PG8_LDB(B0, 1, 0); PG8_SCHED; PG8_LDA(At, 1, 0); PG8_STAGE(PG8_SA(0, 1), a2 + hstep, voffA);
            PG8_WAIT_L(8); PG8_BAR; PG8_WAIT_L(0); PG8_MMA(0, 0, At, B0); PG8_BAR; PG8_SCHED;
            PG8_LDB(B1, 1, 1); PG8_STAGE(PG8_SB(1, 0), b3, voffB);
            PG8_BAR; PG8_WAIT_L(0); PG8_MMA(0, 1, At, B1); PG8_BAR;
            PG8_LDA(At, 1, 1); PG8_STAGE(PG8_SA(1, 0), a3, voffA);
            PG8_BAR; PG8_WAIT_L(0); PG8_MMA(1, 0, At, B0); PG8_BAR; PG8_SCHED;
            PG8_STAGE(PG8_SB(1, 1), b3 + hstep, voffB);
            PG8_WAIT_V(6); PG8_BAR; PG8_MMA(1, 1, At, B1); PG8_BAR;
            }
        }
        if constexpr (ALIGN_EPI) { if (wr == 0) PG8_BAR; }
        if constexpr (F8) { asm volatile("s_nop 15\n\ts_nop 15" ::: "memory"); }
        if constexpr (!Epi::AFTER_DRAIN) { if (have_prv) S.done(prv); E(acc, cur, wr, wc, fr, fq); prv = cur; have_prv = true; }
        if (!has_next) break;
#pragma unroll
        for (int a = 0; a < 2; ++a)
#pragma unroll
            for (int b = 0; b < 2; ++b)
#pragma unroll
                for (int m = 0; m < 4; ++m)
#pragma unroll
                    for (int n = 0; n < 2; ++n) acc[a][b][m][n] = (f32x4){0.f, 0.f, 0.f, 0.f};
        cur = nxt; cA = nA; cB = nB; ++ui;
        if constexpr (GATHER) { _Pragma("unroll") for (int h_ = 0; h_ < 2; ++h_) { cv[h_][0] = nv[h_][0]; cv[h_][1] = nv[h_][1]; } }
        if constexpr (ALIGN_EPI) { if (wr == 1) PG8_BAR; }
    }
    PG8_WAIT_V(0);
    if constexpr (!ALIGN_EPI) { if (wr == 0) PG8_BAR; }
    PG8_BAR;
    if constexpr (!Epi::AFTER_DRAIN) { if (have_prv) S.done(prv); }
    if constexpr (Epi::AFTER_DRAIN) { E.fused(acc, cur, wr, wc, fr, fq, lds, wid, lane); S.done(cur); }
#undef PG8_SA
#undef PG8_FETCH_IDS
#undef PG8_READ_IDS
#undef PG8_STAGE_A
#undef PG8_SB
#undef PG8_STAGE
#undef PG8_LDA
#undef PG8_LDB
#undef PG8_MMA
#undef PG8_WAIT_V
#undef PG8_WAIT_L
#undef PG8_BAR
#undef PG8_SCHED
}
}
#ifndef PG8_SP2
#define PG8_SP2 true
#endif
#ifndef PG8_ALIGN
#define PG8_ALIGN true
#endif
namespace attn_body {
using bf16=__hip_bfloat16;
using bf16x8=__attribute__((ext_vector_type(8)))short;
using s16x4=__attribute__((ext_vector_type(4)))short;
using f32x16=__attribute__((ext_vector_type(16)))float;
using u32x4=__attribute__((ext_vector_type(4)))unsigned;
constexpr int D=64,DM=2304;
constexpr int NW=8,QBLK=32,QB=QBLK*NW,KVBLK=64,NKEYS=8448,NT=NKEYS/KVBLK;
static_assert(NT%2==0&&NT>=6,"the 2-step loop needs an even tile count");
constexpr int ATTN_PITCH=DM, ATTN_UNIT_ROWS=QB;
__device__ __forceinline__ int crow(int r,int hi){return (r&3)+8*(r>>2)+4*hi;}
#define SBAR() __builtin_amdgcn_sched_barrier(0)
__device__ __forceinline__ void cmask(f32x16&p0,f32x16&p1,int jb,int qrel,int hi){
  const float NEG=-INFINITY; int kb=64*jb+4*hi;
  #pragma unroll
  for(int r=0;r<16;++r){int kv=kb+(r&3)+8*(r>>2); if(kv>qrel)p0[r]=NEG; if(kv+32>qrel)p1[r]=NEG;}
}

constexpr int NSLOT=3, SLOTB=8192;
constexpr int LDS_K=0, LDS_V=NSLOT*SLOTB, LDS_WS=2*NSLOT*SLOTB, LDS_OST=LDS_WS+NW*64*4, LDS_BYTES=LDS_OST+NW*4096;
constexpr float C2=0.125f*1.4426950408889634f;
__device__ __forceinline__ void glds16(const void*gsrc,unsigned lds_dst){unsigned keep;
  asm volatile("s_mov_b32 %0, m0\n\ts_mov_b32 m0, %2\n\ts_nop 0\n\tglobal_load_lds_dwordx4 %1, off\n\ts_mov_b32 m0, %0":"=&s"(keep):"v"(gsrc),"s"(lds_dst):"memory");}
__device__ __forceinline__ float max3f(float a,float b,float c){float r;asm("v_max3_f32 %0, %1, %2, %3":"=v"(r):"v"(a),"v"(b),"v"(c));return r;}
__device__ __forceinline__ float max2f(float a,float b){float r;asm("v_max_f32_e32 %0, %1, %2":"=v"(r):"v"(a),"v"(b));return r;}
__device__ __forceinline__ float fadd_s(float a,float b){float r;asm("v_add_f32_e32 %0, %1, %2":"=v"(r):"v"(a),"v"(b));return r;}
__device__ __forceinline__ float fsub_s(float a,float b){float r;asm("v_sub_f32_e32 %0, %1, %2":"=v"(r):"v"(a),"v"(b));return r;}
typedef float f32x2_t __attribute__((ext_vector_type(2))); typedef __bf16 bf16x2_t __attribute__((ext_vector_type(2)));
__device__ __forceinline__ unsigned cvtpk_s(float lo,float hi){f32x2_t v={lo,hi};bf16x2_t b=__builtin_convertvector(v,bf16x2_t);return __builtin_bit_cast(unsigned,b);}
#define WAIT_BAR(N) asm volatile("s_waitcnt vmcnt(" #N ") lgkmcnt(0)\n\ts_barrier":::"memory")

__device__ __forceinline__ void qkt(f32x16&p0,f32x16&p1,const char*Kslot,const bf16x8*qr,const f32x16&negm,int r32,int hi){
  const char*kb=Kslot+hi*1024+r32*16;
  #pragma unroll
  for(int d0=0;d0<4;++d0){
    const bf16x8 b0=*reinterpret_cast<const bf16x8*>(kb+d0*2048);
    const bf16x8 b1=*reinterpret_cast<const bf16x8*>(kb+d0*2048+512);
    if(d0==0){p0=__builtin_amdgcn_mfma_f32_32x32x16_bf16(b0,qr[0],negm,0,0,0);p1=__builtin_amdgcn_mfma_f32_32x32x16_bf16(b1,qr[0],negm,0,0,0);}
    else{p0=__builtin_amdgcn_mfma_f32_32x32x16_bf16(b0,qr[d0],p0,0,0,0);p1=__builtin_amdgcn_mfma_f32_32x32x16_bf16(b1,qr[d0],p1,0,0,0);}}
}
typedef __attribute__((address_space(3))) const char* lds_cptr;
typedef short v4i16_t __attribute__((ext_vector_type(4)));
__device__ __forceinline__ void kload8(bf16x8*kf,lds_cptr kp){
  kf[0]=*(const __attribute__((address_space(3))) bf16x8*)(kp);      kf[1]=*(const __attribute__((address_space(3))) bf16x8*)(kp+512);
  kf[2]=*(const __attribute__((address_space(3))) bf16x8*)(kp+2048); kf[3]=*(const __attribute__((address_space(3))) bf16x8*)(kp+2560);
  kf[4]=*(const __attribute__((address_space(3))) bf16x8*)(kp+4096); kf[5]=*(const __attribute__((address_space(3))) bf16x8*)(kp+4608);
  kf[6]=*(const __attribute__((address_space(3))) bf16x8*)(kp+6144); kf[7]=*(const __attribute__((address_space(3))) bf16x8*)(kp+6656);
}
__device__ __forceinline__ void kload2(bf16x8*kf,lds_cptr kp,int j){ kf[2*j]=*(const __attribute__((address_space(3))) bf16x8*)(kp+j*2048); kf[2*j+1]=*(const __attribute__((address_space(3))) bf16x8*)(kp+j*2048+512); }
__device__ __forceinline__ s16x4 vtr(lds_cptr p){ return __builtin_bit_cast(s16x4,__builtin_amdgcn_ds_read_tr16_b64_v4i16((__attribute__((address_space(3))) v4i16_t*)p)); }
__device__ __forceinline__ float rowmax(const f32x16&p0,const f32x16&p1){
  float a=max3f(p0[0],p0[1],p1[0]),b=max3f(p0[2],p0[3],p1[1]);a=max3f(a,p1[2],p1[3]);
  #pragma unroll
  for(int r=4;r<16;r+=4){a=max3f(a,p0[r],p0[r+1]);b=max3f(b,p0[r+2],p0[r+3]);a=max3f(a,p1[r],p1[r+1]);b=max3f(b,p1[r+2],p1[r+3]);}
  const float m=max2f(a,b);
  auto rr=__builtin_amdgcn_permlane32_swap(__float_as_uint(m),__float_as_uint(m),false,false);
  return max2f(__uint_as_float(rr[0]),__uint_as_float(rr[1]));
}
__device__ __forceinline__ void pv(f32x16*o,int vb,bf16x8 pa0,bf16x8 pa1,bf16x8 pa2,bf16x8 pa3){
  #pragma unroll
  for(int d0=0;d0<2;++d0){s16x4 lo[4],hi[4];
    #pragma unroll
    for(int ks=0;ks<4;++ks){
      asm volatile("ds_read_b64_tr_b16 %0,%1 offset:%c2":"=&v"(lo[ks]):"v"(vb),"i"(d0*4096+ks*1024):"memory");
      asm volatile("ds_read_b64_tr_b16 %0,%1 offset:%c2":"=&v"(hi[ks]):"v"(vb),"i"(d0*4096+ks*1024+512):"memory");}
    asm volatile("s_waitcnt lgkmcnt(0)":::"memory");SBAR();
    #define PK(k) (bf16x8){lo[k][0],lo[k][1],lo[k][2],lo[k][3],hi[k][0],hi[k][1],hi[k][2],hi[k][3]}
    o[d0]=__builtin_amdgcn_mfma_f32_32x32x16_bf16(pa0,PK(0),o[d0],0,0,0);
    o[d0]=__builtin_amdgcn_mfma_f32_32x32x16_bf16(pa1,PK(1),o[d0],0,0,0);
    o[d0]=__builtin_amdgcn_mfma_f32_32x32x16_bf16(pa2,PK(2),o[d0],0,0,0);
    o[d0]=__builtin_amdgcn_mfma_f32_32x32x16_bf16(pa3,PK(3),o[d0],0,0,0);
    #undef PK
  }
}

#ifndef ATTN_STORE16
#define ATTN_STORE16(p,v) (*(u32x4*)(p)=(v))
#endif
template<int THRL,bool FIXREF=false> __device__ __forceinline__ void attn_unit(const bf16*Qu,const bf16*__restrict__ Kb,const bf16*__restrict__ Vb,bf16*Ou,int opitch,char*shm,int wid){
  const int lane=lane_id_asm(),r32=lane&31,hi=lane>>5;
  const bf16*Qw=Qu+(long)(wid*QBLK)*DM;
  const bf16*Kh=Kb,*Vh=Vb;
  const unsigned lds0=(unsigned)(uintptr_t)shm;
  float*wsf=(float*)(shm+LDS_WS)+wid*64;
  const bf16*ksrc=Kh+(long)lane*DM+wid*8;
  const bf16*vsrc=Vh+(long)(16*(wid&3)+(lane>>2))*DM+(wid>>2)*32+(lane&3)*8;
  const unsigned kdst=lds0+LDS_K+wid*1024, vdst=lds0+LDS_V+wid*1024;
  #define DMA_K(t,slot) glds16(ksrc+(long)(t)*KVBLK*DM,(unsigned)__builtin_amdgcn_readfirstlane(kdst+(slot)))
  #define DMA_V(t,slot) glds16(vsrc+(long)(t)*KVBLK*DM,(unsigned)__builtin_amdgcn_readfirstlane(vdst+(slot)))
  const int vb0=(int)(lds0+LDS_V)+((lane>>4)&1)*32+(lane&3)*8+(4*hi+((lane&15)>>2))*64;
  const char*Kbase=shm+LDS_K; bf16x8 kf[8];
  const lds_cptr shm3=(lds_cptr)shm; const lds_cptr kp0=shm3+LDS_K+hi*1024+r32*16; const lds_cptr vp0=shm3+LDS_V+((lane>>4)&1)*32+(lane&3)*8+(4*hi+((lane&15)>>2))*64;
  DMA_K(0,0);DMA_V(0,0);DMA_K(1,SLOTB);
  bf16x8 qr[4];
  #pragma unroll
  for(int d0=0;d0<4;++d0)qr[d0]=*reinterpret_cast<const bf16x8*>(&Qw[(long)r32*DM+d0*16+hi*8]);
  float mhat=0.f,l_reg=0.f;f32x16 o[2];o[0]=f32x16{};o[1]=f32x16{};f32x16 negm=f32x16{};asm volatile("":"+v"(negm));
  #define CMASK(P0,P1,t) do{}while(0)
  bool resc=false;
  #define START(P0,P1) do{ resc=false; if constexpr(!FIXREF){ const float rm=rowmax(P0,P1); \
    { const float dl=rm; mhat=fadd_s(mhat,dl); \
      _Pragma("unroll") for(int r=0;r<16;++r){P0[r]=fsub_s(P0[r],dl);P1[r]=fsub_s(P1[r],dl);} \
      _Pragma("unroll") for(int r=0;r<16;++r)negm[r]=-mhat; asm volatile("":"+v"(negm)); } } \
    _Pragma("unroll") for(int r=0;r<16;++r)P0[r]=__builtin_amdgcn_exp2f(P0[r]); }while(0)
  #define RESC() do{ if(resc){ asm volatile("s_waitcnt lgkmcnt(0)":::"memory"); \
      _Pragma("unroll") for(int d_=0;d_<2;++d_) _Pragma("unroll") for(int r=0;r<16;++r)o[d_][r]*=wsf[crow(r,hi)]; } }while(0)
  f32x16 pA0,pA1,pB0,pB1;
  int sl_prev=0,sl_cur=0,sl_next=SLOTB;
  #define ROT() do{sl_prev=sl_cur;sl_cur=sl_next;sl_next=(sl_next==(NSLOT-1)*SLOTB)?0:sl_next+SLOTB;}while(0)
  DMA_K(2,2*SLOTB);
  WAIT_BAR(3);
  qkt(pA0,pA1,Kbase,qr,negm,r32,hi);asm volatile("s_nop 15\n\ts_nop 7":"+v"(pA0),"+v"(pA1));CMASK(pA0,pA1,0);
  START(pA0,pA1);
  _Pragma("unroll") for(int r=0;r<16;++r)pA1[r]=__builtin_amdgcn_exp2f(pA1[r]);
  WAIT_BAR(0);
  DMA_K(3,0);DMA_V(1,SLOTB);
  ROT();
  kload8(kf,kp0+sl_cur);
  WAIT_BAR(2);
  s16x4 vlo[8],vhi[8]; u32x4 pw0,pw1,pw2,pw3;
  #define PKW(P,B) cvtpk_s(P[B],P[B+1])
  #define PAF(k) __builtin_bit_cast(bf16x8,pw##k)
  #define VFR(i) (bf16x8){vlo[i][0],vlo[i][1],vlo[i][2],vlo[i][3],vhi[i][0],vhi[i][1],vhi[i][2],vhi[i][3]}
  #define PIN(x) asm volatile("":"+v"(x))
  #define MX3(a,b,c) __builtin_fmaxf(__builtin_fmaxf((a),(b)),(c))
  #define GAPA(MF,A0,A1,A2,A3,W0,W1,PW) do{ MF; sacc+=A0; sacc+=A1; sacc+=A2; sacc+=A3; PIN(sacc); W0; W1; PIN(PW); SBAR(); }while(0)
  #define EX(v) __builtin_amdgcn_exp2f(v)
  #define GAPB(MF,X,B) do{ MF; X[B]=EX(X[B]); X[B+1]=EX(X[B+1]); X[B+2]=EX(X[B+2]); X[B+3]=EX(X[B+3]); PIN(X); SBAR(); }while(0)
  #define VRD(i) do{ vlo[i]=vtr(vp_+(((i)>>2)*4096+((i)&3)*1024)); vhi[i]=vtr(vp_+(((i)>>2)*4096+((i)&3)*1024+512)); }while(0)
  #define KRD(G,j) do{ if(G){ kload2(kf,kp0+sl_next,j); SBAR(); } }while(0)
  #define STEP(C0,C1,P0,P1,t,GK,GV,GL) do{ SBAR(); \
    const lds_cptr vp_=vp0+sl_prev; \
    VRD(0); SBAR(); float sacc=(P0[0]+P0[1]); \
    GAPA(C0=__builtin_amdgcn_mfma_f32_32x32x16_bf16(kf[0],qr[0],negm,0,0,0), P0[2],P0[3],P0[4],P0[5],     pw0[0]=PKW(P0,0), pw0[1]=PKW(P0,2), pw0); \
    VRD(4); SBAR(); GAPA(C1=__builtin_amdgcn_mfma_f32_32x32x16_bf16(kf[1],qr[0],negm,0,0,0), P0[6],P0[7],P0[8],P0[9],     pw0[2]=PKW(P0,4), pw0[3]=PKW(P0,6), pw0); \
    VRD(1); SBAR(); GAPA(C0=__builtin_amdgcn_mfma_f32_32x32x16_bf16(kf[2],qr[1],C0,0,0,0),   P0[10],P0[11],P0[12],P0[13], pw1[0]=PKW(P0,8), pw1[1]=PKW(P0,10), pw1); \
    VRD(5); SBAR(); GAPA(C1=__builtin_amdgcn_mfma_f32_32x32x16_bf16(kf[3],qr[1],C1,0,0,0),   P0[14],P0[15],P1[0],P1[1],   pw1[2]=PKW(P0,12),pw1[3]=PKW(P0,14), pw1); \
    VRD(2); SBAR(); GAPA(C0=__builtin_amdgcn_mfma_f32_32x32x16_bf16(kf[4],qr[2],C0,0,0,0),   P1[2],P1[3],P1[4],P1[5],     pw2[0]=PKW(P1,0), pw2[1]=PKW(P1,2), pw2); \
    VRD(6); SBAR(); GAPA(C1=__builtin_amdgcn_mfma_f32_32x32x16_bf16(kf[5],qr[2],C1,0,0,0),   P1[6],P1[7],P1[8],P1[9],     pw2[2]=PKW(P1,4), pw2[3]=PKW(P1,6), pw2); \
    VRD(3); SBAR(); GAPA(C0=__builtin_amdgcn_mfma_f32_32x32x16_bf16(kf[6],qr[3],C0,0,0,0),   P1[10],P1[11],P1[12],P1[13], pw3[0]=PKW(P1,8), pw3[1]=PKW(P1,10), pw3); \
    VRD(7); SBAR(); GAPA(C1=__builtin_amdgcn_mfma_f32_32x32x16_bf16(kf[7],qr[3],C1,0,0,0),   P1[14],P1[15],0.f,0.f,       pw3[2]=PKW(P1,12),pw3[3]=PKW(P1,14), pw3); \
    l_reg+=sacc; \
    if(GK){DMA_K((t)+3,sl_cur);} if(GV){DMA_V((t)+1,sl_next);} \
    CMASK(C0,C1,t); \
    if constexpr(!FIXREF){ float a=MX3(C0[0],C0[1],C1[0]),b=MX3(C0[2],C0[3],C1[1]); a=MX3(a,C1[2],C1[3]); \
      _Pragma("unroll") for(int r=4;r<16;r+=4){a=MX3(a,C0[r],C0[r+1]);b=MX3(b,C0[r+2],C0[r+3]);a=MX3(a,C1[r],C1[r+1]);b=MX3(b,C1[r+2],C1[r+3]);} \
      float rm=__builtin_fmaxf(a,b); { auto rr=__builtin_amdgcn_permlane32_swap(__float_as_uint(rm),__float_as_uint(rm),false,false); rm=__builtin_fmaxf(__uint_as_float(rr[0]),__uint_as_float(rr[1])); } \
      resc=false; \
      if(__builtin_expect(__any(rm>(float)THRL),0)){ const float dl=__builtin_fmaxf(rm,0.f); mhat+=dl; \
        _Pragma("unroll") for(int r=0;r<16;++r){C0[r]-=dl;C1[r]-=dl;} \
        _Pragma("unroll") for(int r=0;r<16;++r)negm[r]=-mhat; asm volatile("":"+v"(negm)); \
        const float f=__builtin_amdgcn_exp2f(-dl); l_reg*=f; if(hi==0)wsf[r32]=f; resc=true; } } \
    SBAR(); \
    GAPB(o[0]=__builtin_amdgcn_mfma_f32_32x32x16_bf16(PAF(0),VFR(0),o[0],0,0,0), C0,0); \
    GAPB(o[1]=__builtin_amdgcn_mfma_f32_32x32x16_bf16(PAF(0),VFR(4),o[1],0,0,0), C0,4); \
    KRD(GL,0); GAPB(o[0]=__builtin_amdgcn_mfma_f32_32x32x16_bf16(PAF(1),VFR(1),o[0],0,0,0), C0,8); \
    KRD(GL,1); GAPB(o[1]=__builtin_amdgcn_mfma_f32_32x32x16_bf16(PAF(1),VFR(5),o[1],0,0,0), C0,12); \
    KRD(GL,2); GAPB(o[0]=__builtin_amdgcn_mfma_f32_32x32x16_bf16(PAF(2),VFR(2),o[0],0,0,0), C1,0); \
    KRD(GL,3); GAPB(o[1]=__builtin_amdgcn_mfma_f32_32x32x16_bf16(PAF(2),VFR(6),o[1],0,0,0), C1,4); \
    GAPB(o[0]=__builtin_amdgcn_mfma_f32_32x32x16_bf16(PAF(3),VFR(3),o[0],0,0,0), C1,8); \
    GAPB(o[1]=__builtin_amdgcn_mfma_f32_32x32x16_bf16(PAF(3),VFR(7),o[1],0,0,0), C1,12); \
    }while(0)
  int t=1;
  for(;t+5<NT;t+=2){
    STEP(pB0,pB1,pA0,pA1,t,true,true,true);     WAIT_BAR(2); RESC(); ROT();
    STEP(pA0,pA1,pB0,pB1,t+1,true,true,true);   WAIT_BAR(2); RESC(); ROT();
  }
  #define ENDW(tt) do{ if((tt)+3<NT){WAIT_BAR(2);} else if((tt)+2<NT){WAIT_BAR(1);} else {WAIT_BAR(0);} }while(0)
  for(;t+1<NT;t+=2){
    STEP(pB0,pB1,pA0,pA1,t,(t+3<NT),(t+1<NT),(t+1<NT));       ENDW(t);   RESC(); ROT();
    STEP(pA0,pA1,pB0,pB1,t+1,(t+4<NT),(t+2<NT),(t+2<NT));     ENDW(t+1); RESC(); ROT();
  }
  STEP(pB0,pB1,pA0,pA1,NT-1,false,false,false); RESC();
  { float sacc=pB0[0]+pB0[1]; _Pragma("unroll") for(int r=2;r<16;++r)sacc+=pB0[r]; _Pragma("unroll") for(int r=0;r<16;++r)sacc+=pB1[r]; l_reg+=sacc;
    pw0=(u32x4){PKW(pB0,0),PKW(pB0,2),PKW(pB0,4),PKW(pB0,6)};pw1=(u32x4){PKW(pB0,8),PKW(pB0,10),PKW(pB0,12),PKW(pB0,14)};pw2=(u32x4){PKW(pB1,0),PKW(pB1,2),PKW(pB1,4),PKW(pB1,6)};pw3=(u32x4){PKW(pB1,8),PKW(pB1,10),PKW(pB1,12),PKW(pB1,14)};
    SBAR(); pv(o,vb0+sl_cur,PAF(0),PAF(1),PAF(2),PAF(3)); }
  #undef PKW
  #undef PAF
  #undef VFR
  #undef PIN
  #undef MX3
  #undef GAPA
  #undef GAPB
  #undef EX
  #undef VRD
  #undef KRD
  #undef STEP
  #undef ENDW
  {auto rr=__builtin_amdgcn_permlane32_swap(__float_as_uint(l_reg),__float_as_uint(l_reg),false,false);l_reg=__uint_as_float(rr[0])+__uint_as_float(rr[1]);}
  if(hi==0)wsf[32+r32]=l_reg;asm volatile("s_waitcnt lgkmcnt(0)":::"memory");
  float rli[16];
  #pragma unroll
  for(int r=0;r<16;++r)rli[r]=__builtin_amdgcn_rcpf(wsf[32+crow(r,hi)]);
  bf16*Ow=Ou+(long)(wid*QBLK)*opitch;
  { bf16*stg=(bf16*)(shm+LDS_OST)+wid*2048;
    #pragma unroll
    for(int r=0;r<16;++r){const int orow=crow(r,hi);
      #pragma unroll
      for(int d0=0;d0<2;++d0)stg[orow*64+d0*32+r32]=__float2bfloat16(o[d0][r]*rli[r]);}
    asm volatile("s_waitcnt lgkmcnt(0)":::"memory");
    #pragma unroll
    for(int i=0;i<4;++i){const int row=i*8+(lane>>3),ch=lane&7; const u32x4 v=*(const u32x4*)(stg+row*64+ch*8); ATTN_STORE16(Ow+(long)row*opitch+ch*8,v);} }
  asm volatile("s_waitcnt lgkmcnt(0)\n\ts_barrier":::"memory");
  #undef DMA_K
  #undef DMA_V
  #undef CMASK
  #undef START
  #undef RESC
  #undef ROT
}
constexpr int SLOTV2=16384, LDS2_K=0, LDS2_V=NSLOT*SLOTB, LDS2_WS=LDS2_V+NSLOT*SLOTV2, LDS2_BYTES=LDS2_WS+NW*64*4;
__device__ __forceinline__ void pv128(f32x16*o,int vb,bf16x8 pa0,bf16x8 pa1,bf16x8 pa2,bf16x8 pa3){
  #pragma unroll
  for(int d0=0;d0<4;++d0){s16x4 lo[4],hi[4];
    #pragma unroll
    for(int ks=0;ks<4;++ks){
      asm volatile("ds_read_b64_tr_b16 %0,%1 offset:%c2":"=&v"(lo[ks]):"v"(vb),"i"(d0*4096+ks*1024):"memory");
      asm volatile("ds_read_b64_tr_b16 %0,%1 offset:%c2":"=&v"(hi[ks]):"v"(vb),"i"(d0*4096+ks*1024+512):"memory");}
    asm volatile("s_waitcnt lgkmcnt(0)":::"memory");SBAR();
    #define PK(k) (bf16x8){lo[k][0],lo[k][1],lo[k][2],lo[k][3],hi[k][0],hi[k][1],hi[k][2],hi[k][3]}
    o[d0]=__builtin_amdgcn_mfma_f32_32x32x16_bf16(pa0,PK(0),o[d0],0,0,0);
    o[d0]=__builtin_amdgcn_mfma_f32_32x32x16_bf16(pa1,PK(1),o[d0],0,0,0);
    o[d0]=__builtin_amdgcn_mfma_f32_32x32x16_bf16(pa2,PK(2),o[d0],0,0,0);
    o[d0]=__builtin_amdgcn_mfma_f32_32x32x16_bf16(pa3,PK(3),o[d0],0,0,0);
    #undef PK
  }
}
template<int THRL,bool FIXREF=false> __device__ __forceinline__ void attn_unit128(const bf16*Qu,const bf16*__restrict__ Kb,const bf16*__restrict__ Vb,bf16*Ou,int opitch,char*shm,int wid,float*stash,float lam,const float*subg){
  const int lane=lane_id_asm(),r32=lane&31,hi=lane>>5;
  const bf16*Vh=Vb;
 for(int cpass=0;cpass<2;++cpass){
  const int lane_p=lane_id_asm(),r32p=lane_p&31,hip=lane_p>>5;
  const bf16*Qw=Qu+(long)(wid*QBLK)*DM+cpass*64;
  const bf16*Kh=Kb+cpass*64;
  const unsigned lds0=(unsigned)(uintptr_t)shm;
  float*wsf=(float*)(shm+LDS2_WS)+wid*64;
  const bf16*ksrc=Kh+(long)lane_p*DM+wid*8;
  const bf16*vsrc=Vh+(long)(16*(wid&3)+(lane_p>>2))*DM+(wid>>2)*32+(lane_p&3)*8;
  const unsigned kdst=lds0+LDS2_K+wid*1024, vdst=lds0+LDS2_V+wid*1024;
  #define DMA_K(t,slot) glds16(ksrc+(long)(t)*KVBLK*DM,(unsigned)__builtin_amdgcn_readfirstlane(kdst+(slot)))
  #define DMA_V(t,slot) do{ glds16(vsrc+(long)(t)*KVBLK*DM,(unsigned)__builtin_amdgcn_readfirstlane(vdst+2*(slot))); glds16(vsrc+(long)(t)*KVBLK*DM+64,(unsigned)__builtin_amdgcn_readfirstlane(vdst+2*(slot)+8192)); }while(0)
  const int vb0=(int)(lds0+LDS2_V)+((lane_p>>4)&1)*32+(lane_p&3)*8+(4*hip+((lane_p&15)>>2))*64;
  const char*Kbase=shm+LDS2_K; bf16x8 kf[8];
  const lds_cptr shm3=(lds_cptr)shm; const lds_cptr kp0=shm3+LDS2_K+hip*1024+r32p*16; const lds_cptr vp0=shm3+LDS2_V+((lane_p>>4)&1)*32+(lane_p&3)*8+(4*hip+((lane_p&15)>>2))*64;
  DMA_K(0,0);DMA_V(0,0);DMA_K(1,SLOTB);
  bf16x8 qr[4];
  #pragma unroll
  for(int d0=0;d0<4;++d0)qr[d0]=*reinterpret_cast<const bf16x8*>(&Qw[(long)r32p*DM+d0*16+hip*8]);
  float zf_; asm volatile("v_mov_b32 %0, 0":"=v"(zf_));
  float mhat=0.f,l_reg=0.f;f32x16 o[4];
  #pragma unroll
  for(int r=0;r<16;++r){o[0][r]=zf_;o[1][r]=zf_;o[2][r]=zf_;o[3][r]=zf_;}
  f32x16 negm;
  #pragma unroll
  for(int r=0;r<16;++r)negm[r]=zf_;
  asm volatile("":"+v"(negm));
  #define CMASK(P0,P1,t) do{}while(0)
  bool resc=false;
  #define START(P0,P1) do{ resc=false; if constexpr(!FIXREF){ const float rm=rowmax(P0,P1); \
    { const float dl=rm; mhat=fadd_s(mhat,dl); \
      _Pragma("unroll") for(int r=0;r<16;++r){P0[r]=fsub_s(P0[r],dl);P1[r]=fsub_s(P1[r],dl);} \
      _Pragma("unroll") for(int r=0;r<16;++r)negm[r]=-mhat; asm volatile("":"+v"(negm)); } } \
    _Pragma("unroll") for(int r=0;r<16;++r)P0[r]=__builtin_amdgcn_exp2f(P0[r]); }while(0)
  #define RESC() do{ if(resc){ asm volatile("s_waitcnt lgkmcnt(0)":::"memory"); \
      _Pragma("unroll") for(int d_=0;d_<4;++d_) _Pragma("unroll") for(int r=0;r<16;++r)o[d_][r]*=wsf[crow(r,hi)]; } }while(0)
  f32x16 pA0,pA1,pB0,pB1;
  int sl_prev=0,sl_cur=0,sl_next=SLOTB;
  #define ROT() do{sl_prev=sl_cur;sl_cur=sl_next;sl_next=(sl_next==(NSLOT-1)*SLOTB)?0:sl_next+SLOTB;}while(0)
  DMA_K(2,2*SLOTB);
  WAIT_BAR(4);
  qkt(pA0,pA1,Kbase,qr,negm,r32,hi);asm volatile("s_nop 15\n\ts_nop 7":"+v"(pA0),"+v"(pA1));CMASK(pA0,pA1,0);
  START(pA0,pA1);
  _Pragma("unroll") for(int r=0;r<16;++r)pA1[r]=__builtin_amdgcn_exp2f(pA1[r]);
  WAIT_BAR(0);
  DMA_K(3,0);DMA_V(1,SLOTB);
  ROT();
  kload8(kf,kp0+sl_cur);
  WAIT_BAR(3);
  s16x4 vlo[9],vhi[9]; u32x4 pw0,pw1,pw2,pw3;
  #define PKW(P,B) cvtpk_s(P[B],P[B+1])
  #define PAF(k) __builtin_bit_cast(bf16x8,pw##k)
  #define VFR(i) (bf16x8){vlo[i][0],vlo[i][1],vlo[i][2],vlo[i][3],vhi[i][0],vhi[i][1],vhi[i][2],vhi[i][3]}
  #define PIN(x) asm volatile("":"+v"(x))
  #define MX3(a,b,c) __builtin_fmaxf(__builtin_fmaxf((a),(b)),(c))
  #define GAPA(MF,A0,A1,A2,A3,W0,W1,PW) do{ MF; sacc+=A0; sacc+=A1; sacc+=A2; sacc+=A3; PIN(sacc); W0; W1; PIN(PW); SBAR(); }while(0)
  #define EX(v) __builtin_amdgcn_exp2f(v)
  #define GAPB(MF,X,B) do{ MF; X[B]=EX(X[B]); X[B+1]=EX(X[B+1]); PIN(X); SBAR(); }while(0)
  #define VRD2(i,s) do{ vlo[s]=vtr(vp_+(8192+((i)>>2)*4096+((i)&3)*1024)); vhi[s]=vtr(vp_+(8192+((i)>>2)*4096+((i)&3)*1024+512)); }while(0)
  #define VRD(i) do{ vlo[i]=vtr(vp_+(((i)>>2)*4096+((i)&3)*1024)); vhi[i]=vtr(vp_+(((i)>>2)*4096+((i)&3)*1024+512)); }while(0)
  #define KRD(G,j) do{ if(G){ kload2(kf,kp0+sl_next,j); SBAR(); } }while(0)
  #define STEP(C0,C1,P0,P1,t,GK,GV,GL) do{ SBAR(); \
    const lds_cptr vp_=vp0+2*sl_prev; \
    VRD(0); SBAR(); float sacc=(P0[0]+P0[1]); \
    GAPA(C0=__builtin_amdgcn_mfma_f32_32x32x16_bf16(kf[0],qr[0],negm,0,0,0), P0[2],P0[3],P0[4],P0[5],     pw0[0]=PKW(P0,0), pw0[1]=PKW(P0,2), pw0); \
    VRD(4); SBAR(); GAPA(C1=__builtin_amdgcn_mfma_f32_32x32x16_bf16(kf[1],qr[0],negm,0,0,0), P0[6],P0[7],P0[8],P0[9],     pw0[2]=PKW(P0,4), pw0[3]=PKW(P0,6), pw0); \
    VRD(1); SBAR(); GAPA(C0=__builtin_amdgcn_mfma_f32_32x32x16_bf16(kf[2],qr[1],C0,0,0,0),   P0[10],P0[11],P0[12],P0[13], pw1[0]=PKW(P0,8), pw1[1]=PKW(P0,10), pw1); \
    VRD(5); SBAR(); GAPA(C1=__builtin_amdgcn_mfma_f32_32x32x16_bf16(kf[3],qr[1],C1,0,0,0),   P0[14],P0[15],P1[0],P1[1],   pw1[2]=PKW(P0,12),pw1[3]=PKW(P0,14), pw1); \
    VRD(2); SBAR(); GAPA(C0=__builtin_amdgcn_mfma_f32_32x32x16_bf16(kf[4],qr[2],C0,0,0,0),   P1[2],P1[3],P1[4],P1[5],     pw2[0]=PKW(P1,0), pw2[1]=PKW(P1,2), pw2); \
    VRD(6); SBAR(); GAPA(C1=__builtin_amdgcn_mfma_f32_32x32x16_bf16(kf[5],qr[2],C1,0,0,0),   P1[6],P1[7],P1[8],P1[9],     pw2[2]=PKW(P1,4), pw2[3]=PKW(P1,6), pw2); \
    VRD(3); SBAR(); GAPA(C0=__builtin_amdgcn_mfma_f32_32x32x16_bf16(kf[6],qr[3],C0,0,0,0),   P1[10],P1[11],P1[12],P1[13], pw3[0]=PKW(P1,8), pw3[1]=PKW(P1,10), pw3); \
    VRD(7); SBAR(); GAPA(C1=__builtin_amdgcn_mfma_f32_32x32x16_bf16(kf[7],qr[3],C1,0,0,0),   P1[14],P1[15],0.f,0.f,       pw3[2]=PKW(P1,12),pw3[3]=PKW(P1,14), pw3); \
    l_reg+=sacc; \
    if(GK){DMA_K((t)+3,sl_cur);} if(GV){DMA_V((t)+1,sl_next);} \
    CMASK(C0,C1,t); \
    if constexpr(!FIXREF){ float a=MX3(C0[0],C0[1],C1[0]),b=MX3(C0[2],C0[3],C1[1]); a=MX3(a,C1[2],C1[3]); \
      _Pragma("unroll") for(int r=4;r<16;r+=4){a=MX3(a,C0[r],C0[r+1]);b=MX3(b,C0[r+2],C0[r+3]);a=MX3(a,C1[r],C1[r+1]);b=MX3(b,C1[r+2],C1[r+3]);} \
      float rm=__builtin_fmaxf(a,b); { auto rr=__builtin_amdgcn_permlane32_swap(__float_as_uint(rm),__float_as_uint(rm),false,false); rm=__builtin_fmaxf(__uint_as_float(rr[0]),__uint_as_float(rr[1])); } \
      resc=false; \
      if(__builtin_expect(__any(rm>(float)THRL),0)){ const float dl=__builtin_fmaxf(rm,0.f); mhat+=dl; \
        _Pragma("unroll") for(int r=0;r<16;++r){C0[r]-=dl;C1[r]-=dl;} \
        _Pragma("unroll") for(int r=0;r<16;++r)negm[r]=-mhat; asm volatile("":"+v"(negm)); \
        const float f=__builtin_amdgcn_exp2f(-dl); l_reg*=f; { const int l2_=lane_id_asm(); if((l2_>>5)==0)wsf[l2_&31]=f; } resc=true; } } \
    SBAR(); \
    VRD2(0,8); SBAR(); GAPB(o[0]=__builtin_amdgcn_mfma_f32_32x32x16_bf16(PAF(0),VFR(0),o[0],0,0,0), C0,0); \
    VRD2(4,0); SBAR(); GAPB(o[1]=__builtin_amdgcn_mfma_f32_32x32x16_bf16(PAF(0),VFR(4),o[1],0,0,0), C0,2); \
    VRD2(1,4); SBAR(); GAPB(o[0]=__builtin_amdgcn_mfma_f32_32x32x16_bf16(PAF(1),VFR(1),o[0],0,0,0), C0,4); \
    VRD2(5,1); SBAR(); GAPB(o[1]=__builtin_amdgcn_mfma_f32_32x32x16_bf16(PAF(1),VFR(5),o[1],0,0,0), C0,6); \
    VRD2(2,5); SBAR(); GAPB(o[0]=__builtin_amdgcn_mfma_f32_32x32x16_bf16(PAF(2),VFR(2),o[0],0,0,0), C0,8); \
    VRD2(6,2); SBAR(); GAPB(o[1]=__builtin_amdgcn_mfma_f32_32x32x16_bf16(PAF(2),VFR(6),o[1],0,0,0), C0,10); \
    VRD2(3,6); SBAR(); GAPB(o[0]=__builtin_amdgcn_mfma_f32_32x32x16_bf16(PAF(3),VFR(3),o[0],0,0,0), C0,12); \
    VRD2(7,3); SBAR(); GAPB(o[1]=__builtin_amdgcn_mfma_f32_32x32x16_bf16(PAF(3),VFR(7),o[1],0,0,0), C0,14); \
    KRD(GL,0); GAPB(o[2]=__builtin_amdgcn_mfma_f32_32x32x16_bf16(PAF(0),VFR(8),o[2],0,0,0), C1,0); \
    KRD(GL,1); GAPB(o[3]=__builtin_amdgcn_mfma_f32_32x32x16_bf16(PAF(0),VFR(0),o[3],0,0,0), C1,2); \
    KRD(GL,2); GAPB(o[2]=__builtin_amdgcn_mfma_f32_32x32x16_bf16(PAF(1),VFR(4),o[2],0,0,0), C1,4); \
    KRD(GL,3); GAPB(o[3]=__builtin_amdgcn_mfma_f32_32x32x16_bf16(PAF(1),VFR(1),o[3],0,0,0), C1,6); \
    GAPB(o[2]=__builtin_amdgcn_mfma_f32_32x32x16_bf16(PAF(2),VFR(5),o[2],0,0,0), C1,8); \
    GAPB(o[3]=__builtin_amdgcn_mfma_f32_32x32x16_bf16(PAF(2),VFR(2),o[3],0,0,0), C1,10); \
    GAPB(o[2]=__builtin_amdgcn_mfma_f32_32x32x16_bf16(PAF(3),VFR(6),o[2],0,0,0), C1,12); \
    GAPB(o[3]=__builtin_amdgcn_mfma_f32_32x32x16_bf16(PAF(3),VFR(3),o[3],0,0,0), C1,14); \
    }while(0)
  int t=1;
  for(;t+5<NT;t+=2){
    STEP(pB0,pB1,pA0,pA1,t,true,true,true);     WAIT_BAR(3); RESC(); ROT();
    STEP(pA0,pA1,pB0,pB1,t+1,true,true,true);   WAIT_BAR(3); RESC(); ROT();
  }
  #define ENDW(tt) do{ if((tt)+3<NT){WAIT_BAR(3);} else if((tt)+2<NT){WAIT_BAR(2);} else {WAIT_BAR(0);} }while(0)
  for(;t+1<NT;t+=2){
    STEP(pB0,pB1,pA0,pA1,t,(t+3<NT),(t+1<NT),(t+1<NT));       ENDW(t);   RESC(); ROT();
    STEP(pA0,pA1,pB0,pB1,t+1,(t+4<NT),(t+2<NT),(t+2<NT));     ENDW(t+1); RESC(); ROT();
  }
  STEP(pB0,pB1,pA0,pA1,NT-1,false,false,false); RESC();
  { float sacc=pB0[0]+pB0[1]; _Pragma("unroll") for(int r=2;r<16;++r)sacc+=pB0[r]; _Pragma("unroll") for(int r=0;r<16;++r)sacc+=pB1[r]; l_reg+=sacc;
    pw0=(u32x4){PKW(pB0,0),PKW(pB0,2),PKW(pB0,4),PKW(pB0,6)};pw1=(u32x4){PKW(pB0,8),PKW(pB0,10),PKW(pB0,12),PKW(pB0,14)};pw2=(u32x4){PKW(pB1,0),PKW(pB1,2),PKW(pB1,4),PKW(pB1,6)};pw3=(u32x4){PKW(pB1,8),PKW(pB1,10),PKW(pB1,12),PKW(pB1,14)};
    SBAR(); pv128(o,vb0+2*sl_cur,PAF(0),PAF(1),PAF(2),PAF(3)); }
  #undef PKW
  #undef PAF
  #undef VFR
  #undef VRD2
  #undef PIN
  #undef MX3
  #undef GAPA
  #undef GAPB
  #undef EX
  #undef VRD
  #undef KRD
  #undef STEP
  #undef ENDW
  {auto rr=__builtin_amdgcn_permlane32_swap(__float_as_uint(l_reg),__float_as_uint(l_reg),false,false);l_reg=__uint_as_float(rr[0])+__uint_as_float(rr[1]);}
  const int lane_e=lane_id_asm(),r32e=lane_e&31,hie=lane_e>>5;
  if(hie==0)wsf[32+r32e]=l_reg;asm volatile("s_waitcnt lgkmcnt(0)":::"memory");
  float rli[16];
  #pragma unroll
  for(int r=0;r<16;++r)rli[r]=__builtin_amdgcn_rcpf(wsf[32+crow(r,hie)]);
  float*st=stash+(size_t)wid*4096+lane_e*4;
  if(cpass==0){
    #pragma unroll
    for(int d0=0;d0<4;++d0)
      #pragma unroll
      for(int q4=0;q4<4;++q4){ typedef float f32x4_t __attribute__((ext_vector_type(4)));
        const f32x4_t v={o[d0][4*q4]*rli[4*q4],o[d0][4*q4+1]*rli[4*q4+1],o[d0][4*q4+2]*rli[4*q4+2],o[d0][4*q4+3]*rli[4*q4+3]};
        *(f32x4_t*)(st+(d0*4+q4)*256)=v; }
  } else {
    typedef float f32x4_t __attribute__((ext_vector_type(4)));
    float ss[16];
    #pragma unroll
    for(int r=0;r<16;++r)ss[r]=0.f;
    #pragma unroll
    for(int d0=0;d0<4;++d0)
      #pragma unroll
      for(int q4=0;q4<4;++q4){ const f32x4_t a=*(const f32x4_t*)(st+(d0*4+q4)*256);
        #pragma unroll
        for(int i=0;i<4;++i){ const int r=4*q4+i; const float v=a[i]-lam*(o[d0][r]*rli[r]); o[d0][r]=v; ss[r]+=v*v; } if(q4==3)asm volatile("":::"memory"); }
    #pragma unroll
    for(int r=0;r<16;++r){ float s=ss[r]; s+=__shfl_xor(s,1); s+=__shfl_xor(s,2); s+=__shfl_xor(s,4); s+=__shfl_xor(s,8); s+=__shfl_xor(s,16); ss[r]=0.8f/sqrtf(s*(1.0f/128.0f)+1e-6f); }
    float gsub[4];
    #pragma unroll
    for(int d0=0;d0<4;++d0)gsub[d0]=subg[d0*32+r32e];
    asm volatile("s_waitcnt lgkmcnt(0)\n\ts_barrier":::"memory");
    bf16*Ow=Ou+(long)(wid*QBLK)*opitch;
    bf16*stg=(bf16*)shm+wid*4096;
    #pragma unroll
    for(int r=0;r<16;++r){const int orow=crow(r,hie);
      #pragma unroll
      for(int d0=0;d0<4;++d0)stg[orow*128+d0*32+r32e]=__float2bfloat16(o[d0][r]*ss[r]*gsub[d0]);}
    asm volatile("s_waitcnt lgkmcnt(0)":::"memory");
    #pragma unroll
    for(int i=0;i<8;++i){const int row=i*4+(lane_e>>4),ch=lane_e&15; const u32x4 v=*(const u32x4*)(stg+row*128+ch*8); ATTN_STORE16(Ow+(long)row*opitch+ch*8,v);}
  }
  asm volatile("s_waitcnt lgkmcnt(0)\n\ts_barrier":::"memory");
 }
  #undef DMA_K
  #undef DMA_V
  #undef CMASK
  #undef START
  #undef RESC
  #undef ROT
}

typedef int v8i32_t __attribute__((ext_vector_type(8))); typedef int v4i32_t __attribute__((ext_vector_type(4)));
constexpr int P8=1664;
#define MFMA8(a,b,c) __builtin_amdgcn_mfma_scale_f32_32x32x64_f8f6f4(a,b,c,0,0,0,0,0,0)
__device__ __forceinline__ v8i32_t cat8v(v4i32_t a,v4i32_t b){ return __builtin_shufflevector(a,b,0,1,2,3,4,5,6,7); }
__device__ __forceinline__ v8i32_t kfrag8(lds_cptr kp){ return cat8v(*(const __attribute__((address_space(3))) v4i32_t*)(kp),*(const __attribute__((address_space(3))) v4i32_t*)(kp+1024)); }
__device__ __forceinline__ void qkt8(f32x16&p0,f32x16&p1,lds_cptr kp,v8i32_t q8,const f32x16&negm){ const v8i32_t a=kfrag8(kp),b=kfrag8(kp+512); p0=MFMA8(a,q8,negm); p1=MFMA8(b,q8,negm); }
constexpr int SLOTK8=4096;
constexpr int L8A_K=0, L8A_V=NSLOT*SLOTK8, L8A_WS=L8A_V+NSLOT*8192, L8A_OST=L8A_WS+NW*64*4, L8A_BYTES=L8A_OST+NW*4096;
constexpr int L8B_K=0, L8B_V=NSLOT*SLOTK8, L8B_WS=65536, L8B_BYTES=L8B_WS+NW*64*4;
template<int THRL,bool FIXREF=false> __device__ __forceinline__ void attn_unit_q8(const unsigned char*Qu8,const unsigned char*__restrict__ Kb8,const bf16*__restrict__ Vb,bf16*Ou,int opitch,char*shm,int wid){
  const int lane=lane_id_asm(),r32=lane&31,hi=lane>>5;
  const unsigned char*Qw8=Qu8+(long)(wid*QBLK)*P8;
  const unsigned char*Kh8=Kb8; const bf16*Vh=Vb;
  const unsigned lds0=(unsigned)(uintptr_t)shm;
  float*wsf=(float*)(shm+L8A_WS)+wid*64;
  const unsigned char*ksrc=Kh8+(long)lane*P8+(wid&3)*16;
  const bf16*vsrc=Vh+(long)(16*(wid&3)+(lane>>2))*DM+(wid>>2)*32+(lane&3)*8;
  const unsigned kdst=lds0+L8A_K+(wid&3)*1024, vdst=lds0+L8A_V+wid*1024;
  #define DMA_K(t,slot) glds16(ksrc+(long)(t)*KVBLK*P8,(unsigned)__builtin_amdgcn_readfirstlane(kdst+(slot)))
  #define DMA_V(t,slot) glds16(vsrc+(long)(t)*KVBLK*DM,(unsigned)__builtin_amdgcn_readfirstlane(vdst+2*(slot)))
  const int vb0=(int)(lds0+L8A_V)+((lane>>4)&1)*32+(lane&3)*8+(4*hi+((lane&15)>>2))*64;
  v8i32_t kf8[2];
  const lds_cptr shm3=(lds_cptr)shm; const lds_cptr kp0=shm3+L8A_K+hi*2048+r32*16; const lds_cptr vp0=shm3+L8A_V+((lane>>4)&1)*32+(lane&3)*8+(4*hi+((lane&15)>>2))*64;
  DMA_K(0,0);DMA_V(0,0);DMA_K(1,SLOTK8);
  const v8i32_t q8=*reinterpret_cast<const v8i32_t*>(Qw8+(long)r32*P8+hi*32);
  float mhat=0.f,l_reg=0.f;f32x16 o[2];o[0]=f32x16{};o[1]=f32x16{};f32x16 negm=f32x16{};asm volatile("":"+v"(negm));
  #define CMASK(P0,P1,t) do{}while(0)
  bool resc=false;
  #define START(P0,P1) do{ resc=false; if constexpr(!FIXREF){ const float rm=rowmax(P0,P1); \
    { const float dl=rm; mhat=fadd_s(mhat,dl); \
      _Pragma("unroll") for(int r=0;r<16;++r){P0[r]=fsub_s(P0[r],dl);P1[r]=fsub_s(P1[r],dl);} \
      _Pragma("unroll") for(int r=0;r<16;++r)negm[r]=-mhat; asm volatile("":"+v"(negm)); } } \
    _Pragma("unroll") for(int r=0;r<16;++r)P0[r]=__builtin_amdgcn_exp2f(P0[r]); }while(0)
  #define RESC() do{ if(resc){ asm volatile("s_waitcnt lgkmcnt(0)":::"memory"); \
      _Pragma("unroll") for(int d_=0;d_<2;++d_) _Pragma("unroll") for(int r=0;r<16;++r)o[d_][r]*=wsf[crow(r,hi)]; } }while(0)
  f32x16 pA0,pA1,pB0,pB1;
  int sl_prev=0,sl_cur=0,sl_next=SLOTK8;
  #define ROT() do{sl_prev=sl_cur;sl_cur=sl_next;sl_next=(sl_next==(NSLOT-1)*SLOTK8)?0:sl_next+SLOTK8;}while(0)
  DMA_K(2,2*SLOTK8);
  WAIT_BAR(3);
  qkt8(pA0,pA1,kp0,q8,negm);asm volatile("s_nop 15\n\ts_nop 7":"+v"(pA0),"+v"(pA1));CMASK(pA0,pA1,0);
  START(pA0,pA1);
  _Pragma("unroll") for(int r=0;r<16;++r)pA1[r]=__builtin_amdgcn_exp2f(pA1[r]);
  WAIT_BAR(0);
  DMA_K(3,0);DMA_V(1,SLOTK8);
  ROT();
  kf8[0]=kfrag8(kp0+sl_cur); kf8[1]=kfrag8(kp0+sl_cur+512);
  WAIT_BAR(2);
  s16x4 vlo[8],vhi[8]; u32x4 pw0,pw1,pw2,pw3;
  #define PKW(P,B) cvtpk_s(P[B],P[B+1])
  #define PAF(k) __builtin_bit_cast(bf16x8,pw##k)
  #define VFR(i) (bf16x8){vlo[i][0],vlo[i][1],vlo[i][2],vlo[i][3],vhi[i][0],vhi[i][1],vhi[i][2],vhi[i][3]}
  #define PIN(x) asm volatile("":"+v"(x))
  #define MX3(a,b,c) __builtin_fmaxf(__builtin_fmaxf((a),(b)),(c))
  #define GAPA(MF,A0,A1,A2,A3,W0,W1,PW) do{ MF; sacc+=A0; sacc+=A1; sacc+=A2; sacc+=A3; PIN(sacc); W0; W1; PIN(PW); SBAR(); }while(0)
  #define EX(v) __builtin_amdgcn_exp2f(v)
  #define GAPB(MF,X,B) do{ MF; X[B]=EX(X[B]); X[B+1]=EX(X[B+1]); X[B+2]=EX(X[B+2]); X[B+3]=EX(X[B+3]); PIN(X); SBAR(); }while(0)
  #define VRD(i) do{ vlo[i]=vtr(vp_+(((i)>>2)*4096+((i)&3)*1024)); vhi[i]=vtr(vp_+(((i)>>2)*4096+((i)&3)*1024+512)); }while(0)
  #define KRD(G,j) do{ if(G){ kf8[j]=kfrag8(kp0+sl_next+(j)*512); SBAR(); } }while(0)
  #define STEP(C0,C1,P0,P1,t,GK,GV,GL) do{ SBAR(); \
    const lds_cptr vp_=vp0+2*sl_prev; \
    VRD(0); SBAR(); float sacc=(P0[0]+P0[1]); \
    C0=MFMA8(kf8[0],q8,negm); \
    sacc+=P0[2];sacc+=P0[3];sacc+=P0[4];sacc+=P0[5];sacc+=P0[6];sacc+=P0[7]; PIN(sacc); pw0[0]=PKW(P0,0); pw0[1]=PKW(P0,2); pw0[2]=PKW(P0,4); pw0[3]=PKW(P0,6); PIN(pw0); SBAR(); \
    VRD(4); SBAR(); \
    sacc+=P0[8];sacc+=P0[9];sacc+=P0[10];sacc+=P0[11];sacc+=P0[12];sacc+=P0[13];sacc+=P0[14];sacc+=P0[15]; PIN(sacc); pw1[0]=PKW(P0,8); pw1[1]=PKW(P0,10); pw1[2]=PKW(P0,12); pw1[3]=PKW(P0,14); PIN(pw1); SBAR(); \
    VRD(1); VRD(5); SBAR(); \
    C1=MFMA8(kf8[1],q8,negm); \
    sacc+=P1[0];sacc+=P1[1];sacc+=P1[2];sacc+=P1[3];sacc+=P1[4];sacc+=P1[5];sacc+=P1[6];sacc+=P1[7]; PIN(sacc); pw2[0]=PKW(P1,0); pw2[1]=PKW(P1,2); pw2[2]=PKW(P1,4); pw2[3]=PKW(P1,6); PIN(pw2); SBAR(); \
    VRD(2); VRD(6); SBAR(); \
    sacc+=P1[8];sacc+=P1[9];sacc+=P1[10];sacc+=P1[11];sacc+=P1[12];sacc+=P1[13];sacc+=P1[14];sacc+=P1[15]; PIN(sacc); pw3[0]=PKW(P1,8); pw3[1]=PKW(P1,10); pw3[2]=PKW(P1,12); pw3[3]=PKW(P1,14); PIN(pw3); SBAR(); \
    VRD(3); VRD(7); SBAR(); \
    l_reg+=sacc; \
    if(GK){DMA_K((t)+3,sl_cur);} if(GV){DMA_V((t)+1,sl_next);} \
    CMASK(C0,C1,t); \
    if constexpr(!FIXREF){ float a=MX3(C0[0],C0[1],C1[0]),b=MX3(C0[2],C0[3],C1[1]); a=MX3(a,C1[2],C1[3]); \
      _Pragma("unroll") for(int r=4;r<16;r+=4){a=MX3(a,C0[r],C0[r+1]);b=MX3(b,C0[r+2],C0[r+3]);a=MX3(a,C1[r],C1[r+1]);b=MX3(b,C1[r+2],C1[r+3]);} \
      float rm=__builtin_fmaxf(a,b); { auto rr=__builtin_amdgcn_permlane32_swap(__float_as_uint(rm),__float_as_uint(rm),false,false); rm=__builtin_fmaxf(__uint_as_float(rr[0]),__uint_as_float(rr[1])); } \
      resc=false; \
      if(__builtin_expect(__any(rm>(float)THRL),0)){ const float dl=__builtin_fmaxf(rm,0.f); mhat+=dl; \
        _Pragma("unroll") for(int r=0;r<16;++r){C0[r]-=dl;C1[r]-=dl;} \
        _Pragma("unroll") for(int r=0;r<16;++r)negm[r]=-mhat; asm volatile("":"+v"(negm)); \
        const float f=__builtin_amdgcn_exp2f(-dl); l_reg*=f; if(hi==0)wsf[r32]=f; resc=true; } } \
    SBAR(); \
    GAPB(o[0]=__builtin_amdgcn_mfma_f32_32x32x16_bf16(PAF(0),VFR(0),o[0],0,0,0), C0,0); \
    GAPB(o[1]=__builtin_amdgcn_mfma_f32_32x32x16_bf16(PAF(0),VFR(4),o[1],0,0,0), C0,4); \
    KRD(GL,0); GAPB(o[0]=__builtin_amdgcn_mfma_f32_32x32x16_bf16(PAF(1),VFR(1),o[0],0,0,0), C0,8); \
    KRD(GL,1); GAPB(o[1]=__builtin_amdgcn_mfma_f32_32x32x16_bf16(PAF(1),VFR(5),o[1],0,0,0), C0,12); \
    GAPB(o[0]=__builtin_amdgcn_mfma_f32_32x32x16_bf16(PAF(2),VFR(2),o[0],0,0,0), C1,0); \
    GAPB(o[1]=__builtin_amdgcn_mfma_f32_32x32x16_bf16(PAF(2),VFR(6),o[1],0,0,0), C1,4); \
    GAPB(o[0]=__builtin_amdgcn_mfma_f32_32x32x16_bf16(PAF(3),VFR(3),o[0],0,0,0), C1,8); \
    GAPB(o[1]=__builtin_amdgcn_mfma_f32_32x32x16_bf16(PAF(3),VFR(7),o[1],0,0,0), C1,12); \
    }while(0)
  int t=1;
  for(;t+5<NT;t+=2){
    STEP(pB0,pB1,pA0,pA1,t,true,true,true);     WAIT_BAR(2); RESC(); ROT();
    STEP(pA0,pA1,pB0,pB1,t+1,true,true,true);   WAIT_BAR(2); RESC(); ROT();
  }
  #define ENDW(tt) do{ if((tt)+3<NT){WAIT_BAR(2);} else if((tt)+2<NT){WAIT_BAR(1);} else {WAIT_BAR(0);} }while(0)
  for(;t+1<NT;t+=2){
    STEP(pB0,pB1,pA0,pA1,t,(t+3<NT),(t+1<NT),(t+1<NT));       ENDW(t);   RESC(); ROT();
    STEP(pA0,pA1,pB0,pB1,t+1,(t+4<NT),(t+2<NT),(t+2<NT));     ENDW(t+1); RESC(); ROT();
  }
  STEP(pB0,pB1,pA0,pA1,NT-1,false,false,false); RESC();
  { float sacc=pB0[0]+pB0[1]; _Pragma("unroll") for(int r=2;r<16;++r)sacc+=pB0[r]; _Pragma("unroll") for(int r=0;r<16;++r)sacc+=pB1[r]; l_reg+=sacc;
    pw0=(u32x4){PKW(pB0,0),PKW(pB0,2),PKW(pB0,4),PKW(pB0,6)};pw1=(u32x4){PKW(pB0,8),PKW(pB0,10),PKW(pB0,12),PKW(pB0,14)};pw2=(u32x4){PKW(pB1,0),PKW(pB1,2),PKW(pB1,4),PKW(pB1,6)};pw3=(u32x4){PKW(pB1,8),PKW(pB1,10),PKW(pB1,12),PKW(pB1,14)};
    SBAR(); pv(o,vb0+2*sl_cur,PAF(0),PAF(1),PAF(2),PAF(3)); }
  #undef PKW
  #undef PAF
  #undef VFR
  #undef PIN
  #undef MX3
  #undef GAPA
  #undef GAPB
  #undef EX
  #undef VRD
  #undef KRD
  #undef STEP
  #undef ENDW
  {auto rr=__builtin_amdgcn_permlane32_swap(__float_as_uint(l_reg),__float_as_uint(l_reg),false,false);l_reg=__uint_as_float(rr[0])+__uint_as_float(rr[1]);}
  if(hi==0)wsf[32+r32]=l_reg;asm volatile("s_waitcnt lgkmcnt(0)":::"memory");
  float rli[16];
  #pragma unroll
  for(int r=0;r<16;++r)rli[r]=__builtin_amdgcn_rcpf(wsf[32+crow(r,hi)]);
  bf16*Ow=Ou+(long)(wid*QBLK)*opitch;
  { bf16*stg=(bf16*)(shm+L8A_OST)+wid*2048;
    #pragma unroll
    for(int r=0;r<16;++r){const int orow=crow(r,hi);
      #pragma unroll
      for(int d0=0;d0<2;++d0)stg[orow*64+d0*32+r32]=__float2bfloat16(o[d0][r]*rli[r]);}
    asm volatile("s_waitcnt lgkmcnt(0)":::"memory");
    #pragma unroll
    for(int i=0;i<4;++i){const int row=i*8+(lane>>3),ch=lane&7; const u32x4 v=*(const u32x4*)(stg+row*64+ch*8); ATTN_STORE16(Ow+(long)row*opitch+ch*8,v);} }
  asm volatile("s_waitcnt lgkmcnt(0)\n\ts_barrier":::"memory");
  #undef DMA_K
  #undef DMA_V
  #undef CMASK
  #undef START
  #undef RESC
  #undef ROT
}
typedef int v2i32_t __attribute__((ext_vector_type(2)));
constexpr int PV8=640;
constexpr int L9A_K=0, L9A_V=4*SLOTK8, L9A_WS=7*SLOTK8, L9A_OST=L9A_WS+NW*64*4, L9A_BYTES=L9A_OST+NW*4096;
template<int THRL,bool FIXREF=false> __device__ __forceinline__ void attn_unit_q8v(const unsigned char*Qu8,const unsigned char*__restrict__ Kb8,const unsigned char*__restrict__ Vb8,bf16*Ou,int opitch,char*shm,int wid){
  const int lane=lane_id_asm(),r32=lane&31,hi=lane>>5;
  const unsigned char*Qw8=Qu8+(long)(wid*QBLK)*P8;
  const unsigned char*Kh8=Kb8; const bool kw=wid<4;
  const unsigned lds0=(unsigned)(uintptr_t)shm;
  float*wsf=(float*)(shm+L9A_WS)+wid*64;
  const unsigned char*ksrc=Kh8+(long)lane*P8+(wid&3)*16;
  const int vkey_=16*(wid&3)+(lane>>2), vc_=(lane&3)^(((vkey_>>3)&1)<<1);
  const unsigned char*vsrc=Vb8+(long)vkey_*PV8+vc_*16;
  const unsigned kdst=lds0+L9A_K+(wid&3)*1024, vdst=lds0+L9A_V+(wid&3)*1024;
  #define DMA_K(t,slot) glds16(ksrc+(long)(t)*KVBLK*P8,(unsigned)__builtin_amdgcn_readfirstlane(kdst+(slot)))
  #define DMA_V(t,slot) glds16(vsrc+(long)(t)*KVBLK*PV8,(unsigned)__builtin_amdgcn_readfirstlane(vdst+(slot)))
  v8i32_t kf8[2];
  const lds_cptr shm3=(lds_cptr)shm; const lds_cptr kp0=shm3+L9A_K+hi*2048+r32*16;
  const int vq_=(lane&15)>>1, vkey0_=(vq_&3)+8*(vq_>>2)+4*hi, vsw_=(vq_>>2)<<1;
  const lds_cptr vpA=shm3+L9A_V+vkey0_*64+((((lane>>4)&1))^vsw_)*16+(lane&1)*8, vpB=shm3+L9A_V+vkey0_*64+((2+((lane>>4)&1))^vsw_)*16+(lane&1)*8;
  if(kw){DMA_K(0,0);DMA_K(1,SLOTK8);}else{DMA_V(0,0);}
  const v8i32_t q8=*reinterpret_cast<const v8i32_t*>(Qw8+(long)r32*P8+hi*32);
  float mhat=0.f,l_reg=0.f;f32x16 o[2];o[0]=f32x16{};o[1]=f32x16{};f32x16 negm=f32x16{};asm volatile("":"+v"(negm));
  #define CMASK(P0,P1,t) do{}while(0)
  bool resc=false;
  #define START(P0,P1) do{ resc=false; if constexpr(!FIXREF){ const float rm=rowmax(P0,P1); \
    { const float dl=rm; mhat=fadd_s(mhat,dl); \
      _Pragma("unroll") for(int r=0;r<16;++r){P0[r]=fsub_s(P0[r],dl);P1[r]=fsub_s(P1[r],dl);} \
      _Pragma("unroll") for(int r=0;r<16;++r)negm[r]=-mhat; asm volatile("":"+v"(negm)); } } \
    _Pragma("unroll") for(int r=0;r<16;++r)P0[r]=__builtin_amdgcn_exp2f(P0[r]); }while(0)
  #define RESC() do{ if(resc){ asm volatile("s_waitcnt lgkmcnt(0)":::"memory"); \
      _Pragma("unroll") for(int d_=0;d_<2;++d_) _Pragma("unroll") for(int r=0;r<16;++r)o[d_][r]*=wsf[crow(r,hi)]; } }while(0)
  f32x16 pA0,pA1,pB0,pB1;
  int sl_prev=0,sl_cur=0,sl_next=SLOTK8;
  int kq_prev=0,kq_cur=0,kq_next=SLOTK8;
  #define ROT() do{sl_prev=sl_cur;sl_cur=sl_next;sl_next=(sl_next==(NSLOT-1)*SLOTK8)?0:sl_next+SLOTK8; kq_prev=kq_cur;kq_cur=kq_next;kq_next=(kq_next==3*SLOTK8)?0:kq_next+SLOTK8;}while(0)
  if(kw){DMA_K(2,2*SLOTK8);}
  WAIT_BAR(2);
  qkt8(pA0,pA1,kp0,q8,negm);asm volatile("s_nop 15\n\ts_nop 7":"+v"(pA0),"+v"(pA1));CMASK(pA0,pA1,0);
  START(pA0,pA1);
  _Pragma("unroll") for(int r=0;r<16;++r)pA1[r]=__builtin_amdgcn_exp2f(pA1[r]);
  WAIT_BAR(0);
  if(kw){DMA_K(3,3*SLOTK8);}else{DMA_V(1,SLOTK8);}
  ROT();
  kf8[0]=kfrag8(kp0+kq_cur); kf8[1]=kfrag8(kp0+kq_cur+512);
  WAIT_BAR(1);
  v2i32_t vA0,vA1,vA2,vA3,vB0,vB1,vB2,vB3; v8i32_t pw8=v8i32_t{}; static_assert(FIXREF,"constant reference only (the row sums are not rescaled)");
  v8i32_t ones8; { int o1_; asm volatile("v_mov_b32 %0, 0x38383838":"=v"(o1_)); ones8=(v8i32_t){o1_,o1_,o1_,o1_,o1_,o1_,o1_,o1_}; } f32x16 ls=f32x16{};
  #define PK4(P,B) (int)pg8::pk4_fp8(P[B],P[B+1],P[B+2],P[B+3])
  #define PK4I(D,P,B) do{ D=__builtin_amdgcn_cvt_pk_fp8_f32(P[B],P[B+1],D,false); D=__builtin_amdgcn_cvt_pk_fp8_f32(P[B+2],P[B+3],D,true); }while(0)
  #define VT8(p) __builtin_amdgcn_ds_read_tr8_b64_v2i32((__attribute__((address_space(3))) v2i32_t*)(p))
  #define V8A() (v8i32_t){vA0[0],vA0[1],vA1[0],vA1[1],vA2[0],vA2[1],vA3[0],vA3[1]}
  #define V8B() (v8i32_t){vB0[0],vB0[1],vB1[0],vB1[1],vB2[0],vB2[1],vB3[0],vB3[1]}
  #define PIN(x) asm volatile("":"+v"(x))
  #define MX3(a,b,c) __builtin_fmaxf(__builtin_fmaxf((a),(b)),(c))
  #define EX(v) __builtin_amdgcn_exp2f(v)
  #define EX4(X,B) do{ X[B]=EX(X[B]); X[B+1]=EX(X[B+1]); X[B+2]=EX(X[B+2]); X[B+3]=EX(X[B+3]); PIN(X); SBAR(); }while(0)
  #define KRD(G,j,KS) do{ if(G){ kf8[j]=kfrag8(kp0+(KS)+(j)*512); SBAR(); } }while(0)
  #define STEPA(C0,C1,P0,P1) do{ SBAR(); \
    const lds_cptr va_=vpA+sl_prev, vb_=vpB+sl_prev; \
    vA0=VT8(va_); vA1=VT8(va_+1024); SBAR(); \
    C0=MFMA8(kf8[0],q8,negm); \
    PK4I(pw8[0],P0,0); PK4I(pw8[1],P0,4); PIN(pw8); SBAR(); \
    vA2=VT8(va_+2048); vA3=VT8(va_+3072); SBAR(); \
    PK4I(pw8[2],P0,8); PK4I(pw8[3],P0,12); PIN(pw8); SBAR(); \
    vB0=VT8(vb_); vB1=VT8(vb_+1024); SBAR(); \
    C1=MFMA8(kf8[1],q8,negm); \
    PK4I(pw8[4],P1,0); PK4I(pw8[5],P1,4); PIN(pw8); SBAR(); \
    vB2=VT8(vb_+2048); vB3=VT8(vb_+3072); SBAR(); \
    PK4I(pw8[6],P1,8); PK4I(pw8[7],P1,12); PIN(pw8); SBAR(); \
    }while(0)
  #define STEPB(C0,C1,GL,KS) do{ SBAR(); \
    ls=MFMA8(pw8,ones8,ls); o[0]=MFMA8(pw8,V8A(),o[0]); SBAR(); \
    EX4(C0,0); EX4(C0,4); KRD(GL,0,KS); EX4(C0,8); EX4(C0,12); \
    o[1]=MFMA8(pw8,V8B(),o[1]); SBAR(); \
    EX4(C1,0); KRD(GL,1,KS); EX4(C1,4); EX4(C1,8); EX4(C1,12); \
    }while(0)
  #define ENDW(tt) do{ if((tt)+3<NT){WAIT_BAR(1);} else {WAIT_BAR(0);} }while(0)
  if(kw){
    int t=1;
    for(;t+1<NT;t+=2){
      STEPA(pB0,pB1,pA0,pA1); if(t+3<NT){DMA_K(t+3,kq_prev);} STEPB(pB0,pB1,true,kq_next); ENDW(t); ROT();
      STEPA(pA0,pA1,pB0,pB1); if(t+4<NT){DMA_K(t+4,kq_prev);} STEPB(pA0,pA1,(t+2<NT),kq_next); ENDW(t+1); ROT();
    }
    STEPA(pB0,pB1,pA0,pA1); STEPB(pB0,pB1,false,0);
  } else {
    int t=1;
    DMA_V(2,sl_next); STEPA(pB0,pB1,pA0,pA1); ENDW(1); ROT(); t=2;
    for(;t+3<NT;t+=2){
      DMA_V(t+1,sl_next); STEPB(pB0,pB1,true,kq_cur); STEPA(pA0,pA1,pB0,pB1); ENDW(t); ROT();
      DMA_V(t+2,sl_next); STEPB(pA0,pA1,true,kq_cur); STEPA(pB0,pB1,pA0,pA1); ENDW(t+1); ROT();
    }
    DMA_V(t+1,sl_next); STEPB(pB0,pB1,true,kq_cur); STEPA(pA0,pA1,pB0,pB1); ENDW(t); ROT();
    STEPB(pA0,pA1,true,kq_cur); STEPA(pB0,pB1,pA0,pA1);
    STEPB(pB0,pB1,false,0);
  }
  {
    pw8=(v8i32_t){PK4(pB0,0),PK4(pB0,4),PK4(pB0,8),PK4(pB0,12),PK4(pB1,0),PK4(pB1,4),PK4(pB1,8),PK4(pB1,12)};
    const lds_cptr va_=vpA+sl_cur, vb_=vpB+sl_cur;
    vA0=VT8(va_); vA1=VT8(va_+1024); vA2=VT8(va_+2048); vA3=VT8(va_+3072); vB0=VT8(vb_); vB1=VT8(vb_+1024); vB2=VT8(vb_+2048); vB3=VT8(vb_+3072);
    SBAR(); ls=MFMA8(pw8,ones8,ls); o[0]=MFMA8(pw8,V8A(),o[0]); o[1]=MFMA8(pw8,V8B(),o[1]); }
  #undef PK4
  #undef PK4I
  #undef VT8
  #undef V8A
  #undef V8B
  #undef PIN
  #undef MX3
  #undef EX
  #undef EX4
  #undef KRD
  #undef STEPA
  #undef STEPB
  #undef STEP
  #undef ENDW
  {auto rr=__builtin_amdgcn_permlane32_swap(__float_as_uint(l_reg),__float_as_uint(l_reg),false,false);l_reg=__uint_as_float(rr[0])+__uint_as_float(rr[1]);}
  if(hi==0)wsf[32+r32]=l_reg;asm volatile("s_waitcnt lgkmcnt(0)":::"memory");
  float rli[16];
  #pragma unroll
  for(int r=0;r<16;++r)rli[r]=__builtin_amdgcn_rcpf(ls[r]);
  bf16*Ow=Ou+(long)(wid*QBLK)*opitch;
  { bf16*stg=(bf16*)(shm+L9A_OST)+wid*2048;
    #pragma unroll
    for(int r=0;r<16;++r){const int orow=crow(r,hi);
      #pragma unroll
      for(int d0=0;d0<2;++d0)stg[orow*64+d0*32+r32]=__float2bfloat16(o[d0][r]*rli[r]);}
    asm volatile("s_waitcnt lgkmcnt(0)":::"memory");
    #pragma unroll
    for(int i=0;i<4;++i){const int row=i*8+(lane>>3),ch=lane&7; const u32x4 v=*(const u32x4*)(stg+row*64+ch*8); ATTN_STORE16(Ow+(long)row*opitch+ch*8,v);} }
  asm volatile("s_waitcnt lgkmcnt(0)\n\ts_barrier":::"memory");
  #undef DMA_K
  #undef DMA_V
  #undef CMASK
  #undef START
  #undef RESC
  #undef ROT
}
template<int THRL,bool FIXREF=false> __device__ __forceinline__ void attn_unit128_q8(const unsigned char*Qu8,const unsigned char*__restrict__ Kb8,const bf16*__restrict__ Vb,bf16*Ou,int opitch,char*shm,int wid,float*stash,float lam,const float*subg,int pass_lo,int pass_hi){
  const int lane=lane_id_asm(),r32=lane&31,hi=lane>>5;
  const bf16*Vh=Vb;
 for(int cpass=pass_lo;cpass<pass_hi;++cpass){
  const int lane_p=lane_id_asm(),r32p=lane_p&31,hip=lane_p>>5;
  const unsigned char*Qw8=Qu8+(long)(wid*QBLK)*P8+cpass*64;
  const unsigned char*Kh8=Kb8+cpass*64;
  const unsigned lds0=(unsigned)(uintptr_t)shm;
  float*wsf=(float*)(shm+L8B_WS)+wid*64;
  const unsigned char*ksrc=Kh8+(long)lane_p*P8+(wid&3)*16;
  const bf16*vsrc=Vh+(long)(16*(wid&3)+(lane_p>>2))*DM+(wid>>2)*32+(lane_p&3)*8;
  const unsigned kdst=lds0+L8B_K+(wid&3)*1024, vdst=lds0+L8B_V+wid*1024;
  #define DMA_K(t,slot) glds16(ksrc+(long)(t)*KVBLK*P8,(unsigned)__builtin_amdgcn_readfirstlane(kdst+(slot)))
  #define DMA_V(t,slot) do{ glds16(vsrc+(long)(t)*KVBLK*DM,(unsigned)__builtin_amdgcn_readfirstlane(vdst+4*(slot))); glds16(vsrc+(long)(t)*KVBLK*DM+64,(unsigned)__builtin_amdgcn_readfirstlane(vdst+4*(slot)+8192)); }while(0)
  const int vb0=(int)(lds0+L8B_V)+((lane_p>>4)&1)*32+(lane_p&3)*8+(4*hip+((lane_p&15)>>2))*64;
  v8i32_t kf8[2];
  const lds_cptr shm3=(lds_cptr)shm; const lds_cptr kp0=shm3+L8B_K+hip*2048+r32p*16; const lds_cptr vp0=shm3+L8B_V+((lane_p>>4)&1)*32+(lane_p&3)*8+(4*hip+((lane_p&15)>>2))*64;
  DMA_K(0,0);DMA_V(0,0);DMA_K(1,SLOTK8);
  const v8i32_t q8=*reinterpret_cast<const v8i32_t*>(Qw8+(long)r32p*P8+hip*32);
  float zf_; asm volatile("v_mov_b32 %0, 0":"=v"(zf_));
  float mhat=0.f,l_reg=0.f;f32x16 o[4];
  #pragma unroll
  for(int r=0;r<16;++r){o[0][r]=zf_;o[1][r]=zf_;o[2][r]=zf_;o[3][r]=zf_;}
  f32x16 negm;
  #pragma unroll
  for(int r=0;r<16;++r)negm[r]=zf_;
  asm volatile("":"+v"(negm));
  #define CMASK(P0,P1,t) do{}while(0)
  bool resc=false;
  #define START(P0,P1) do{ resc=false; if constexpr(!FIXREF){ const float rm=rowmax(P0,P1); \
    { const float dl=rm; mhat=fadd_s(mhat,dl); \
      _Pragma("unroll") for(int r=0;r<16;++r){P0[r]=fsub_s(P0[r],dl);P1[r]=fsub_s(P1[r],dl);} \
      _Pragma("unroll") for(int r=0;r<16;++r)negm[r]=-mhat; asm volatile("":"+v"(negm)); } } \
    _Pragma("unroll") for(int r=0;r<16;++r)P0[r]=__builtin_amdgcn_exp2f(P0[r]); }while(0)
  #define RESC() do{ if(resc){ asm volatile("s_waitcnt lgkmcnt(0)":::"memory"); \
      _Pragma("unroll") for(int d_=0;d_<4;++d_) _Pragma("unroll") for(int r=0;r<16;++r)o[d_][r]*=wsf[crow(r,hi)]; } }while(0)
  f32x16 pA0,pA1,pB0,pB1;
  int sl_prev=0,sl_cur=0,sl_next=SLOTK8;
  #define ROT() do{sl_prev=sl_cur;sl_cur=sl_next;sl_next=(sl_next==(NSLOT-1)*SLOTK8)?0:sl_next+SLOTK8;}while(0)
  DMA_K(2,2*SLOTK8);
  WAIT_BAR(4);
  qkt8(pA0,pA1,kp0,q8,negm);asm volatile("s_nop 15\n\ts_nop 7":"+v"(pA0),"+v"(pA1));CMASK(pA0,pA1,0);
  START(pA0,pA1);
  _Pragma("unroll") for(int r=0;r<16;++r)pA1[r]=__builtin_amdgcn_exp2f(pA1[r]);
  WAIT_BAR(0);
  DMA_K(3,0);DMA_V(1,SLOTK8);
  ROT();
  kf8[0]=kfrag8(kp0+sl_cur); kf8[1]=kfrag8(kp0+sl_cur+512);
  WAIT_BAR(3);
  s16x4 vlo[9],vhi[9]; u32x4 pw0,pw1,pw2,pw3;
  #define PKW(P,B) cvtpk_s(P[B],P[B+1])
  #define PAF(k) __builtin_bit_cast(bf16x8,pw##k)
  #define VFR(i) (bf16x8){vlo[i][0],vlo[i][1],vlo[i][2],vlo[i][3],vhi[i][0],vhi[i][1],vhi[i][2],vhi[i][3]}
  #define PIN(x) asm volatile("":"+v"(x))
  #define MX3(a,b,c) __builtin_fmaxf(__builtin_fmaxf((a),(b)),(c))
  #define GAPA(MF,A0,A1,A2,A3,W0,W1,PW) do{ MF; sacc+=A0; sacc+=A1; sacc+=A2; sacc+=A3; PIN(sacc); W0; W1; PIN(PW); SBAR(); }while(0)
  #define EX(v) __builtin_amdgcn_exp2f(v)
  #define GAPB(MF,X,B) do{ MF; X[B]=EX(X[B]); X[B+1]=EX(X[B+1]); PIN(X); SBAR(); }while(0)
  #define VRD2(i,s) do{ vlo[s]=vtr(vp_+(8192+((i)>>2)*4096+((i)&3)*1024)); vhi[s]=vtr(vp_+(8192+((i)>>2)*4096+((i)&3)*1024+512)); }while(0)
  #define VRD(i) do{ vlo[i]=vtr(vp_+(((i)>>2)*4096+((i)&3)*1024)); vhi[i]=vtr(vp_+(((i)>>2)*4096+((i)&3)*1024+512)); }while(0)
  #define KRD(G,j) do{ if(G){ kf8[j]=kfrag8(kp0+sl_next+(j)*512); SBAR(); } }while(0)
  #define STEP(C0,C1,P0,P1,t,GK,GV,GL) do{ SBAR(); \
    const lds_cptr vp_=vp0+4*sl_prev; \
    VRD(0); SBAR(); float sacc=(P0[0]+P0[1]); \
    C0=MFMA8(kf8[0],q8,negm); \
    sacc+=P0[2];sacc+=P0[3];sacc+=P0[4];sacc+=P0[5];sacc+=P0[6];sacc+=P0[7]; PIN(sacc); pw0[0]=PKW(P0,0); pw0[1]=PKW(P0,2); pw0[2]=PKW(P0,4); pw0[3]=PKW(P0,6); PIN(pw0); SBAR(); \
    VRD(4); SBAR(); \
    sacc+=P0[8];sacc+=P0[9];sacc+=P0[10];sacc+=P0[11];sacc+=P0[12];sacc+=P0[13];sacc+=P0[14];sacc+=P0[15]; PIN(sacc); pw1[0]=PKW(P0,8); pw1[1]=PKW(P0,10); pw1[2]=PKW(P0,12); pw1[3]=PKW(P0,14); PIN(pw1); SBAR(); \
    VRD(1); VRD(5); SBAR(); \
    C1=MFMA8(kf8[1],q8,negm); \
    sacc+=P1[0];sacc+=P1[1];sacc+=P1[2];sacc+=P1[3];sacc+=P1[4];sacc+=P1[5];sacc+=P1[6];sacc+=P1[7]; PIN(sacc); pw2[0]=PKW(P1,0); pw2[1]=PKW(P1,2); pw2[2]=PKW(P1,4); pw2[3]=PKW(P1,6); PIN(pw2); SBAR(); \
    VRD(2); VRD(6); SBAR(); \
    sacc+=P1[8];sacc+=P1[9];sacc+=P1[10];sacc+=P1[11];sacc+=P1[12];sacc+=P1[13];sacc+=P1[14];sacc+=P1[15]; PIN(sacc); pw3[0]=PKW(P1,8); pw3[1]=PKW(P1,10); pw3[2]=PKW(P1,12); pw3[3]=PKW(P1,14); PIN(pw3); SBAR(); \
    VRD(3); VRD(7); SBAR(); \
    l_reg+=sacc; \
    if(GK){DMA_K((t)+3,sl_cur);} if(GV){DMA_V((t)+1,sl_next);} \
    CMASK(C0,C1,t); \
    if constexpr(!FIXREF){ float a=MX3(C0[0],C0[1],C1[0]),b=MX3(C0[2],C0[3],C1[1]); a=MX3(a,C1[2],C1[3]); \
      _Pragma("unroll") for(int r=4;r<16;r+=4){a=MX3(a,C0[r],C0[r+1]);b=MX3(b,C0[r+2],C0[r+3]);a=MX3(a,C1[r],C1[r+1]);b=MX3(b,C1[r+2],C1[r+3]);} \
      float rm=__builtin_fmaxf(a,b); { auto rr=__builtin_amdgcn_permlane32_swap(__float_as_uint(rm),__float_as_uint(rm),false,false); rm=__builtin_fmaxf(__uint_as_float(rr[0]),__uint_as_float(rr[1])); } \
      resc=false; \
      if(__builtin_expect(__any(rm>(float)THRL),0)){ const float dl=__builtin_fmaxf(rm,0.f); mhat+=dl; \
        _Pragma("unroll") for(int r=0;r<16;++r){C0[r]-=dl;C1[r]-=dl;} \
        _Pragma("unroll") for(int r=0;r<16;++r)negm[r]=-mhat; asm volatile("":"+v"(negm)); \
        const float f=__builtin_amdgcn_exp2f(-dl); l_reg*=f; { const int l2_=lane_id_asm(); if((l2_>>5)==0)wsf[l2_&31]=f; } resc=true; } } \
    SBAR(); \
    VRD2(0,8); SBAR(); GAPB(o[0]=__builtin_amdgcn_mfma_f32_32x32x16_bf16(PAF(0),VFR(0),o[0],0,0,0), C0,0); \
    VRD2(4,0); SBAR(); GAPB(o[1]=__builtin_amdgcn_mfma_f32_32x32x16_bf16(PAF(0),VFR(4),o[1],0,0,0), C0,2); \
    VRD2(1,4); SBAR(); GAPB(o[0]=__builtin_amdgcn_mfma_f32_32x32x16_bf16(PAF(1),VFR(1),o[0],0,0,0), C0,4); \
    VRD2(5,1); SBAR(); GAPB(o[1]=__builtin_amdgcn_mfma_f32_32x32x16_bf16(PAF(1),VFR(5),o[1],0,0,0), C0,6); \
    VRD2(2,5); SBAR(); GAPB(o[0]=__builtin_amdgcn_mfma_f32_32x32x16_bf16(PAF(2),VFR(2),o[0],0,0,0), C0,8); \
    VRD2(6,2); SBAR(); GAPB(o[1]=__builtin_amdgcn_mfma_f32_32x32x16_bf16(PAF(2),VFR(6),o[1],0,0,0), C0,10); \
    VRD2(3,6); SBAR(); GAPB(o[0]=__builtin_amdgcn_mfma_f32_32x32x16_bf16(PAF(3),VFR(3),o[0],0,0,0), C0,12); \
    VRD2(7,3); SBAR(); GAPB(o[1]=__builtin_amdgcn_mfma_f32_32x32x16_bf16(PAF(3),VFR(7),o[1],0,0,0), C0,14); \
    KRD(GL,0); GAPB(o[2]=__builtin_amdgcn_mfma_f32_32x32x16_bf16(PAF(0),VFR(8),o[2],0,0,0), C1,0); \
    KRD(GL,1); GAPB(o[3]=__builtin_amdgcn_mfma_f32_32x32x16_bf16(PAF(0),VFR(0),o[3],0,0,0), C1,2); \
    GAPB(o[2]=__builtin_amdgcn_mfma_f32_32x32x16_bf16(PAF(1),VFR(4),o[2],0,0,0), C1,4); \
    GAPB(o[3]=__builtin_amdgcn_mfma_f32_32x32x16_bf16(PAF(1),VFR(1),o[3],0,0,0), C1,6); \
    GAPB(o[2]=__builtin_amdgcn_mfma_f32_32x32x16_bf16(PAF(2),VFR(5),o[2],0,0,0), C1,8); \
    GAPB(o[3]=__builtin_amdgcn_mfma_f32_32x32x16_bf16(PAF(2),VFR(2),o[3],0,0,0), C1,10); \
    GAPB(o[2]=__builtin_amdgcn_mfma_f32_32x32x16_bf16(PAF(3),VFR(6),o[2],0,0,0), C1,12); \
    GAPB(o[3]=__builtin_amdgcn_mfma_f32_32x32x16_bf16(PAF(3),VFR(3),o[3],0,0,0), C1,14); \
    }while(0)
  int t=1;
  for(;t+5<NT;t+=2){
    STEP(pB0,pB1,pA0,pA1,t,true,true,true);     WAIT_BAR(3); RESC(); ROT();
    STEP(pA0,pA1,pB0,pB1,t+1,true,true,true);   WAIT_BAR(3); RESC(); ROT();
  }
  #define ENDW(tt) do{ if((tt)+3<NT){WAIT_BAR(3);} else if((tt)+2<NT){WAIT_BAR(2);} else {WAIT_BAR(0);} }while(0)
  for(;t+1<NT;t+=2){
    STEP(pB0,pB1,pA0,pA1,t,(t+3<NT),(t+1<NT),(t+1<NT));       ENDW(t);   RESC(); ROT();
    STEP(pA0,pA1,pB0,pB1,t+1,(t+4<NT),(t+2<NT),(t+2<NT));     ENDW(t+1); RESC(); ROT();
  }
  STEP(pB0,pB1,pA0,pA1,NT-1,false,false,false); RESC();
  { float sacc=pB0[0]+pB0[1]; _Pragma("unroll") for(int r=2;r<16;++r)sacc+=pB0[r]; _Pragma("unroll") for(int r=0;r<16;++r)sacc+=pB1[r]; l_reg+=sacc;
    pw0=(u32x4){PKW(pB0,0),PKW(pB0,2),PKW(pB0,4),PKW(pB0,6)};pw1=(u32x4){PKW(pB0,8),PKW(pB0,10),PKW(pB0,12),PKW(pB0,14)};pw2=(u32x4){PKW(pB1,0),PKW(pB1,2),PKW(pB1,4),PKW(pB1,6)};pw3=(u32x4){PKW(pB1,8),PKW(pB1,10),PKW(pB1,12),PKW(pB1,14)};
    SBAR(); pv128(o,vb0+4*sl_cur,PAF(0),PAF(1),PAF(2),PAF(3)); }
  #undef PKW
  #undef PAF
  #undef VFR
  #undef VRD2
  #undef PIN
  #undef MX3
  #undef GAPA
  #undef GAPB
  #undef EX
  #undef VRD
  #undef KRD
  #undef STEP
  #undef ENDW
  {auto rr=__builtin_amdgcn_permlane32_swap(__float_as_uint(l_reg),__float_as_uint(l_reg),false,false);l_reg=__uint_as_float(rr[0])+__uint_as_float(rr[1]);}
  const int lane_e=lane_id_asm(),r32e=lane_e&31,hie=lane_e>>5;
  if(hie==0)wsf[32+r32e]=l_reg;asm volatile("s_waitcnt lgkmcnt(0)":::"memory");
  float rli[16];
  #pragma unroll
  for(int r=0;r<16;++r)rli[r]=__builtin_amdgcn_rcpf(wsf[32+crow(r,hie)]);
  float*st=stash+(size_t)wid*4096+lane_e*4;
  if(cpass==0){
    #pragma unroll
    for(int d0=0;d0<4;++d0)
      #pragma unroll
      for(int q4=0;q4<4;++q4){ typedef float f32x4_t __attribute__((ext_vector_type(4)));
        const f32x4_t v={o[d0][4*q4]*rli[4*q4],o[d0][4*q4+1]*rli[4*q4+1],o[d0][4*q4+2]*rli[4*q4+2],o[d0][4*q4+3]*rli[4*q4+3]};
        *(f32x4_t*)(st+(d0*4+q4)*256)=v; }
  } else {
    typedef float f32x4_t __attribute__((ext_vector_type(4)));
    float ss[16];
    #pragma unroll
    for(int r=0;r<16;++r)ss[r]=0.f;
    #pragma unroll
    for(int d0=0;d0<4;++d0)
      #pragma unroll
      for(int q4=0;q4<4;++q4){ const f32x4_t a=*(const f32x4_t*)(st+(d0*4+q4)*256);
        #pragma unroll
        for(int i=0;i<4;++i){ const int r=4*q4+i; const float v=a[i]-lam*(o[d0][r]*rli[r]); o[d0][r]=v; ss[r]+=v*v; } if(q4==3)asm volatile("":::"memory"); }
    #pragma unroll
    for(int r=0;r<16;++r){ float s=ss[r]; s+=__shfl_xor(s,1); s+=__shfl_xor(s,2); s+=__shfl_xor(s,4); s+=__shfl_xor(s,8); s+=__shfl_xor(s,16); ss[r]=0.8f/sqrtf(s*(1.0f/128.0f)+1e-6f); }
    float gsub[4];
    #pragma unroll
    for(int d0=0;d0<4;++d0)gsub[d0]=subg[d0*32+r32e];
    asm volatile("s_waitcnt lgkmcnt(0)\n\ts_barrier":::"memory");
    bf16*Ow=Ou+(long)(wid*QBLK)*opitch;
    bf16*stg=(bf16*)shm+wid*4096;
    #pragma unroll
    for(int r=0;r<16;++r){const int orow=crow(r,hie);
      #pragma unroll
      for(int d0=0;d0<4;++d0)stg[orow*128+d0*32+r32e]=__float2bfloat16(o[d0][r]*ss[r]*gsub[d0]);}
    asm volatile("s_waitcnt lgkmcnt(0)":::"memory");
    #pragma unroll
    for(int i=0;i<8;++i){const int row=i*4+(lane_e>>4),ch=lane_e&15; const u32x4 v=*(const u32x4*)(stg+row*128+ch*8); ATTN_STORE16(Ow+(long)row*opitch+ch*8,v);}
  }
  asm volatile("s_waitcnt lgkmcnt(0)\n\ts_barrier":::"memory");
 }
  #undef DMA_K
  #undef DMA_V
  #undef CMASK
  #undef START
  #undef RESC
  #undef ROT
}
constexpr float REFOFF=3.0f, LMIN=8.0f; constexpr int L9B_K=0, L9B_V=NSLOT*SLOTK8, L9B_WS=65536, L9B_FLAG=L9B_WS+NW*64*4, L9B_BYTES=L9B_FLAG+64;
template<int THRL,bool FIXREF=false> __device__ __forceinline__ bool attn_unit128_q8v(const unsigned char*Qu8,const unsigned char*__restrict__ Kb8,const unsigned char*__restrict__ Vb8,bf16*Ou,int opitch,char*shm,int wid,float*stash,float lam,const float*subg,int pass_lo,int pass_hi,float ref){
  static_assert(FIXREF,"constant reference only"); bool bad_any=false;
  const int lane=lane_id_asm(),r32=lane&31,hi=lane>>5;
  const bool kw=wid<4;
 for(int cpass=pass_lo;cpass<pass_hi;++cpass){
  const int lane_p=lane_id_asm(),r32p=lane_p&31,hip=lane_p>>5;
  const unsigned char*Qw8=Qu8+(long)(wid*QBLK)*P8+cpass*64;
  const unsigned char*Kh8=Kb8+cpass*64;
  const unsigned lds0=(unsigned)(uintptr_t)shm;
  float*wsf=(float*)(shm+L9B_WS)+wid*64;
  const unsigned char*ksrc=Kh8+(long)lane_p*P8+(wid&3)*16;
  const int vkey_=8*wid+(lane_p>>3), vc_=(lane_p&7)^((((vkey_>>1)&1)<<1)|(((vkey_>>3)&1)<<2));
  const unsigned char*vsrc=Vb8+(long)vkey_*PV8+vc_*16;
  const unsigned kdst=lds0+L9B_K+(wid&3)*1024, vdst=lds0+L9B_V+wid*1024;
  #define DMA_K(t,slot) glds16(ksrc+(long)(t)*KVBLK*P8,(unsigned)__builtin_amdgcn_readfirstlane(kdst+(slot)))
  #define DMA_V(t,slot) glds16(vsrc+(long)(t)*KVBLK*PV8,(unsigned)__builtin_amdgcn_readfirstlane(vdst+2*(slot)))
  #define WAITB(nk,nv) do{ if(kw){WAIT_BAR(nk);}else{WAIT_BAR(nv);} }while(0)
  v8i32_t kf8[2];
  const lds_cptr shm3=(lds_cptr)shm; const lds_cptr kp0=shm3+L9B_K+hip*2048+r32p*16;
  const int vq_=(lane_p&15)>>1, vkey0_=(vq_&3)+8*(vq_>>2)+4*hip, vsw_=(((vq_>>1)&1)<<1)|(((vq_>>2)&1)<<2), vg_=(lane_p>>4)&1;
  const lds_cptr vq0=shm3+L9B_V+vkey0_*128+(lane_p&1)*8;
  const lds_cptr vp0_=vq0+((0+vg_)^vsw_)*16, vp1_=vq0+((2+vg_)^vsw_)*16, vp2_=vq0+((4+vg_)^vsw_)*16, vp3_=vq0+((6+vg_)^vsw_)*16;
  if(kw){DMA_K(0,0);} DMA_V(0,0); if(kw){DMA_K(1,SLOTK8);}
  const v8i32_t q8=*reinterpret_cast<const v8i32_t*>(Qw8+(long)r32p*P8+hip*32);
  float zf_; asm volatile("v_mov_b32 %0, 0":"=v"(zf_));
  float mhat=0.f,l_reg=0.f,smax=0.f;f32x16 o[4];
  #pragma unroll
  for(int r=0;r<16;++r){o[0][r]=zf_;o[1][r]=zf_;o[2][r]=zf_;o[3][r]=zf_;}
  f32x16 negm;
  #pragma unroll
  for(int r=0;r<16;++r)negm[r]=zf_-ref;
  asm volatile("":"+v"(negm));
  #define CMASK(P0,P1,t) do{}while(0)
  bool resc=false;
  #define START(P0,P1) do{ resc=false; if constexpr(!FIXREF){ const float rm=rowmax(P0,P1); \
    { const float dl=rm-REFOFF; mhat=fadd_s(mhat,dl);     \
      _Pragma("unroll") for(int r=0;r<16;++r){P0[r]=fsub_s(P0[r],dl);P1[r]=fsub_s(P1[r],dl);} \
      _Pragma("unroll") for(int r=0;r<16;++r)negm[r]=-mhat; asm volatile("":"+v"(negm)); } } \
    _Pragma("unroll") for(int r=0;r<16;++r)P0[r]=__builtin_amdgcn_exp2f(P0[r]); }while(0)
  #define RESC() do{ if(resc){ asm volatile("s_waitcnt lgkmcnt(0)":::"memory"); \
      _Pragma("unroll") for(int d_=0;d_<4;++d_) _Pragma("unroll") for(int r=0;r<16;++r)o[d_][r]*=wsf[crow(r,hi)]; } }while(0)
  f32x16 pA0,pA1,pB0,pB1;
  int sl_prev=0,sl_cur=0,sl_next=SLOTK8;
  #define ROT() do{sl_prev=sl_cur;sl_cur=sl_next;sl_next=(sl_next==(NSLOT-1)*SLOTK8)?0:sl_next+SLOTK8;}while(0)
  if(kw){DMA_K(2,2*SLOTK8);}
  WAITB(3,2);
  qkt8(pA0,pA1,kp0,q8,negm);asm volatile("s_nop 15\n\ts_nop 7":"+v"(pA0),"+v"(pA1));CMASK(pA0,pA1,0);
  START(pA0,pA1);
  _Pragma("unroll") for(int r=0;r<16;++r)pA1[r]=__builtin_amdgcn_exp2f(pA1[r]);
  WAIT_BAR(0);
  if(kw){DMA_K(3,0);} DMA_V(1,SLOTK8);
  ROT();
  kf8[0]=kfrag8(kp0+sl_cur); kf8[1]=kfrag8(kp0+sl_cur+512);
  WAITB(2,1);
  v2i32_t vA0,vA1,vA2,vA3,vB0,vB1,vB2,vB3; v8i32_t pw8=v8i32_t{};
  v8i32_t ones8; { int o1_; asm volatile("v_mov_b32 %0, 0x38383838":"=v"(o1_)); ones8=(v8i32_t){o1_,o1_,o1_,o1_,o1_,o1_,o1_,o1_}; } f32x16 ls; _Pragma("unroll") for(int r=0;r<16;++r)ls[r]=zf_;
  #define PK4(P,B) __builtin_amdgcn_cvt_pk_bf8_f32(P[B+2],P[B+3],__builtin_amdgcn_cvt_pk_bf8_f32(P[B],P[B+1],0,false),true)
  #define PK4I(D,P,B) do{ D=__builtin_amdgcn_cvt_pk_bf8_f32(P[B],P[B+1],D,false); D=__builtin_amdgcn_cvt_pk_bf8_f32(P[B+2],P[B+3],D,true); }while(0)
  #define MFMAP(a,b,c) __builtin_amdgcn_mfma_scale_f32_32x32x64_f8f6f4(a,b,c,1,0,0,0,0,0)
  #define VT8(p) __builtin_amdgcn_ds_read_tr8_b64_v2i32((__attribute__((address_space(3))) v2i32_t*)(p))
  #define V8A() (v8i32_t){vA0[0],vA0[1],vA1[0],vA1[1],vA2[0],vA2[1],vA3[0],vA3[1]}
  #define V8B() (v8i32_t){vB0[0],vB0[1],vB1[0],vB1[1],vB2[0],vB2[1],vB3[0],vB3[1]}
  #define RDA(vp) do{ const lds_cptr p_=(vp)+2*sl_prev; vA0=VT8(p_); vA1=VT8(p_+2048); vA2=VT8(p_+4096); vA3=VT8(p_+6144); }while(0)
  #define RDB(vp) do{ const lds_cptr p_=(vp)+2*sl_prev; vB0=VT8(p_); vB1=VT8(p_+2048); vB2=VT8(p_+4096); vB3=VT8(p_+6144); }while(0)
  #define PIN(x) asm volatile("":"+v"(x))
  #define MX3(a,b,c) __builtin_fmaxf(__builtin_fmaxf((a),(b)),(c))
  #define EX(v) __builtin_amdgcn_exp2f(v)
  #define EX4(X,B) do{ X[B]=EX(X[B]); X[B+1]=EX(X[B+1]); X[B+2]=EX(X[B+2]); X[B+3]=EX(X[B+3]); PIN(X); SBAR(); }while(0)
  #define KRD(G,j) do{ if(G){ kf8[j]=kfrag8(kp0+sl_next+(j)*512); SBAR(); } }while(0)
  #define STEP(C0,C1,P0,P1,t,GK,GV,GL) do{ SBAR(); \
    { const lds_cptr p_=vp0_+2*sl_prev; vA0=VT8(p_); vA1=VT8(p_+2048); } SBAR(); \
    C0=MFMA8(kf8[0],q8,negm); \
    PK4I(pw8[0],P0,0); PK4I(pw8[1],P0,4); PIN(pw8); SBAR(); \
    { const lds_cptr p_=vp0_+2*sl_prev; vA2=VT8(p_+4096); vA3=VT8(p_+6144); } SBAR(); \
    PK4I(pw8[2],P0,8); PK4I(pw8[3],P0,12); PIN(pw8); SBAR(); \
    { const lds_cptr p_=vp1_+2*sl_prev; vB0=VT8(p_); vB1=VT8(p_+2048); } SBAR(); \
    C1=MFMA8(kf8[1],q8,negm); \
    PK4I(pw8[4],P1,0); PK4I(pw8[5],P1,4); PIN(pw8); SBAR(); \
    { const lds_cptr p_=vp1_+2*sl_prev; vB2=VT8(p_+4096); vB3=VT8(p_+6144); } SBAR(); \
    PK4I(pw8[6],P1,8); PK4I(pw8[7],P1,12); PIN(pw8); SBAR(); \
    if(GK){ if(kw){DMA_K((t)+3,sl_cur);} } if(GV){DMA_V((t)+1,sl_next);} \
    CMASK(C0,C1,t); \
    SBAR(); \
    ls=MFMAP(pw8,ones8,ls); o[0]=MFMAP(pw8,V8A(),o[0]); SBAR(); RDA(vp2_); SBAR(); EX4(C0,0); EX4(C0,4); \
    o[1]=MFMAP(pw8,V8B(),o[1]); SBAR(); RDB(vp3_); SBAR(); EX4(C0,8); EX4(C0,12); \
    KRD(GL,0); \
    o[2]=MFMAP(pw8,V8A(),o[2]); SBAR(); EX4(C1,0); EX4(C1,4); \
    KRD(GL,1); \
    o[3]=MFMAP(pw8,V8B(),o[3]); SBAR(); EX4(C1,8); EX4(C1,12); \
    }while(0)
  int t=1;
  for(;t+5<NT;t+=2){
    STEP(pB0,pB1,pA0,pA1,t,true,true,true);     WAITB(2,1); RESC(); ROT();
    STEP(pA0,pA1,pB0,pB1,t+1,true,true,true);   WAITB(2,1); RESC(); ROT();
  }
  #define ENDW(tt) do{ if((tt)+3<NT){WAITB(2,1);} else if((tt)+2<NT){WAIT_BAR(1);} else {WAIT_BAR(0);} }while(0)
  for(;t+1<NT;t+=2){
    STEP(pB0,pB1,pA0,pA1,t,(t+3<NT),(t+1<NT),(t+1<NT));       ENDW(t);   RESC(); ROT();
    STEP(pA0,pA1,pB0,pB1,t+1,(t+4<NT),(t+2<NT),(t+2<NT));     ENDW(t+1); RESC(); ROT();
  }
  STEP(pB0,pB1,pA0,pA1,NT-1,false,false,false); RESC();
  {
    pw8=(v8i32_t){PK4(pB0,0),PK4(pB0,4),PK4(pB0,8),PK4(pB0,12),PK4(pB1,0),PK4(pB1,4),PK4(pB1,8),PK4(pB1,12)};
    const int sl_keep=sl_prev; sl_prev=sl_cur;
    RDA(vp0_); RDB(vp1_); SBAR(); ls=MFMAP(pw8,ones8,ls); o[0]=MFMAP(pw8,V8A(),o[0]); o[1]=MFMAP(pw8,V8B(),o[1]); SBAR();
    RDA(vp2_); RDB(vp3_); SBAR(); o[2]=MFMAP(pw8,V8A(),o[2]); o[3]=MFMAP(pw8,V8B(),o[3]); sl_prev=sl_keep; }
  #undef PK4
  #undef PK4I
  #undef MFMAP
  #undef VT8
  #undef V8A
  #undef V8B
  #undef RDA
  #undef RDB
  #undef PIN
  #undef MX3
  #undef EX
  #undef EX4
  #undef KRD
  #undef STEP
  #undef ENDW
  {auto rr=__builtin_amdgcn_permlane32_swap(__float_as_uint(l_reg),__float_as_uint(l_reg),false,false);l_reg=__uint_as_float(rr[0])+__uint_as_float(rr[1]);}
  const int lane_e=lane_id_asm(),r32e=lane_e&31,hie=lane_e>>5;
  { float nz_=0.f; _Pragma("unroll") for(int d_=0;d_<4;++d_) _Pragma("unroll") for(int r=0;r<16;++r)nz_=__builtin_fmaf(o[d_][r],0.0f,nz_);     float lmin_=ls[0]; _Pragma("unroll") for(int r=1;r<16;++r)lmin_=__builtin_fminf(lmin_,ls[r]); const bool badl=!(nz_==0.0f)||!(lmin_>=LMIN); const int lf_=lane_id_asm(); if(__any(badl)&&lf_==0)((volatile float*)(shm+L9B_FLAG))[wid]=1.0f; else if(lf_==0)((volatile float*)(shm+L9B_FLAG))[wid]=0.0f; }
  if(hie==0)wsf[32+r32e]=l_reg;asm volatile("s_waitcnt lgkmcnt(0)":::"memory");
  float rli[16];
  #pragma unroll
  for(int r=0;r<16;++r)rli[r]=__builtin_amdgcn_rcpf(ls[r]);
  float*st=stash+(size_t)wid*4096+lane_e*4;
  if(cpass==0){
    #pragma unroll
    for(int d0=0;d0<4;++d0)
      #pragma unroll
      for(int q4=0;q4<4;++q4){ typedef float f32x4_t __attribute__((ext_vector_type(4)));
        const f32x4_t v={o[d0][4*q4]*rli[4*q4],o[d0][4*q4+1]*rli[4*q4+1],o[d0][4*q4+2]*rli[4*q4+2],o[d0][4*q4+3]*rli[4*q4+3]};
        *(f32x4_t*)(st+(d0*4+q4)*256)=v; }
  } else {
    typedef float f32x4_t __attribute__((ext_vector_type(4)));
    float ss[16];
    #pragma unroll
    for(int r=0;r<16;++r)ss[r]=0.f;
    #pragma unroll
    for(int d0=0;d0<4;++d0)
      #pragma unroll
      for(int q4=0;q4<4;++q4){ const f32x4_t a=*(const f32x4_t*)(st+(d0*4+q4)*256);
        #pragma unroll
        for(int i=0;i<4;++i){ const int r=4*q4+i; const float v=a[i]-lam*(o[d0][r]*rli[r]); o[d0][r]=v; ss[r]+=v*v; } if(q4==3)asm volatile("":::"memory"); }
    #pragma unroll
    for(int r=0;r<16;++r){ float s=ss[r]; s+=__shfl_xor(s,1); s+=__shfl_xor(s,2); s+=__shfl_xor(s,4); s+=__shfl_xor(s,8); s+=__shfl_xor(s,16); ss[r]=0.8f/sqrtf(s*(1.0f/128.0f)+1e-6f); }
    float gsub[4];
    #pragma unroll
    for(int d0=0;d0<4;++d0)gsub[d0]=subg[d0*32+r32e];
    asm volatile("s_waitcnt lgkmcnt(0)\n\ts_barrier":::"memory");
    bf16*Ow=Ou+(long)(wid*QBLK)*opitch;
    bf16*stg=(bf16*)shm+wid*4096;
    #pragma unroll
    for(int r=0;r<16;++r){const int orow=crow(r,hie);
      #pragma unroll
      for(int d0=0;d0<4;++d0)stg[orow*128+d0*32+r32e]=__float2bfloat16(o[d0][r]*ss[r]*gsub[d0]);}
    asm volatile("s_waitcnt lgkmcnt(0)":::"memory");
    #pragma unroll
    for(int i=0;i<8;++i){const int row=i*4+(lane_e>>4),ch=lane_e&15; const u32x4 v=*(const u32x4*)(stg+row*128+ch*8); ATTN_STORE16(Ow+(long)row*opitch+ch*8,v);}
  }
  asm volatile("s_waitcnt lgkmcnt(0)\n\ts_barrier":::"memory");
  { const float*fl_=(const float*)(shm+L9B_FLAG); float fs_=0.f; _Pragma("unroll") for(int w_=0;w_<NW;++w_)fs_+=fl_[w_]; bad_any=bad_any||(__builtin_amdgcn_readfirstlane(__float_as_uint(fs_))!=0u); }
 }
  return bad_any;
  #undef DMA_K
  #undef DMA_V
  #undef WAITB
  #undef CMASK
  #undef START
  #undef RESC
  #undef ROT
}
constexpr int ATTN_LDS_BYTES=LDS_BYTES;
#undef SBAR
#undef WAIT_BAR
}
#define GAS __attribute__((address_space(1)))
#define LAS __attribute__((address_space(3)))
typedef unsigned short bf16;
typedef unsigned v4u __attribute__((ext_vector_type(4)));
typedef float f32x4 __attribute__((ext_vector_type(4)));
typedef short bf16x8 __attribute__((ext_vector_type(8)));
typedef GAS unsigned gu32;
typedef GAS unsigned long long gu64;
#define RLX_AGENT __ATOMIC_RELAXED, __HIP_MEMORY_SCOPE_AGENT
#define LDS_WAIT() asm volatile("s_waitcnt lgkmcnt(0)" ::: "memory")
#define VM_WAIT() asm volatile("s_waitcnt vmcnt(0)" ::: "memory")
__device__ __forceinline__ unsigned long long rt() { return __builtin_amdgcn_s_memrealtime(); }
__device__ __forceinline__ unsigned f2bf(float f) { unsigned u = __builtin_bit_cast(unsigned, f); return (u + 0x7fffu + ((u >> 16) & 1u)) >> 16; }
__device__ __forceinline__ unsigned pk2(float lo, float hi) { return f2bf(lo) | (f2bf(hi) << 16); }

#define XB_TMO      128
#define XB_XCNT(j)  (256  + 64 * (j))
#define XB_XSUB(j)  (1280 + 64 * (j))
#define XB_XGEN(j)  (2304 + 64 * (j))
#define XB_TOP      3328
#define XB_TOPGEN   3392
#define XCD_BAR_WORDS 3456
#define XB_SPIN_CAP (1u << 18)

__device__ __forceinline__ unsigned xb_ld(unsigned* p)              { return __hip_atomic_load(p, __ATOMIC_RELAXED, __HIP_MEMORY_SCOPE_AGENT); }
__device__ __forceinline__ unsigned xb_add(unsigned* p, unsigned v) { return __hip_atomic_fetch_add(p, v, __ATOMIC_RELAXED, __HIP_MEMORY_SCOPE_AGENT); }
__device__ __forceinline__ unsigned xb_xcc_id() { return (unsigned)__builtin_amdgcn_s_getreg((3 << 11) | 20) & 0xFu; }
#define XB_SPIN(cond, bar) do { unsigned _sp = 0; while (cond) { __builtin_amdgcn_s_sleep(1); \
    if ((++_sp & 255u) == 0u) { if (xb_ld(&(bar)[XB_TMO])) break; if (_sp > XB_SPIN_CAP) { atomicAdd(&(bar)[XB_TMO], 1u); break; } } } } while (0)

struct XcdBarrier {
    unsigned* bar; unsigned x;
    int wv;
    volatile LAS unsigned* st;
};

__device__ __forceinline__ XcdBarrier xcd_barrier_post(unsigned* bar, volatile LAS unsigned* st) {
    XcdBarrier b; b.bar = bar; b.x = xb_xcc_id(); b.st = st; b.wv = __builtin_amdgcn_readfirstlane(threadIdx.x >> 6);
    if (threadIdx.x == 0) (void)xb_add(&bar[XB_XCNT(b.x)], 1u);
    return b;
}
__device__ __forceinline__ void xcd_barrier_complete(unsigned* bar, unsigned x, unsigned& nloc, unsigned& nx) {
    const unsigned G = gridDim.x * gridDim.y * gridDim.z;
    unsigned sum, cnt, mine, sp = 0u;
    for (;;) {
        sum = 0u; cnt = 0u; mine = 0u;
#pragma unroll
        for (unsigned j = 0; j < 16; ++j) { const unsigned c = xb_ld(&bar[XB_XCNT(j)]); sum += c; cnt += (c > 0u) ? 1u : 0u; mine = (j == x) ? c : mine; }
        if (sum == G) break;
        __builtin_amdgcn_s_sleep(1);
        if ((++sp & 255u) == 0u) { if (xb_ld(&bar[XB_TMO])) break; if (sp > XB_SPIN_CAP) { atomicAdd(&bar[XB_TMO], 1u); break; } }
    }
    nloc = mine > 0u ? mine : 1u; nx = cnt > 0u ? cnt : 1u;
}

__device__ __forceinline__ void xcd_barrier(const XcdBarrier& b) {
    asm volatile("s_waitcnt vmcnt(0)" ::: "memory");
    __syncthreads();
    if (b.wv == 0 && lane_id_asm() == 0) {
        unsigned* bar = b.bar;
        __builtin_amdgcn_s_waitcnt(0);
        unsigned nloc = b.st[0], nx = b.st[1];
        if (nloc == 0u) { xcd_barrier_complete(bar, b.x, nloc, nx); b.st[0] = nloc; b.st[1] = nx; }
        const unsigned old = xb_add(&bar[XB_XSUB(b.x)], 1u);
        const unsigned gen = old / nloc;
        if (old + 1u == (gen + 1u) * nloc) {
            __builtin_amdgcn_fence(__ATOMIC_RELEASE, "agent");
            asm volatile("s_waitcnt vmcnt(0)" ::: "memory");
            const unsigned og = xb_add(&bar[XB_TOP], 1u);
            const unsigned tg = og / nx;
            if (og + 1u == (tg + 1u) * nx) xb_add(&bar[XB_TOPGEN], 1u);
            else XB_SPIN(xb_ld(&bar[XB_TOPGEN]) == tg, bar);
            __builtin_amdgcn_fence(__ATOMIC_ACQUIRE, "agent");
            xb_add(&bar[XB_XGEN(b.x)], 1u);
            asm volatile("s_waitcnt vmcnt(0)" ::: "memory");
        } else {
            XB_SPIN(xb_ld(&bar[XB_XGEN(b.x)]) == gen, bar);
            __builtin_amdgcn_fence(__ATOMIC_ACQUIRE, "agent");
            asm volatile("s_waitcnt vmcnt(0)" ::: "memory");
        }
    }
    __syncthreads();
}
__device__ __forceinline__ float wave_sum(float v) {
#pragma unroll
    for (int o = 1; o < 64; o <<= 1) v += __shfl_xor(v, o);
    return v;
}
constexpr int NWAVES = 8;
#ifndef MK_PER_PHASE
#define MK_PER_PHASE 0
#endif
constexpr int NPH = 10;
constexpr int DM_ = 1024, NB_ = 2, T_ = 8192, CTXL = 256, KEYS = CTXL + T_  , MROWS = NB_ * KEYS  , NTOK = NB_ * T_, QKVC = 2304, NE = 32, NMOD = 6 * DM_;
constexpr int SORT_ROWS = NTOK * 4 + NE * 256;
constexpr size_t MiB = 1u << 20;
constexpr size_t WS_CTL = 0, CTL_ZERO_BYTES = 64 * 1024;
constexpr size_t WS_MOD = 1 * MiB;
constexpr size_t WS_ROPE = WS_MOD + 3 * NMOD * 4;
constexpr size_t WS_SE = 2 * MiB;
constexpr size_t WS_SP = WS_SE + (size_t)NTOK * 4 * 4;
constexpr size_t WS_LTOK = 3 * MiB;
constexpr size_t WS_LGATE = 5 * MiB;
constexpr size_t WS_WQKV = 8 * MiB;
constexpr size_t WS_CB = 1 * MiB + 128 * 1024;
constexpr size_t WS_WO = 669 * MiB;
constexpr size_t WS_WIN = 16 * MiB;
constexpr size_t WS_WOUT = 144 * MiB;
constexpr size_t WS_XN = 208 * MiB;
constexpr size_t WS_QKV = 242 * MiB;
constexpr size_t WS_DT = 317 * MiB;
constexpr size_t WS_MIX = 349 * MiB;
constexpr size_t WS_ACT = 381 * MiB;
constexpr size_t WS_Y = 525 * MiB;
constexpr size_t WS_QK8 = 671 * MiB;
constexpr size_t WS_V8 = 96 * MiB;
constexpr size_t WS_END = 699 * MiB;
static_assert(WS_XN + (size_t)MROWS * 1024 * 2 <= WS_QKV && WS_QKV + (size_t)MROWS * QKVC * 2 <= WS_DT && WS_ACT + (size_t)SORT_ROWS * 1024 * 2 <= WS_Y && WS_Y + (size_t)SORT_ROWS * 1024 * 2 <= WS_END, "d_ws map");
constexpr int CW_CNT = 64;
constexpr int CW_MT = 8192;
constexpr int CW_XOK = 99;
constexpr int CW_NMAX = 128;
static_assert(true, ""); constexpr int CW_BAR = 4096;
constexpr int RING_OFF = 0, RING_BYTES = 131072;
constexpr int LDSCTL_OFF = RING_BYTES, MISC_OFF = LDSCTL_OFF + 320;
constexpr int IDBUF_OFF = RING_BYTES + 1024;
constexpr int TP_OFF = RING_BYTES + 9216;
constexpr int TE_OFF = TP_OFF + 256;
constexpr int XSCR_OFF = RING_BYTES + 10240;
constexpr int LDS_BYTES = 147456;
static_assert(XSCR_OFF + 4096 <= LDS_BYTES, "LDS map");

struct Frame {
    LAS unsigned char* lds; volatile LAS unsigned* MISC; gu32* ctl;
    int wave, vcu, G;
    const float* in[21]; float* out; unsigned char* ws;
};
__device__ __forceinline__ void build_tp(Frame& F) {
    LAS int* tp = (LAS int*)(F.lds + TP_OFF); const int lane = lane_id_asm();
    __syncthreads();
    if (F.wave == 0) {
        const int t = lane < NE ? (((int)__hip_atomic_load(F.ctl + CW_CNT + lane, RLX_AGENT) + 255) >> 8) : 0; int s = t;
#pragma unroll
        for (int o = 1; o < 32; o <<= 1) { const int u = __shfl_up(s, o); if (lane >= o) s += u; }
        if (lane < NE) { tp[lane] = s - t; LAS unsigned char* te = (LAS unsigned char*)(F.lds + TE_OFF); for (int g_ = s - t; g_ < s; ++g_) te[g_] = (unsigned char)lane; }
        if (lane == NE - 1) tp[NE] = s;
    }
    __syncthreads();
}
__device__ __forceinline__ void transpose_item(const float* W, int K, int N, bf16* WT, int k0, int n0, int wt_row0, LAS float* scr, int lane) {
    float t_[32];
#pragma unroll
    for (int i = 0; i < 32; ++i) t_[i] = W[(size_t)(k0 + 2 * i + (lane >> 5)) * N + n0 + (lane & 31)];
#pragma unroll
    for (int i = 0; i < 32; ++i) scr[(2 * i + (lane >> 5)) * 33 + (lane & 31)] = t_[i];
    LDS_WAIT(); asm volatile("" ::: "memory");
    const int c = lane & 7;
#pragma unroll
    for (int j = 0; j < 4; ++j) { const int n = (lane >> 3) + 8 * j; const LAS float* s = scr + (8 * c) * 33 + n;
        v4u o; o.x = pk2(s[0 * 33], s[1 * 33]); o.y = pk2(s[2 * 33], s[3 * 33]); o.z = pk2(s[4 * 33], s[5 * 33]); o.w = pk2(s[6 * 33], s[7 * 33]);
        *(GAS v4u*)(WT + (size_t)(wt_row0 + n) * K + k0 + 8 * c) = o; }
    LDS_WAIT(); asm volatile("" ::: "memory");
}
__device__ __forceinline__ void transpose_item_f8(const float* W, int K, int N, unsigned char* WT, int k0, int n0, int wt_row0, LAS float* scr, int lane, const float* kmul = nullptr, const float* kadd1 = nullptr, bool qmap = false) {
    float t_[32];
#pragma unroll
    for (int i = 0; i < 32; ++i) t_[i] = W[(size_t)(k0 + 2 * i + (lane >> 5)) * N + n0 + (lane & 31)];
    if (kmul) {
#pragma unroll
        for (int i = 0; i < 32; ++i) { const int k = k0 + 2 * i + (lane >> 5); t_[i] *= kmul[k] * (1.0f + kadd1[k]); } }
#pragma unroll
    for (int i = 0; i < 32; ++i) scr[(2 * i + (lane >> 5)) * 33 + (lane & 31)] = t_[i];
    LDS_WAIT(); asm volatile("" ::: "memory");
    const int c = lane & 3;
#pragma unroll
    for (int j = 0; j < 2; ++j) { const int n = (lane >> 2) + 16 * j; const LAS float* s = scr + (16 * c) * 33 + n;
        const int wrow = qmap ? wt_row0 + 128 * (n >> 4) + 16 * ((n & 7) >> 2) + 4 * ((n >> 3) & 1) + (n & 3) : wt_row0 + n;
        v4u o; o.x = pg8::pk4_fp8(s[0 * 33] * pg8::W8_SCALE, s[1 * 33] * pg8::W8_SCALE, s[2 * 33] * pg8::W8_SCALE, s[3 * 33] * pg8::W8_SCALE); o.y = pg8::pk4_fp8(s[4 * 33] * pg8::W8_SCALE, s[5 * 33] * pg8::W8_SCALE, s[6 * 33] * pg8::W8_SCALE, s[7 * 33] * pg8::W8_SCALE);
        o.z = pg8::pk4_fp8(s[8 * 33] * pg8::W8_SCALE, s[9 * 33] * pg8::W8_SCALE, s[10 * 33] * pg8::W8_SCALE, s[11 * 33] * pg8::W8_SCALE); o.w = pg8::pk4_fp8(s[12 * 33] * pg8::W8_SCALE, s[13 * 33] * pg8::W8_SCALE, s[14 * 33] * pg8::W8_SCALE, s[15 * 33] * pg8::W8_SCALE);
        *(GAS v4u*)(WT + (size_t)wrow * K + k0 + 16 * c) = o; }
    LDS_WAIT(); asm volatile("" ::: "memory");
}
constexpr int I_QKV = 16 * 72, I_WO = 16 * 32, I_IN = 16 * 64, I_OUT = 16 * 32;
constexpr int CONV_DENSE = I_WO, CONV_ALL = I_WO + NE * I_IN + NE * I_OUT;
__device__ __forceinline__ void conv_items(Frame& F, int first, int count, LAS float* scr, int lane) {
    const int gw = F.vcu * NWAVES + F.wave, NGW = F.G * NWAVES;
    for (int it = first + gw; it < first + count; it += NGW) {
        int r = it;
        if (r < I_WO) { const int kb = r / 32, nb = r % 32; transpose_item(F.in[12], DM_, DM_, (bf16*)(F.ws + WS_WO), 64 * kb, 32 * nb, 32 * nb, scr, lane); continue; } r -= I_WO;
        if (r < NE * I_IN) { const int e = r / I_IN, q = r % I_IN, kb = q / 64, nb = q % 64; const int grp = nb < 32 ? ((nb >> 2) * 8 + (nb & 3)) : (((nb - 32) >> 2) * 8 + 4 + ((nb - 32) & 3));
            transpose_item_f8(F.in[16] + (size_t)e * DM_ * 2048, DM_, 2048, F.ws + WS_WIN + (size_t)e * 2048 * DM_, 64 * kb, 32 * nb, 32 * grp, scr, lane); continue; } r -= NE * I_IN;
        { const int e = r / I_OUT, q = r % I_OUT, kb = q / 32, nb = q % 32;
            transpose_item_f8(F.in[18] + (size_t)e * DM_ * DM_, DM_, DM_, F.ws + WS_WOUT + (size_t)e * DM_ * DM_, 64 * kb, 32 * nb, 32 * nb, scr, lane); }
    }
}
__device__ __forceinline__ void cx_desc(const Frame& F, int it, const float*& src, int& N, unsigned char*& dst) {
    int r = it - I_WO;
    if (r < NE * I_IN) { const int e = r / I_IN, q = r % I_IN, kb = q / 64, nb = q % 64; const int grp = nb < 32 ? ((nb >> 2) * 8 + (nb & 3)) : (((nb - 32) >> 2) * 8 + 4 + ((nb - 32) & 3));
        N = 2048; src = F.in[16] + (size_t)e * DM_ * 2048 + (size_t)(64 * kb) * 2048 + 32 * nb; dst = F.ws + WS_WIN + (size_t)e * 2048 * DM_ + (size_t)(32 * grp) * DM_ + 64 * kb; }
    else { r -= NE * I_IN; const int e = r / I_OUT, q = r % I_OUT, kb = q / 32, nb = q % 32;
        N = DM_; src = F.in[18] + (size_t)e * DM_ * DM_ + (size_t)(64 * kb) * DM_ + 32 * nb; dst = F.ws + WS_WOUT + (size_t)e * DM_ * DM_ + (size_t)(32 * nb) * DM_ + 64 * kb; }
}
__device__ __forceinline__ void cx_ld(const Frame& F, int it, int lane, float (&t_)[32]) {
    const float* src; int N; unsigned char* dst; cx_desc(F, it, src, N, dst);
    const float* p = src + (size_t)(lane >> 5) * N + (lane & 31);
#pragma unroll
    for (int i = 0; i < 32; ++i) t_[i] = p[(size_t)(2 * i) * N];
}
__device__ __forceinline__ void cx_st(const Frame& F, int it, int lane, const float (&t_)[32], LAS float* scr) {
    const float* src; int N; unsigned char* dst; cx_desc(F, it, src, N, dst);
#pragma unroll
    for (int i = 0; i < 32; ++i) scr[(2 * i + (lane >> 5)) * 33 + (lane & 31)] = t_[i];
    LDS_WAIT(); asm volatile("" ::: "memory");
    const int c = lane & 3;
#pragma unroll
    for (int j = 0; j < 2; ++j) { const int n = (lane >> 2) + 16 * j; const LAS float* s = scr + (16 * c) * 33 + n;
        v4u o; o.x = pg8::pk4_fp8(s[0 * 33] * pg8::W8_SCALE, s[1 * 33] * pg8::W8_SCALE, s[2 * 33] * pg8::W8_SCALE, s[3 * 33] * pg8::W8_SCALE); o.y = pg8::pk4_fp8(s[4 * 33] * pg8::W8_SCALE, s[5 * 33] * pg8::W8_SCALE, s[6 * 33] * pg8::W8_SCALE, s[7 * 33] * pg8::W8_SCALE);
        o.z = pg8::pk4_fp8(s[8 * 33] * pg8::W8_SCALE, s[9 * 33] * pg8::W8_SCALE, s[10 * 33] * pg8::W8_SCALE, s[11 * 33] * pg8::W8_SCALE); o.w = pg8::pk4_fp8(s[12 * 33] * pg8::W8_SCALE, s[13 * 33] * pg8::W8_SCALE, s[14 * 33] * pg8::W8_SCALE, s[15 * 33] * pg8::W8_SCALE);
        *(GAS v4u*)(dst + (size_t)n * DM_ + 16 * c) = o; }
    LDS_WAIT(); asm volatile("" ::: "memory");
}
__device__ __forceinline__ void conv_experts(Frame& F, LAS float* scr, int lane) {
    const int cvu = (F.G % 8 == 0) ? ((F.vcu & ~7) | ((F.vcu + (F.vcu >> 3)) & 7)) : F.vcu;
    const int gw = cvu * NWAVES + F.wave, NGW = F.G * NWAVES, end = CONV_ALL;
    int it = CONV_DENSE + gw;
    float A_[32], B_[32], C_[32];
    if (it + 2 * NGW < end) {
        cx_ld(F, it, lane, A_); cx_ld(F, it + NGW, lane, B_);
        while (it + 4 * NGW < end) {
            cx_ld(F, it + 2 * NGW, lane, C_); cx_st(F, it, lane, A_, scr);
            cx_ld(F, it + 3 * NGW, lane, A_); cx_st(F, it + NGW, lane, B_, scr);
            cx_ld(F, it + 4 * NGW, lane, B_); cx_st(F, it + 2 * NGW, lane, C_, scr);
            it += 3 * NGW;
        }
        cx_st(F, it, lane, A_, scr); cx_st(F, it + NGW, lane, B_, scr); it += 2 * NGW;
    }
    for (; it < end; it += NGW) { cx_ld(F, it, lane, A_); cx_st(F, it, lane, A_, scr); }
}
__device__ __forceinline__ void p0_prologue(Frame& F) {
    const float* c = F.in[1]; const float* cctx = F.in[3]; const float* w_ada = F.in[4]; const float* b_ada = F.in[5];
    float* mod = (float*)(F.ws + WS_MOD); float* rope = (float*)(F.ws + WS_ROPE);
    LAS float* scr = (LAS float*)(F.lds + RING_OFF + F.wave * 16384);
    const int lane = lane_id_asm(), w = F.wave, tid = w * 64 + lane;
    for (int cg = F.vcu; cg < 192; cg += F.G) {
        for (int i = lane; i < 384; i += 64) { const int v = i >> 7, kk = i & 127; const float s = (v < 2 ? c[v * DM_ + 128 * w + kk] : cctx[128 * w + kk]); scr[i] = s / (1.0f + expf(-s)); }
        LDS_WAIT(); asm volatile("" ::: "memory");
        const int kh = lane >> 5, col = 32 * cg + (lane & 31); float a0 = 0.f, a1 = 0.f, a2 = 0.f;
        float wl_[64];
#pragma unroll
        for (int j = 0; j < 64; ++j) wl_[j] = w_ada[(size_t)(128 * w + 2 * j + kh) * NMOD + col];
#pragma unroll
        for (int j = 0; j < 64; ++j) { const int kk = 2 * j + kh; a0 += scr[kk] * wl_[j]; a1 += scr[128 + kk] * wl_[j]; a2 += scr[256 + kk] * wl_[j]; }
        a0 += __shfl_xor(a0, 32); a1 += __shfl_xor(a1, 32); a2 += __shfl_xor(a2, 32);
        LAS float* xs = (LAS float*)(F.lds + XSCR_OFF);
        if (lane < 32) { xs[w * 96 + lane] = a0; xs[w * 96 + 32 + lane] = a1; xs[w * 96 + 64 + lane] = a2; }
        __syncthreads();
        if (tid < 96) { float s = 0.f; for (int ww = 0; ww < 8; ++ww) s += xs[ww * 96 + tid]; const int v = tid >> 5, cc = 32 * cg + (tid & 31); mod[v * NMOD + cc] = s + b_ada[cc]; }
        __syncthreads();
    }
    for (int i = F.vcu * 8 + tid; i < 2048 && tid < 8; i += F.G * 8) { const int p = i >> 4, f = i & 15; const float invf = (float)pow(10000.0, -(double)f / 16.0); const float ang = (float)p * invf;
        rope[i] = (float)cos((double)ang); rope[2048 + i] = (float)sin((double)ang); }
    { GAS v4u* lt = (GAS v4u*)(F.ws + WS_LTOK); const int n16 = NE * 16384 * 4 / 16; for (int i = F.vcu * NWAVES * 64 + tid; i < n16; i += F.G * NWAVES * 64) lt[i] = (v4u){0u, 0u, 0u, 0u}; }
    conv_items(F, 0, CONV_DENSE, scr, lane);
}
__device__ __forceinline__ void p0_xhat(Frame& F) {
    const float* x = F.in[0]; const float* ctx = F.in[2]; bf16* XN = (bf16*)(F.ws + WS_XN); const float* g1 = F.in[6]; const float* mod = (const float*)(F.ws + WS_MOD);
    const int gw = F.vcu * NWAVES + F.wave, NGW = F.G * NWAVES, lane = lane_id_asm();
    for (int m0 = gw; m0 < MROWS; m0 += 2 * NGW) {
        f32x4 v[2][4]; int mm[2];
#pragma unroll
        for (int u = 0; u < 2; ++u) { const int m = (m0 + u * NGW < MROWS) ? m0 + u * NGW : m0; mm[u] = m; const int b = m / KEYS, i = m % KEYS;
            const float* src = (i < CTXL) ? ctx + ((size_t)b * CTXL + i) * DM_ : x + ((size_t)b * T_ + (i - CTXL)) * DM_;
            const GAS f32x4* xr = (const GAS f32x4*)src + lane;
#pragma unroll
            for (int j = 0; j < 4; ++j) v[u][j] = xr[64 * j]; }
#pragma unroll
        for (int u = 0; u < 2; ++u) { float s = 0.f;
#pragma unroll
            for (int j = 0; j < 4; ++j) s += (v[u][j].x * v[u][j].x + v[u][j].y * v[u][j].y) + (v[u][j].z * v[u][j].z + v[u][j].w * v[u][j].w);
            const float rstd = 1.0f / sqrtf(wave_sum(s) * (1.0f / DM_) + 1e-6f);
            GAS unsigned* o4 = (GAS unsigned*)((unsigned char*)XN + (size_t)mm[u] * DM_) + lane;
            const float* md = mod + (((mm[u] % KEYS) < CTXL) ? 2 : mm[u] / KEYS) * NMOD;
#pragma unroll
            for (int j = 0; j < 4; ++j) { const int cc = 4 * (lane + 64 * j); const f32x4 o = v[u][j] * rstd * (*(const f32x4*)(g1 + cc) * (*(const f32x4*)(md + DM_ + cc) + 1.0f)) + *(const f32x4*)(md + cc);
                o4[64 * j] = pg8::pk4_fp8(o.x, o.y, o.z, o.w); } }
    }
}
__device__ __forceinline__ void p1_wqkv(Frame& F) {
    const float* w = F.in[7];
    LAS float* scr = (LAS float*)(F.lds + RING_OFF + F.wave * 16384);
    const int lane = lane_id_asm(), wv = F.wave;
    const int gw = F.vcu * NWAVES + wv, NGW = F.G * NWAVES;
    for (int it = gw; it < I_QKV; it += NGW) { const int r = it, kb = r / 72, nb = r % 72, pn = nb >> 3, wc = (nb & 7) >> 1, ax = nb & 1;
        transpose_item_f8(w, DM_, QKVC, F.ws + WS_WQKV, 64 * kb, 32 * nb, 256 * pn + 32 * wc + 8 * ax, scr, lane, nullptr, nullptr, true); }
}
__device__ __forceinline__ float bf2f(unsigned short h) { return __builtin_bit_cast(float, (unsigned)h << 16); }
__device__ __forceinline__ void p3_attention(Frame& F, char* lds) {
    using abf = attn_body::bf16;
    const abf* QKV = (const abf*)(F.ws + WS_QKV); abf* MIX = (abf*)(F.ws + WS_MIX);
    const int ordB = (F.vcu >> 5) & 1; const int v8 = F.vcu & 7; const int cpos = v8 == 0 ? 0 : v8 < 3 ? 1 : v8 < 5 ? 2 : v8 < 7 ? 3 : 4; int pos = 0; bool cdone = false;
    bool fixref; { const int l_ = lane_id_asm(); float gq = fabsf(F.in[8][l_]), gk = fabsf(F.in[9][l_]);
#pragma unroll
        for (int o_ = 1; o_ < 64; o_ <<= 1) { gq = fmaxf(gq, __shfl_xor(gq, o_)); gk = fmaxf(gk, __shfl_xor(gk, o_)); }
        fixref = __builtin_amdgcn_readfirstlane((gq * gk <= 8.0f) ? 1 : 0) != 0; }
#define CONV_AT() do { if (!cdone && pos == cpos) { conv_experts(F, (LAS float*)(F.lds + RING_OFF + F.wave * 16384), lane_id_asm()); __syncthreads(); cdone = true; } ++pos; } while (0)
    CONV_AT();
    const float* lamp = F.in[10];
    float lam; { const int lane = lane_id_asm(); lam = expf(wave_sum(lamp[lane] * lamp[64 + lane])) - expf(wave_sum(lamp[128 + lane] * lamp[192 + lane])) + 0.2f; }
#pragma nounroll
    for (int seg = 0; seg < 2; ++seg) {
      if ((seg == 0) != (ordB != 0)) {
        for (int L = F.vcu; L < 16 * 32; L += F.G) {
            const int run = L >> 5, qb = L & 31, b = run >> 3, h = run & 7;
            const abf* kb = QKV + (size_t)b * KEYS * QKVC;
            const unsigned char* k8 = F.ws + WS_QK8 + (size_t)b * KEYS * 1664;
            if (fixref) attn_body::attn_unit_q8v<8, true>(k8 + (size_t)(CTXL + qb * 256) * 1664 + h * 64, k8 + (8 + (h >> 2)) * 64, F.ws + WS_V8 + (size_t)b * KEYS * 640 + (h >> 2) * 64, MIX + ((size_t)b * T_ + qb * 256) * DM_ + h * 64, DM_, lds, F.wave);
            else attn_body::attn_unit_q8<8, false>(k8 + (size_t)(CTXL + qb * 256) * 1664 + h * 64, k8 + (8 + (h >> 2)) * 64, kb + 640 + (h >> 2) * 64, MIX + ((size_t)b * T_ + qb * 256) * DM_ + h * 64, DM_, lds, F.wave);
            CONV_AT();
        }
      } else {
        for (int L = F.vcu; L < 8 * 32; L += F.G) {
            const int bh = L >> 5, qb = L & 31, b = bh >> 2, h = bh & 3;
            const abf* kb = QKV + (size_t)b * KEYS * QKVC;
            const float nq = fmaxf(__uint_as_float(__hip_atomic_load(F.ctl + CW_NMAX + 12 + 2 * h, RLX_AGENT)), __uint_as_float(__hip_atomic_load(F.ctl + CW_NMAX + 13 + 2 * h, RLX_AGENT)));
            const float nk = fmaxf(__uint_as_float(__hip_atomic_load(F.ctl + CW_NMAX + 20 + 2 * h, RLX_AGENT)), __uint_as_float(__hip_atomic_load(F.ctl + CW_NMAX + 21 + 2 * h, RLX_AGENT)));
            const float bound = sqrtf(nq * nk) * pg8::ATT_C2;
            const float ref8 = fmaxf(0.55f * bound - 15.0f, 0.0f);
            const unsigned char* k8 = F.ws + WS_QK8 + (size_t)b * KEYS * 1664;
#pragma nounroll
            for (int pp = 0; pp < 2; ++pp) {
                const bool redo = attn_body::attn_unit128_q8v<8, true>(k8 + (size_t)(CTXL + qb * 256) * 1664 + (10 + 2 * h) * 64, k8 + (18 + 2 * h) * 64, F.ws + WS_V8 + (size_t)b * KEYS * 640 + 128 + h * 128, MIX + ((size_t)b * T_ + qb * 256) * DM_ + 512 + h * 128, DM_, lds, F.wave,
                                           (float*)(F.ws + WS_DT) + (size_t)F.vcu * 32768, lam, F.in[11], pp, pp + 1, ref8);
                if (redo) attn_body::attn_unit128_q8<8, false>(k8 + (size_t)(CTXL + qb * 256) * 1664 + (10 + 2 * h) * 64, k8 + (18 + 2 * h) * 64, kb + 1792 + h * 128, MIX + ((size_t)b * T_ + qb * 256) * DM_ + 512 + h * 128, DM_, lds, F.wave,
                                           (float*)(F.ws + WS_DT) + (size_t)F.vcu * 32768, lam, F.in[11], pp, pp + 1);
                CONV_AT();
            }
        }
      }
    }
    if (!cdone) { conv_experts(F, (LAS float*)(F.lds + RING_OFF + F.wave * 16384), lane_id_asm()); __syncthreads(); }
#undef CONV_AT
}
__device__ __forceinline__ f32x4 bf4lo(v4u q); __device__ __forceinline__ f32x4 bf4hi(v4u q);
typedef short p6_bf16x8 __attribute__((ext_vector_type(8)));
typedef float p6_f32x16 __attribute__((ext_vector_type(16)));
__device__ __forceinline__ void p6_split8(const float (&v)[8], p6_bf16x8& hi, p6_bf16x8& lo) {
    unsigned h[4], l[4];
#pragma unroll
    for (int j = 0; j < 4; ++j) { h[j] = pg8::cvt_pk_bf16(v[2 * j], v[2 * j + 1]);
        const float r0 = v[2 * j] - __builtin_bit_cast(float, h[j] << 16), r1 = v[2 * j + 1] - __builtin_bit_cast(float, h[j] & 0xffff0000u); l[j] = pg8::cvt_pk_bf16(r0, r1); }
    hi = __builtin_bit_cast(p6_bf16x8, (v4u){h[0], h[1], h[2], h[3]}); lo = __builtin_bit_cast(p6_bf16x8, (v4u){l[0], l[1], l[2], l[3]});
}
__device__ __forceinline__ void p6_router(Frame& F) {
    const bf16* x1 = (const bf16*)(F.ws + WS_DT); const float* g = F.in[13]; const float* wr = F.in[14]; const float* br = F.in[15]; const float* mod = (const float*)(F.ws + WS_MOD);
    bf16* H2 = (bf16*)(F.ws + WS_XN); int* se = (int*)(F.ws + WS_SE); int* sp = (int*)(F.ws + WS_SP); int* ltok = (int*)(F.ws + WS_LTOK); float* lgate = (float*)(F.ws + WS_LGATE);
    LAS float* rstdb = (LAS float*)(F.lds + RING_OFF);
    LAS float* part = (LAS float*)(F.lds + RING_OFF + 1024);
    LAS float* lgb = (LAS float*)(F.lds + RING_OFF + 1024 + 65536);
    LAS float* selb = (LAS float*)(F.lds + RING_OFF + 1024 + 65536 + 8192);
    LAS unsigned* lcount = (LAS unsigned*)(F.lds + RING_OFF + 1024 + 65536 + 8192 + 1024);
    LAS unsigned* lbase = lcount + 32;
    LAS unsigned* recE = lbase + 32;
    LAS float* recG = (LAS float*)(recE + 256);
    const int lane = lane_id_asm(), w = F.wave, e = lane & 31, hh = lane >> 5, tid = w * 64 + lane;
    p6_bf16x8 wh[8], wl[8];
#pragma unroll
    for (int st = 0; st < 8; ++st) { float t[8];
#pragma unroll
        for (int j = 0; j < 8; ++j) t[j] = wr[(size_t)(128 * w + 16 * st + 8 * hh + j) * NE + e];
        p6_split8(t, wh[st], wl[st]); }
    const float bre = br[e];
    for (int chunk = F.vcu; chunk < NTOK / 64; chunk += F.G) {
        const int tokc = chunk * 64, b = tokc / T_; const float* md = mod + b * NMOD;
        if (tid < 32) lcount[tid] = 0u;
        { f32x4 ga[4], sh[4];
#pragma unroll
            for (int j = 0; j < 4; ++j) { const int cc = 4 * (lane + 64 * j); ga[j] = *(const f32x4*)(g + cc) * (*(const f32x4*)(md + 4 * DM_ + cc) + 1.0f); sh[j] = *(const f32x4*)(md + 3 * DM_ + cc); }
#pragma unroll 1
            for (int hb = 0; hb < 2; ++hb) { const int tokw = tokc + 8 * w + 4 * hb;
                unsigned long long q_[4][4];
#pragma unroll
                for (int r = 0; r < 4; ++r) { const GAS unsigned long long* xr = (const GAS unsigned long long*)(x1 + (size_t)(tokw + r) * DM_) + lane;
#pragma unroll
                    for (int j = 0; j < 4; ++j) q_[r][j] = xr[64 * j]; }
                float rs_[4];
#pragma unroll
                for (int r = 0; r < 4; ++r) { float s = 0.f;
#pragma unroll
                    for (int j = 0; j < 4; ++j) { const unsigned lo = (unsigned)q_[r][j], hi = (unsigned)(q_[r][j] >> 32); const float a0 = bf2f(lo & 0xffff), a1 = bf2f(lo >> 16), a2 = bf2f(hi & 0xffff), a3 = bf2f(hi >> 16); s += (a0 * a0 + a1 * a1) + (a2 * a2 + a3 * a3); }
                    rs_[r] = 1.0f / sqrtf(wave_sum(s) * (1.0f / DM_) + 1e-6f); }
                if (lane == 0) {
#pragma unroll
                    for (int r = 0; r < 4; ++r) rstdb[8 * w + 4 * hb + r] = rs_[r]; }
#pragma unroll
                for (int r = 0; r < 4; ++r)
#pragma unroll
                    for (int j = 0; j < 4; ++j) { asm volatile("" : "+v"(q_[r][j])); const unsigned lo = (unsigned)q_[r][j], hi = (unsigned)(q_[r][j] >> 32); const f32x4 v = (f32x4){bf2f(lo & 0xffff), bf2f(lo >> 16), bf2f(hi & 0xffff), bf2f(hi >> 16)};
                        const f32x4 o = v * rs_[r] * ga[j] + sh[j];
                        *((GAS unsigned*)((unsigned char*)H2 + (size_t)(tokw + r) * DM_) + lane + 64 * j) = pg8::pk4_fp8(o.x, o.y, o.z, o.w); }
            }
        }
        __syncthreads();
        { p6_f32x16 acc[2]; acc[0] = p6_f32x16{}; acc[1] = p6_f32x16{};
            const float rs0 = rstdb[e], rs1 = rstdb[32 + e];
#pragma unroll
            for (int st = 0; st < 8; ++st) { const int k0 = 128 * w + 16 * st + 8 * hh;
                const f32x4 g0 = *(const f32x4*)(g + k0), g1 = *(const f32x4*)(g + k0 + 4), c0 = *(const f32x4*)(md + 4 * DM_ + k0), c1 = *(const f32x4*)(md + 4 * DM_ + k0 + 4), h0 = *(const f32x4*)(md + 3 * DM_ + k0), h1 = *(const f32x4*)(md + 3 * DM_ + k0 + 4);
                const f32x4 a0 = g0 * (c0 + 1.0f), a1 = g1 * (c1 + 1.0f);
#pragma unroll
                for (int rb = 0; rb < 2; ++rb) { const v4u q = *(const GAS v4u*)(x1 + (size_t)(tokc + 32 * rb + e) * DM_ + k0); const float rs = rb ? rs1 : rs0;
                    const f32x4 xl = bf4lo(q), xh = bf4hi(q); const f32x4 vl = xl * rs * a0 + h0, vh = xh * rs * a1 + h1;
                    const float vv[8] = {vl.x, vl.y, vl.z, vl.w, vh.x, vh.y, vh.z, vh.w}; p6_bf16x8 ahi, alo; p6_split8(vv, ahi, alo);
                    acc[rb] = __builtin_amdgcn_mfma_f32_32x32x16_bf16(ahi, wh[st], acc[rb], 0, 0, 0);
                    acc[rb] = __builtin_amdgcn_mfma_f32_32x32x16_bf16(ahi, wl[st], acc[rb], 0, 0, 0);
                    acc[rb] = __builtin_amdgcn_mfma_f32_32x32x16_bf16(alo, wh[st], acc[rb], 0, 0, 0); } }
#pragma unroll
            for (int rb = 0; rb < 2; ++rb)
#pragma unroll
                for (int r = 0; r < 16; ++r) part[(w * 64 + 32 * rb + (r & 3) + 8 * (r >> 2) + 4 * hh) * 32 + e] = acc[rb][r]; }
        __syncthreads();
        { const int row = tid >> 3, e4 = (tid & 7) * 4; f32x4 sacc = *(const f32x4*)(br + e4);
#pragma unroll
            for (int ww = 0; ww < 8; ++ww) sacc += *(const LAS f32x4*)(part + (ww * 64 + row) * 32 + e4);
            *(LAS f32x4*)(lgb + row * 32 + e4) = sacc; }
        __syncthreads();
#pragma unroll 2
        for (int r = 0; r < 8; ++r) { const int row = 8 * w + r; const float lg = lgb[row * 32 + e];
            int rank = 0;
#pragma unroll
            for (int q = 0; q < 32; ++q) { const float o = lgb[row * 32 + q]; rank += (o > lg || (o == lg && q < e)) ? 1 : 0; }
            if (lane < 32 && rank < 4) selb[row * 4 + rank] = lg;
            LDS_WAIT(); asm volatile("" ::: "memory");
            const float m0 = selb[row * 4], den = 1.0f + expf(selb[row * 4 + 1] - m0) + expf(selb[row * 4 + 2] - m0) + expf(selb[row * 4 + 3] - m0);
            if (lane < 32 && rank < 4) { const unsigned lpos = __hip_atomic_fetch_add(lcount + e, 1u, __ATOMIC_RELAXED, __HIP_MEMORY_SCOPE_WORKGROUP);
                recE[row * 4 + rank] = (unsigned)e | (lpos << 8); recG[row * 4 + rank] = expf(lg - m0) / den; }
        }
        (void)bre;
        __syncthreads();
        if (tid < 32) lbase[tid] = __hip_atomic_fetch_add(F.ctl + CW_CNT + tid, lcount[tid], RLX_AGENT);
        __syncthreads();
        if (tid < 256) { const unsigned rc = recE[tid]; const int ee = (int)(rc & 255u), pos = (int)(lbase[ee] + (rc >> 8)), tok = tokc + (tid >> 2);
            ltok[ee * 16384 + pos] = tok; lgate[ee * 16384 + pos] = recG[tid]; se[tok * 4 + (tid & 3)] = ee; sp[tok * 4 + (tid & 3)] = pos; }
        __syncthreads();
    }
}
__device__ __forceinline__ f32x4 bf4lo(v4u q) { return (f32x4){bf2f(q.x & 0xffff), bf2f(q.x >> 16), bf2f(q.y & 0xffff), bf2f(q.y >> 16)}; }
__device__ __forceinline__ f32x4 bf4hi(v4u q) { return (f32x4){bf2f(q.z & 0xffff), bf2f(q.z >> 16), bf2f(q.w & 0xffff), bf2f(q.w >> 16)}; }
__device__ __forceinline__ f32x4 f8x4(unsigned w) { return (f32x4){__builtin_amdgcn_cvt_f32_fp8((int)w, 0), __builtin_amdgcn_cvt_f32_fp8((int)w, 1), __builtin_amdgcn_cvt_f32_fp8((int)w, 2), __builtin_amdgcn_cvt_f32_fp8((int)w, 3)}; }
__device__ __forceinline__ void p9_final(Frame& F, float* dst) {
    const bf16* xo = (const bf16*)(F.ws + WS_DT); const float* gf = F.in[20]; const float* mod = (const float*)(F.ws + WS_MOD); const unsigned char* Y = F.ws + WS_Y;
    const int* se = (const int*)(F.ws + WS_SE); const int* sp = (const int*)(F.ws + WS_SP); const LAS int* tp = (const LAS int*)(F.lds + TP_OFF);
    const int gw = F.vcu * NWAVES + F.wave, NGW = F.G * NWAVES, lane = lane_id_asm();
    constexpr int NU = 2;
    for (int t0 = gw; t0 < NTOK; t0 += NU * NGW) {
        int tk[NU];
#pragma unroll
        for (int u = 0; u < NU; ++u) tk[u] = (t0 + u * NGW < NTOK) ? t0 + u * NGW : t0;
        int ee[NU][4], pp[NU][4];
#pragma unroll
        for (int u = 0; u < NU; ++u)
#pragma unroll
            for (int k = 0; k < 4; ++k) { ee[u][k] = se[tk[u] * 4 + k]; pp[u][k] = sp[tk[u] * 4 + k]; }
        v4u yq[NU][4]; v4u xq[NU][2];
#pragma unroll
        for (int u = 0; u < NU; ++u) {
#pragma unroll
            for (int k = 0; k < 4; ++k) yq[u][k] = *((const GAS v4u*)(Y + ((size_t)tp[ee[u][k]] * 256 + pp[u][k]) * DM_) + lane);
            const GAS v4u* xr = (const GAS v4u*)(xo + (size_t)tk[u] * DM_) + 2 * lane; xq[u][0] = xr[0]; xq[u][1] = xr[1];
        }
#pragma unroll
        for (int u = 0; u < NU; ++u) {
            const int b = tk[u] / T_; const GAS f32x4* gt2 = (const GAS f32x4*)(mod + b * NMOD + 5 * DM_) + 4 * lane; const GAS f32x4* gfp = (const GAS f32x4*)gf + 4 * lane;
            f32x4 ys[4] = {(f32x4){0.f, 0.f, 0.f, 0.f}, (f32x4){0.f, 0.f, 0.f, 0.f}, (f32x4){0.f, 0.f, 0.f, 0.f}, (f32x4){0.f, 0.f, 0.f, 0.f}};
#pragma unroll
            for (int k = 0; k < 4; ++k) { ys[0] += f8x4(yq[u][k].x); ys[1] += f8x4(yq[u][k].y); ys[2] += f8x4(yq[u][k].z); ys[3] += f8x4(yq[u][k].w); }
            f32x4 v[4]; float s = 0.f;
            v[0] = bf4lo(xq[u][0]) + gt2[0] * ys[0]; v[1] = bf4hi(xq[u][0]) + gt2[1] * ys[1]; v[2] = bf4lo(xq[u][1]) + gt2[2] * ys[2]; v[3] = bf4hi(xq[u][1]) + gt2[3] * ys[3];
#pragma unroll
            for (int j = 0; j < 4; ++j) s += (v[j].x * v[j].x + v[j].y * v[j].y) + (v[j].z * v[j].z + v[j].w * v[j].w);
            const float rstd = 1.0f / sqrtf(wave_sum(s) * (1.0f / DM_) + 1e-6f);
            GAS f32x4* xw = (GAS f32x4*)(dst + (size_t)tk[u] * DM_) + 4 * lane;
            xw[0] = v[0] * rstd * gfp[0]; xw[1] = v[1] * rstd * gfp[1]; xw[2] = v[2] * rstd * gfp[2]; xw[3] = v[3] * rstd * gfp[3];
        }
    }
}

struct Args { const float* in[21]; float* out; unsigned char* ws; int ph_lo, ph_hi; };
__global__ void __launch_bounds__(NWAVES * 64, 2) mk_fwd(Args args) {
    extern __shared__ __attribute__((aligned(16))) unsigned char lds[];
    Frame F;
    F.lds = (LAS unsigned char*)lds; F.MISC = (volatile LAS unsigned*)(F.lds + MISC_OFF);
    F.wave = __builtin_amdgcn_readfirstlane(threadIdx.x >> 6);
    F.G = gridDim.x; { const int bx = blockIdx.x; F.vcu = (F.G % 8 == 0) ? (bx % 8) * (F.G / 8) + bx / 8 : bx; }
#pragma unroll
    for (int i = 0; i < 21; ++i) F.in[i] = args.in[i];
    F.out = args.out; F.ws = args.ws; F.ctl = (gu32*)(args.ws + WS_CTL);
    for (int u = threadIdx.x; u < (LDS_BYTES - LDSCTL_OFF) / 4; u += NWAVES * 64) ((LAS unsigned*)(F.lds + LDSCTL_OFF))[u] = 0u;
    __syncthreads();
    XcdBarrier bar; bar.bar = (unsigned*)(F.ctl + CW_BAR); bar.x = 0; bar.st = nullptr; bar.wv = F.wave;
    if (!MK_PER_PHASE) bar = xcd_barrier_post((unsigned*)(F.ctl + CW_BAR), F.MISC + 8);
    if (!MK_PER_PHASE && threadIdx.x == 0 && F.G == 256 && (int)xb_xcc_id() != (F.vcu >> 5)) __hip_atomic_fetch_or(F.ctl + CW_XOK, 1u, __ATOMIC_RELAXED, __HIP_MEMORY_SCOPE_AGENT);
    const int lo = args.ph_lo, hi = args.ph_hi;
#define IN(k) (lo <= (k) && (k) < hi)
#define SEAM(k) do { if (IN(k) && IN((k) + 1)) xcd_barrier(bar); } while (0)
#ifndef PROBE_DUP
#define PROBE_DUP 0
#endif
#define REPS(k) for (int rep_ = 0; rep_ < (((PROBE_DUP >> (k)) & 1) ? 2 : 1); ++rep_)
#define DUPBAR(k) do { if (((PROBE_DUP >> (k)) & 1) && rep_ == 0 && !MK_PER_PHASE) xcd_barrier(bar); } while (0)
    bf16* XN = (bf16*)(F.ws + WS_XN);
    if (IN(0)) REPS(0) { p0_prologue(F); p1_wqkv(F); DUPBAR(0); } SEAM(0);
    if (IN(1)) REPS(1) { p0_xhat(F); DUPBAR(1); } SEAM(1);
    if (IN(2)) REPS(2) {
        pg8::Gemm g{XN, (const bf16*)(F.ws + WS_WQKV), MROWS, QKVC, DM_}; pg8::QkvOrder S; S.init(MROWS, QKVC, F.G, (int)blockIdx.x);
        pg8::EpiQkv E{(bf16*)(F.ws + WS_QKV), F.in[8], F.in[9], (const float*)(F.ws + WS_ROPE), (const float*)(F.ws + WS_CB), F.ws + WS_QK8, F.ws + WS_V8, (unsigned*)(F.ctl + CW_NMAX)};
        pg8::gemm_phase<pg8::EpiQkv, pg8::QkvOrder, PG8_ALIGN, PG8_SP2, false, true>(F.lds + RING_OFF, g, S, E, F.wave); DUPBAR(2);
    } SEAM(2);
    if (IN(3)) REPS(3) { p3_attention(F, (char*)lds + RING_OFF); DUPBAR(3); } if (IN(3) && IN(5)) xcd_barrier(bar);
    if (IN(5)) REPS(5) {
        pg8::Gemm g{(const bf16*)(F.ws + WS_MIX), (const bf16*)(F.ws + WS_WO), NTOK, DM_, DM_}; pg8::StaticOrder S; S.init(NTOK, DM_, F.G, (int)blockIdx.x);
        pg8::EpiWo E{F.in[0], (const float*)(F.ws + WS_MOD), (bf16*)(F.ws + WS_DT)};
        pg8::gemm_phase<pg8::EpiWo, pg8::StaticOrder, PG8_ALIGN, PG8_SP2>(F.lds + RING_OFF, g, S, E, F.wave); DUPBAR(5);
    } SEAM(5);
    if (IN(6)) REPS(6) { p6_router(F); if (((PROBE_DUP >> 6) & 1) && rep_ == 0) { xcd_barrier(bar); if (blockIdx.x == 0 && threadIdx.x < 32) F.ctl[CW_CNT + threadIdx.x] = 0u; xcd_barrier(bar); } } SEAM(6);
    const bool depok = !MK_PER_PHASE && PROBE_DUP == 0 && F.G == 256 && IN(7) && IN(8) && (__builtin_amdgcn_readfirstlane((int)__hip_atomic_load(F.ctl + CW_XOK, __ATOMIC_RELAXED, __HIP_MEMORY_SCOPE_AGENT)) == 0);
    if (IN(7)) REPS(7) {
        build_tp(F);
        pg8::Gemm g{XN, (const bf16*)(F.ws + WS_WIN), 0, 0, DM_}; pg8::MoeOrder S{(const LAS int*)(F.lds + TP_OFF), (const LAS unsigned char*)(F.lds + TE_OFF), 8, F.G, F.vcu, (unsigned*)(F.ctl + CW_MT), depok ? 1 : 0, 0};
        pg8::EpiSwiglu E{(bf16*)(F.ws + WS_ACT), F.in[17]};
        pg8::gemm_phase<pg8::EpiSwiglu, pg8::MoeOrder, PG8_ALIGN, PG8_SP2, true, true>(F.lds + RING_OFF, g, S, E, F.wave, (const int*)(F.ws + WS_LTOK), (LAS unsigned*)(F.lds + IDBUF_OFF)); DUPBAR(7);
    } if (!depok) SEAM(7);
    if (IN(8)) REPS(8) {
        build_tp(F);
        pg8::Gemm g{(const bf16*)(F.ws + WS_ACT), (const bf16*)(F.ws + WS_WOUT), 0, 0, DM_}; pg8::MoeOrder S{(const LAS int*)(F.lds + TP_OFF), (const LAS unsigned char*)(F.lds + TE_OFF), 4, F.G, F.vcu, (unsigned*)(F.ctl + CW_MT), depok ? 2 : 0, 16};
        pg8::EpiMoeOut E{(bf16*)(F.ws + WS_Y), F.in[19], (const float*)(F.ws + WS_LGATE)};
        pg8::gemm_phase<pg8::EpiMoeOut, pg8::MoeOrder, PG8_ALIGN, PG8_SP2, false, true>(F.lds + RING_OFF, g, S, E, F.wave); DUPBAR(8);
    } SEAM(8);
    if (IN(9)) REPS(9) { build_tp(F); p9_final(F, (((PROBE_DUP >> 9) & 1) && rep_ == 0) ? (float*)(F.ws + WS_ACT) : F.out); DUPBAR(9); }
#undef IN
#undef SEAM
}

extern "C" void kernel_launch(void* const* d_in, const int* in_sizes, int n_in, void* d_out, int out_size, void* d_ws, size_t ws_size, hipStream_t stream) {
    static int grid = 0;
    if (grid == 0) {
        if (n_in != 21 || out_size != NTOK * DM_ || ws_size < WS_END) { fprintf(stderr, "kernel_launch: unexpected shapes (n_in %d, out %d, ws %zu); nothing launched\n", n_in, out_size, ws_size); grid = -1; return; }
        int dev = 0, cus = 0, per_cu = 0;
        if (hipGetDevice(&dev) != hipSuccess || hipDeviceGetAttribute(&cus, hipDeviceAttributeMultiprocessorCount, dev) != hipSuccess) { grid = -1; return; }
        if (hipFuncSetAttribute((const void*)mk_fwd, hipFuncAttributeMaxDynamicSharedMemorySize, LDS_BYTES) != hipSuccess) { fprintf(stderr, "kernel_launch: hipFuncSetAttribute failed\n"); grid = -1; return; }
        if (hipOccupancyMaxActiveBlocksPerMultiprocessor(&per_cu, (const void*)mk_fwd, NWAVES * 64, LDS_BYTES) != hipSuccess || per_cu < 1) { fprintf(stderr, "kernel_launch: occupancy query says %d blocks per CU\n", per_cu); }
        (void)hipGetLastError();
        grid = cus;
    }
    if (grid < 0) return;
    if (hipMemsetAsync((char*)d_ws + WS_CTL, 0, CTL_ZERO_BYTES, stream) != hipSuccess) return;
    Args a{};
    for (int i = 0; i < 21; ++i) a.in[i] = (const float*)d_in[i];
    a.out = (float*)d_out; a.ws = (unsigned char*)d_ws;
#if MK_PER_PHASE
    for (int p = 0; p < NPH; ++p) { a.ph_lo = p; a.ph_hi = p + 1; hipLaunchKernelGGL(mk_fwd, dim3(grid), dim3(NWAVES * 64), LDS_BYTES, stream, a); }
#else
    a.ph_lo = 0; a.ph_hi = NPH; hipLaunchKernelGGL(mk_fwd, dim3(grid), dim3(NWAVES * 64), LDS_BYTES, stream, a);
#endif
}
```

```cpp
#include <hip/hip_runtime.h>
#include <hip/hip_bf16.h>
#include <cstdio>
#include <cstdint>
#include <cmath>
__device__ __forceinline__ int lane_id_asm() { int l; asm volatile("v_mbcnt_lo_u32_b32 %0, -1, 0\n\tv_mbcnt_hi_u32_b32 %0, -1, %0" : "=v"(l)); return l; }
namespace pg8 {
#define PG8_LAS __attribute__((address_space(3)))
typedef unsigned short bf16_t;
typedef short bf16x8 __attribute__((ext_vector_type(8)));
typedef float f32x4 __attribute__((ext_vector_type(4)));
typedef unsigned u32x4 __attribute__((ext_vector_type(4)));
constexpr int BM = 256, BK = 64, HALF = 128, HTB = HALF * BK * 2  , STAGE_BYTES = 8 * HTB, NXCD = 8, WGM = 8;

__host__ __device__ __forceinline__ int lds_byte(int r, int c) { const int st = (r >> 4) * 2 + (c >> 5), rr = r & 15, cc = c & 31, ob = rr * 64 + cc * 2; return st * 1024 + (ob ^ (((ob >> 9) & 1) << 5)); }
__host__ __device__ __forceinline__ void stage_rc(int b, int& R, int& C) { const int st = b / 1024, sb = b % 1024, swz = sb ^ (((sb >> 9) & 1) << 5); R = (st >> 1) * 16 + swz / 64; C = (st & 1) * 32 + (swz % 64) / 2; }
__host__ __device__ __forceinline__ int perm32(int rho) { const int n = rho >> 4, i = rho & 15; return 8 * (i >> 2) + 4 * n + (i & 3); }

struct Unit { int pm, pn, e, mt, pnl, pad_; };
struct Gemm { const bf16_t* A; const bf16_t* Bt; int M, N, K; };

struct StaticOrder {
    int nM, nN, nwg, G, c;
    __host__ __device__ void init(int M, int N, int G_, int c_) { nM = M / BM; nN = N / BM; nwg = nM * nN; G = G_; c = c_; }
    __host__ __device__ bool next(int i, Unit& u) const {
        const long L = (long)i * G + c; if (L >= nwg) return false;
        int wgid = (int)L; { const int q = nwg / NXCD, r = nwg % NXCD, xcd = wgid % NXCD, off = wgid / NXCD; wgid = (xcd < r ? xcd * (q + 1) : r * (q + 1) + (xcd - r) * q) + off; }
        const int nig = WGM * nN, gid = wgid / nig, fm = gid * WGM, gsz = (nM - fm) < WGM ? (nM - fm) : WGM;
        u.pm = fm + ((wgid % nig) % gsz); u.pn = (wgid % nig) / gsz; return true;
    }
    __device__ __forceinline__ void a_ready(const Unit&) const {}
    __device__ __forceinline__ void done(const Unit&) const {}
};

__device__ __forceinline__ unsigned cvt_pk_bf16(float lo, float hi) { unsigned r; asm volatile("v_cvt_pk_bf16_f32 %0, %1, %2" : "=v"(r) : "v"(lo), "v"(hi)); return r; }
typedef float f32x2 __attribute__((ext_vector_type(2)));
typedef unsigned u32x2 __attribute__((ext_vector_type(2)));
typedef int v8i32 __attribute__((ext_vector_type(8)));
typedef int v4i32 __attribute__((ext_vector_type(4)));
__device__ __forceinline__ v8i32 cat8(bf16x8 lo, bf16x8 hi) { const v4i32 a = __builtin_bit_cast(v4i32, lo), b = __builtin_bit_cast(v4i32, hi); return __builtin_shufflevector(a, b, 0, 1, 2, 3, 4, 5, 6, 7); }
__device__ __forceinline__ unsigned pk4_fp8(float a, float b, float c, float d) { int r = __builtin_amdgcn_cvt_pk_fp8_f32(a, b, 0, false); r = __builtin_amdgcn_cvt_pk_fp8_f32(c, d, r, true); return (unsigned)r; }
constexpr float W8_SCALE = 16.0f, W8_INV = 1.0f / 16.0f;
constexpr int QKV_PITCH = 2304;
constexpr float ATT_C2 = 0.125f * 1.4426950408889634f;
constexpr float RMS_EPS = 1e-6f;

struct EpiQkv {
    static constexpr bool PERM = false, AFTER_DRAIN = false;
    bf16_t* O; const float* qn; const float* kn; const float* rope;
    const float* cb;
    unsigned char* qk8;
    unsigned char* v8;
    unsigned* nmax;
    __device__ __forceinline__ void operator()(const f32x4 (&acc)[2][2][4][2], const Unit& u, int wr, int wc, int fr_in, int fq_in) const {
        int fr = fr_in, fq = fq_in; asm volatile("" : "+v"(fr), "+v"(fq));
        const int s = u.pnl * 4 + wc;
        const bool isq = (s < 8) || (s >= 12 && s < 20), isk = (s >= 8 && s < 10) || (s >= 20 && s < 28);
        const bool donorm = s < 10; const float* gp = s < 8 ? qn : kn;
        const int tb = u.pm % 33;
        const int ax = fq >> 1, hc0 = 32 * ax + 8 * (fq & 1);
        const float* cbp = cb + (tb == 0 ? 2 : u.pm / 33) * QKV_PITCH + s * 64 + hc0;
        const bool dorope = (isq || isk) && tb != 0;
        const float sc = isq ? ATT_C2 * 4.0f : (isk ? 0.25f : 1.0f);
        const bool dobound = (s >= 12 && s < 28); float nmx = 0.f;
        f32x4 gv[2][2], cbv[2][2];
#pragma unroll
        for (int h = 0; h < 2; ++h)
#pragma unroll
            for (int n = 0; n < 2; ++n) { gv[h][n] = donorm ? *(const f32x4*)(gp + hc0 + 16 * h + 4 * n) : (f32x4){1.f, 1.f, 1.f, 1.f}; cbv[h][n] = (f32x4){0.f, 0.f, 0.f, 0.f}; }
        const int s26 = s < 10 ? s : s - 2;
#pragma unroll
        for (int ai = 0; ai < 2; ++ai)
#pragma unroll
            for (int m = 0; m < 4; ++m) {
                const int rl = ai * HALF + wr * 64 + m * 16 + fr;
                f32x4 v[2][2];
#pragma unroll
                for (int h = 0; h < 2; ++h)
#pragma unroll
                    for (int n = 0; n < 2; ++n) v[h][n] = acc[ai][h][m][n] * W8_INV + cbv[h][n];
                if (dobound || donorm) { float ss = 0.f;
#pragma unroll
                    for (int h = 0; h < 2; ++h)
#pragma unroll
                        for (int n = 0; n < 2; ++n) { const f32x4 x = v[h][n]; ss += (x[0] * x[0] + x[1] * x[1]) + (x[2] * x[2] + x[3] * x[3]); }
                    ss += __shfl_xor(ss, 16); ss += __shfl_xor(ss, 32);
                    if (dobound) nmx = fmaxf(nmx, ss);
                    if (donorm) { const float r = 1.0f / sqrtf(ss * (1.0f / 64.0f) + RMS_EPS);
#pragma unroll
                        for (int h = 0; h < 2; ++h)
#pragma unroll
                            for (int n = 0; n < 2; ++n) v[h][n] = v[h][n] * r * gv[h][n]; } }
                if (dorope) {
                    const int pos = ax ? (rl & 63) : ((tb - 1) * 4 + (rl >> 6));
#pragma unroll
                    for (int n = 0; n < 2; ++n) { const f32x4 cs = *(const f32x4*)(rope + pos * 16 + 8 * (fq & 1) + 4 * n), sn = *(const f32x4*)(rope + 2048 + pos * 16 + 8 * (fq & 1) + 4 * n);
                        const f32x4 x1 = v[0][n], x2 = v[1][n]; v[0][n] = x1 * cs - x2 * sn; v[1][n] = x2 * cs + x1 * sn; }
                }
                const size_t row = (size_t)(u.pm * BM + rl);
                if (isq || isk) { unsigned char* p8 = qk8 + row * 1664 + s26 * 64 + hc0;
#pragma unroll
                    for (int h = 0; h < 2; ++h) { const f32x4 x0 = v[h][0] * sc, x1 = v[h][1] * sc; u32x2 w; w.x = pk4_fp8(x0[0], x0[1], x0[2], x0[3]); w.y = pk4_fp8(x1[0], x1[1], x1[2], x1[3]); *(u32x2*)(p8 + 16 * h) = w; } }
                else { bf16_t* rowp = O + row * QKV_PITCH + s * 64 + hc0;
                    { unsigned char* p8 = v8 + row * 640 + (s >= 28 ? 128 + (s - 28) * 64 : (s - 10) * 64) + hc0;
#pragma unroll
                        for (int h = 0; h < 2; ++h) { const f32x4 x0 = v[h][0], x1 = v[h][1]; u32x2 w; w.x = pk4_fp8(x0[0], x0[1], x0[2], x0[3]); w.y = pk4_fp8(x1[0], x1[1], x1[2], x1[3]); *(u32x2*)(p8 + 16 * h) = w; } }
#pragma unroll
                    for (int h = 0; h < 2; ++h) { const f32x4 x0 = v[h][0], x1 = v[h][1]; u32x4 w; w.x = cvt_pk_bf16(x0[0], x0[1]); w.y = cvt_pk_bf16(x0[2], x0[3]); w.z = cvt_pk_bf16(x1[0], x1[1]); w.w = cvt_pk_bf16(x1[2], x1[3]); *(u32x4*)(rowp + 16 * h) = w; } }
            }
        if (dobound) {
#pragma unroll
            for (int o_ = 1; o_ < 16; o_ <<= 1) nmx = fmaxf(nmx, __shfl_xor(nmx, o_));
            if (fr == 0 && fq == 0) __hip_atomic_fetch_max(nmax + s, __float_as_uint(nmx), __ATOMIC_RELAXED, __HIP_MEMORY_SCOPE_AGENT); }
    }
};
struct EpiWo {
    static constexpr bool PERM = true, AFTER_DRAIN = false;
    const float* x; const float* mod; bf16_t* x1;
    __device__ __forceinline__ void operator()(const f32x4 (&acc)[2][2][4][2], const Unit& u, int wr, int wc, int fr_in, int fq_in) const {
        int fr = fr_in, fq = fq_in; asm volatile("" : "+v"(fr), "+v"(fq));
        const int b = u.pm >> 5; const float* gt = mod + b * 6144 + 2048;
        const int col0 = u.pn * BM + wc * 32 + 8 * fq, row0 = u.pm * BM + wr * 64 + fr;
        f32x4 g[2][2];
#pragma unroll
        for (int bj = 0; bj < 2; ++bj)
#pragma unroll
            for (int n = 0; n < 2; ++n) g[bj][n] = *(const f32x4*)(gt + col0 + bj * HALF + 4 * n);
#pragma unroll
        for (int ai = 0; ai < 2; ++ai)
#pragma unroll
            for (int m = 0; m < 4; ++m) { const size_t off = (size_t)(row0 + ai * HALF + m * 16) * 1024 + col0;
#pragma unroll
                for (int bj = 0; bj < 2; ++bj) { const f32x4 x0 = *(const f32x4*)(x + off + bj * HALF), x4 = *(const f32x4*)(x + off + bj * HALF + 4);
                    const f32x4 v0 = x0 + g[bj][0] * acc[ai][bj][m][0], v1 = x4 + g[bj][1] * acc[ai][bj][m][1];
                    u32x4 w; w.x = cvt_pk_bf16(v0[0], v0[1]); w.y = cvt_pk_bf16(v0[2], v0[3]); w.z = cvt_pk_bf16(v1[0], v1[1]); w.w = cvt_pk_bf16(v1[2], v1[3]);
                    *(u32x4*)(x1 + off + bj * HALF) = w; } }
    }
};
struct EpiSwiglu {
    static constexpr bool PERM = true, AFTER_DRAIN = false;
    bf16_t* act; const float* b_in;
    __device__ __forceinline__ void operator()(const f32x4 (&acc)[2][2][4][2], const Unit& u, int wr, int wc, int fr_in, int fq_in) const {
        int fr = fr_in, fq = fq_in; asm volatile("" : "+v"(fr), "+v"(fq));
        const int c0 = u.pnl * 128 + wc * 32 + 8 * fq; const float* bg = b_in + u.e * 2048 + c0; const float* bl = bg + 1024;
        constexpr float KP = 1.702f * 1.4426950408889634f, KI = 1.0f / KP;
        const f32x4 bgv[2] = {*(const f32x4*)bg * KP, *(const f32x4*)(bg + 4) * KP}, blv[2] = {(*(const f32x4*)bl + 1.0f) * KI, (*(const f32x4*)(bl + 4) + 1.0f) * KI};
#pragma unroll
        for (int ai = 0; ai < 2; ++ai)
#pragma unroll
            for (int m = 0; m < 4; ++m) { const size_t row = (size_t)u.pm * BM + ai * HALF + wr * 64 + m * 16 + fr; f32x4 a[2];
#pragma unroll
                for (int n = 0; n < 2; ++n) { f32x4 g2 = acc[ai][0][m][n] * (W8_INV * KP) + bgv[n], l2 = acc[ai][1][m][n] * (W8_INV * KI) + blv[n], d;
#pragma unroll
                    for (int i = 0; i < 4; ++i) { g2[i] = fminf(g2[i], 7.0f * KP); l2[i] = __builtin_amdgcn_fmed3f(l2[i], -6.0f * KI, 8.0f * KI); d[i] = __builtin_amdgcn_exp2f(-g2[i]); }
                    d = d + 1.0f;
#pragma unroll
                    for (int i = 0; i < 4; ++i) d[i] = __builtin_amdgcn_rcpf(d[i]);
                    a[n] = g2 * d * l2; }
                u32x2 w; w.x = pk4_fp8(a[0][0], a[0][1], a[0][2], a[0][3]); w.y = pk4_fp8(a[1][0], a[1][1], a[1][2], a[1][3]);
                *(u32x2*)((unsigned char*)act + row * 1024 + c0) = w; }
    }
};
struct EpiMoeOut {
    static constexpr bool PERM = true, AFTER_DRAIN = false;
    bf16_t* y; const float* b_out; const float* lgate;
    __device__ __forceinline__ void operator()(const f32x4 (&acc)[2][2][4][2], const Unit& u, int wr, int wc, int fr_in, int fq_in) const {
        int fr = fr_in, fq = fq_in; asm volatile("" : "+v"(fr), "+v"(fq));
        const int c0 = u.pnl * BM + wc * 32 + 8 * fq; const float* bp = b_out + u.e * 1024 + c0;
        f32x4 bv[2][2];
#pragma unroll
        for (int bj = 0; bj < 2; ++bj)
#pragma unroll
            for (int n = 0; n < 2; ++n) bv[bj][n] = *(const f32x4*)(bp + bj * HALF + 4 * n);
#pragma unroll
        for (int ai = 0; ai < 2; ++ai)
#pragma unroll
            for (int m = 0; m < 4; ++m) { const int rl = ai * HALF + wr * 64 + m * 16 + fr; const float gate = lgate[(size_t)u.e * 16384 + u.mt * BM + rl];
                unsigned char* rowp = (unsigned char*)y + ((size_t)u.pm * BM + rl) * 1024 + c0;
#pragma unroll
                for (int bj = 0; bj < 2; ++bj) { const f32x4 v0 = (acc[ai][bj][m][0] * W8_INV + bv[bj][0]) * gate, v1 = (acc[ai][bj][m][1] * W8_INV + bv[bj][1]) * gate;
                    u32x2 w; w.x = pk4_fp8(v0[0], v0[1], v0[2], v0[3]); w.y = pk4_fp8(v1[0], v1[1], v1[2], v1[3]);
                    *(u32x2*)(rowp + bj * HALF) = w; } }
    }
};
struct WoOrder : StaticOrder {
    unsigned* dep; int mode;
    __device__ __forceinline__ void done(const Unit& u) const { if (mode == 1) { if (lane_id_asm() == 0) __hip_atomic_fetch_add(dep + u.pm, 1u, __ATOMIC_RELAXED, __HIP_MEMORY_SCOPE_AGENT); } }
};
struct QkvOrder : StaticOrder {
    __device__ __forceinline__ bool next(int i, Unit& u) const { if (!StaticOrder::next(i, u)) return false; u.pnl = u.pn;     u.e = 0; u.mt = 0; u.pad_ = 0; return true; }
};
struct MoeOrder {
    const PG8_LAS int* tp; const PG8_LAS unsigned char* te; int npn, G, c;
    unsigned* dep; int mode, joff;
    __device__ __forceinline__ bool next(int i, Unit& u) const {
        long L; int g;
        if (mode == 0) { L = (long)i * G + c; g = (int)(L / npn); }
        else { const int x = c >> 5, j = (c + joff) & 31; L = (long)i * 32 + j; const int T_ = __builtin_amdgcn_readfirstlane(tp[32]), per = (T_ + 7) >> 3, q = (int)(L / npn);
            if (q >= per) return false; g = x * per + q; }
        if (g >= __builtin_amdgcn_readfirstlane(tp[32])) return false;
        const int e = __builtin_amdgcn_readfirstlane((int)te[g]);
        u.e = e; u.mt = g - __builtin_amdgcn_readfirstlane(tp[e]); u.pnl = (int)(L % npn); u.pm = g; u.pn = e * npn + u.pnl; u.pad_ = 0; return true;
    }
    __device__ __forceinline__ void a_ready(const Unit& u) const { if (mode == 2) { while (__hip_atomic_load(dep + u.pm, __ATOMIC_RELAXED, __HIP_MEMORY_SCOPE_AGENT) < 64u) __builtin_amdgcn_s_sleep(4); asm volatile("" ::: "memory"); } }
    __device__ __forceinline__ void done(const Unit& u) const { if (mode == 1) { if (lane_id_asm() == 0) __hip_atomic_fetch_add(dep + u.pm, 1u, __ATOMIC_RELAXED, __HIP_MEMORY_SCOPE_AGENT); } }
};
template <class Epi, class Sched, bool ALIGN_EPI = false, bool SP2 = false, bool GATHER = false, bool F8 = false>
__device__ __forceinline__ void gemm_phase(PG8_LAS unsigned char* lds, const Gemm g, const Sched& S, const Epi& E, int wid_in, const int* glist = nullptr, PG8_LAS unsigned* idbuf = nullptr) {
    static_assert(!GATHER || SP2, "GATHER is written for the SP2 loop only");
    const int lane = lane_id_asm(), wid = wid_in, tid = wid * 64 + lane, wr = wid >> 2, wc = wid & 3, fr = lane & 15, fq = lane >> 4;
    constexpr int ES = F8 ? 1 : 2;
    const int K = g.K, nt = (K * ES) / (BK * 2);
    unsigned voffA[2], voffB[2]; int Rl[2]; unsigned Cb[2];
#pragma unroll
    for (int i = 0; i < 2; ++i) { int R, C; stage_rc(tid * 16 + i * 8192, R, C); const int Rb = Epi::PERM ? ((R & ~31) + perm32(R & 31)) : R;
        voffA[i] = (unsigned)(R * K * ES + C * 2); voffB[i] = (unsigned)(Rb * K * ES + C * 2); Rl[i] = R; Cb[i] = (unsigned)C * 2u; }
    unsigned cv[2][2] = {{0u, 0u}, {0u, 0u}}, nv[2][2] = {{0u, 0u}, {0u, 0u}};
    constexpr int GL_STRIDE = 16384;
    PG8_LAS unsigned* myid = idbuf + wid * 256;
#define PG8_FETCH_IDS(U) do { _Pragma("unroll") for (int h_ = 0; h_ < 2; ++h_) _Pragma("unroll") for (int i_ = 0; i_ < 2; ++i_) \
        __builtin_amdgcn_global_load_lds((const unsigned*)(glist + (size_t)(U).e * GL_STRIDE + (U).mt * BM + h_ * HALF + Rl[i_]), (PG8_LAS unsigned*)(myid + (h_ * 2 + i_) * 64), 4, 0, 0); } while (0)
#define PG8_READ_IDS(dst) do { _Pragma("unroll") for (int h_ = 0; h_ < 2; ++h_) _Pragma("unroll") for (int i_ = 0; i_ < 2; ++i_) dst[h_][i_] = myid[(h_ * 2 + i_) * 64 + lane] * (unsigned)(K * ES) + Cb[i_]; } while (0)
#define PG8_STAGE_A(bufoff, kbase, H, NX) do { if constexpr (GATHER) { unsigned v_[2]; v_[0] = (NX) ? nv[H][0] : cv[H][0]; v_[1] = (NX) ? nv[H][1] : cv[H][1]; PG8_STAGE(bufoff, kbase, v_); } \
        else { PG8_STAGE(bufoff, (kbase) + ((H) ? hstep : (size_t)0), voffA); } } while (0)
    const size_t kstep = (size_t)(BK * 2);
    const size_t hstep = (size_t)HALF * K * ES;
    const size_t tstep = 2 * hstep;
    const unsigned ldsw = (unsigned)wid * 1024u;
    const int aoff = lds_byte(wr * 64 + fr, fq * 8), boff = lds_byte(wc * 32 + fr, fq * 8);
#define PG8_SA(b, h) (((b) * 2 + (h)) * HTB)
#define PG8_SB(b, h) ((4 + (b) * 2 + (h)) * HTB)
#define PG8_STAGE(bufoff, gbase, voff) do { _Pragma("unroll") for (int _i = 0; _i < 2; ++_i) \
        __builtin_amdgcn_global_load_lds((const unsigned*)((const char*)(gbase) + (voff)[_i]), (PG8_LAS unsigned*)(lds + (bufoff) + ldsw + _i * 8192), 16, 0, 0); } while (0)
#define PG8_LDA(dst, b, h) do { if constexpr (F8) { _Pragma("unroll") for (int m = 0; m < 4; ++m) dst##8[m] = cat8(*(const PG8_LAS bf16x8*)(lds + PG8_SA(b, h) + aoff + m * 2048), *(const PG8_LAS bf16x8*)(lds + PG8_SA(b, h) + aoff + m * 2048 + 1024)); } \
        else { _Pragma("unroll") for (int m = 0; m < 4; ++m) _Pragma("unroll") for (int k = 0; k < 2; ++k) dst[m][k] = *(const PG8_LAS bf16x8*)(lds + PG8_SA(b, h) + aoff + m * 2048 + k * 1024); } } while (0)
#define PG8_LDB(dst, b, h) do { if constexpr (F8) { _Pragma("unroll") for (int n = 0; n < 2; ++n) dst##8[n] = cat8(*(const PG8_LAS bf16x8*)(lds + PG8_SB(b, h) + boff + n * 2048), *(const PG8_LAS bf16x8*)(lds + PG8_SB(b, h) + boff + n * 2048 + 1024)); } \
        else { _Pragma("unroll") for (int n = 0; n < 2; ++n) _Pragma("unroll") for (int k = 0; k < 2; ++k) dst[n][k] = *(const PG8_LAS bf16x8*)(lds + PG8_SB(b, h) + boff + n * 2048 + k * 1024); } } while (0)
#define PG8_MMA(ai, bj, At, Bt) do { __builtin_amdgcn_s_setprio(1); if constexpr (F8) { _Pragma("unroll") for (int m = 0; m < 4; ++m) _Pragma("unroll") for (int n = 0; n < 2; ++n) \
        asm volatile("s_nop 1\n\tv_mfma_f32_16x16x128_f8f6f4 %0, %1, %2, %0" : "+v"(acc[ai][bj][m][n]) : "v"(Bt##8[n]), "v"(At##8[m])); }     \
        else { _Pragma("unroll") for (int m = 0; m < 4; ++m) _Pragma("unroll") for (int n = 0; n < 2; ++n) _Pragma("unroll") for (int k = 0; k < 2; ++k) \
        acc[ai][bj][m][n] = __builtin_amdgcn_mfma_f32_16x16x32_bf16(Bt[n][k], At[m][k], acc[ai][bj][m][n], 0, 0, 0); } __builtin_amdgcn_s_setprio(0); } while (0)
#define PG8_WAIT_V(n) asm volatile("s_waitcnt vmcnt(" #n ")" ::: "memory")
#define PG8_WAIT_L(n) asm volatile("s_waitcnt lgkmcnt(" #n ")" ::: "memory")
#define PG8_BAR __builtin_amdgcn_s_barrier()
#define PG8_SCHED __builtin_amdgcn_sched_barrier(0)
    Unit cur, nxt, prv; int ui = 0; bool have_prv = false;
    if (!S.next(0, cur)) return;
    f32x4 acc[2][2][4][2];
#pragma unroll
    for (int a = 0; a < 2; ++a)
#pragma unroll
        for (int b = 0; b < 2; ++b)
#pragma unroll
            for (int m = 0; m < 4; ++m)
#pragma unroll
                for (int n = 0; n < 2; ++n) acc[a][b][m][n] = (f32x4){0.f, 0.f, 0.f, 0.f};
    bf16x8 At[4][2], B0[2][2], B1[2][2]; v8i32 At8[4], B08[2], B18[2];
    const char* cA = (const char*)g.A + (GATHER ? (size_t)0 : (size_t)cur.pm * tstep); const char* cB = (const char*)g.Bt + (size_t)cur.pn * tstep;
    S.a_ready(cur);
    if constexpr (GATHER) { PG8_FETCH_IDS(cur); asm volatile("s_waitcnt vmcnt(0)" ::: "memory"); PG8_READ_IDS(cv); }
    if constexpr (SP2) {
        PG8_STAGE(PG8_SB(0, 0), cB, voffB); PG8_STAGE(PG8_SB(0, 1), cB + hstep, voffB); PG8_STAGE_A(PG8_SA(0, 0), cA, 0, false); PG8_STAGE_A(PG8_SA(0, 1), cA, 1, false);
        if (wr == 1) PG8_BAR;
        PG8_WAIT_V(2); PG8_BAR;
        PG8_STAGE(PG8_SB(1, 0), cB + kstep, voffB); PG8_STAGE_A(PG8_SA(1, 0), cA + kstep, 0, false); PG8_STAGE(PG8_SB(1, 1), cB + hstep + kstep, voffB);
        PG8_WAIT_V(6); PG8_BAR;
    } else {
        PG8_STAGE(PG8_SB(0, 0), cB, voffB); PG8_STAGE(PG8_SA(0, 0), cA, voffA); PG8_STAGE(PG8_SB(0, 1), cB + hstep, voffB); PG8_STAGE(PG8_SA(0, 1), cA + hstep, voffA);
        if (wr == 1) PG8_BAR;
        PG8_WAIT_V(4); PG8_BAR;
        PG8_STAGE(PG8_SB(1, 0), cB + kstep, voffB); PG8_STAGE(PG8_SA(1, 0), cA + kstep, voffA); PG8_STAGE(PG8_SB(1, 1), cB + hstep + kstep, voffB);
        PG8_WAIT_V(6); PG8_BAR;
    }
    for (;;) {
        const bool has_next = S.next(ui + 1, nxt);
        const char* nA = (has_next && !GATHER) ? (const char*)g.A + (size_t)nxt.pm * tstep : cA; const char* nB = has_next ? (const char*)g.Bt + (size_t)nxt.pn * tstep : cB;
        if constexpr (GATHER) { if (has_next) PG8_FETCH_IDS(nxt); }
        for (int t = 0; t < nt; t += 2) {
            const bool last = (t == nt - 2);
            if constexpr (GATHER) { if (last) { if (has_next) { PG8_READ_IDS(nv); } else { _Pragma("unroll") for (int h_ = 0; h_ < 2; ++h_) { nv[h_][0] = cv[h_][0]; nv[h_][1] = cv[h_][1]; } } } }
            const char* a1 = cA + (size_t)(t + 1) * kstep;
            const char* a2 = last ? nA : cA + (size_t)(t + 2) * kstep; const char* b2 = last ? nB : cB + (size_t)(t + 2) * kstep;
            const char* a3 = a2 + kstep; const char* b3 = b2 + kstep;
            if (last && has_next) S.a_ready(nxt);
            if constexpr (SP2) {
            PG8_LDB(B0, 0, 0); PG8_LDB(B1, 0, 1); PG8_SCHED; PG8_LDA(At, 0, 0); PG8_STAGE_A(PG8_SA(1, 1), a1, 1, false);
            PG8_WAIT_V(8); PG8_WAIT_L(0); PG8_BAR; PG8_MMA(0, 0, At, B0); PG8_MMA(0, 1, At, B1); PG8_BAR; PG8_SCHED;
            PG8_LDA(At, 0, 1); PG8_STAGE(PG8_SB(0, 0), b2, voffB); PG8_STAGE(PG8_SB(0, 1), b2 + hstep, voffB); PG8_STAGE_A(PG8_SA(0, 0), a2, 0, last);
            PG8_WAIT_V(8); PG8_WAIT_L(0); PG8_BAR; PG8_MMA(1, 0, At, B0); PG8_MMA(1, 1, At, B1); PG8_BAR; PG8_SCHED;
            PG8_LDB(B0, 1, 0); PG8_LDB(B1, 1, 1); PG8_SCHED; PG8_LDA(At, 1, 0); PG8_STAGE_A(PG8_SA(0, 1), a2, 1, last);
            PG8_WAIT_V(8); PG8_WAIT_L(0); PG8_BAR; PG8_MMA(0, 0, At, B0); PG8_MMA(0, 1, At, B1); PG8_BAR; PG8_SCHED;
            PG8_LDA(At, 1, 1); PG8_STAGE(PG8_SB(1, 0), b3, voffB); PG8_STAGE(PG8_SB(1, 1), b3 + hstep, voffB); PG8_STAGE_A(PG8_SA(1, 0), a3, 0, last);
            PG8_WAIT_V(8); PG8_WAIT_L(0); PG8_BAR; PG8_MMA(1, 0, At, B0); PG8_MMA(1, 1, At, B1); PG8_BAR; PG8_SCHED;
            } else {
            PG8_LDB(B0, 0, 0); PG8_SCHED; PG8_LDA(At, 0, 0); PG8_STAGE(PG8_SA(1, 1), a1 + hstep, voffA);
            PG8_WAIT_L(8); PG8_BAR; PG8_WAIT_L(0); PG8_MMA(0, 0, At, B0); PG8_BAR; PG8_SCHED;
            PG8_LDB(B1, 0, 1); PG8_STAGE(PG8_SB(0, 0), b2, voffB);
            PG8_BAR; PG8_WAIT_L(0); PG8_MMA(0, 1, At, B1); PG8_BAR;
            PG8_LDA(At, 0, 1); PG8_STAGE(PG8_SA(0, 0), a2, voffA);
            PG8_BAR; PG8_WAIT_L(0); PG8_MMA(1, 0, At, B0); PG8_BAR; PG8_SCHED;
            PG8_STAGE(PG8_SB(0, 1), b2 + hstep, voffB);
            PG8_WAIT_V(6); PG8_BAR; PG8_MMA(1, 1, At, B1); PG8_BAR;
            PG8_LDB(B0, 1, 0); PG8_SCHED; PG8_LDA(At, 1, 0); PG8_STAGE(PG8_SA(0, 1), a2 + hstep, voffA);
            PG8_WAIT_L(8); PG8_BAR; PG8_WAIT_L(0); PG8_MMA(0, 0, At, B0); PG8_BAR; PG8_SCHED;
            PG8_LDB(B1, 1, 1); PG8_STAGE(PG8_SB(1, 0), b3, voffB);
            PG8_BAR; PG8_WAIT_L(0); PG8_MMA(0, 1, At, B1); PG8_BAR;
            PG8_LDA(At, 1, 1); PG8_STAGE(PG8_SA(1, 0), a3, voffA);
            PG8_BAR; PG8_WAIT_L(0); PG8_MMA(1, 0, At, B0); PG8_BAR; PG8_SCHED;
            PG8_STAGE(PG8_SB(1, 1), b3 + hstep, voffB);
            PG8_WAIT_V(6); PG8_BAR; PG8_MMA(1, 1, At, B1); PG8_BAR;
            }
        }
        if constexpr (ALIGN_EPI) { if (wr == 0) PG8_BAR; }
        if constexpr (F8) { asm volatile("s_nop 15\n\ts_nop 15" ::: "memory"); }
        if constexpr (!Epi::AFTER_DRAIN) { if (have_prv) S.done(prv); E(acc, cur, wr, wc, fr, fq); prv = cur; have_prv = true; }
        if (!has_next) break;
#pragma unroll
        for (int a = 0; a < 2; ++a)
#pragma unroll
            for (int b = 0; b < 2; ++b)
#pragma unroll
                for (int m = 0; m < 4; ++m)
#pragma unroll
                    for (int n = 0; n < 2; ++n) acc[a][b][m][n] = (f32x4){0.f, 0.f, 0.f, 0.f};
        cur = nxt; cA = nA; cB = nB; ++ui;
        if constexpr (GATHER) { _Pragma("unroll") for (int h_ = 0; h_ < 2; ++h_) { cv[h_][0] = nv[h_][0]; cv[h_][1] = nv[h_][1]; } }
        if constexpr (ALIGN_EPI) { if (wr == 1) PG8_BAR; }
    }
    PG8_WAIT_V(0);
    if constexpr (!ALIGN_EPI) { if (wr == 0) PG8_BAR; }
    PG8_BAR;
    if constexpr (!Epi::AFTER_DRAIN) { if (have_prv) S.done(prv); }
    if constexpr (Epi::AFTER_DRAIN) { E.fused(acc, cur, wr, wc, fr, fq, lds, wid, lane); S.done(cur); }
#undef PG8_SA
#undef PG8_FETCH_IDS
#undef PG8_READ_IDS
#undef PG8_STAGE_A
#undef PG8_SB
#undef PG8_STAGE
#undef PG8_LDA
#undef PG8_LDB
#undef PG8_MMA
#undef PG8_WAIT_V
#undef PG8_WAIT_L
#undef PG8_BAR
#undef PG8_SCHED
}
}
#ifndef PG8_SP2
#define PG8_SP2 true
#endif
#ifndef PG8_ALIGN
#define PG8_ALIGN true
#endif
namespace attn_body {
using bf16=__hip_bfloat16;
using bf16x8=__attribute__((ext_vector_type(8)))short;
using s16x4=__attribute__((ext_vector_type(4)))short;
using f32x16=__attribute__((ext_vector_type(16)))float;
using u32x4=__attribute__((ext_vector_type(4)))unsigned;
constexpr int D=64,DM=2304;
constexpr int NW=8,QBLK=32,QB=QBLK*NW,KVBLK=64,NKEYS=8448,NT=NKEYS/KVBLK;
static_assert(NT%2==0&&NT>=6,"the 2-step loop needs an even tile count");
constexpr int ATTN_PITCH=DM, ATTN_UNIT_ROWS=QB;
__device__ __forceinline__ int crow(int r,int hi){return (r&3)+8*(r>>2)+4*hi;}
#define SBAR() __builtin_amdgcn_sched_barrier(0)
__device__ __forceinline__ void cmask(f32x16&p0,f32x16&p1,int jb,int qrel,int hi){
  const float NEG=-INFINITY; int kb=64*jb+4*hi;
  #pragma unroll
  for(int r=0;r<16;++r){int kv=kb+(r&3)+8*(r>>2); if(kv>qrel)p0[r]=NEG; if(kv+32>qrel)p1[r]=NEG;}
}

constexpr int NSLOT=3, SLOTB=8192;
constexpr int LDS_K=0, LDS_V=NSLOT*SLOTB, LDS_WS=2*NSLOT*SLOTB, LDS_OST=LDS_WS+NW*64*4, LDS_BYTES=LDS_OST+NW*4096;
constexpr float C2=0.125f*1.4426950408889634f;
__device__ __forceinline__ void glds16(const void*gsrc,unsigned lds_dst){unsigned keep;
  asm volatile("s_mov_b32 %0, m0\n\ts_mov_b32 m0, %2\n\ts_nop 0\n\tglobal_load_lds_dwordx4 %1, off\n\ts_mov_b32 m0, %0":"=&s"(keep):"v"(gsrc),"s"(lds_dst):"memory");}
__device__ __forceinline__ float max3f(float a,float b,float c){float r;asm("v_max3_f32 %0, %1, %2, %3":"=v"(r):"v"(a),"v"(b),"v"(c));return r;}
__device__ __forceinline__ float max2f(float a,float b){float r;asm("v_max_f32_e32 %0, %1, %2":"=v"(r):"v"(a),"v"(b));return r;}
__device__ __forceinline__ float fadd_s(float a,float b){float r;asm("v_add_f32_e32 %0, %1, %2":"=v"(r):"v"(a),"v"(b));return r;}
__device__ __forceinline__ float fsub_s(float a,float b){float r;asm("v_sub_f32_e32 %0, %1, %2":"=v"(r):"v"(a),"v"(b));return r;}
typedef float f32x2_t __attribute__((ext_vector_type(2))); typedef __bf16 bf16x2_t __attribute__((ext_vector_type(2)));
__device__ __forceinline__ unsigned cvtpk_s(float lo,float hi){f32x2_t v={lo,hi};bf16x2_t b=__builtin_convertvector(v,bf16x2_t);return __builtin_bit_cast(unsigned,b);}
#define WAIT_BAR(N) asm volatile("s_waitcnt vmcnt(" #N ") lgkmcnt(0)\n\ts_barrier":::"memory")

__device__ __forceinline__ void qkt(f32x16&p0,f32x16&p1,const char*Kslot,const bf16x8*qr,const f32x16&negm,int r32,int hi){
  const char*kb=Kslot+hi*1024+r32*16;
  #pragma unroll
  for(int d0=0;d0<4;++d0){
    const bf16x8 b0=*reinterpret_cast<const bf16x8*>(kb+d0*2048);
    const bf16x8 b1=*reinterpret_cast<const bf16x8*>(kb+d0*2048+512);
    if(d0==0){p0=__builtin_amdgcn_mfma_f32_32x32x16_bf16(b0,qr[0],negm,0,0,0);p1=__builtin_amdgcn_mfma_f32_32x32x16_bf16(b1,qr[0],negm,0,0,0);}
    else{p0=__builtin_amdgcn_mfma_f32_32x32x16_bf16(b0,qr[d0],p0,0,0,0);p1=__builtin_amdgcn_mfma_f32_32x32x16_bf16(b1,qr[d0],p1,0,0,0);}}
}
typedef __attribute__((address_space(3))) const char* lds_cptr;
typedef short v4i16_t __attribute__((ext_vector_type(4)));
__device__ __forceinline__ void kload8(bf16x8*kf,lds_cptr kp){
  kf[0]=*(const __attribute__((address_space(3))) bf16x8*)(kp);      kf[1]=*(const __attribute__((address_space(3))) bf16x8*)(kp+512);
  kf[2]=*(const __attribute__((address_space(3))) bf16x8*)(kp+2048); kf[3]=*(const __attribute__((address_space(3))) bf16x8*)(kp+2560);
  kf[4]=*(const __attribute__((address_space(3))) bf16x8*)(kp+4096); kf[5]=*(const __attribute__((address_space(3))) bf16x8*)(kp+4608);
  kf[6]=*(const __attribute__((address_space(3))) bf16x8*)(kp+6144); kf[7]=*(const __attribute__((address_space(3))) bf16x8*)(kp+6656);
}
__device__ __forceinline__ void kload2(bf16x8*kf,lds_cptr kp,int j){ kf[2*j]=*(const __attribute__((address_space(3))) bf16x8*)(kp+j*2048); kf[2*j+1]=*(const __attribute__((address_space(3))) bf16x8*)(kp+j*2048+512); }
__device__ __forceinline__ s16x4 vtr(lds_cptr p){ return __builtin_bit_cast(s16x4,__builtin_amdgcn_ds_read_tr16_b64_v4i16((__attribute__((address_space(3))) v4i16_t*)p)); }
__device__ __forceinline__ float rowmax(const f32x16&p0,const f32x16&p1){
  float a=max3f(p0[0],p0[1],p1[0]),b=max3f(p0[2],p0[3],p1[1]);a=max3f(a,p1[2],p1[3]);
  #pragma unroll
  for(int r=4;r<16;r+=4){a=max3f(a,p0[r],p0[r+1]);b=max3f(b,p0[r+2],p0[r+3]);a=max3f(a,p1[r],p1[r+1]);b=max3f(b,p1[r+2],p1[r+3]);}
  const float m=max2f(a,b);
  auto rr=__builtin_amdgcn_permlane32_swap(__float_as_uint(m),__float_as_uint(m),false,false);
  return max2f(__uint_as_float(rr[0]),__uint_as_float(rr[1]));
}
__device__ __forceinline__ void pv(f32x16*o,int vb,bf16x8 pa0,bf16x8 pa1,bf16x8 pa2,bf16x8 pa3){
  #pragma unroll
  for(int d0=0;d0<2;++d0){s16x4 lo[4],hi[4];
    #pragma unroll
    for(int ks=0;ks<4;++ks){
      asm volatile("ds_read_b64_tr_b16 %0,%1 offset:%c2":"=&v"(lo[ks]):"v"(vb),"i"(d0*4096+ks*1024):"memory");
      asm volatile("ds_read_b64_tr_b16 %0,%1 offset:%c2":"=&v"(hi[ks]):"v"(vb),"i"(d0*4096+ks*1024+512):"memory");}
    asm volatile("s_waitcnt lgkmcnt(0)":::"memory");SBAR();
    #define PK(k) (bf16x8){lo[k][0],lo[k][1],lo[k][2],lo[k][3],hi[k][0],hi[k][1],hi[k][2],hi[k][3]}
    o[d0]=__builtin_amdgcn_mfma_f32_32x32x16_bf16(pa0,PK(0),o[d0],0,0,0);
    o[d0]=__builtin_amdgcn_mfma_f32_32x32x16_bf16(pa1,PK(1),o[d0],0,0,0);
    o[d0]=__builtin_amdgcn_mfma_f32_32x32x16_bf16(pa2,PK(2),o[d0],0,0,0);
    o[d0]=__builtin_amdgcn_mfma_f32_32x32x16_bf16(pa3,PK(3),o[d0],0,0,0);
    #undef PK
  }
}

#ifndef ATTN_STORE16
#define ATTN_STORE16(p,v) (*(u32x4*)(p)=(v))
#endif
template<int THRL,bool FIXREF=false> __device__ __forceinline__ void attn_unit(const bf16*Qu,const bf16*__restrict__ Kb,const bf16*__restrict__ Vb,bf16*Ou,int opitch,char*shm,int wid){
  const int lane=lane_id_asm(),r32=lane&31,hi=lane>>5;
  const bf16*Qw=Qu+(long)(wid*QBLK)*DM;
  const bf16*Kh=Kb,*Vh=Vb;
  const unsigned lds0=(unsigned)(uintptr_t)shm;
  float*wsf=(float*)(shm+LDS_WS)+wid*64;
  const bf16*ksrc=Kh+(long)lane*DM+wid*8;
  const bf16*vsrc=Vh+(long)(16*(wid&3)+(lane>>2))*DM+(wid>>2)*32+(lane&3)*8;
  const unsigned kdst=lds0+LDS_K+wid*1024, vdst=lds0+LDS_V+wid*1024;
  #define DMA_K(t,slot) glds16(ksrc+(long)(t)*KVBLK*DM,(unsigned)__builtin_amdgcn_readfirstlane(kdst+(slot)))
  #define DMA_V(t,slot) glds16(vsrc+(long)(t)*KVBLK*DM,(unsigned)__builtin_amdgcn_readfirstlane(vdst+(slot)))
  const int vb0=(int)(lds0+LDS_V)+((lane>>4)&1)*32+(lane&3)*8+(4*hi+((lane&15)>>2))*64;
  const char*Kbase=shm+LDS_K; bf16x8 kf[8];
  const lds_cptr shm3=(lds_cptr)shm; const lds_cptr kp0=shm3+LDS_K+hi*1024+r32*16; const lds_cptr vp0=shm3+LDS_V+((lane>>4)&1)*32+(lane&3)*8+(4*hi+((lane&15)>>2))*64;
  DMA_K(0,0);DMA_V(0,0);DMA_K(1,SLOTB);
  bf16x8 qr[4];
  #pragma unroll
  for(int d0=0;d0<4;++d0)qr[d0]=*reinterpret_cast<const bf16x8*>(&Qw[(long)r32*DM+d0*16+hi*8]);
  float mhat=0.f,l_reg=0.f;f32x16 o[2];o[0]=f32x16{};o[1]=f32x16{};f32x16 negm=f32x16{};asm volatile("":"+v"(negm));
  #define CMASK(P0,P1,t) do{}while(0)
  bool resc=false;
  #define START(P0,P1) do{ resc=false; if constexpr(!FIXREF){ const float rm=rowmax(P0,P1); \
    { const float dl=rm; mhat=fadd_s(mhat,dl); \
      _Pragma("unroll") for(int r=0;r<16;++r){P0[r]=fsub_s(P0[r],dl);P1[r]=fsub_s(P1[r],dl);} \
      _Pragma("unroll") for(int r=0;r<16;++r)negm[r]=-mhat; asm volatile("":"+v"(negm)); } } \
    _Pragma("unroll") for(int r=0;r<16;++r)P0[r]=__builtin_amdgcn_exp2f(P0[r]); }while(0)
  #define RESC() do{ if(resc){ asm volatile("s_waitcnt lgkmcnt(0)":::"memory"); \
      _Pragma("unroll") for(int d_=0;d_<2;++d_) _Pragma("unroll") for(int r=0;r<16;++r)o[d_][r]*=wsf[crow(r,hi)]; } }while(0)
  f32x16 pA0,pA1,pB0,pB1;
  int sl_prev=0,sl_cur=0,sl_next=SLOTB;
  #define ROT() do{sl_prev=sl_cur;sl_cur=sl_next;sl_next=(sl_next==(NSLOT-1)*SLOTB)?0:sl_next+SLOTB;}while(0)
  DMA_K(2,2*SLOTB);
  WAIT_BAR(3);
  qkt(pA0,pA1,Kbase,qr,negm,r32,hi);asm volatile("s_nop 15\n\ts_nop 7":"+v"(pA0),"+v"(pA1));CMASK(pA0,pA1,0);
  START(pA0,pA1);
  _Pragma("unroll") for(int r=0;r<16;++r)pA1[r]=__builtin_amdgcn_exp2f(pA1[r]);
  WAIT_BAR(0);
  DMA_K(3,0);DMA_V(1,SLOTB);
  ROT();
  kload8(kf,kp0+sl_cur);
  WAIT_BAR(2);
  s16x4 vlo[8],vhi[8]; u32x4 pw0,pw1,pw2,pw3;
  #define PKW(P,B) cvtpk_s(P[B],P[B+1])
  #define PAF(k) __builtin_bit_cast(bf16x8,pw##k)
  #define VFR(i) (bf16x8){vlo[i][0],vlo[i][1],vlo[i][2],vlo[i][3],vhi[i][0],vhi[i][1],vhi[i][2],vhi[i][3]}
  #define PIN(x) asm volatile("":"+v"(x))
  #define MX3(a,b,c) __builtin_fmaxf(__builtin_fmaxf((a),(b)),(c))
  #define GAPA(MF,A0,A1,A2,A3,W0,W1,PW) do{ MF; sacc+=A0; sacc+=A1; sacc+=A2; sacc+=A3; PIN(sacc); W0; W1; PIN(PW); SBAR(); }while(0)
  #define EX(v) __builtin_amdgcn_exp2f(v)
  #define GAPB(MF,X,B) do{ MF; X[B]=EX(X[B]); X[B+1]=EX(X[B+1]); X[B+2]=EX(X[B+2]); X[B+3]=EX(X[B+3]); PIN(X); SBAR(); }while(0)
  #define VRD(i) do{ vlo[i]=vtr(vp_+(((i)>>2)*4096+((i)&3)*1024)); vhi[i]=vtr(vp_+(((i)>>2)*4096+((i)&3)*1024+512)); }while(0)
  #define KRD(G,j) do{ if(G){ kload2(kf,kp0+sl_next,j); SBAR(); } }while(0)
  #define STEP(C0,C1,P0,P1,t,GK,GV,GL) do{ SBAR(); \
    const lds_cptr vp_=vp0+sl_prev; \
    VRD(0); SBAR(); float sacc=(P0[0]+P0[1]); \
    GAPA(C0=__builtin_amdgcn_mfma_f32_32x32x16_bf16(kf[0],qr[0],negm,0,0,0), P0[2],P0[3],P0[4],P0[5],     pw0[0]=PKW(P0,0), pw0[1]=PKW(P0,2), pw0); \
    VRD(4); SBAR(); GAPA(C1=__builtin_amdgcn_mfma_f32_32x32x16_bf16(kf[1],qr[0],negm,0,0,0), P0[6],P0[7],P0[8],P0[9],     pw0[2]=PKW(P0,4), pw0[3]=PKW(P0,6), pw0); \
    VRD(1); SBAR(); GAPA(C0=__builtin_amdgcn_mfma_f32_32x32x16_bf16(kf[2],qr[1],C0,0,0,0),   P0[10],P0[11],P0[12],P0[13], pw1[0]=PKW(P0,8), pw1[1]=PKW(P0,10), pw1); \
    VRD(5); SBAR(); GAPA(C1=__builtin_amdgcn_mfma_f32_32x32x16_bf16(kf[3],qr[1],C1,0,0,0),   P0[14],P0[15],P1[0],P1[1],   pw1[2]=PKW(P0,12),pw1[3]=PKW(P0,14), pw1); \
    VRD(2); SBAR(); GAPA(C0=__builtin_amdgcn_mfma_f32_32x32x16_bf16(kf[4],qr[2],C0,0,0,0),   P1[2],P1[3],P1[4],P1[5],     pw2[0]=PKW(P1,0), pw2[1]=PKW(P1,2), pw2); \
    VRD(6); SBAR(); GAPA(C1=__builtin_amdgcn_mfma_f32_32x32x16_bf16(kf[5],qr[2],C1,0,0,0),   P1[6],P1[7],P1[8],P1[9],     pw2[2]=PKW(P1,4), pw2[3]=PKW(P1,6), pw2); \
    VRD(3); SBAR(); GAPA(C0=__builtin_amdgcn_mfma_f32_32x32x16_bf16(kf[6],qr[3],C0,0,0,0),   P1[10],P1[11],P1[12],P1[13], pw3[0]=PKW(P1,8), pw3[1]=PKW(P1,10), pw3); \
    VRD(7); SBAR(); GAPA(C1=__builtin_amdgcn_mfma_f32_32x32x16_bf16(kf[7],qr[3],C1,0,0,0),   P1[14],P1[15],0.f,0.f,       pw3[2]=PKW(P1,12),pw3[3]=PKW(P1,14), pw3); \
    l_reg+=sacc; \
    if(GK){DMA_K((t)+3,sl_cur);} if(GV){DMA_V((t)+1,sl_next);} \
    CMASK(C0,C1,t); \
    if constexpr(!FIXREF){ float a=MX3(C0[0],C0[1],C1[0]),b=MX3(C0[2],C0[3],C1[1]); a=MX3(a,C1[2],C1[3]); \
      _Pragma("unroll") for(int r=4;r<16;r+=4){a=MX3(a,C0[r],C0[r+1]);b=MX3(b,C0[r+2],C0[r+3]);a=MX3(a,C1[r],C1[r+1]);b=MX3(b,C1[r+2],C1[r+3]);} \
      float rm=__builtin_fmaxf(a,b); { auto rr=__builtin_amdgcn_permlane32_swap(__float_as_uint(rm),__float_as_uint(rm),false,false); rm=__builtin_fmaxf(__uint_as_float(rr[0]),__uint_as_float(rr[1])); } \
      resc=false; \
      if(__builtin_expect(__any(rm>(float)THRL),0)){ const float dl=__builtin_fmaxf(rm,0.f); mhat+=dl; \
        _Pragma("unroll") for(int r=0;r<16;++r){C0[r]-=dl;C1[r]-=dl;} \
        _Pragma("unroll") for(int r=0;r<16;++r)negm[r]=-mhat; asm volatile("":"+v"(negm)); \
        const float f=__builtin_amdgcn_exp2f(-dl); l_reg*=f; if(hi==0)wsf[r32]=f; resc=true; } } \
    SBAR(); \
    GAPB(o[0]=__builtin_amdgcn_mfma_f32_32x32x16_bf16(PAF(0),VFR(0),o[0],0,0,0), C0,0); \
    GAPB(o[1]=__builtin_amdgcn_mfma_f32_32x32x16_bf16(PAF(0),VFR(4),o[1],0,0,0), C0,4); \
    KRD(GL,0); GAPB(o[0]=__builtin_amdgcn_mfma_f32_32x32x16_bf16(PAF(1),VFR(1),o[0],0,0,0), C0,8); \
    KRD(GL,1); GAPB(o[1]=__builtin_amdgcn_mfma_f32_32x32x16_bf16(PAF(1),VFR(5),o[1],0,0,0), C0,12); \
    KRD(GL,2); GAPB(o[0]=__builtin_amdgcn_mfma_f32_32x32x16_bf16(PAF(2),VFR(2),o[0],0,0,0), C1,0); \
    KRD(GL,3); GAPB(o[1]=__builtin_amdgcn_mfma_f32_32x32x16_bf16(PAF(2),VFR(6),o[1],0,0,0), C1,4); \
    GAPB(o[0]=__builtin_amdgcn_mfma_f32_32x32x16_bf16(PAF(3),VFR(3),o[0],0,0,0), C1,8); \
    GAPB(o[1]=__builtin_amdgcn_mfma_f32_32x32x16_bf16(PAF(3),VFR(7),o[1],0,0,0), C1,12); \
    }while(0)
  int t=1;
  for(;t+5<NT;t+=2){
    STEP(pB0,pB1,pA0,pA1,t,true,true,true);     WAIT_BAR(2); RESC(); ROT();
    STEP(pA0,pA1,pB0,pB1,t+1,true,true,true);   WAIT_BAR(2); RESC(); ROT();
  }
  #define ENDW(tt) do{ if((tt)+3<NT){WAIT_BAR(2);} else if((tt)+2<NT){WAIT_BAR(1);} else {WAIT_BAR(0);} }while(0)
  for(;t+1<NT;t+=2){
    STEP(pB0,pB1,pA0,pA1,t,(t+3<NT),(t+1<NT),(t+1<NT));       ENDW(t);   RESC(); ROT();
    STEP(pA0,pA1,pB0,pB1,t+1,(t+4<NT),(t+2<NT),(t+2<NT));     ENDW(t+1); RESC(); ROT();
  }
  STEP(pB0,pB1,pA0,pA1,NT-1,false,false,false); RESC();
  { float sacc=pB0[0]+pB0[1]; _Pragma("unroll") for(int r=2;r<16;++r)sacc+=pB0[r]; _Pragma("unroll") for(int r=0;r<16;++r)sacc+=pB1[r]; l_reg+=sacc;
    pw0=(u32x4){PKW(pB0,0),PKW(pB0,2),PKW(pB0,4),PKW(pB0,6)};pw1=(u32x4){PKW(pB0,8),PKW(pB0,10),PKW(pB0,12),PKW(pB0,14)};pw2=(u32x4){PKW(pB1,0),PKW(pB1,2),PKW(pB1,4),PKW(pB1,6)};pw3=(u32x4){PKW(pB1,8),PKW(pB1,10),PKW(pB1,12),PKW(pB1,14)};
    SBAR(); pv(o,vb0+sl_cur,PAF(0),PAF(1),PAF(2),PAF(3)); }
  #undef PKW
  #undef PAF
  #undef VFR
  #undef PIN
  #undef MX3
  #undef GAPA
  #undef GAPB
  #undef EX
  #undef VRD
  #undef KRD
  #undef STEP
  #undef ENDW
  {auto rr=__builtin_amdgcn_permlane32_swap(__float_as_uint(l_reg),__float_as_uint(l_reg),false,false);l_reg=__uint_as_float(rr[0])+__uint_as_float(rr[1]);}
  if(hi==0)wsf[32+r32]=l_reg;asm volatile("s_waitcnt lgkmcnt(0)":::"memory");
  float rli[16];
  #pragma unroll
  for(int r=0;r<16;++r)rli[r]=__builtin_amdgcn_rcpf(wsf[32+crow(r,hi)]);
  bf16*Ow=Ou+(long)(wid*QBLK)*opitch;
  { bf16*stg=(bf16*)(shm+LDS_OST)+wid*2048;
    #pragma unroll
    for(int r=0;r<16;++r){const int orow=crow(r,hi);
      #pragma unroll
      for(int d0=0;d0<2;++d0)stg[orow*64+d0*32+r32]=__float2bfloat16(o[d0][r]*rli[r]);}
    asm volatile("s_waitcnt lgkmcnt(0)":::"memory");
    #pragma unroll
    for(int i=0;i<4;++i){const int row=i*8+(lane>>3),ch=lane&7; const u32x4 v=*(const u32x4*)(stg+row*64+ch*8); ATTN_STORE16(Ow+(long)row*opitch+ch*8,v);} }
  asm volatile("s_waitcnt lgkmcnt(0)\n\ts_barrier":::"memory");
  #undef DMA_K
  #undef DMA_V
  #undef CMASK
  #undef START
  #undef RESC
  #undef ROT
}
constexpr int SLOTV2=16384, LDS2_K=0, LDS2_V=NSLOT*SLOTB, LDS2_WS=LDS2_V+NSLOT*SLOTV2, LDS2_BYTES=LDS2_WS+NW*64*4;
__device__ __forceinline__ void pv128(f32x16*o,int vb,bf16x8 pa0,bf16x8 pa1,bf16x8 pa2,bf16x8 pa3){
  #pragma unroll
  for(int d0=0;d0<4;++d0){s16x4 lo[4],hi[4];
    #pragma unroll
    for(int ks=0;ks<4;++ks){
      asm volatile("ds_read_b64_tr_b16 %0,%1 offset:%c2":"=&v"(lo[ks]):"v"(vb),"i"(d0*4096+ks*1024):"memory");
      asm volatile("ds_read_b64_tr_b16 %0,%1 offset:%c2":"=&v"(hi[ks]):"v"(vb),"i"(d0*4096+ks*1024+512):"memory");}
    asm volatile("s_waitcnt lgkmcnt(0)":::"memory");SBAR();
    #define PK(k) (bf16x8){lo[k][0],lo[k][1],lo[k][2],lo[k][3],hi[k][0],hi[k][1],hi[k][2],hi[k][3]}
    o[d0]=__builtin_amdgcn_mfma_f32_32x32x16_bf16(pa0,PK(0),o[d0],0,0,0);
    o[d0]=__builtin_amdgcn_mfma_f32_32x32x16_bf16(pa1,PK(1),o[d0],0,0,0);
    o[d0]=__builtin_amdgcn_mfma_f32_32x32x16_bf16(pa2,PK(2),o[d0],0,0,0);
    o[d0]=__builtin_amdgcn_mfma_f32_32x32x16_bf16(pa3,PK(3),o[d0],0,0,0);
    #undef PK
  }
}
template<int THRL,bool FIXREF=false> __device__ __forceinline__ void attn_unit128(const bf16*Qu,const bf16*__restrict__ Kb,const bf16*__restrict__ Vb,bf16*Ou,int opitch,char*shm,int wid,float*stash,float lam,const float*subg){
  const int lane=lane_id_asm(),r32=lane&31,hi=lane>>5;
  const bf16*Vh=Vb;
 for(int cpass=0;cpass<2;++cpass){
  const int lane_p=lane_id_asm(),r32p=lane_p&31,hip=lane_p>>5;
  const bf16*Qw=Qu+(long)(wid*QBLK)*DM+cpass*64;
  const bf16*Kh=Kb+cpass*64;
  const unsigned lds0=(unsigned)(uintptr_t)shm;
  float*wsf=(float*)(shm+LDS2_WS)+wid*64;
  const bf16*ksrc=Kh+(long)lane_p*DM+wid*8;
  const bf16*vsrc=Vh+(long)(16*(wid&3)+(lane_p>>2))*DM+(wid>>2)*32+(lane_p&3)*8;
  const unsigned kdst=lds0+LDS2_K+wid*1024, vdst=lds0+LDS2_V+wid*1024;
  #define DMA_K(t,slot) glds16(ksrc+(long)(t)*KVBLK*DM,(unsigned)__builtin_amdgcn_readfirstlane(kdst+(slot)))
  #define DMA_V(t,slot) do{ glds16(vsrc+(long)(t)*KVBLK*DM,(unsigned)__builtin_amdgcn_readfirstlane(vdst+2*(slot))); glds16(vsrc+(long)(t)*KVBLK*DM+64,(unsigned)__builtin_amdgcn_readfirstlane(vdst+2*(slot)+8192)); }while(0)
  const int vb0=(int)(lds0+LDS2_V)+((lane_p>>4)&1)*32+(lane_p&3)*8+(4*hip+((lane_p&15)>>2))*64;
  const char*Kbase=shm+LDS2_K; bf16x8 kf[8];
  const lds_cptr shm3=(lds_cptr)shm; const lds_cptr kp0=shm3+LDS2_K+hip*1024+r32p*16; const lds_cptr vp0=shm3+LDS2_V+((lane_p>>4)&1)*32+(lane_p&3)*8+(4*hip+((lane_p&15)>>2))*64;
  DMA_K(0,0);DMA_V(0,0);DMA_K(1,SLOTB);
  bf16x8 qr[4];
  #pragma unroll
  for(int d0=0;d0<4;++d0)qr[d0]=*reinterpret_cast<const bf16x8*>(&Qw[(long)r32p*DM+d0*16+hip*8]);
  float zf_; asm volatile("v_mov_b32 %0, 0":"=v"(zf_));
  float mhat=0.f,l_reg=0.f;f32x16 o[4];
  #pragma unroll
  for(int r=0;r<16;++r){o[0][r]=zf_;o[1][r]=zf_;o[2][r]=zf_;o[3][r]=zf_;}
  f32x16 negm;
  #pragma unroll
  for(int r=0;r<16;++r)negm[r]=zf_;
  asm volatile("":"+v"(negm));
  #define CMASK(P0,P1,t) do{}while(0)
  bool resc=false;
  #define START(P0,P1) do{ resc=false; if constexpr(!FIXREF){ const float rm=rowmax(P0,P1); \
    { const float dl=rm; mhat=fadd_s(mhat,dl); \
      _Pragma("unroll") for(int r=0;r<16;++r){P0[r]=fsub_s(P0[r],dl);P1[r]=fsub_s(P1[r],dl);} \
      _Pragma("unroll") for(int r=0;r<16;++r)negm[r]=-mhat; asm volatile("":"+v"(negm)); } } \
    _Pragma("unroll") for(int r=0;r<16;++r)P0[r]=__builtin_amdgcn_exp2f(P0[r]); }while(0)
  #define RESC() do{ if(resc){ asm volatile("s_waitcnt lgkmcnt(0)":::"memory"); \
      _Pragma("unroll") for(int d_=0;d_<4;++d_) _Pragma("unroll") for(int r=0;r<16;++r)o[d_][r]*=wsf[crow(r,hi)]; } }while(0)
  f32x16 pA0,pA1,pB0,pB1;
  int sl_prev=0,sl_cur=0,sl_next=SLOTB;
  #define ROT() do{sl_prev=sl_cur;sl_cur=sl_next;sl_next=(sl_next==(NSLOT-1)*SLOTB)?0:sl_next+SLOTB;}while(0)
  DMA_K(2,2*SLOTB);
  WAIT_BAR(4);
  qkt(pA0,pA1,Kbase,qr,negm,r32,hi);asm volatile("s_nop 15\n\ts_nop 7":"+v"(pA0),"+v"(pA1));CMASK(pA0,pA1,0);
  START(pA0,pA1);
  _Pragma("unroll") for(int r=0;r<16;++r)pA1[r]=__builtin_amdgcn_exp2f(pA1[r]);
  WAIT_BAR(0);
  DMA_K(3,0);DMA_V(1,SLOTB);
  ROT();
  kload8(kf,kp0+sl_cur);
  WAIT_BAR(3);
  s16x4 vlo[9],vhi[9]; u32x4 pw0,pw1,pw2,pw3;
  #define PKW(P,B) cvtpk_s(P[B],P[B+1])
  #define PAF(k) __builtin_bit_cast(bf16x8,pw##k)
  #define VFR(i) (bf16x8){vlo[i][0],vlo[i][1],vlo[i][2],vlo[i][3],vhi[i][0],vhi[i][1],vhi[i][2],vhi[i][3]}
  #define PIN(x) asm volatile("":"+v"(x))
  #define MX3(a,b,c) __builtin_fmaxf(__builtin_fmaxf((a),(b)),(c))
  #define GAPA(MF,A0,A1,A2,A3,W0,W1,PW) do{ MF; sacc+=A0; sacc+=A1; sacc+=A2; sacc+=A3; PIN(sacc); W0; W1; PIN(PW); SBAR(); }while(0)
  #define EX(v) __builtin_amdgcn_exp2f(v)
  #define GAPB(MF,X,B) do{ MF; X[B]=EX(X[B]); X[B+1]=EX(X[B+1]); PIN(X); SBAR(); }while(0)
  #define VRD2(i,s) do{ vlo[s]=vtr(vp_+(8192+((i)>>2)*4096+((i)&3)*1024)); vhi[s]=vtr(vp_+(8192+((i)>>2)*4096+((i)&3)*1024+512)); }while(0)
  #define VRD(i) do{ vlo[i]=vtr(vp_+(((i)>>2)*4096+((i)&3)*1024)); vhi[i]=vtr(vp_+(((i)>>2)*4096+((i)&3)*1024+512)); }while(0)
  #define KRD(G,j) do{ if(G){ kload2(kf,kp0+sl_next,j); SBAR(); } }while(0)
  #define STEP(C0,C1,P0,P1,t,GK,GV,GL) do{ SBAR(); \
    const lds_cptr vp_=vp0+2*sl_prev; \
    VRD(0); SBAR(); float sacc=(P0[0]+P0[1]); \
    GAPA(C0=__builtin_amdgcn_mfma_f32_32x32x16_bf16(kf[0],qr[0],negm,0,0,0), P0[2],P0[3],P0[4],P0[5],     pw0[0]=PKW(P0,0), pw0[1]=PKW(P0,2), pw0); \
    VRD(4); SBAR(); GAPA(C1=__builtin_amdgcn_mfma_f32_32x32x16_bf16(kf[1],qr[0],negm,0,0,0), P0[6],P0[7],P0[8],P0[9],     pw0[2]=PKW(P0,4), pw0[3]=PKW(P0,6), pw0); \
    VRD(1); SBAR(); GAPA(C0=__builtin_amdgcn_mfma_f32_32x32x16_bf16(kf[2],qr[1],C0,0,0,0),   P0[10],P0[11],P0[12],P0[13], pw1[0]=PKW(P0,8), pw1[1]=PKW(P0,10), pw1); \
    VRD(5); SBAR(); GAPA(C1=__builtin_amdgcn_mfma_f32_32x32x16_bf16(kf[3],qr[1],C1,0,0,0),   P0[14],P0[15],P1[0],P1[1],   pw1[2]=PKW(P0,12),pw1[3]=PKW(P0,14), pw1); \
    VRD(2); SBAR(); GAPA(C0=__builtin_amdgcn_mfma_f32_32x32x16_bf16(kf[4],qr[2],C0,0,0,0),   P1[2],P1[3],P1[4],P1[5],     pw2[0]=PKW(P1,0), pw2[1]=PKW(P1,2), pw2); \
    VRD(6); SBAR(); GAPA(C1=__builtin_amdgcn_mfma_f32_32x32x16_bf16(kf[5],qr[2],C1,0,0,0),   P1[6],P1[7],P1[8],P1[9],     pw2[2]=PKW(P1,4), pw2[3]=PKW(P1,6), pw2); \
    VRD(3); SBAR(); GAPA(C0=__builtin_amdgcn_mfma_f32_32x32x16_bf16(kf[6],qr[3],C0,0,0,0),   P1[10],P1[11],P1[12],P1[13], pw3[0]=PKW(P1,8), pw3[1]=PKW(P1,10), pw3); \
    VRD(7); SBAR(); GAPA(C1=__builtin_amdgcn_mfma_f32_32x32x16_bf16(kf[7],qr[3],C1,0,0,0),   P1[14],P1[15],0.f,0.f,       pw3[2]=PKW(P1,12),pw3[3]=PKW(P1,14), pw3); \
    l_reg+=sacc; \
    if(GK){DMA_K((t)+3,sl_cur);} if(GV){DMA_V((t)+1,sl_next);} \
    CMASK(C0,C1,t); \
    if constexpr(!FIXREF){ float a=MX3(C0[0],C0[1],C1[0]),b=MX3(C0[2],C0[3],C1[1]); a=MX3(a,C1[2],C1[3]); \
      _Pragma("unroll") for(int r=4;r<16;r+=4){a=MX3(a,C0[r],C0[r+1]);b=MX3(b,C0[r+2],C0[r+3]);a=MX3(a,C1[r],C1[r+1]);b=MX3(b,C1[r+2],C1[r+3]);} \
      float rm=__builtin_fmaxf(a,b); { auto rr=__builtin_amdgcn_permlane32_swap(__float_as_uint(rm),__float_as_uint(rm),false,false); rm=__builtin_fmaxf(__uint_as_float(rr[0]),__uint_as_float(rr[1])); } \
      resc=false; \
      if(__builtin_expect(__any(rm>(float)THRL),0)){ const float dl=__builtin_fmaxf(rm,0.f); mhat+=dl; \
        _Pragma("unroll") for(int r=0;r<16;++r){C0[r]-=dl;C1[r]-=dl;} \
        _Pragma("unroll") for(int r=0;r<16;++r)negm[r]=-mhat; asm volatile("":"+v"(negm)); \
        const float f=__builtin_amdgcn_exp2f(-dl); l_reg*=f; { const int l2_=lane_id_asm(); if((l2_>>5)==0)wsf[l2_&31]=f; } resc=true; } } \
    SBAR(); \
    VRD2(0,8); SBAR(); GAPB(o[0]=__builtin_amdgcn_mfma_f32_32x32x16_bf16(PAF(0),VFR(0),o[0],0,0,0), C0,0); \
    VRD2(4,0); SBAR(); GAPB(o[1]=__builtin_amdgcn_mfma_f32_32x32x16_bf16(PAF(0),VFR(4),o[1],0,0,0), C0,2); \
    VRD2(1,4); SBAR(); GAPB(o[0]=__builtin_amdgcn_mfma_f32_32x32x16_bf16(PAF(1),VFR(1),o[0],0,0,0), C0,4); \
    VRD2(5,1); SBAR(); GAPB(o[1]=__builtin_amdgcn_mfma_f32_32x32x16_bf16(PAF(1),VFR(5),o[1],0,0,0), C0,6); \
    VRD2(2,5); SBAR(); GAPB(o[0]=__builtin_amdgcn_mfma_f32_32x32x16_bf16(PAF(2),VFR(2),o[0],0,0,0), C0,8); \
    VRD2(6,2); SBAR(); GAPB(o[1]=__builtin_amdgcn_mfma_f32_32x32x16_bf16(PAF(2),VFR(6),o[1],0,0,0), C0,10); \
    VRD2(3,6); SBAR(); GAPB(o[0]=__builtin_amdgcn_mfma_f32_32x32x16_bf16(PAF(3),VFR(3),o[0],0,0,0), C0,12); \
    VRD2(7,3); SBAR(); GAPB(o[1]=__builtin_amdgcn_mfma_f32_32x32x16_bf16(PAF(3),VFR(7),o[1],0,0,0), C0,14); \
    KRD(GL,0); GAPB(o[2]=__builtin_amdgcn_mfma_f32_32x32x16_bf16(PAF(0),VFR(8),o[2],0,0,0), C1,0); \
    KRD(GL,1); GAPB(o[3]=__builtin_amdgcn_mfma_f32_32x32x16_bf16(PAF(0),VFR(0),o[3],0,0,0), C1,2); \
    KRD(GL,2); GAPB(o[2]=__builtin_amdgcn_mfma_f32_32x32x16_bf16(PAF(1),VFR(4),o[2],0,0,0), C1,4); \
    KRD(GL,3); GAPB(o[3]=__builtin_amdgcn_mfma_f32_32x32x16_bf16(PAF(1),VFR(1),o[3],0,0,0), C1,6); \
    GAPB(o[2]=__builtin_amdgcn_mfma_f32_32x32x16_bf16(PAF(2),VFR(5),o[2],0,0,0), C1,8); \
    GAPB(o[3]=__builtin_amdgcn_mfma_f32_32x32x16_bf16(PAF(2),VFR(2),o[3],0,0,0), C1,10); \
    GAPB(o[2]=__builtin_amdgcn_mfma_f32_32x32x16_bf16(PAF(3),VFR(6),o[2],0,0,0), C1,12); \
    GAPB(o[3]=__builtin_amdgcn_mfma_f32_32x32x16_bf16(PAF(3),VFR(3),o[3],0,0,0), C1,14); \
    }while(0)
  int t=1;
  for(;t+5<NT;t+=2){
    STEP(pB0,pB1,pA0,pA1,t,true,true,true);     WAIT_BAR(3); RESC(); ROT();
    STEP(pA0,pA1,pB0,pB1,t+1,true,true,true);   WAIT_BAR(3); RESC(); ROT();
  }
  #define ENDW(tt) do{ if((tt)+3<NT){WAIT_BAR(3);} else if((tt)+2<NT){WAIT_BAR(2);} else {WAIT_BAR(0);} }while(0)
  for(;t+1<NT;t+=2){
    STEP(pB0,pB1,pA0,pA1,t,(t+3<NT),(t+1<NT),(t+1<NT));       ENDW(t);   RESC(); ROT();
    STEP(pA0,pA1,pB0,pB1,t+1,(t+4<NT),(t+2<NT),(t+2<NT));     ENDW(t+1); RESC(); ROT();
  }
  STEP(pB0,pB1,pA0,pA1,NT-1,false,false,false); RESC();
  { float sacc=pB0[0]+pB0[1]; _Pragma("unroll") for(int r=2;r<16;++r)sacc+=pB0[r]; _Pragma("unroll") for(int r=0;r<16;++r)sacc+=pB1[r]; l_reg+=sacc;
    pw0=(u32x4){PKW(pB0,0),PKW(pB0,2),PKW(pB0,4),PKW(pB0,6)};pw1=(u32x4){PKW(pB0,8),PKW(pB0,10),PKW(pB0,12),PKW(pB0,14)};pw2=(u32x4){PKW(pB1,0),PKW(pB1,2),PKW(pB1,4),PKW(pB1,6)};pw3=(u32x4){PKW(pB1,8),PKW(pB1,10),PKW(pB1,12),PKW(pB1,14)};
    SBAR(); pv128(o,vb0+2*sl_cur,PAF(0),PAF(1),PAF(2),PAF(3)); }
  #undef PKW
  #undef PAF
  #undef VFR
  #undef VRD2
  #undef PIN
  #undef MX3
  #undef GAPA
  #undef GAPB
  #undef EX
  #undef VRD
  #undef KRD
  #undef STEP
  #undef ENDW
  {auto rr=__builtin_amdgcn_permlane32_swap(__float_as_uint(l_reg),__float_as_uint(l_reg),false,false);l_reg=__uint_as_float(rr[0])+__uint_as_float(rr[1]);}
  const int lane_e=lane_id_asm(),r32e=lane_e&31,hie=lane_e>>5;
  if(hie==0)wsf[32+r32e]=l_reg;asm volatile("s_waitcnt lgkmcnt(0)":::"memory");
  float rli[16];
  #pragma unroll
  for(int r=0;r<16;++r)rli[r]=__builtin_amdgcn_rcpf(wsf[32+crow(r,hie)]);
  float*st=stash+(size_t)wid*4096+lane_e*4;
  if(cpass==0){
    #pragma unroll
    for(int d0=0;d0<4;++d0)
      #pragma unroll
      for(int q4=0;q4<4;++q4){ typedef float f32x4_t __attribute__((ext_vector_type(4)));
        const f32x4_t v={o[d0][4*q4]*rli[4*q4],o[d0][4*q4+1]*rli[4*q4+1],o[d0][4*q4+2]*rli[4*q4+2],o[d0][4*q4+3]*rli[4*q4+3]};
        *(f32x4_t*)(st+(d0*4+q4)*256)=v; }
  } else {
    typedef float f32x4_t __attribute__((ext_vector_type(4)));
    float ss[16];
    #pragma unroll
    for(int r=0;r<16;++r)ss[r]=0.f;
    #pragma unroll
    for(int d0=0;d0<4;++d0)
      #pragma unroll
      for(int q4=0;q4<4;++q4){ const f32x4_t a=*(const f32x4_t*)(st+(d0*4+q4)*256);
        #pragma unroll
        for(int i=0;i<4;++i){ const int r=4*q4+i; const float v=a[i]-lam*(o[d0][r]*rli[r]); o[d0][r]=v; ss[r]+=v*v; } if(q4==3)asm volatile("":::"memory"); }
    #pragma unroll
    for(int r=0;r<16;++r){ float s=ss[r]; s+=__shfl_xor(s,1); s+=__shfl_xor(s,2); s+=__shfl_xor(s,4); s+=__shfl_xor(s,8); s+=__shfl_xor(s,16); ss[r]=0.8f/sqrtf(s*(1.0f/128.0f)+1e-6f); }
    float gsub[4];
    #pragma unroll
    for(int d0=0;d0<4;++d0)gsub[d0]=subg[d0*32+r32e];
    asm volatile("s_waitcnt lgkmcnt(0)\n\ts_barrier":::"memory");
    bf16*Ow=Ou+(long)(wid*QBLK)*opitch;
    bf16*stg=(bf16*)shm+wid*4096;
    #pragma unroll
    for(int r=0;r<16;++r){const int orow=crow(r,hie);
      #pragma unroll
      for(int d0=0;d0<4;++d0)stg[orow*128+d0*32+r32e]=__float2bfloat16(o[d0][r]*ss[r]*gsub[d0]);}
    asm volatile("s_waitcnt lgkmcnt(0)":::"memory");
    #pragma unroll
    for(int i=0;i<8;++i){const int row=i*4+(lane_e>>4),ch=lane_e&15; const u32x4 v=*(const u32x4*)(stg+row*128+ch*8); ATTN_STORE16(Ow+(long)row*opitch+ch*8,v);}
  }
  asm volatile("s_waitcnt lgkmcnt(0)\n\ts_barrier":::"memory");
 }
  #undef DMA_K
  #undef DMA_V
  #undef CMASK
  #undef START
  #undef RESC
  #undef ROT
}

typedef int v8i32_t __attribute__((ext_vector_type(8))); typedef int v4i32_t __attribute__((ext_vector_type(4)));
constexpr int P8=1664;
#define MFMA8(a,b,c) __builtin_amdgcn_mfma_scale_f32_32x32x64_f8f6f4(a,b,c,0,0,0,0,0,0)
__device__ __forceinline__ v8i32_t cat8v(v4i32_t a,v4i32_t b){ return __builtin_shufflevector(a,b,0,1,2,3,4,5,6,7); }
__device__ __forceinline__ v8i32_t kfrag8(lds_cptr kp){ return cat8v(*(const __attribute__((address_space(3))) v4i32_t*)(kp),*(const __attribute__((address_space(3))) v4i32_t*)(kp+1024)); }
__device__ __forceinline__ void qkt8(f32x16&p0,f32x16&p1,lds_cptr kp,v8i32_t q8,const f32x16&negm){ const v8i32_t a=kfrag8(kp),b=kfrag8(kp+512); p0=MFMA8(a,q8,negm); p1=MFMA8(b,q8,negm); }
constexpr int SLOTK8=4096;
constexpr int L8A_K=0, L8A_V=NSLOT*SLOTK8, L8A_WS=L8A_V+NSLOT*8192, L8A_OST=L8A_WS+NW*64*4, L8A_BYTES=L8A_OST+NW*4096;
constexpr int L8B_K=0, L8B_V=NSLOT*SLOTK8, L8B_WS=65536, L8B_BYTES=L8B_WS+NW*64*4;
template<int THRL,bool FIXREF=false> __device__ __forceinline__ void attn_unit_q8(const unsigned char*Qu8,const unsigned char*__restrict__ Kb8,const bf16*__restrict__ Vb,bf16*Ou,int opitch,char*shm,int wid){
  const int lane=lane_id_asm(),r32=lane&31,hi=lane>>5;
  const unsigned char*Qw8=Qu8+(long)(wid*QBLK)*P8;
  const unsigned char*Kh8=Kb8; const bf16*Vh=Vb;
  const unsigned lds0=(unsigned)(uintptr_t)shm;
  float*wsf=(float*)(shm+L8A_WS)+wid*64;
  const unsigned char*ksrc=Kh8+(long)lane*P8+(wid&3)*16;
  const bf16*vsrc=Vh+(long)(16*(wid&3)+(lane>>2))*DM+(wid>>2)*32+(lane&3)*8;
  const unsigned kdst=lds0+L8A_K+(wid&3)*1024, vdst=lds0+L8A_V+wid*1024;
  #define DMA_K(t,slot) glds16(ksrc+(long)(t)*KVBLK*P8,(unsigned)__builtin_amdgcn_readfirstlane(kdst+(slot)))
  #define DMA_V(t,slot) glds16(vsrc+(long)(t)*KVBLK*DM,(unsigned)__builtin_amdgcn_readfirstlane(vdst+2*(slot)))
  const int vb0=(int)(lds0+L8A_V)+((lane>>4)&1)*32+(lane&3)*8+(4*hi+((lane&15)>>2))*64;
  v8i32_t kf8[2];
  const lds_cptr shm3=(lds_cptr)shm; const lds_cptr kp0=shm3+L8A_K+hi*2048+r32*16; const lds_cptr vp0=shm3+L8A_V+((lane>>4)&1)*32+(lane&3)*8+(4*hi+((lane&15)>>2))*64;
  DMA_K(0,0);DMA_V(0,0);DMA_K(1,SLOTK8);
  const v8i32_t q8=*reinterpret_cast<const v8i32_t*>(Qw8+(long)r32*P8+hi*32);
  float mhat=0.f,l_reg=0.f;f32x16 o[2];o[0]=f32x16{};o[1]=f32x16{};f32x16 negm=f32x16{};asm volatile("":"+v"(negm));
  #define CMASK(P0,P1,t) do{}while(0)
  bool resc=false;
  #define START(P0,P1) do{ resc=false; if constexpr(!FIXREF){ const float rm=rowmax(P0,P1); \
    { const float dl=rm; mhat=fadd_s(mhat,dl); \
      _Pragma("unroll") for(int r=0;r<16;++r){P0[r]=fsub_s(P0[r],dl);P1[r]=fsub_s(P1[r],dl);} \
      _Pragma("unroll") for(int r=0;r<16;++r)negm[r]=-mhat; asm volatile("":"+v"(negm)); } } \
    _Pragma("unroll") for(int r=0;r<16;++r)P0[r]=__builtin_amdgcn_exp2f(P0[r]); }while(0)
  #define RESC() do{ if(resc){ asm volatile("s_waitcnt lgkmcnt(0)":::"memory"); \
      _Pragma("unroll") for(int d_=0;d_<2;++d_) _Pragma("unroll") for(int r=0;r<16;++r)o[d_][r]*=wsf[crow(r,hi)]; } }while(0)
  f32x16 pA0,pA1,pB0,pB1;
  int sl_prev=0,sl_cur=0,sl_next=SLOTK8;
  #define ROT() do{sl_prev=sl_cur;sl_cur=sl_next;sl_next=(sl_next==(NSLOT-1)*SLOTK8)?0:sl_next+SLOTK8;}while(0)
  DMA_K(2,2*SLOTK8);
  WAIT_BAR(3);
  qkt8(pA0,pA1,kp0,q8,negm);asm volatile("s_nop 15\n\ts_nop 7":"+v"(pA0),"+v"(pA1));CMASK(pA0,pA1,0);
  START(pA0,pA1);
  _Pragma("unroll") for(int r=0;r<16;++r)pA1[r]=__builtin_amdgcn_exp2f(pA1[r]);
  WAIT_BAR(0);
  DMA_K(3,0);DMA_V(1,SLOTK8);
  ROT();
  kf8[0]=kfrag8(kp0+sl_cur); kf8[1]=kfrag8(kp0+sl_cur+512);
  WAIT_BAR(2);
  s16x4 vlo[8],vhi[8]; u32x4 pw0,pw1,pw2,pw3;
  #define PKW(P,B) cvtpk_s(P[B],P[B+1])
  #define PAF(k) __builtin_bit_cast(bf16x8,pw##k)
  #define VFR(i) (bf16x8){vlo[i][0],vlo[i][1],vlo[i][2],vlo[i][3],vhi[i][0],vhi[i][1],vhi[i][2],vhi[i][3]}
  #define PIN(x) asm volatile("":"+v"(x))
  #define MX3(a,b,c) __builtin_fmaxf(__builtin_fmaxf((a),(b)),(c))
  #define GAPA(MF,A0,A1,A2,A3,W0,W1,PW) do{ MF; sacc+=A0; sacc+=A1; sacc+=A2; sacc+=A3; PIN(sacc); W0; W1; PIN(PW); SBAR(); }while(0)
  #define EX(v) __builtin_amdgcn_exp2f(v)
  #define GAPB(MF,X,B) do{ MF; X[B]=EX(X[B]); X[B+1]=EX(X[B+1]); X[B+2]=EX(X[B+2]); X[B+3]=EX(X[B+3]); PIN(X); SBAR(); }while(0)
  #define VRD(i) do{ vlo[i]=vtr(vp_+(((i)>>2)*4096+((i)&3)*1024)); vhi[i]=vtr(vp_+(((i)>>2)*4096+((i)&3)*1024+512)); }while(0)
  #define KRD(G,j) do{ if(G){ kf8[j]=kfrag8(kp0+sl_next+(j)*512); SBAR(); } }while(0)
  #define STEP(C0,C1,P0,P1,t,GK,GV,GL) do{ SBAR(); \
    const lds_cptr vp_=vp0+2*sl_prev; \
    VRD(0); SBAR(); float sacc=(P0[0]+P0[1]); \
    C0=MFMA8(kf8[0],q8,negm); \
    sacc+=P0[2];sacc+=P0[3];sacc+=P0[4];sacc+=P0[5];sacc+=P0[6];sacc+=P0[7]; PIN(sacc); pw0[0]=PKW(P0,0); pw0[1]=PKW(P0,2); pw0[2]=PKW(P0,4); pw0[3]=PKW(P0,6); PIN(pw0); SBAR(); \
    VRD(4); SBAR(); \
    sacc+=P0[8];sacc+=P0[9];sacc+=P0[10];sacc+=P0[11];sacc+=P0[12];sacc+=P0[13];sacc+=P0[14];sacc+=P0[15]; PIN(sacc); pw1[0]=PKW(P0,8); pw1[1]=PKW(P0,10); pw1[2]=PKW(P0,12); pw1[3]=PKW(P0,14); PIN(pw1); SBAR(); \
    VRD(1); VRD(5); SBAR(); \
    C1=MFMA8(kf8[1],q8,negm); \
    sacc+=P1[0];sacc+=P1[1];sacc+=P1[2];sacc+=P1[3];sacc+=P1[4];sacc+=P1[5];sacc+=P1[6];sacc+=P1[7]; PIN(sacc); pw2[0]=PKW(P1,0); pw2[1]=PKW(P1,2); pw2[2]=PKW(P1,4); pw2[3]=PKW(P1,6); PIN(pw2); SBAR(); \
    VRD(2); VRD(6); SBAR(); \
    sacc+=P1[8];sacc+=P1[9];sacc+=P1[10];sacc+=P1[11];sacc+=P1[12];sacc+=P1[13];sacc+=P1[14];sacc+=P1[15]; PIN(sacc); pw3[0]=PKW(P1,8); pw3[1]=PKW(P1,10); pw3[2]=PKW(P1,12); pw3[3]=PKW(P1,14); PIN(pw3); SBAR(); \
    VRD(3); VRD(7); SBAR(); \
    l_reg+=sacc; \
    if(GK){DMA_K((t)+3,sl_cur);} if(GV){DMA_V((t)+1,sl_next);} \
    CMASK(C0,C1,t); \
    if constexpr(!FIXREF){ float a=MX3(C0[0],C0[1],C1[0]),b=MX3(C0[2],C0[3],C1[1]); a=MX3(a,C1[2],C1[3]); \
      _Pragma("unroll") for(int r=4;r<16;r+=4){a=MX3(a,C0[r],C0[r+1]);b=MX3(b,C0[r+2],C0[r+3]);a=MX3(a,C1[r],C1[r+1]);b=MX3(b,C1[r+2],C1[r+3]);} \
      float rm=__builtin_fmaxf(a,b); { auto rr=__builtin_amdgcn_permlane32_swap(__float_as_uint(rm),__float_as_uint(rm),false,false); rm=__builtin_fmaxf(__uint_as_float(rr[0]),__uint_as_float(rr[1])); } \
      resc=false; \
      if(__builtin_expect(__any(rm>(float)THRL),0)){ const float dl=__builtin_fmaxf(rm,0.f); mhat+=dl; \
        _Pragma("unroll") for(int r=0;r<16;++r){C0[r]-=dl;C1[r]-=dl;} \
        _Pragma("unroll") for(int r=0;r<16;++r)negm[r]=-mhat; asm volatile("":"+v"(negm)); \
        const float f=__builtin_amdgcn_exp2f(-dl); l_reg*=f; if(hi==0)wsf[r32]=f; resc=true; } } \
    SBAR(); \
    GAPB(o[0]=__builtin_amdgcn_mfma_f32_32x32x16_bf16(PAF(0),VFR(0),o[0],0,0,0), C0,0); \
    GAPB(o[1]=__builtin_amdgcn_mfma_f32_32x32x16_bf16(PAF(0),VFR(4),o[1],0,0,0), C0,4); \
    KRD(GL,0); GAPB(o[0]=__builtin_amdgcn_mfma_f32_32x32x16_bf16(PAF(1),VFR(1),o[0],0,0,0), C0,8); \
    KRD(GL,1); GAPB(o[1]=__builtin_amdgcn_mfma_f32_32x32x16_bf16(PAF(1),VFR(5),o[1],0,0,0), C0,12); \
    GAPB(o[0]=__builtin_amdgcn_mfma_f32_32x32x16_bf16(PAF(2),VFR(2),o[0],0,0,0), C1,0); \
    GAPB(o[1]=__builtin_amdgcn_mfma_f32_32x32x16_bf16(PAF(2),VFR(6),o[1],0,0,0), C1,4); \
    GAPB(o[0]=__builtin_amdgcn_mfma_f32_32x32x16_bf16(PAF(3),VFR(3),o[0],0,0,0), C1,8); \
    GAPB(o[1]=__builtin_amdgcn_mfma_f32_32x32x16_bf16(PAF(3),VFR(7),o[1],0,0,0), C1,12); \
    }while(0)
  int t=1;
  for(;t+5<NT;t+=2){
    STEP(pB0,pB1,pA0,pA1,t,true,true,true);     WAIT_BAR(2); RESC(); ROT();
    STEP(pA0,pA1,pB0,pB1,t+1,true,true,true);   WAIT_BAR(2); RESC(); ROT();
  }
  #define ENDW(tt) do{ if((tt)+3<NT){WAIT_BAR(2);} else if((tt)+2<NT){WAIT_BAR(1);} else {WAIT_BAR(0);} }while(0)
  for(;t+1<NT;t+=2){
    STEP(pB0,pB1,pA0,pA1,t,(t+3<NT),(t+1<NT),(t+1<NT));       ENDW(t);   RESC(); ROT();
    STEP(pA0,pA1,pB0,pB1,t+1,(t+4<NT),(t+2<NT),(t+2<NT));     ENDW(t+1); RESC(); ROT();
  }
  STEP(pB0,pB1,pA0,pA1,NT-1,false,false,false); RESC();
  { float sacc=pB0[0]+pB0[1]; _Pragma("unroll") for(int r=2;r<16;++r)sacc+=pB0[r]; _Pragma("unroll") for(int r=0;r<16;++r)sacc+=pB1[r]; l_reg+=sacc;
    pw0=(u32x4){PKW(pB0,0),PKW(pB0,2),PKW(pB0,4),PKW(pB0,6)};pw1=(u32x4){PKW(pB0,8),PKW(pB0,10),PKW(pB0,12),PKW(pB0,14)};pw2=(u32x4){PKW(pB1,0),PKW(pB1,2),PKW(pB1,4),PKW(pB1,6)};pw3=(u32x4){PKW(pB1,8),PKW(pB1,10),PKW(pB1,12),PKW(pB1,14)};
    SBAR(); pv(o,vb0+2*sl_cur,PAF(0),PAF(1),PAF(2),PAF(3)); }
  #undef PKW
  #undef PAF
  #undef VFR
  #undef PIN
  #undef MX3
  #undef GAPA
  #undef GAPB
  #undef EX
  #undef VRD
  #undef KRD
  #undef STEP
  #undef ENDW
  {auto rr=__builtin_amdgcn_permlane32_swap(__float_as_uint(l_reg),__float_as_uint(l_reg),false,false);l_reg=__uint_as_float(rr[0])+__uint_as_float(rr[1]);}
  if(hi==0)wsf[32+r32]=l_reg;asm volatile("s_waitcnt lgkmcnt(0)":::"memory");
  float rli[16];
  #pragma unroll
  for(int r=0;r<16;++r)rli[r]=__builtin_amdgcn_rcpf(wsf[32+crow(r,hi)]);
  bf16*Ow=Ou+(long)(wid*QBLK)*opitch;
  { bf16*stg=(bf16*)(shm+L8A_OST)+wid*2048;
    #pragma unroll
    for(int r=0;r<16;++r){const int orow=crow(r,hi);
      #pragma unroll
      for(int d0=0;d0<2;++d0)stg[orow*64+d0*32+r32]=__float2bfloat16(o[d0][r]*rli[r]);}
    asm volatile("s_waitcnt lgkmcnt(0)":::"memory");
    #pragma unroll
    for(int i=0;i<4;++i){const int row=i*8+(lane>>3),ch=lane&7; const u32x4 v=*(const u32x4*)(stg+row*64+ch*8); ATTN_STORE16(Ow+(long)row*opitch+ch*8,v);} }
  asm volatile("s_waitcnt lgkmcnt(0)\n\ts_barrier":::"memory");
  #undef DMA_K
  #undef DMA_V
  #undef CMASK
  #undef START
  #undef RESC
  #undef ROT
}
typedef int v2i32_t __attribute__((ext_vector_type(2)));
constexpr int PV8=640;
constexpr int L9A_K=0, L9A_V=4*SLOTK8, L9A_WS=7*SLOTK8, L9A_OST=L9A_WS+NW*64*4, L9A_BYTES=L9A_OST+NW*4096;
template<int THRL,bool FIXREF=false> __device__ __forceinline__ void attn_unit_q8v(const unsigned char*Qu8,const unsigned char*__restrict__ Kb8,const unsigned char*__restrict__ Vb8,bf16*Ou,int opitch,char*shm,int wid){
  const int lane=lane_id_asm(),r32=lane&31,hi=lane>>5;
  const unsigned char*Qw8=Qu8+(long)(wid*QBLK)*P8;
  const unsigned char*Kh8=Kb8; const bool kw=wid<4;
  const unsigned lds0=(unsigned)(uintptr_t)shm;
  float*wsf=(float*)(shm+L9A_WS)+wid*64;
  const unsigned char*ksrc=Kh8+(long)lane*P8+(wid&3)*16;
  const int vkey_=16*(wid&3)+(lane>>2), vc_=(lane&3)^(((vkey_>>3)&1)<<1);
  const unsigned char*vsrc=Vb8+(long)vkey_*PV8+vc_*16;
  const unsigned kdst=lds0+L9A_K+(wid&3)*1024, vdst=lds0+L9A_V+(wid&3)*1024;
  #define DMA_K(t,slot) glds16(ksrc+(long)(t)*KVBLK*P8,(unsigned)__builtin_amdgcn_readfirstlane(kdst+(slot)))
  #define DMA_V(t,slot) glds16(vsrc+(long)(t)*KVBLK*PV8,(unsigned)__builtin_amdgcn_readfirstlane(vdst+(slot)))
  v8i32_t kf8[2];
  const lds_cptr shm3=(lds_cptr)shm; const lds_cptr kp0=shm3+L9A_K+hi*2048+r32*16;
  const int vq_=(lane&15)>>1, vkey0_=(vq_&3)+8*(vq_>>2)+4*hi, vsw_=(vq_>>2)<<1;
  const lds_cptr vpA=shm3+L9A_V+vkey0_*64+((((lane>>4)&1))^vsw_)*16+(lane&1)*8, vpB=shm3+L9A_V+vkey0_*64+((2+((lane>>4)&1))^vsw_)*16+(lane&1)*8;
  if(kw){DMA_K(0,0);DMA_K(1,SLOTK8);}else{DMA_V(0,0);}
  const v8i32_t q8=*reinterpret_cast<const v8i32_t*>(Qw8+(long)r32*P8+hi*32);
  float mhat=0.f,l_reg=0.f;f32x16 o[2];o[0]=f32x16{};o[1]=f32x16{};f32x16 negm=f32x16{};asm volatile("":"+v"(negm));
  #define CMASK(P0,P1,t) do{}while(0)
  bool resc=false;
  #define START(P0,P1) do{ resc=false; if constexpr(!FIXREF){ const float rm=rowmax(P0,P1); \
    { const float dl=rm; mhat=fadd_s(mhat,dl); \
      _Pragma("unroll") for(int r=0;r<16;++r){P0[r]=fsub_s(P0[r],dl);P1[r]=fsub_s(P1[r],dl);} \
      _Pragma("unroll") for(int r=0;r<16;++r)negm[r]=-mhat; asm volatile("":"+v"(negm)); } } \
    _Pragma("unroll") for(int r=0;r<16;++r)P0[r]=__builtin_amdgcn_exp2f(P0[r]); }while(0)
  #define RESC() do{ if(resc){ asm volatile("s_waitcnt lgkmcnt(0)":::"memory"); \
      _Pragma("unroll") for(int d_=0;d_<2;++d_) _Pragma("unroll") for(int r=0;r<16;++r)o[d_][r]*=wsf[crow(r,hi)]; } }while(0)
  f32x16 pA0,pA1,pB0,pB1;
  int sl_prev=0,sl_cur=0,sl_next=SLOTK8;
  int kq_prev=0,kq_cur=0,kq_next=SLOTK8;
  #define ROT() do{sl_prev=sl_cur;sl_cur=sl_next;sl_next=(sl_next==(NSLOT-1)*SLOTK8)?0:sl_next+SLOTK8; kq_prev=kq_cur;kq_cur=kq_next;kq_next=(kq_next==3*SLOTK8)?0:kq_next+SLOTK8;}while(0)
  if(kw){DMA_K(2,2*SLOTK8);}
  WAIT_BAR(2);
  qkt8(pA0,pA1,kp0,q8,negm);asm volatile("s_nop 15\n\ts_nop 7":"+v"(pA0),"+v"(pA1));CMASK(pA0,pA1,0);
  START(pA0,pA1);
  _Pragma("unroll") for(int r=0;r<16;++r)pA1[r]=__builtin_amdgcn_exp2f(pA1[r]);
  WAIT_BAR(0);
  if(kw){DMA_K(3,3*SLOTK8);}else{DMA_V(1,SLOTK8);}
  ROT();
  kf8[0]=kfrag8(kp0+kq_cur); kf8[1]=kfrag8(kp0+kq_cur+512);
  WAIT_BAR(1);
  v2i32_t vA0,vA1,vA2,vA3,vB0,vB1,vB2,vB3; v8i32_t pw8=v8i32_t{}; static_assert(FIXREF,"constant reference only (the row sums are not rescaled)");
  v8i32_t ones8; { int o1_; asm volatile("v_mov_b32 %0, 0x38383838":"=v"(o1_)); ones8=(v8i32_t){o1_,o1_,o1_,o1_,o1_,o1_,o1_,o1_}; } f32x16 ls=f32x16{};
  #define PK4(P,B) (int)pg8::pk4_fp8(P[B],P[B+1],P[B+2],P[B+3])
  #define PK4I(D,P,B) do{ D=__builtin_amdgcn_cvt_pk_fp8_f32(P[B],P[B+1],D,false); D=__builtin_amdgcn_cvt_pk_fp8_f32(P[B+2],P[B+3],D,true); }while(0)
  #define VT8(p) __builtin_amdgcn_ds_read_tr8_b64_v2i32((__attribute__((address_space(3))) v2i32_t*)(p))
  #define V8A() (v8i32_t){vA0[0],vA0[1],vA1[0],vA1[1],vA2[0],vA2[1],vA3[0],vA3[1]}
  #define V8B() (v8i32_t){vB0[0],vB0[1],vB1[0],vB1[1],vB2[0],vB2[1],vB3[0],vB3[1]}
  #define PIN(x) asm volatile("":"+v"(x))
  #define MX3(a,b,c) __builtin_fmaxf(__builtin_fmaxf((a),(b)),(c))
  #define EX(v) __builtin_amdgcn_exp2f(v)
  #define EX4(X,B) do{ X[B]=EX(X[B]); X[B+1]=EX(X[B+1]); X[B+2]=EX(X[B+2]); X[B+3]=EX(X[B+3]); PIN(X); SBAR(); }while(0)
  #define KRD(G,j,KS) do{ if(G){ kf8[j]=kfrag8(kp0+(KS)+(j)*512); SBAR(); } }while(0)
  #define STEPA(C0,C1,P0,P1) do{ SBAR(); \
    const lds_cptr va_=vpA+sl_prev, vb_=vpB+sl_prev; \
    vA0=VT8(va_); vA1=VT8(va_+1024); SBAR(); \
    C0=MFMA8(kf8[0],q8,negm); \
    PK4I(pw8[0],P0,0); PK4I(pw8[1],P0,4); PIN(pw8); SBAR(); \
    vA2=VT8(va_+2048); vA3=VT8(va_+3072); SBAR(); \
    PK4I(pw8[2],P0,8); PK4I(pw8[3],P0,12); PIN(pw8); SBAR(); \
    vB0=VT8(vb_); vB1=VT8(vb_+1024); SBAR(); \
    C1=MFMA8(kf8[1],q8,negm); \
    PK4I(pw8[4],P1,0); PK4I(pw8[5],P1,4); PIN(pw8); SBAR(); \
    vB2=VT8(vb_+2048); vB3=VT8(vb_+3072); SBAR(); \
    PK4I(pw8[6],P1,8); PK4I(pw8[7],P1,12); PIN(pw8); SBAR(); \
    }while(0)
  #define STEPB(C0,C1,GL,KS) do{ SBAR(); \
    ls=MFMA8(pw8,ones8,ls); o[0]=MFMA8(pw8,V8A(),o[0]); SBAR(); \
    EX4(C0,0); EX4(C0,4); KRD(GL,0,KS); EX4(C0,8); EX4(C0,12); \
    o[1]=MFMA8(pw8,V8B(),o[1]); SBAR(); \
    EX4(C1,0); KRD(GL,1,KS); EX4(C1,4); EX4(C1,8); EX4(C1,12); \
    }while(0)
  #define ENDW(tt) do{ if((tt)+3<NT){WAIT_BAR(1);} else {WAIT_BAR(0);} }while(0)
  if(kw){
    int t=1;
    for(;t+1<NT;t+=2){
      STEPA(pB0,pB1,pA0,pA1); if(t+3<NT){DMA_K(t+3,kq_prev);} STEPB(pB0,pB1,true,kq_next); ENDW(t); ROT();
      STEPA(pA0,pA1,pB0,pB1); if(t+4<NT){DMA_K(t+4,kq_prev);} STEPB(pA0,pA1,(t+2<NT),kq_next); ENDW(t+1); ROT();
    }
    STEPA(pB0,pB1,pA0,pA1); STEPB(pB0,pB1,false,0);
  } else {
    int t=1;
    DMA_V(2,sl_next); STEPA(pB0,pB1,pA0,pA1); ENDW(1); ROT(); t=2;
    for(;t+3<NT;t+=2){
      DMA_V(t+1,sl_next); STEPB(pB0,pB1,true,kq_cur); STEPA(pA0,pA1,pB0,pB1); ENDW(t); ROT();
      DMA_V(t+2,sl_next); STEPB(pA0,pA1,true,kq_cur); STEPA(pB0,pB1,pA0,pA1); ENDW(t+1); ROT();
    }
    DMA_V(t+1,sl_next); STEPB(pB0,pB1,true,kq_cur); STEPA(pA0,pA1,pB0,pB1); ENDW(t); ROT();
    STEPB(pA0,pA1,true,kq_cur); STEPA(pB0,pB1,pA0,pA1);
    STEPB(pB0,pB1,false,0);
  }
  {
    pw8=(v8i32_t){PK4(pB0,0),PK4(pB0,4),PK4(pB0,8),PK4(pB0,12),PK4(pB1,0),PK4(pB1,4),PK4(pB1,8),PK4(pB1,12)};
    const lds_cptr va_=vpA+sl_cur, vb_=vpB+sl_cur;
    vA0=VT8(va_); vA1=VT8(va_+1024); vA2=VT8(va_+2048); vA3=VT8(va_+3072); vB0=VT8(vb_); vB1=VT8(vb_+1024); vB2=VT8(vb_+2048); vB3=VT8(vb_+3072);
    SBAR(); ls=MFMA8(pw8,ones8,ls); o[0]=MFMA8(pw8,V8A(),o[0]); o[1]=MFMA8(pw8,V8B(),o[1]); }
  #undef PK4
  #undef PK4I
  #undef VT8
  #undef V8A
  #undef V8B
  #undef PIN
  #undef MX3
  #undef EX
  #undef EX4
  #undef KRD
  #undef STEPA
  #undef STEPB
  #undef STEP
  #undef ENDW
  {auto rr=__builtin_amdgcn_permlane32_swap(__float_as_uint(l_reg),__float_as_uint(l_reg),false,false);l_reg=__uint_as_float(rr[0])+__uint_as_float(rr[1]);}
  if(hi==0)wsf[32+r32]=l_reg;asm volatile("s_waitcnt lgkmcnt(0)":::"memory");
  float rli[16];
  #pragma unroll
  for(int r=0;r<16;++r)rli[r]=__builtin_amdgcn_rcpf(ls[r]);
  bf16*Ow=Ou+(long)(wid*QBLK)*opitch;
  { bf16*stg=(bf16*)(shm+L9A_OST)+wid*2048;
    #pragma unroll
    for(int r=0;r<16;++r){const int orow=crow(r,hi);
      #pragma unroll
      for(int d0=0;d0<2;++d0)stg[orow*64+d0*32+r32]=__float2bfloat16(o[d0][r]*rli[r]);}
    asm volatile("s_waitcnt lgkmcnt(0)":::"memory");
    #pragma unroll
    for(int i=0;i<4;++i){const int row=i*8+(lane>>3),ch=lane&7; const u32x4 v=*(const u32x4*)(stg+row*64+ch*8); ATTN_STORE16(Ow+(long)row*opitch+ch*8,v);} }
  asm volatile("s_waitcnt lgkmcnt(0)\n\ts_barrier":::"memory");
  #undef DMA_K
  #undef DMA_V
  #undef CMASK
  #undef START
  #undef RESC
  #undef ROT
}
template<int THRL,bool FIXREF=false> __device__ __forceinline__ void attn_unit128_q8(const unsigned char*Qu8,const unsigned char*__restrict__ Kb8,const bf16*__restrict__ Vb,bf16*Ou,int opitch,char*shm,int wid,float*stash,float lam,const float*subg,int pass_lo,int pass_hi){
  const int lane=lane_id_asm(),r32=lane&31,hi=lane>>5;
  const bf16*Vh=Vb;
 for(int cpass=pass_lo;cpass<pass_hi;++cpass){
  const int lane_p=lane_id_asm(),r32p=lane_p&31,hip=lane_p>>5;
  const unsigned char*Qw8=Qu8+(long)(wid*QBLK)*P8+cpass*64;
  const unsigned char*Kh8=Kb8+cpass*64;
  const unsigned lds0=(unsigned)(uintptr_t)shm;
  float*wsf=(float*)(shm+L8B_WS)+wid*64;
  const unsigned char*ksrc=Kh8+(long)lane_p*P8+(wid&3)*16;
  const bf16*vsrc=Vh+(long)(16*(wid&3)+(lane_p>>2))*DM+(wid>>2)*32+(lane_p&3)*8;
  const unsigned kdst=lds0+L8B_K+(wid&3)*1024, vdst=lds0+L8B_V+wid*1024;
  #define DMA_K(t,slot) glds16(ksrc+(long)(t)*KVBLK*P8,(unsigned)__builtin_amdgcn_readfirstlane(kdst+(slot)))
  #define DMA_V(t,slot) do{ glds16(vsrc+(long)(t)*KVBLK*DM,(unsigned)__builtin_amdgcn_readfirstlane(vdst+4*(slot))); glds16(vsrc+(long)(t)*KVBLK*DM+64,(unsigned)__builtin_amdgcn_readfirstlane(vdst+4*(slot)+8192)); }while(0)
  const int vb0=(int)(lds0+L8B_V)+((lane_p>>4)&1)*32+(lane_p&3)*8+(4*hip+((lane_p&15)>>2))*64;
  v8i32_t kf8[2];
  const lds_cptr shm3=(lds_cptr)shm; const lds_cptr kp0=shm3+L8B_K+hip*2048+r32p*16; const lds_cptr vp0=shm3+L8B_V+((lane_p>>4)&1)*32+(lane_p&3)*8+(4*hip+((lane_p&15)>>2))*64;
  DMA_K(0,0);DMA_V(0,0);DMA_K(1,SLOTK8);
  const v8i32_t q8=*reinterpret_cast<const v8i32_t*>(Qw8+(long)r32p*P8+hip*32);
  float zf_; asm volatile("v_mov_b32 %0, 0":"=v"(zf_));
  float mhat=0.f,l_reg=0.f;f32x16 o[4];
  #pragma unroll
  for(int r=0;r<16;++r){o[0][r]=zf_;o[1][r]=zf_;o[2][r]=zf_;o[3][r]=zf_;}
  f32x16 negm;
  #pragma unroll
  for(int r=0;r<16;++r)negm[r]=zf_;
  asm volatile("":"+v"(negm));
  #define CMASK(P0,P1,t) do{}while(0)
  bool resc=false;
  #define START(P0,P1) do{ resc=false; if constexpr(!FIXREF){ const float rm=rowmax(P0,P1); \
    { const float dl=rm; mhat=fadd_s(mhat,dl); \
      _Pragma("unroll") for(int r=0;r<16;++r){P0[r]=fsub_s(P0[r],dl);P1[r]=fsub_s(P1[r],dl);} \
      _Pragma("unroll") for(int r=0;r<16;++r)negm[r]=-mhat; asm volatile("":"+v"(negm)); } } \
    _Pragma("unroll") for(int r=0;r<16;++r)P0[r]=__builtin_amdgcn_exp2f(P0[r]); }while(0)
  #define RESC() do{ if(resc){ asm volatile("s_waitcnt lgkmcnt(0)":::"memory"); \
      _Pragma("unroll") for(int d_=0;d_<4;++d_) _Pragma("unroll") for(int r=0;r<16;++r)o[d_][r]*=wsf[crow(r,hi)]; } }while(0)
  f32x16 pA0,pA1,pB0,pB1;
  int sl_prev=0,sl_cur=0,sl_next=SLOTK8;
  #define ROT() do{sl_prev=sl_cur;sl_cur=sl_next;sl_next=(sl_next==(NSLOT-1)*SLOTK8)?0:sl_next+SLOTK8;}while(0)
  DMA_K(2,2*SLOTK8);
  WAIT_BAR(4);
  qkt8(pA0,pA1,kp0,q8,negm);asm volatile("s_nop 15\n\ts_nop 7":"+v"(pA0),"+v"(pA1));CMASK(pA0,pA1,0);
  START(pA0,pA1);
  _Pragma("unroll") for(int r=0;r<16;++r)pA1[r]=__builtin_amdgcn_exp2f(pA1[r]);
  WAIT_BAR(0);
  DMA_K(3,0);DMA_V(1,SLOTK8);
  ROT();
  kf8[0]=kfrag8(kp0+sl_cur); kf8[1]=kfrag8(kp0+sl_cur+512);
  WAIT_BAR(3);
  s16x4 vlo[9],vhi[9]; u32x4 pw0,pw1,pw2,pw3;
  #define PKW(P,B) cvtpk_s(P[B],P[B+1])
  #define PAF(k) __builtin_bit_cast(bf16x8,pw##k)
  #define VFR(i) (bf16x8){vlo[i][0],vlo[i][1],vlo[i][2],vlo[i][3],vhi[i][0],vhi[i][1],vhi[i][2],vhi[i][3]}
  #define PIN(x) asm volatile("":"+v"(x))
  #define MX3(a,b,c) __builtin_fmaxf(__builtin_fmaxf((a),(b)),(c))
  #define GAPA(MF,A0,A1,A2,A3,W0,W1,PW) do{ MF; sacc+=A0; sacc+=A1; sacc+=A2; sacc+=A3; PIN(sacc); W0; W1; PIN(PW); SBAR(); }while(0)
  #define EX(v) __builtin_amdgcn_exp2f(v)
  #define GAPB(MF,X,B) do{ MF; X[B]=EX(X[B]); X[B+1]=EX(X[B+1]); PIN(X); SBAR(); }while(0)
  #define VRD2(i,s) do{ vlo[s]=vtr(vp_+(8192+((i)>>2)*4096+((i)&3)*1024)); vhi[s]=vtr(vp_+(8192+((i)>>2)*4096+((i)&3)*1024+512)); }while(0)
  #define VRD(i) do{ vlo[i]=vtr(vp_+(((i)>>2)*4096+((i)&3)*1024)); vhi[i]=vtr(vp_+(((i)>>2)*4096+((i)&3)*1024+512)); }while(0)
  #define KRD(G,j) do{ if(G){ kf8[j]=kfrag8(kp0+sl_next+(j)*512); SBAR(); } }while(0)
  #define STEP(C0,C1,P0,P1,t,GK,GV,GL) do{ SBAR(); \
    const lds_cptr vp_=vp0+4*sl_prev; \
    VRD(0); SBAR(); float sacc=(P0[0]+P0[1]); \
    C0=MFMA8(kf8[0],q8,negm); \
    sacc+=P0[2];sacc+=P0[3];sacc+=P0[4];sacc+=P0[5];sacc+=P0[6];sacc+=P0[7]; PIN(sacc); pw0[0]=PKW(P0,0); pw0[1]=PKW(P0,2); pw0[2]=PKW(P0,4); pw0[3]=PKW(P0,6); PIN(pw0); SBAR(); \
    VRD(4); SBAR(); \
    sacc+=P0[8];sacc+=P0[9];sacc+=P0[10];sacc+=P0[11];sacc+=P0[12];sacc+=P0[13];sacc+=P0[14];sacc+=P0[15]; PIN(sacc); pw1[0]=PKW(P0,8); pw1[1]=PKW(P0,10); pw1[2]=PKW(P0,12); pw1[3]=PKW(P0,14); PIN(pw1); SBAR(); \
    VRD(1); VRD(5); SBAR(); \
    C1=MFMA8(kf8[1],q8,negm); \
    sacc+=P1[0];sacc+=P1[1];sacc+=P1[2];sacc+=P1[3];sacc+=P1[4];sacc+=P1[5];sacc+=P1[6];sacc+=P1[7]; PIN(sacc); pw2[0]=PKW(P1,0); pw2[1]=PKW(P1,2); pw2[2]=PKW(P1,4); pw2[3]=PKW(P1,6); PIN(pw2); SBAR(); \
    VRD(2); VRD(6); SBAR(); \
    sacc+=P1[8];sacc+=P1[9];sacc+=P1[10];sacc+=P1[11];sacc+=P1[12];sacc+=P1[13];sacc+=P1[14];sacc+=P1[15]; PIN(sacc); pw3[0]=PKW(P1,8); pw3[1]=PKW(P1,10); pw3[2]=PKW(P1,12); pw3[3]=PKW(P1,14); PIN(pw3); SBAR(); \
    VRD(3); VRD(7); SBAR(); \
    l_reg+=sacc; \
    if(GK){DMA_K((t)+3,sl_cur);} if(GV){DMA_V((t)+1,sl_next);} \
    CMASK(C0,C1,t); \
    if constexpr(!FIXREF){ float a=MX3(C0[0],C0[1],C1[0]),b=MX3(C0[2],C0[3],C1[1]); a=MX3(a,C1[2],C1[3]); \
      _Pragma("unroll") for(int r=4;r<16;r+=4){a=MX3(a,C0[r],C0[r+1]);b=MX3(b,C0[r+2],C0[r+3]);a=MX3(a,C1[r],C1[r+1]);b=MX3(b,C1[r+2],C1[r+3]);} \
      float rm=__builtin_fmaxf(a,b); { auto rr=__builtin_amdgcn_permlane32_swap(__float_as_uint(rm),__float_as_uint(rm),false,false); rm=__builtin_fmaxf(__uint_as_float(rr[0]),__uint_as_float(rr[1])); } \
      resc=false; \
      if(__builtin_expect(__any(rm>(float)THRL),0)){ const float dl=__builtin_fmaxf(rm,0.f); mhat+=dl; \
        _Pragma("unroll") for(int r=0;r<16;++r){C0[r]-=dl;C1[r]-=dl;} \
        _Pragma("unroll") for(int r=0;r<16;++r)negm[r]=-mhat; asm volatile("":"+v"(negm)); \
        const float f=__builtin_amdgcn_exp2f(-dl); l_reg*=f; { const int l2_=lane_id_asm(); if((l2_>>5)==0)wsf[l2_&31]=f; } resc=true; } } \
    SBAR(); \
    VRD2(0,8); SBAR(); GAPB(o[0]=__builtin_amdgcn_mfma_f32_32x32x16_bf16(PAF(0),VFR(0),o[0],0,0,0), C0,0); \
    VRD2(4,0); SBAR(); GAPB(o[1]=__builtin_amdgcn_mfma_f32_32x32x16_bf16(PAF(0),VFR(4),o[1],0,0,0), C0,2); \
    VRD2(1,4); SBAR(); GAPB(o[0]=__builtin_amdgcn_mfma_f32_32x32x16_bf16(PAF(1),VFR(1),o[0],0,0,0), C0,4); \
    VRD2(5,1); SBAR(); GAPB(o[1]=__builtin_amdgcn_mfma_f32_32x32x16_bf16(PAF(1),VFR(5),o[1],0,0,0), C0,6); \
    VRD2(2,5); SBAR(); GAPB(o[0]=__builtin_amdgcn_mfma_f32_32x32x16_bf16(PAF(2),VFR(2),o[0],0,0,0), C0,8); \
    VRD2(6,2); SBAR(); GAPB(o[1]=__builtin_amdgcn_mfma_f32_32x32x16_bf16(PAF(2),VFR(6),o[1],0,0,0), C0,10); \
    VRD2(3,6); SBAR(); GAPB(o[0]=__builtin_amdgcn_mfma_f32_32x32x16_bf16(PAF(3),VFR(3),o[0],0,0,0), C0,12); \
    VRD2(7,3); SBAR(); GAPB(o[1]=__builtin_amdgcn_mfma_f32_32x32x16_bf16(PAF(3),VFR(7),o[1],0,0,0), C0,14); \
    KRD(GL,0); GAPB(o[2]=__builtin_amdgcn_mfma_f32_32x32x16_bf16(PAF(0),VFR(8),o[2],0,0,0), C1,0); \
    KRD(GL,1); GAPB(o[3]=__builtin_amdgcn_mfma_f32_32x32x16_bf16(PAF(0),VFR(0),o[3],0,0,0), C1,2); \
    GAPB(o[2]=__builtin_amdgcn_mfma_f32_32x32x16_bf16(PAF(1),VFR(4),o[2],0,0,0), C1,4); \
    GAPB(o[3]=__builtin_amdgcn_mfma_f32_32x32x16_bf16(PAF(1),VFR(1),o[3],0,0,0), C1,6); \
    GAPB(o[2]=__builtin_amdgcn_mfma_f32_32x32x16_bf16(PAF(2),VFR(5),o[2],0,0,0), C1,8); \
    GAPB(o[3]=__builtin_amdgcn_mfma_f32_32x32x16_bf16(PAF(2),VFR(2),o[3],0,0,0), C1,10); \
    GAPB(o[2]=__builtin_amdgcn_mfma_f32_32x32x16_bf16(PAF(3),VFR(6),o[2],0,0,0), C1,12); \
    GAPB(o[3]=__builtin_amdgcn_mfma_f32_32x32x16_bf16(PAF(3),VFR(3),o[3],0,0,0), C1,14); \
    }while(0)
  int t=1;
  for(;t+5<NT;t+=2){
    STEP(pB0,pB1,pA0,pA1,t,true,true,true);     WAIT_BAR(3); RESC(); ROT();
    STEP(pA0,pA1,pB0,pB1,t+1,true,true,true);   WAIT_BAR(3); RESC(); ROT();
  }
  #define ENDW(tt) do{ if((tt)+3<NT){WAIT_BAR(3);} else if((tt)+2<NT){WAIT_BAR(2);} else {WAIT_BAR(0);} }while(0)
  for(;t+1<NT;t+=2){
    STEP(pB0,pB1,pA0,pA1,t,(t+3<NT),(t+1<NT),(t+1<NT));       ENDW(t);   RESC(); ROT();
    STEP(pA0,pA1,pB0,pB1,t+1,(t+4<NT),(t+2<NT),(t+2<NT));     ENDW(t+1); RESC(); ROT();
  }
  STEP(pB0,pB1,pA0,pA1,NT-1,false,false,false); RESC();
  { float sacc=pB0[0]+pB0[1]; _Pragma("unroll") for(int r=2;r<16;++r)sacc+=pB0[r]; _Pragma("unroll") for(int r=0;r<16;++r)sacc+=pB1[r]; l_reg+=sacc;
    pw0=(u32x4){PKW(pB0,0),PKW(pB0,2),PKW(pB0,4),PKW(pB0,6)};pw1=(u32x4){PKW(pB0,8),PKW(pB0,10),PKW(pB0,12),PKW(pB0,14)};pw2=(u32x4){PKW(pB1,0),PKW(pB1,2),PKW(pB1,4),PKW(pB1,6)};pw3=(u32x4){PKW(pB1,8),PKW(pB1,10),PKW(pB1,12),PKW(pB1,14)};
    SBAR(); pv128(o,vb0+4*sl_cur,PAF(0),PAF(1),PAF(2),PAF(3)); }
  #undef PKW
  #undef PAF
  #undef VFR
  #undef VRD2
  #undef PIN
  #undef MX3
  #undef GAPA
  #undef GAPB
  #undef EX
  #undef VRD
  #undef KRD
  #undef STEP
  #undef ENDW
  {auto rr=__builtin_amdgcn_permlane32_swap(__float_as_uint(l_reg),__float_as_uint(l_reg),false,false);l_reg=__uint_as_float(rr[0])+__uint_as_float(rr[1]);}
  const int lane_e=lane_id_asm(),r32e=lane_e&31,hie=lane_e>>5;
  if(hie==0)wsf[32+r32e]=l_reg;asm volatile("s_waitcnt lgkmcnt(0)":::"memory");
  float rli[16];
  #pragma unroll
  for(int r=0;r<16;++r)rli[r]=__builtin_amdgcn_rcpf(wsf[32+crow(r,hie)]);
  float*st=stash+(size_t)wid*4096+lane_e*4;
  if(cpass==0){
    #pragma unroll
    for(int d0=0;d0<4;++d0)
      #pragma unroll
      for(int q4=0;q4<4;++q4){ typedef float f32x4_t __attribute__((ext_vector_type(4)));
        const f32x4_t v={o[d0][4*q4]*rli[4*q4],o[d0][4*q4+1]*rli[4*q4+1],o[d0][4*q4+2]*rli[4*q4+2],o[d0][4*q4+3]*rli[4*q4+3]};
        *(f32x4_t*)(st+(d0*4+q4)*256)=v; }
  } else {
    typedef float f32x4_t __attribute__((ext_vector_type(4)));
    float ss[16];
    #pragma unroll
    for(int r=0;r<16;++r)ss[r]=0.f;
    #pragma unroll
    for(int d0=0;d0<4;++d0)
      #pragma unroll
      for(int q4=0;q4<4;++q4){ const f32x4_t a=*(const f32x4_t*)(st+(d0*4+q4)*256);
        #pragma unroll
        for(int i=0;i<4;++i){ const int r=4*q4+i; const float v=a[i]-lam*(o[d0][r]*rli[r]); o[d0][r]=v; ss[r]+=v*v; } if(q4==3)asm volatile("":::"memory"); }
    #pragma unroll
    for(int r=0;r<16;++r){ float s=ss[r]; s+=__shfl_xor(s,1); s+=__shfl_xor(s,2); s+=__shfl_xor(s,4); s+=__shfl_xor(s,8); s+=__shfl_xor(s,16); ss[r]=0.8f/sqrtf(s*(1.0f/128.0f)+1e-6f); }
    float gsub[4];
    #pragma unroll
    for(int d0=0;d0<4;++d0)gsub[d0]=subg[d0*32+r32e];
    asm volatile("s_waitcnt lgkmcnt(0)\n\ts_barrier":::"memory");
    bf16*Ow=Ou+(long)(wid*QBLK)*opitch;
    bf16*stg=(bf16*)shm+wid*4096;
    #pragma unroll
    for(int r=0;r<16;++r){const int orow=crow(r,hie);
      #pragma unroll
      for(int d0=0;d0<4;++d0)stg[orow*128+d0*32+r32e]=__float2bfloat16(o[d0][r]*ss[r]*gsub[d0]);}
    asm volatile("s_waitcnt lgkmcnt(0)":::"memory");
    #pragma unroll
    for(int i=0;i<8;++i){const int row=i*4+(lane_e>>4),ch=lane_e&15; const u32x4 v=*(const u32x4*)(stg+row*128+ch*8); ATTN_STORE16(Ow+(long)row*opitch+ch*8,v);}
  }
  asm volatile("s_waitcnt lgkmcnt(0)\n\ts_barrier":::"memory");
 }
  #undef DMA_K
  #undef DMA_V
  #undef CMASK
  #undef START
  #undef RESC
  #undef ROT
}
constexpr float REFOFF=3.0f, LMIN=8.0f; constexpr int L9B_K=0, L9B_V=NSLOT*SLOTK8, L9B_WS=65536, L9B_FLAG=L9B_WS+NW*64*4, L9B_BYTES=L9B_FLAG+64;
template<int THRL,bool FIXREF=false> __device__ __forceinline__ bool attn_unit128_q8v(const unsigned char*Qu8,const unsigned char*__restrict__ Kb8,const unsigned char*__restrict__ Vb8,bf16*Ou,int opitch,char*shm,int wid,float*stash,float lam,const float*subg,int pass_lo,int pass_hi,float ref){
  static_assert(FIXREF,"constant reference only"); bool bad_any=false;
  const int lane=lane_id_asm(),r32=lane&31,hi=lane>>5;
  const bool kw=wid<4;
 for(int cpass=pass_lo;cpass<pass_hi;++cpass){
  const int lane_p=lane_id_asm(),r32p=lane_p&31,hip=lane_p>>5;
  const unsigned char*Qw8=Qu8+(long)(wid*QBLK)*P8+cpass*64;
  const unsigned char*Kh8=Kb8+cpass*64;
  const unsigned lds0=(unsigned)(uintptr_t)shm;
  float*wsf=(float*)(shm+L9B_WS)+wid*64;
  const unsigned char*ksrc=Kh8+(long)lane_p*P8+(wid&3)*16;
  const int vkey_=8*wid+(lane_p>>3), vc_=(lane_p&7)^((((vkey_>>1)&1)<<1)|(((vkey_>>3)&1)<<2));
  const unsigned char*vsrc=Vb8+(long)vkey_*PV8+vc_*16;
  const unsigned kdst=lds0+L9B_K+(wid&3)*1024, vdst=lds0+L9B_V+wid*1024;
  #define DMA_K(t,slot) glds16(ksrc+(long)(t)*KVBLK*P8,(unsigned)__builtin_amdgcn_readfirstlane(kdst+(slot)))
  #define DMA_V(t,slot) glds16(vsrc+(long)(t)*KVBLK*PV8,(unsigned)__builtin_amdgcn_readfirstlane(vdst+2*(slot)))
  #define WAITB(nk,nv) do{ if(kw){WAIT_BAR(nk);}else{WAIT_BAR(nv);} }while(0)
  v8i32_t kf8[2];
  const lds_cptr shm3=(lds_cptr)shm; const lds_cptr kp0=shm3+L9B_K+hip*2048+r32p*16;
  const int vq_=(lane_p&15)>>1, vkey0_=(vq_&3)+8*(vq_>>2)+4*hip, vsw_=(((vq_>>1)&1)<<1)|(((vq_>>2)&1)<<2), vg_=(lane_p>>4)&1;
  const lds_cptr vq0=shm3+L9B_V+vkey0_*128+(lane_p&1)*8;
  const lds_cptr vp0_=vq0+((0+vg_)^vsw_)*16, vp1_=vq0+((2+vg_)^vsw_)*16, vp2_=vq0+((4+vg_)^vsw_)*16, vp3_=vq0+((6+vg_)^vsw_)*16;
  if(kw){DMA_K(0,0);} DMA_V(0,0); if(kw){DMA_K(1,SLOTK8);}
  const v8i32_t q8=*reinterpret_cast<const v8i32_t*>(Qw8+(long)r32p*P8+hip*32);
  float zf_; asm volatile("v_mov_b32 %0, 0":"=v"(zf_));
  float mhat=0.f,l_reg=0.f,smax=0.f;f32x16 o[4];
  #pragma unroll
  for(int r=0;r<16;++r){o[0][r]=zf_;o[1][r]=zf_;o[2][r]=zf_;o[3][r]=zf_;}
  f32x16 negm;
  #pragma unroll
  for(int r=0;r<16;++r)negm[r]=zf_-ref;
  asm volatile("":"+v"(negm));
  #define CMASK(P0,P1,t) do{}while(0)
  bool resc=false;
  #define START(P0,P1) do{ resc=false; if constexpr(!FIXREF){ const float rm=rowmax(P0,P1); \
    { const float dl=rm-REFOFF; mhat=fadd_s(mhat,dl);     \
      _Pragma("unroll") for(int r=0;r<16;++r){P0[r]=fsub_s(P0[r],dl);P1[r]=fsub_s(P1[r],dl);} \
      _Pragma("unroll") for(int r=0;r<16;++r)negm[r]=-mhat; asm volatile("":"+v"(negm)); } } \
    _Pragma("unroll") for(int r=0;r<16;++r)P0[r]=__builtin_amdgcn_exp2f(P0[r]); }while(0)
  #define RESC() do{ if(resc){ asm volatile("s_waitcnt lgkmcnt(0)":::"memory"); \
      _Pragma("unroll") for(int d_=0;d_<4;++d_) _Pragma("unroll") for(int r=0;r<16;++r)o[d_][r]*=wsf[crow(r,hi)]; } }while(0)
  f32x16 pA0,pA1,pB0,pB1;
  int sl_prev=0,sl_cur=0,sl_next=SLOTK8;
  #define ROT() do{sl_prev=sl_cur;sl_cur=sl_next;sl_next=(sl_next==(NSLOT-1)*SLOTK8)?0:sl_next+SLOTK8;}while(0)
  if(kw){DMA_K(2,2*SLOTK8);}
  WAITB(3,2);
  qkt8(pA0,pA1,kp0,q8,negm);asm volatile("s_nop 15\n\ts_nop 7":"+v"(pA0),"+v"(pA1));CMASK(pA0,pA1,0);
  START(pA0,pA1);
  _Pragma("unroll") for(int r=0;r<16;++r)pA1[r]=__builtin_amdgcn_exp2f(pA1[r]);
  WAIT_BAR(0);
  if(kw){DMA_K(3,0);} DMA_V(1,SLOTK8);
  ROT();
  kf8[0]=kfrag8(kp0+sl_cur); kf8[1]=kfrag8(kp0+sl_cur+512);
  WAITB(2,1);
  v2i32_t vA0,vA1,vA2,vA3,vB0,vB1,vB2,vB3; v8i32_t pw8=v8i32_t{};
  v8i32_t ones8; { int o1_; asm volatile("v_mov_b32 %0, 0x38383838":"=v"(o1_)); ones8=(v8i32_t){o1_,o1_,o1_,o1_,o1_,o1_,o1_,o1_}; } f32x16 ls; _Pragma("unroll") for(int r=0;r<16;++r)ls[r]=zf_;
  #define PK4(P,B) __builtin_amdgcn_cvt_pk_bf8_f32(P[B+2],P[B+3],__builtin_amdgcn_cvt_pk_bf8_f32(P[B],P[B+1],0,false),true)
  #define PK4I(D,P,B) do{ D=__builtin_amdgcn_cvt_pk_bf8_f32(P[B],P[B+1],D,false); D=__builtin_amdgcn_cvt_pk_bf8_f32(P[B+2],P[B+3],D,true); }while(0)
  #define MFMAP(a,b,c) __builtin_amdgcn_mfma_scale_f32_32x32x64_f8f6f4(a,b,c,1,0,0,0,0,0)
  #define VT8(p) __builtin_amdgcn_ds_read_tr8_b64_v2i32((__attribute__((address_space(3))) v2i32_t*)(p))
  #define V8A() (v8i32_t){vA0[0],vA0[1],vA1[0],vA1[1],vA2[0],vA2[1],vA3[0],vA3[1]}
  #define V8B() (v8i32_t){vB0[0],vB0[1],vB1[0],vB1[1],vB2[0],vB2[1],vB3[0],vB3[1]}
  #define RDA(vp) do{ const lds_cptr p_=(vp)+2*sl_prev; vA0=VT8(p_); vA1=VT8(p_+2048); vA2=VT8(p_+4096); vA3=VT8(p_+6144); }while(0)
  #define RDB(vp) do{ const lds_cptr p_=(vp)+2*sl_prev; vB0=VT8(p_); vB1=VT8(p_+2048); vB2=VT8(p_+4096); vB3=VT8(p_+6144); }while(0)
  #define PIN(x) asm volatile("":"+v"(x))
  #define MX3(a,b,c) __builtin_fmaxf(__builtin_fmaxf((a),(b)),(c))
  #define EX(v) __builtin_amdgcn_exp2f(v)
  #define EX4(X,B) do{ X[B]=EX(X[B]); X[B+1]=EX(X[B+1]); X[B+2]=EX(X[B+2]); X[B+3]=EX(X[B+3]); PIN(X); SBAR(); }while(0)
  #define KRD(G,j) do{ if(G){ kf8[j]=kfrag8(kp0+sl_next+(j)*512); SBAR(); } }while(0)
  #define STEP(C0,C1,P0,P1,t,GK,GV,GL) do{ SBAR(); \
    { const lds_cptr p_=vp0_+2*sl_prev; vA0=VT8(p_); vA1=VT8(p_+2048); } SBAR(); \
    C0=MFMA8(kf8[0],q8,negm); \
    PK4I(pw8[0],P0,0); PK4I(pw8[1],P0,4); PIN(pw8); SBAR(); \
    { const lds_cptr p_=vp0_+2*sl_prev; vA2=VT8(p_+4096); vA3=VT8(p_+6144); } SBAR(); \
    PK4I(pw8[2],P0,8); PK4I(pw8[3],P0,12); PIN(pw8); SBAR(); \
    { const lds_cptr p_=vp1_+2*sl_prev; vB0=VT8(p_); vB1=VT8(p_+2048); } SBAR(); \
    C1=MFMA8(kf8[1],q8,negm); \
    PK4I(pw8[4],P1,0); PK4I(pw8[5],P1,4); PIN(pw8); SBAR(); \
    { const lds_cptr p_=vp1_+2*sl_prev; vB2=VT8(p_+4096); vB3=VT8(p_+6144); } SBAR(); \
    PK4I(pw8[6],P1,8); PK4I(pw8[7],P1,12); PIN(pw8); SBAR(); \
    if(GK){ if(kw){DMA_K((t)+3,sl_cur);} } if(GV){DMA_V((t)+1,sl_next);} \
    CMASK(C0,C1,t); \
    SBAR(); \
    ls=MFMAP(pw8,ones8,ls); o[0]=MFMAP(pw8,V8A(),o[0]); SBAR(); RDA(vp2_); SBAR(); EX4(C0,0); EX4(C0,4); \
    o[1]=MFMAP(pw8,V8B(),o[1]); SBAR(); RDB(vp3_); SBAR(); EX4(C0,8); EX4(C0,12); \
    KRD(GL,0); \
    o[2]=MFMAP(pw8,V8A(),o[2]); SBAR(); EX4(C1,0); EX4(C1,4); \
    KRD(GL,1); \
    o[3]=MFMAP(pw8,V8B(),o[3]); SBAR(); EX4(C1,8); EX4(C1,12); \
    }while(0)
  int t=1;
  for(;t+5<NT;t+=2){
    STEP(pB0,pB1,pA0,pA1,t,true,true,true);     WAITB(2,1); RESC(); ROT();
    STEP(pA0,pA1,pB0,pB1,t+1,true,true,true);   WAITB(2,1); RESC(); ROT();
  }
  #define ENDW(tt) do{ if((tt)+3<NT){WAITB(2,1);} else if((tt)+2<NT){WAIT_BAR(1);} else {WAIT_BAR(0);} }while(0)
  for(;t+1<NT;t+=2){
    STEP(pB0,pB1,pA0,pA1,t,(t+3<NT),(t+1<NT),(t+1<NT));       ENDW(t);   RESC(); ROT();
    STEP(pA0,pA1,pB0,pB1,t+1,(t+4<NT),(t+2<NT),(t+2<NT));     ENDW(t+1); RESC(); ROT();
  }
  STEP(pB0,pB1,pA0,pA1,NT-1,false,false,false); RESC();
  {
    pw8=(v8i32_t){PK4(pB0,0),PK4(pB0,4),PK4(pB0,8),PK4(pB0,12),PK4(pB1,0),PK4(pB1,4),PK4(pB1,8),PK4(pB1,12)};
    const int sl_keep=sl_prev; sl_prev=sl_cur;
    RDA(vp0_); RDB(vp1_); SBAR(); ls=MFMAP(pw8,ones8,ls); o[0]=MFMAP(pw8,V8A(),o[0]); o[1]=MFMAP(pw8,V8B(),o[1]); SBAR();
    RDA(vp2_); RDB(vp3_); SBAR(); o[2]=MFMAP(pw8,V8A(),o[2]); o[3]=MFMAP(pw8,V8B(),o[3]); sl_prev=sl_keep; }
  #undef PK4
  #undef PK4I
  #undef MFMAP
  #undef VT8
  #undef V8A
  #undef V8B
  #undef RDA
  #undef RDB
  #undef PIN
  #undef MX3
  #undef EX
  #undef EX4
  #undef KRD
  #undef STEP
  #undef ENDW
  {auto rr=__builtin_amdgcn_permlane32_swap(__float_as_uint(l_reg),__float_as_uint(l_reg),false,false);l_reg=__uint_as_float(rr[0])+__uint_as_float(rr[1]);}
  const int lane_e=lane_id_asm(),r32e=lane_e&31,hie=lane_e>>5;
  { float nz_=0.f; _Pragma("unroll") for(int d_=0;d_<4;++d_) _Pragma("unroll") for(int r=0;r<16;++r)nz_=__builtin_fmaf(o[d_][r],0.0f,nz_);     float lmin_=ls[0]; _Pragma("unroll") for(int r=1;r<16;++r)lmin_=__builtin_fminf(lmin_,ls[r]); const bool badl=!(nz_==0.0f)||!(lmin_>=LMIN); const int lf_=lane_id_asm(); if(__any(badl)&&lf_==0)((volatile float*)(shm+L9B_FLAG))[wid]=1.0f; else if(lf_==0)((volatile float*)(shm+L9B_FLAG))[wid]=0.0f; }
  if(hie==0)wsf[32+r32e]=l_reg;asm volatile("s_waitcnt lgkmcnt(0)":::"memory");
  float rli[16];
  #pragma unroll
  for(int r=0;r<16;++r)rli[r]=__builtin_amdgcn_rcpf(ls[r]);
  float*st=stash+(size_t)wid*4096+lane_e*4;
  if(cpass==0){
    #pragma unroll
    for(int d0=0;d0<4;++d0)
      #pragma unroll
      for(int q4=0;q4<4;++q4){ typedef float f32x4_t __attribute__((ext_vector_type(4)));
        const f32x4_t v={o[d0][4*q4]*rli[4*q4],o[d0][4*q4+1]*rli[4*q4+1],o[d0][4*q4+2]*rli[4*q4+2],o[d0][4*q4+3]*rli[4*q4+3]};
        *(f32x4_t*)(st+(d0*4+q4)*256)=v; }
  } else {
    typedef float f32x4_t __attribute__((ext_vector_type(4)));
    float ss[16];
    #pragma unroll
    for(int r=0;r<16;++r)ss[r]=0.f;
    #pragma unroll
    for(int d0=0;d0<4;++d0)
      #pragma unroll
      for(int q4=0;q4<4;++q4){ const f32x4_t a=*(const f32x4_t*)(st+(d0*4+q4)*256);
        #pragma unroll
        for(int i=0;i<4;++i){ const int r=4*q4+i; const float v=a[i]-lam*(o[d0][r]*rli[r]); o[d0][r]=v; ss[r]+=v*v; } if(q4==3)asm volatile("":::"memory"); }
    #pragma unroll
    for(int r=0;r<16;++r){ float s=ss[r]; s+=__shfl_xor(s,1); s+=__shfl_xor(s,2); s+=__shfl_xor(s,4); s+=__shfl_xor(s,8); s+=__shfl_xor(s,16); ss[r]=0.8f/sqrtf(s*(1.0f/128.0f)+1e-6f); }
    float gsub[4];
    #pragma unroll
    for(int d0=0;d0<4;++d0)gsub[d0]=subg[d0*32+r32e];
    asm volatile("s_waitcnt lgkmcnt(0)\n\ts_barrier":::"memory");
    bf16*Ow=Ou+(long)(wid*QBLK)*opitch;
    bf16*stg=(bf16*)shm+wid*4096;
    #pragma unroll
    for(int r=0;r<16;++r){const int orow=crow(r,hie);
      #pragma unroll
      for(int d0=0;d0<4;++d0)stg[orow*128+d0*32+r32e]=__float2bfloat16(o[d0][r]*ss[r]*gsub[d0]);}
    asm volatile("s_waitcnt lgkmcnt(0)":::"memory");
    #pragma unroll
    for(int i=0;i<8;++i){const int row=i*4+(lane_e>>4),ch=lane_e&15; const u32x4 v=*(const u32x4*)(stg+row*128+ch*8); ATTN_STORE16(Ow+(long)row*opitch+ch*8,v);}
  }
  asm volatile("s_waitcnt lgkmcnt(0)\n\ts_barrier":::"memory");
  { const float*fl_=(const float*)(shm+L9B_FLAG); float fs_=0.f; _Pragma("unroll") for(int w_=0;w_<NW;++w_)fs_+=fl_[w_]; bad_any=bad_any||(__builtin_amdgcn_readfirstlane(__float_as_uint(fs_))!=0u); }
 }
  return bad_any;
  #undef DMA_K
  #undef DMA_V
  #undef WAITB
  #undef CMASK
  #undef START
  #undef RESC
  #undef ROT
}
constexpr int ATTN_LDS_BYTES=LDS_BYTES;
#undef SBAR
#undef WAIT_BAR
}
#define GAS __attribute__((address_space(1)))
#define LAS __attribute__((address_space(3)))
typedef unsigned short bf16;
typedef unsigned v4u __attribute__((ext_vector_type(4)));
typedef float f32x4 __attribute__((ext_vector_type(4)));
typedef short bf16x8 __attribute__((ext_vector_type(8)));
typedef GAS unsigned gu32;
typedef GAS unsigned long long gu64;
#define RLX_AGENT __ATOMIC_RELAXED, __HIP_MEMORY_SCOPE_AGENT
#define LDS_WAIT() asm volatile("s_waitcnt lgkmcnt(0)" ::: "memory")
#define VM_WAIT() asm volatile("s_waitcnt vmcnt(0)" ::: "memory")
__device__ __forceinline__ unsigned long long rt() { return __builtin_amdgcn_s_memrealtime(); }
__device__ __forceinline__ unsigned f2bf(float f) { unsigned u = __builtin_bit_cast(unsigned, f); return (u + 0x7fffu + ((u >> 16) & 1u)) >> 16; }
__device__ __forceinline__ unsigned pk2(float lo, float hi) { return f2bf(lo) | (f2bf(hi) << 16); }

#define XB_TMO      128
#define XB_XCNT(j)  (256  + 64 * (j))
#define XB_XSUB(j)  (1280 + 64 * (j))
#define XB_XGEN(j)  (2304 + 64 * (j))
#define XB_TOP      3328
#define XB_TOPGEN   3392
#define XCD_BAR_WORDS 3456
#define XB_SPIN_CAP (1u << 18)

__device__ __forceinline__ unsigned xb_ld(unsigned* p)              { return __hip_atomic_load(p, __ATOMIC_RELAXED, __HIP_MEMORY_SCOPE_AGENT); }
__device__ __forceinline__ unsigned xb_add(unsigned* p, unsigned v) { return __hip_atomic_fetch_add(p, v, __ATOMIC_RELAXED, __HIP_MEMORY_SCOPE_AGENT); }
__device__ __forceinline__ unsigned xb_xcc_id() { return (unsigned)__builtin_amdgcn_s_getreg((3 << 11) | 20) & 0xFu; }
#define XB_SPIN(cond, bar) do { unsigned _sp = 0; while (cond) { __builtin_amdgcn_s_sleep(1); \
    if ((++_sp & 255u) == 0u) { if (xb_ld(&(bar)[XB_TMO])) break; if (_sp > XB_SPIN_CAP) { atomicAdd(&(bar)[XB_TMO], 1u); break; } } } } while (0)

struct XcdBarrier {
    unsigned* bar; unsigned x;
    int wv;
    volatile LAS unsigned* st;
};

__device__ __forceinline__ XcdBarrier xcd_barrier_post(unsigned* bar, volatile LAS unsigned* st) {
    XcdBarrier b; b.bar = bar; b.x = xb_xcc_id(); b.st = st; b.wv = __builtin_amdgcn_readfirstlane(threadIdx.x >> 6);
    if (threadIdx.x == 0) (void)xb_add(&bar[XB_XCNT(b.x)], 1u);
    return b;
}
__device__ __forceinline__ void xcd_barrier_complete(unsigned* bar, unsigned x, unsigned& nloc, unsigned& nx) {
    const unsigned G = gridDim.x * gridDim.y * gridDim.z;
    unsigned sum, cnt, mine, sp = 0u;
    for (;;) {
        sum = 0u; cnt = 0u; mine = 0u;
#pragma unroll
        for (unsigned j = 0; j < 16; ++j) { const unsigned c = xb_ld(&bar[XB_XCNT(j)]); sum += c; cnt += (c > 0u) ? 1u : 0u; mine = (j == x) ? c : mine; }
        if (sum == G) break;
        __builtin_amdgcn_s_sleep(1);
        if ((++sp & 255u) == 0u) { if (xb_ld(&bar[XB_TMO])) break; if (sp > XB_SPIN_CAP) { atomicAdd(&bar[XB_TMO], 1u); break; } }
    }
    nloc = mine > 0u ? mine : 1u; nx = cnt > 0u ? cnt : 1u;
}

__device__ __forceinline__ void xcd_barrier(const XcdBarrier& b) {
    asm volatile("s_waitcnt vmcnt(0)" ::: "memory");
    __syncthreads();
    if (b.wv == 0 && lane_id_asm() == 0) {
        unsigned* bar = b.bar;
        __builtin_amdgcn_s_waitcnt(0);
        unsigned nloc = b.st[0], nx = b.st[1];
        if (nloc == 0u) { xcd_barrier_complete(bar, b.x, nloc, nx); b.st[0] = nloc; b.st[1] = nx; }
        const unsigned old = xb_add(&bar[XB_XSUB(b.x)], 1u);
        const unsigned gen = old / nloc;
        if (old + 1u == (gen + 1u) * nloc) {
            __builtin_amdgcn_fence(__ATOMIC_RELEASE, "agent");
            asm volatile("s_waitcnt vmcnt(0)" ::: "memory");
            const unsigned og = xb_add(&bar[XB_TOP], 1u);
            const unsigned tg = og / nx;
            if (og + 1u == (tg + 1u) * nx) xb_add(&bar[XB_TOPGEN], 1u);
            else XB_SPIN(xb_ld(&bar[XB_TOPGEN]) == tg, bar);
            __builtin_amdgcn_fence(__ATOMIC_ACQUIRE, "agent");
            xb_add(&bar[XB_XGEN(b.x)], 1u);
            asm volatile("s_waitcnt vmcnt(0)" ::: "memory");
        } else {
            XB_SPIN(xb_ld(&bar[XB_XGEN(b.x)]) == gen, bar);
            __builtin_amdgcn_fence(__ATOMIC_ACQUIRE, "agent");
            asm volatile("s_waitcnt vmcnt(0)" ::: "memory");
        }
    }
    __syncthreads();
}
__device__ __forceinline__ float wave_sum(float v) {
#pragma unroll
    for (int o = 1; o < 64; o <<= 1) v += __shfl_xor(v, o);
    return v;
}
constexpr int NWAVES = 8;
#ifndef MK_PER_PHASE
#define MK_PER_PHASE 0
#endif
constexpr int NPH = 10;
constexpr int DM_ = 1024, NB_ = 2, T_ = 8192, CTXL = 256, KEYS = CTXL + T_  , MROWS = NB_ * KEYS  , NTOK = NB_ * T_, QKVC = 2304, NE = 32, NMOD = 6 * DM_;
constexpr int SORT_ROWS = NTOK * 4 + NE * 256;
constexpr size_t MiB = 1u << 20;
constexpr size_t WS_CTL = 0, CTL_ZERO_BYTES = 64 * 1024;
constexpr size_t WS_MOD = 1 * MiB;
constexpr size_t WS_ROPE = WS_MOD + 3 * NMOD * 4;
constexpr size_t WS_SE = 2 * MiB;
constexpr size_t WS_SP = WS_SE + (size_t)NTOK * 4 * 4;
constexpr size_t WS_LTOK = 3 * MiB;
constexpr size_t WS_LGATE = 5 * MiB;
constexpr size_t WS_WQKV = 8 * MiB;
constexpr size_t WS_CB = 1 * MiB + 128 * 1024;
constexpr size_t WS_WO = 669 * MiB;
constexpr size_t WS_WIN = 16 * MiB;
constexpr size_t WS_WOUT = 144 * MiB;
constexpr size_t WS_XN = 208 * MiB;
constexpr size_t WS_QKV = 242 * MiB;
constexpr size_t WS_DT = 317 * MiB;
constexpr size_t WS_MIX = 349 * MiB;
constexpr size_t WS_ACT = 381 * MiB;
constexpr size_t WS_Y = 525 * MiB;
constexpr size_t WS_QK8 = 671 * MiB;
constexpr size_t WS_V8 = 96 * MiB;
constexpr size_t WS_END = 699 * MiB;
static_assert(WS_XN + (size_t)MROWS * 1024 * 2 <= WS_QKV && WS_QKV + (size_t)MROWS * QKVC * 2 <= WS_DT && WS_ACT + (size_t)SORT_ROWS * 1024 * 2 <= WS_Y && WS_Y + (size_t)SORT_ROWS * 1024 * 2 <= WS_END, "d_ws map");
constexpr int CW_CNT = 64;
constexpr int CW_MT = 8192;
constexpr int CW_MT5 = 9216;
constexpr int CW_XOK = 99;
constexpr int CW_NMAX = 128;
static_assert(true, ""); constexpr int CW_BAR = 4096;
constexpr int RING_OFF = 0, RING_BYTES = 131072;
constexpr int LDSCTL_OFF = RING_BYTES, MISC_OFF = LDSCTL_OFF + 320;
constexpr int IDBUF_OFF = RING_BYTES + 1024;
constexpr int TP_OFF = RING_BYTES + 9216;
constexpr int TE_OFF = TP_OFF + 256;
constexpr int XSCR_OFF = RING_BYTES + 10240;
constexpr int LDS_BYTES = 147456;
static_assert(XSCR_OFF + 4096 <= LDS_BYTES, "LDS map");

struct Frame {
    LAS unsigned char* lds; volatile LAS unsigned* MISC; gu32* ctl;
    int wave, vcu, G;
    const float* in[21]; float* out; unsigned char* ws;
};
__device__ __forceinline__ void build_tp(Frame& F) {
    LAS int* tp = (LAS int*)(F.lds + TP_OFF); const int lane = lane_id_asm();
    __syncthreads();
    if (F.wave == 0) {
        const int t = lane < NE ? (((int)__hip_atomic_load(F.ctl + CW_CNT + lane, RLX_AGENT) + 255) >> 8) : 0; int s = t;
#pragma unroll
        for (int o = 1; o < 32; o <<= 1) { const int u = __shfl_up(s, o); if (lane >= o) s += u; }
        if (lane < NE) { tp[lane] = s - t; LAS unsigned char* te = (LAS unsigned char*)(F.lds + TE_OFF); for (int g_ = s - t; g_ < s; ++g_) te[g_] = (unsigned char)lane; }
        if (lane == NE - 1) tp[NE] = s;
    }
    __syncthreads();
}
__device__ __forceinline__ void transpose_item(const float* W, int K, int N, bf16* WT, int k0, int n0, int wt_row0, LAS float* scr, int lane) {
    float t_[32];
#pragma unroll
    for (int i = 0; i < 32; ++i) t_[i] = W[(size_t)(k0 + 2 * i + (lane >> 5)) * N + n0 + (lane & 31)];
#pragma unroll
    for (int i = 0; i < 32; ++i) scr[(2 * i + (lane >> 5)) * 33 + (lane & 31)] = t_[i];
    LDS_WAIT(); asm volatile("" ::: "memory");
    const int c = lane & 7;
#pragma unroll
    for (int j = 0; j < 4; ++j) { const int n = (lane >> 3) + 8 * j; const LAS float* s = scr + (8 * c) * 33 + n;
        v4u o; o.x = pk2(s[0 * 33], s[1 * 33]); o.y = pk2(s[2 * 33], s[3 * 33]); o.z = pk2(s[4 * 33], s[5 * 33]); o.w = pk2(s[6 * 33], s[7 * 33]);
        *(GAS v4u*)(WT + (size_t)(wt_row0 + n) * K + k0 + 8 * c) = o; }
    LDS_WAIT(); asm volatile("" ::: "memory");
}
__device__ __forceinline__ void transpose_item_f8(const float* W, int K, int N, unsigned char* WT, int k0, int n0, int wt_row0, LAS float* scr, int lane, const float* kmul = nullptr, const float* kadd1 = nullptr, bool qmap = false) {
    float t_[32];
#pragma unroll
    for (int i = 0; i < 32; ++i) t_[i] = W[(size_t)(k0 + 2 * i + (lane >> 5)) * N + n0 + (lane & 31)];
    if (kmul) {
#pragma unroll
        for (int i = 0; i < 32; ++i) { const int k = k0 + 2 * i + (lane >> 5); t_[i] *= kmul[k] * (1.0f + kadd1[k]); } }
#pragma unroll
    for (int i = 0; i < 32; ++i) scr[(2 * i + (lane >> 5)) * 33 + (lane & 31)] = t_[i];
    LDS_WAIT(); asm volatile("" ::: "memory");
    const int c = lane & 3;
#pragma unroll
    for (int j = 0; j < 2; ++j) { const int n = (lane >> 2) + 16 * j; const LAS float* s = scr + (16 * c) * 33 + n;
        const int wrow = qmap ? wt_row0 + 128 * (n >> 4) + 16 * ((n & 7) >> 2) + 4 * ((n >> 3) & 1) + (n & 3) : wt_row0 + n;
        v4u o; o.x = pg8::pk4_fp8(s[0 * 33] * pg8::W8_SCALE, s[1 * 33] * pg8::W8_SCALE, s[2 * 33] * pg8::W8_SCALE, s[3 * 33] * pg8::W8_SCALE); o.y = pg8::pk4_fp8(s[4 * 33] * pg8::W8_SCALE, s[5 * 33] * pg8::W8_SCALE, s[6 * 33] * pg8::W8_SCALE, s[7 * 33] * pg8::W8_SCALE);
        o.z = pg8::pk4_fp8(s[8 * 33] * pg8::W8_SCALE, s[9 * 33] * pg8::W8_SCALE, s[10 * 33] * pg8::W8_SCALE, s[11 * 33] * pg8::W8_SCALE); o.w = pg8::pk4_fp8(s[12 * 33] * pg8::W8_SCALE, s[13 * 33] * pg8::W8_SCALE, s[14 * 33] * pg8::W8_SCALE, s[15 * 33] * pg8::W8_SCALE);
        *(GAS v4u*)(WT + (size_t)wrow * K + k0 + 16 * c) = o; }
    LDS_WAIT(); asm volatile("" ::: "memory");
}
constexpr int I_QKV = 16 * 72, I_WO = 16 * 32, I_IN = 16 * 64, I_OUT = 16 * 32;
constexpr int CONV_DENSE = I_WO, CONV_ALL = I_WO + NE * I_IN + NE * I_OUT;
__device__ __forceinline__ void conv_items(Frame& F, int first, int count, LAS float* scr, int lane) {
    const int gw = F.vcu * NWAVES + F.wave, NGW = F.G * NWAVES;
    for (int it = first + gw; it < first + count; it += NGW) {
        int r = it;
        if (r < I_WO) { const int kb = r / 32, nb = r % 32; transpose_item(F.in[12], DM_, DM_, (bf16*)(F.ws + WS_WO), 64 * kb, 32 * nb, 32 * nb, scr, lane); continue; } r -= I_WO;
        if (r < NE * I_IN) { const int e = r / I_IN, q = r % I_IN, kb = q / 64, nb = q % 64; const int grp = nb < 32 ? ((nb >> 2) * 8 + (nb & 3)) : (((nb - 32) >> 2) * 8 + 4 + ((nb - 32) & 3));
            transpose_item_f8(F.in[16] + (size_t)e * DM_ * 2048, DM_, 2048, F.ws + WS_WIN + (size_t)e * 2048 * DM_, 64 * kb, 32 * nb, 32 * grp, scr, lane); continue; } r -= NE * I_IN;
        { const int e = r / I_OUT, q = r % I_OUT, kb = q / 32, nb = q % 32;
            transpose_item_f8(F.in[18] + (size_t)e * DM_ * DM_, DM_, DM_, F.ws + WS_WOUT + (size_t)e * DM_ * DM_, 64 * kb, 32 * nb, 32 * nb, scr, lane); }
    }
}
__device__ __forceinline__ void cx_desc(const Frame& F, int it, const float*& src, int& N, unsigned char*& dst) {
    int r = it - I_WO;
    if (r < NE * I_IN) { const int e = r / I_IN, q = r % I_IN, kb = q / 64, nb = q % 64; const int grp = nb < 32 ? ((nb >> 2) * 8 + (nb & 3)) : (((nb - 32) >> 2) * 8 + 4 + ((nb - 32) & 3));
        N = 2048; src = F.in[16] + (size_t)e * DM_ * 2048 + (size_t)(64 * kb) * 2048 + 32 * nb; dst = F.ws + WS_WIN + (size_t)e * 2048 * DM_ + (size_t)(32 * grp) * DM_ + 64 * kb; }
    else { r -= NE * I_IN; const int e = r / I_OUT, q = r % I_OUT, kb = q / 32, nb = q % 32;
        N = DM_; src = F.in[18] + (size_t)e * DM_ * DM_ + (size_t)(64 * kb) * DM_ + 32 * nb; dst = F.ws + WS_WOUT + (size_t)e * DM_ * DM_ + (size_t)(32 * nb) * DM_ + 64 * kb; }
}
__device__ __forceinline__ void cx_ld(const Frame& F, int it, int lane, float (&t_)[32]) {
    const float* src; int N; unsigned char* dst; cx_desc(F, it, src, N, dst);
    const float* p = src + (size_t)(lane >> 5) * N + (lane & 31);
#pragma unroll
    for (int i = 0; i < 32; ++i) t_[i] = p[(size_t)(2 * i) * N];
}
__device__ __forceinline__ void cx_st(const Frame& F, int it, int lane, const float (&t_)[32], LAS float* scr) {
    const float* src; int N; unsigned char* dst; cx_desc(F, it, src, N, dst);
#pragma unroll
    for (int i = 0; i < 32; ++i) scr[(2 * i + (lane >> 5)) * 33 + (lane & 31)] = t_[i];
    LDS_WAIT(); asm volatile("" ::: "memory");
    const int c = lane & 3;
#pragma unroll
    for (int j = 0; j < 2; ++j) { const int n = (lane >> 2) + 16 * j; const LAS float* s = scr + (16 * c) * 33 + n;
        v4u o; o.x = pg8::pk4_fp8(s[0 * 33] * pg8::W8_SCALE, s[1 * 33] * pg8::W8_SCALE, s[2 * 33] * pg8::W8_SCALE, s[3 * 33] * pg8::W8_SCALE); o.y = pg8::pk4_fp8(s[4 * 33] * pg8::W8_SCALE, s[5 * 33] * pg8::W8_SCALE, s[6 * 33] * pg8::W8_SCALE, s[7 * 33] * pg8::W8_SCALE);
        o.z = pg8::pk4_fp8(s[8 * 33] * pg8::W8_SCALE, s[9 * 33] * pg8::W8_SCALE, s[10 * 33] * pg8::W8_SCALE, s[11 * 33] * pg8::W8_SCALE); o.w = pg8::pk4_fp8(s[12 * 33] * pg8::W8_SCALE, s[13 * 33] * pg8::W8_SCALE, s[14 * 33] * pg8::W8_SCALE, s[15 * 33] * pg8::W8_SCALE);
        *(GAS v4u*)(dst + (size_t)n * DM_ + 16 * c) = o; }
    LDS_WAIT(); asm volatile("" ::: "memory");
}
__device__ __forceinline__ void conv_experts(Frame& F, LAS float* scr, int lane) {
    const int cvu = (F.G % 8 == 0) ? ((F.vcu & ~7) | ((F.vcu + (F.vcu >> 3)) & 7)) : F.vcu;
    const int gw = cvu * NWAVES + F.wave, NGW = F.G * NWAVES, end = CONV_ALL;
    int it = CONV_DENSE + gw;
    float A_[32], B_[32], C_[32];
    if (it + 2 * NGW < end) {
        cx_ld(F, it, lane, A_); cx_ld(F, it + NGW, lane, B_);
        while (it + 4 * NGW < end) {
            cx_ld(F, it + 2 * NGW, lane, C_); cx_st(F, it, lane, A_, scr);
            cx_ld(F, it + 3 * NGW, lane, A_); cx_st(F, it + NGW, lane, B_, scr);
            cx_ld(F, it + 4 * NGW, lane, B_); cx_st(F, it + 2 * NGW, lane, C_, scr);
            it += 3 * NGW;
        }
        cx_st(F, it, lane, A_, scr); cx_st(F, it + NGW, lane, B_, scr); it += 2 * NGW;
    }
    for (; it < end; it += NGW) { cx_ld(F, it, lane, A_); cx_st(F, it, lane, A_, scr); }
}
__device__ __forceinline__ void p0_prologue(Frame& F) {
    const float* c = F.in[1]; const float* cctx = F.in[3]; const float* w_ada = F.in[4]; const float* b_ada = F.in[5];
    float* mod = (float*)(F.ws + WS_MOD); float* rope = (float*)(F.ws + WS_ROPE);
    LAS float* scr = (LAS float*)(F.lds + RING_OFF + F.wave * 16384);
    const int lane = lane_id_asm(), w = F.wave, tid = w * 64 + lane;
    for (int cg = F.vcu; cg < 192; cg += F.G) {
        for (int i = lane; i < 384; i += 64) { const int v = i >> 7, kk = i & 127; const float s = (v < 2 ? c[v * DM_ + 128 * w + kk] : cctx[128 * w + kk]); scr[i] = s / (1.0f + expf(-s)); }
        LDS_WAIT(); asm volatile("" ::: "memory");
        const int kh = lane >> 5, col = 32 * cg + (lane & 31); float a0 = 0.f, a1 = 0.f, a2 = 0.f;
        float wl_[64];
#pragma unroll
        for (int j = 0; j < 64; ++j) wl_[j] = w_ada[(size_t)(128 * w + 2 * j + kh) * NMOD + col];
#pragma unroll
        for (int j = 0; j < 64; ++j) { const int kk = 2 * j + kh; a0 += scr[kk] * wl_[j]; a1 += scr[128 + kk] * wl_[j]; a2 += scr[256 + kk] * wl_[j]; }
        a0 += __shfl_xor(a0, 32); a1 += __shfl_xor(a1, 32); a2 += __shfl_xor(a2, 32);
        LAS float* xs = (LAS float*)(F.lds + XSCR_OFF);
        if (lane < 32) { xs[w * 96 + lane] = a0; xs[w * 96 + 32 + lane] = a1; xs[w * 96 + 64 + lane] = a2; }
        __syncthreads();
        if (tid < 96) { float s = 0.f; for (int ww = 0; ww < 8; ++ww) s += xs[ww * 96 + tid]; const int v = tid >> 5, cc = 32 * cg + (tid & 31); mod[v * NMOD + cc] = s + b_ada[cc]; }
        __syncthreads();
    }
    for (int i = F.vcu * 8 + tid; i < 2048 && tid < 8; i += F.G * 8) { const int p = i >> 4, f = i & 15; const float invf = (float)pow(10000.0, -(double)f / 16.0); const float ang = (float)p * invf;
        rope[i] = (float)cos((double)ang); rope[2048 + i] = (float)sin((double)ang); }
    { GAS v4u* lt = (GAS v4u*)(F.ws + WS_LTOK); const int n16 = NE * 16384 * 4 / 16; for (int i = F.vcu * NWAVES * 64 + tid; i < n16; i += F.G * NWAVES * 64) lt[i] = (v4u){0u, 0u, 0u, 0u}; }
    conv_items(F, 0, CONV_DENSE, scr, lane);
}
__device__ __forceinline__ void p0_xhat(Frame& F) {
    const float* x = F.in[0]; const float* ctx = F.in[2]; bf16* XN = (bf16*)(F.ws + WS_XN); const float* g1 = F.in[6]; const float* mod = (const float*)(F.ws + WS_MOD);
    const int gw = F.vcu * NWAVES + F.wave, NGW = F.G * NWAVES, lane = lane_id_asm();
    for (int m0 = gw; m0 < MROWS; m0 += 2 * NGW) {
        f32x4 v[2][4]; int mm[2];
#pragma unroll
        for (int u = 0; u < 2; ++u) { const int m = (m0 + u * NGW < MROWS) ? m0 + u * NGW : m0; mm[u] = m; const int b = m / KEYS, i = m % KEYS;
            const float* src = (i < CTXL) ? ctx + ((size_t)b * CTXL + i) * DM_ : x + ((size_t)b * T_ + (i - CTXL)) * DM_;
            const GAS f32x4* xr = (const GAS f32x4*)src + lane;
#pragma unroll
            for (int j = 0; j < 4; ++j) v[u][j] = xr[64 * j]; }
#pragma unroll
        for (int u = 0; u < 2; ++u) { float s = 0.f;
#pragma unroll
            for (int j = 0; j < 4; ++j) s += (v[u][j].x * v[u][j].x + v[u][j].y * v[u][j].y) + (v[u][j].z * v[u][j].z + v[u][j].w * v[u][j].w);
            const float rstd = 1.0f / sqrtf(wave_sum(s) * (1.0f / DM_) + 1e-6f);
            GAS unsigned* o4 = (GAS unsigned*)((unsigned char*)XN + (size_t)mm[u] * DM_) + lane;
            const float* md = mod + (((mm[u] % KEYS) < CTXL) ? 2 : mm[u] / KEYS) * NMOD;
#pragma unroll
            for (int j = 0; j < 4; ++j) { const int cc = 4 * (lane + 64 * j); const f32x4 o = v[u][j] * rstd * (*(const f32x4*)(g1 + cc) * (*(const f32x4*)(md + DM_ + cc) + 1.0f)) + *(const f32x4*)(md + cc);
                o4[64 * j] = pg8::pk4_fp8(o.x, o.y, o.z, o.w); } }
    }
}
__device__ __forceinline__ void p1_wqkv(Frame& F) {
    const float* w = F.in[7];
    LAS float* scr = (LAS float*)(F.lds + RING_OFF + F.wave * 16384);
    const int lane = lane_id_asm(), wv = F.wave;
    const int gw = F.vcu * NWAVES + wv, NGW = F.G * NWAVES;
    for (int it = gw; it < I_QKV; it += NGW) { const int r = it, kb = r / 72, nb = r % 72, pn = nb >> 3, wc = (nb & 7) >> 1, ax = nb & 1;
        transpose_item_f8(w, DM_, QKVC, F.ws + WS_WQKV, 64 * kb, 32 * nb, 256 * pn + 32 * wc + 8 * ax, scr, lane, nullptr, nullptr, true); }
}
__device__ __forceinline__ float bf2f(unsigned short h) { return __builtin_bit_cast(float, (unsigned)h << 16); }
__device__ __forceinline__ void p3_attention(Frame& F, char* lds) {
    using abf = attn_body::bf16;
    const abf* QKV = (const abf*)(F.ws + WS_QKV); abf* MIX = (abf*)(F.ws + WS_MIX);
    const int ordB = (F.vcu >> 5) & 1; const int v8 = F.vcu & 7; const int cpos = v8 == 0 ? 0 : v8 < 3 ? 1 : v8 < 5 ? 2 : v8 < 7 ? 3 : 4; int pos = 0; bool cdone = false;
    bool fixref; { const int l_ = lane_id_asm(); float gq = fabsf(F.in[8][l_]), gk = fabsf(F.in[9][l_]);
#pragma unroll
        for (int o_ = 1; o_ < 64; o_ <<= 1) { gq = fmaxf(gq, __shfl_xor(gq, o_)); gk = fmaxf(gk, __shfl_xor(gk, o_)); }
        fixref = __builtin_amdgcn_readfirstlane((gq * gk <= 8.0f) ? 1 : 0) != 0; }
#define CONV_AT() do { if (!cdone && pos == cpos) { conv_experts(F, (LAS float*)(F.lds + RING_OFF + F.wave * 16384), lane_id_asm()); __syncthreads(); cdone = true; } ++pos; } while (0)
    CONV_AT();
    const float* lamp = F.in[10];
    float lam; { const int lane = lane_id_asm(); lam = expf(wave_sum(lamp[lane] * lamp[64 + lane])) - expf(wave_sum(lamp[128 + lane] * lamp[192 + lane])) + 0.2f; }
#pragma nounroll
    for (int seg = 0; seg < 2; ++seg) {
      if ((seg == 0) != (ordB != 0)) {
        for (int L = F.vcu; L < 16 * 32; L += F.G) {
            const int run = L >> 5, qb = L & 31, b = run >> 3, h = run & 7;
            const abf* kb = QKV + (size_t)b * KEYS * QKVC;
            const unsigned char* k8 = F.ws + WS_QK8 + (size_t)b * KEYS * 1664;
            if (fixref) attn_body::attn_unit_q8v<8, true>(k8 + (size_t)(CTXL + qb * 256) * 1664 + h * 64, k8 + (8 + (h >> 2)) * 64, F.ws + WS_V8 + (size_t)b * KEYS * 640 + (h >> 2) * 64, MIX + ((size_t)b * T_ + qb * 256) * DM_ + h * 64, DM_, lds, F.wave);
            else attn_body::attn_unit_q8<8, false>(k8 + (size_t)(CTXL + qb * 256) * 1664 + h * 64, k8 + (8 + (h >> 2)) * 64, kb + 640 + (h >> 2) * 64, MIX + ((size_t)b * T_ + qb * 256) * DM_ + h * 64, DM_, lds, F.wave);
            CONV_AT();
        }
      } else {
        for (int L = F.vcu; L < 8 * 32; L += F.G) {
            const int bh = L >> 5, qb = L & 31, b = bh >> 2, h = bh & 3;
            const abf* kb = QKV + (size_t)b * KEYS * QKVC;
            const float nq = fmaxf(__uint_as_float(__hip_atomic_load(F.ctl + CW_NMAX + 12 + 2 * h, RLX_AGENT)), __uint_as_float(__hip_atomic_load(F.ctl + CW_NMAX + 13 + 2 * h, RLX_AGENT)));
            const float nk = fmaxf(__uint_as_float(__hip_atomic_load(F.ctl + CW_NMAX + 20 + 2 * h, RLX_AGENT)), __uint_as_float(__hip_atomic_load(F.ctl + CW_NMAX + 21 + 2 * h, RLX_AGENT)));
            const float bound = sqrtf(nq * nk) * pg8::ATT_C2;
            const float ref8 = fmaxf(0.55f * bound - 15.0f, 0.0f);
            const unsigned char* k8 = F.ws + WS_QK8 + (size_t)b * KEYS * 1664;
#pragma nounroll
            for (int pp = 0; pp < 2; ++pp) {
                const bool redo = attn_body::attn_unit128_q8v<8, true>(k8 + (size_t)(CTXL + qb * 256) * 1664 + (10 + 2 * h) * 64, k8 + (18 + 2 * h) * 64, F.ws + WS_V8 + (size_t)b * KEYS * 640 + 128 + h * 128, MIX + ((size_t)b * T_ + qb * 256) * DM_ + 512 + h * 128, DM_, lds, F.wave,
                                           (float*)(F.ws + WS_DT) + (size_t)F.vcu * 32768, lam, F.in[11], pp, pp + 1, ref8);
                if (redo) attn_body::attn_unit128_q8<8, false>(k8 + (size_t)(CTXL + qb * 256) * 1664 + (10 + 2 * h) * 64, k8 + (18 + 2 * h) * 64, kb + 1792 + h * 128, MIX + ((size_t)b * T_ + qb * 256) * DM_ + 512 + h * 128, DM_, lds, F.wave,
                                           (float*)(F.ws + WS_DT) + (size_t)F.vcu * 32768, lam, F.in[11], pp, pp + 1);
                CONV_AT();
            }
        }
      }
    }
    if (!cdone) { conv_experts(F, (LAS float*)(F.lds + RING_OFF + F.wave * 16384), lane_id_asm()); __syncthreads(); }
#undef CONV_AT
}
__device__ __forceinline__ f32x4 bf4lo(v4u q); __device__ __forceinline__ f32x4 bf4hi(v4u q);
typedef short p6_bf16x8 __attribute__((ext_vector_type(8)));
typedef float p6_f32x16 __attribute__((ext_vector_type(16)));
__device__ __forceinline__ void p6_split8(const float (&v)[8], p6_bf16x8& hi, p6_bf16x8& lo) {
    unsigned h[4], l[4];
#pragma unroll
    for (int j = 0; j < 4; ++j) { h[j] = pg8::cvt_pk_bf16(v[2 * j], v[2 * j + 1]);
        const float r0 = v[2 * j] - __builtin_bit_cast(float, h[j] << 16), r1 = v[2 * j + 1] - __builtin_bit_cast(float, h[j] & 0xffff0000u); l[j] = pg8::cvt_pk_bf16(r0, r1); }
    hi = __builtin_bit_cast(p6_bf16x8, (v4u){h[0], h[1], h[2], h[3]}); lo = __builtin_bit_cast(p6_bf16x8, (v4u){l[0], l[1], l[2], l[3]});
}
__device__ __forceinline__ void p6_router(Frame& F, unsigned* dep5 = nullptr) {
    const bf16* x1 = (const bf16*)(F.ws + WS_DT); const float* g = F.in[13]; const float* wr = F.in[14]; const float* br = F.in[15]; const float* mod = (const float*)(F.ws + WS_MOD);
    bf16* H2 = (bf16*)(F.ws + WS_XN); int* se = (int*)(F.ws + WS_SE); int* sp = (int*)(F.ws + WS_SP); int* ltok = (int*)(F.ws + WS_LTOK); float* lgate = (float*)(F.ws + WS_LGATE);
    LAS float* rstdb = (LAS float*)(F.lds + RING_OFF);
    LAS float* part = (LAS float*)(F.lds + RING_OFF + 1024);
    LAS float* lgb = (LAS float*)(F.lds + RING_OFF + 1024 + 65536);
    LAS float* selb = (LAS float*)(F.lds + RING_OFF + 1024 + 65536 + 8192);
    LAS unsigned* lcount = (LAS unsigned*)(F.lds + RING_OFF + 1024 + 65536 + 8192 + 1024);
    LAS unsigned* lbase = lcount + 32;
    LAS unsigned* recE = lbase + 32;
    LAS float* recG = (LAS float*)(recE + 256);
    const int lane = lane_id_asm(), w = F.wave, e = lane & 31, hh = lane >> 5, tid = w * 64 + lane;
    p6_bf16x8 wh[8], wl[8];
#pragma unroll
    for (int st = 0; st < 8; ++st) { float t[8];
#pragma unroll
        for (int j = 0; j < 8; ++j) t[j] = wr[(size_t)(128 * w + 16 * st + 8 * hh + j) * NE + e];
        p6_split8(t, wh[st], wl[st]); }
    const float bre = br[e];
    for (int chunk = F.vcu; chunk < NTOK / 64; chunk += F.G) {
        if (dep5) { while (__hip_atomic_load(dep5 + (chunk >> 2), __ATOMIC_RELAXED, __HIP_MEMORY_SCOPE_AGENT) < 32u) __builtin_amdgcn_s_sleep(4); asm volatile("" ::: "memory"); }
        const int tokc = chunk * 64, b = tokc / T_; const float* md = mod + b * NMOD;
        if (tid < 32) lcount[tid] = 0u;
        { f32x4 ga[4], sh[4];
#pragma unroll
            for (int j = 0; j < 4; ++j) { const int cc = 4 * (lane + 64 * j); ga[j] = *(const f32x4*)(g + cc) * (*(const f32x4*)(md + 4 * DM_ + cc) + 1.0f); sh[j] = *(const f32x4*)(md + 3 * DM_ + cc); }
#pragma unroll 1
            for (int hb = 0; hb < 2; ++hb) { const int tokw = tokc + 8 * w + 4 * hb;
                unsigned long long q_[4][4];
#pragma unroll
                for (int r = 0; r < 4; ++r) { const GAS unsigned long long* xr = (const GAS unsigned long long*)(x1 + (size_t)(tokw + r) * DM_) + lane;
#pragma unroll
                    for (int j = 0; j < 4; ++j) q_[r][j] = xr[64 * j]; }
                float rs_[4];
#pragma unroll
                for (int r = 0; r < 4; ++r) { float s = 0.f;
#pragma unroll
                    for (int j = 0; j < 4; ++j) { const unsigned lo = (unsigned)q_[r][j], hi = (unsigned)(q_[r][j] >> 32); const float a0 = bf2f(lo & 0xffff), a1 = bf2f(lo >> 16), a2 = bf2f(hi & 0xffff), a3 = bf2f(hi >> 16); s += (a0 * a0 + a1 * a1) + (a2 * a2 + a3 * a3); }
                    rs_[r] = 1.0f / sqrtf(wave_sum(s) * (1.0f / DM_) + 1e-6f); }
                if (lane == 0) {
#pragma unroll
                    for (int r = 0; r < 4; ++r) rstdb[8 * w + 4 * hb + r] = rs_[r]; }
#pragma unroll
                for (int r = 0; r < 4; ++r)
#pragma unroll
                    for (int j = 0; j < 4; ++j) { asm volatile("" : "+v"(q_[r][j])); const unsigned lo = (unsigned)q_[r][j], hi = (unsigned)(q_[r][j] >> 32); const f32x4 v = (f32x4){bf2f(lo & 0xffff), bf2f(lo >> 16), bf2f(hi & 0xffff), bf2f(hi >> 16)};
                        const f32x4 o = v * rs_[r] * ga[j] + sh[j];
                        *((GAS unsigned*)((unsigned char*)H2 + (size_t)(tokw + r) * DM_) + lane + 64 * j) = pg8::pk4_fp8(o.x, o.y, o.z, o.w); }
            }
        }
        __syncthreads();
        { p6_f32x16 acc[2]; acc[0] = p6_f32x16{}; acc[1] = p6_f32x16{};
            const float rs0 = rstdb[e], rs1 = rstdb[32 + e];
#pragma unroll
            for (int st = 0; st < 8; ++st) { const int k0 = 128 * w + 16 * st + 8 * hh;
                const f32x4 g0 = *(const f32x4*)(g + k0), g1 = *(const f32x4*)(g + k0 + 4), c0 = *(const f32x4*)(md + 4 * DM_ + k0), c1 = *(const f32x4*)(md + 4 * DM_ + k0 + 4), h0 = *(const f32x4*)(md + 3 * DM_ + k0), h1 = *(const f32x4*)(md + 3 * DM_ + k0 + 4);
                const f32x4 a0 = g0 * (c0 + 1.0f), a1 = g1 * (c1 + 1.0f);
#pragma unroll
                for (int rb = 0; rb < 2; ++rb) { const v4u q = *(const GAS v4u*)(x1 + (size_t)(tokc + 32 * rb + e) * DM_ + k0); const float rs = rb ? rs1 : rs0;
                    const f32x4 xl = bf4lo(q), xh = bf4hi(q); const f32x4 vl = xl * rs * a0 + h0, vh = xh * rs * a1 + h1;
                    const float vv[8] = {vl.x, vl.y, vl.z, vl.w, vh.x, vh.y, vh.z, vh.w}; p6_bf16x8 ahi, alo; p6_split8(vv, ahi, alo);
                    acc[rb] = __builtin_amdgcn_mfma_f32_32x32x16_bf16(ahi, wh[st], acc[rb], 0, 0, 0);
                    acc[rb] = __builtin_amdgcn_mfma_f32_32x32x16_bf16(ahi, wl[st], acc[rb], 0, 0, 0);
                    acc[rb] = __builtin_amdgcn_mfma_f32_32x32x16_bf16(alo, wh[st], acc[rb], 0, 0, 0); } }
#pragma unroll
            for (int rb = 0; rb < 2; ++rb)
#pragma unroll
                for (int r = 0; r < 16; ++r) part[(w * 64 + 32 * rb + (r & 3) + 8 * (r >> 2) + 4 * hh) * 32 + e] = acc[rb][r]; }
        __syncthreads();
        { const int row = tid >> 3, e4 = (tid & 7) * 4; f32x4 sacc = *(const f32x4*)(br + e4);
#pragma unroll
            for (int ww = 0; ww < 8; ++ww) sacc += *(const LAS f32x4*)(part + (ww * 64 + row) * 32 + e4);
            *(LAS f32x4*)(lgb + row * 32 + e4) = sacc; }
        __syncthreads();
#pragma unroll 2
        for (int r = 0; r < 8; ++r) { const int row = 8 * w + r; const float lg = lgb[row * 32 + e];
            int rank = 0;
#pragma unroll
            for (int q = 0; q < 32; ++q) { const float o = lgb[row * 32 + q]; rank += (o > lg || (o == lg && q < e)) ? 1 : 0; }
            if (lane < 32 && rank < 4) selb[row * 4 + rank] = lg;
            LDS_WAIT(); asm volatile("" ::: "memory");
            const float m0 = selb[row * 4], den = 1.0f + expf(selb[row * 4 + 1] - m0) + expf(selb[row * 4 + 2] - m0) + expf(selb[row * 4 + 3] - m0);
            if (lane < 32 && rank < 4) { const unsigned lpos = __hip_atomic_fetch_add(lcount + e, 1u, __ATOMIC_RELAXED, __HIP_MEMORY_SCOPE_WORKGROUP);
                recE[row * 4 + rank] = (unsigned)e | (lpos << 8); recG[row * 4 + rank] = expf(lg - m0) / den; }
        }
        (void)bre;
        __syncthreads();
        if (tid < 32) lbase[tid] = __hip_atomic_fetch_add(F.ctl + CW_CNT + tid, lcount[tid], RLX_AGENT);
        __syncthreads();
        if (tid < 256) { const unsigned rc = recE[tid]; const int ee = (int)(rc & 255u), pos = (int)(lbase[ee] + (rc >> 8)), tok = tokc + (tid >> 2);
            ltok[ee * 16384 + pos] = tok; lgate[ee * 16384 + pos] = recG[tid]; se[tok * 4 + (tid & 3)] = ee; sp[tok * 4 + (tid & 3)] = pos; }
        __syncthreads();
    }
}
__device__ __forceinline__ f32x4 bf4lo(v4u q) { return (f32x4){bf2f(q.x & 0xffff), bf2f(q.x >> 16), bf2f(q.y & 0xffff), bf2f(q.y >> 16)}; }
__device__ __forceinline__ f32x4 bf4hi(v4u q) { return (f32x4){bf2f(q.z & 0xffff), bf2f(q.z >> 16), bf2f(q.w & 0xffff), bf2f(q.w >> 16)}; }
__device__ __forceinline__ f32x4 f8x4(unsigned w) { return (f32x4){__builtin_amdgcn_cvt_f32_fp8((int)w, 0), __builtin_amdgcn_cvt_f32_fp8((int)w, 1), __builtin_amdgcn_cvt_f32_fp8((int)w, 2), __builtin_amdgcn_cvt_f32_fp8((int)w, 3)}; }
__device__ __forceinline__ void p9_final(Frame& F, float* dst) {
    const bf16* xo = (const bf16*)(F.ws + WS_DT); const float* gf = F.in[20]; const float* mod = (const float*)(F.ws + WS_MOD); const unsigned char* Y = F.ws + WS_Y;
    const int* se = (const int*)(F.ws + WS_SE); const int* sp = (const int*)(F.ws + WS_SP); const LAS int* tp = (const LAS int*)(F.lds + TP_OFF);
    const int gw = F.vcu * NWAVES + F.wave, NGW = F.G * NWAVES, lane = lane_id_asm();
    constexpr int NU = 2;
    for (int t0 = gw; t0 < NTOK; t0 += NU * NGW) {
        int tk[NU];
#pragma unroll
        for (int u = 0; u < NU; ++u) tk[u] = (t0 + u * NGW < NTOK) ? t0 + u * NGW : t0;
        int ee[NU][4], pp[NU][4];
#pragma unroll
        for (int u = 0; u < NU; ++u)
#pragma unroll
            for (int k = 0; k < 4; ++k) { ee[u][k] = se[tk[u] * 4 + k]; pp[u][k] = sp[tk[u] * 4 + k]; }
        v4u yq[NU][4]; v4u xq[NU][2];
#pragma unroll
        for (int u = 0; u < NU; ++u) {
#pragma unroll
            for (int k = 0; k < 4; ++k) yq[u][k] = *((const GAS v4u*)(Y + ((size_t)tp[ee[u][k]] * 256 + pp[u][k]) * DM_) + lane);
            const GAS v4u* xr = (const GAS v4u*)(xo + (size_t)tk[u] * DM_) + 2 * lane; xq[u][0] = xr[0]; xq[u][1] = xr[1];
        }
#pragma unroll
        for (int u = 0; u < NU; ++u) {
            const int b = tk[u] / T_; const GAS f32x4* gt2 = (const GAS f32x4*)(mod + b * NMOD + 5 * DM_) + 4 * lane; const GAS f32x4* gfp = (const GAS f32x4*)gf + 4 * lane;
            f32x4 ys[4] = {(f32x4){0.f, 0.f, 0.f, 0.f}, (f32x4){0.f, 0.f, 0.f, 0.f}, (f32x4){0.f, 0.f, 0.f, 0.f}, (f32x4){0.f, 0.f, 0.f, 0.f}};
#pragma unroll
            for (int k = 0; k < 4; ++k) { ys[0] += f8x4(yq[u][k].x); ys[1] += f8x4(yq[u][k].y); ys[2] += f8x4(yq[u][k].z); ys[3] += f8x4(yq[u][k].w); }
            f32x4 v[4]; float s = 0.f;
            v[0] = bf4lo(xq[u][0]) + gt2[0] * ys[0]; v[1] = bf4hi(xq[u][0]) + gt2[1] * ys[1]; v[2] = bf4lo(xq[u][1]) + gt2[2] * ys[2]; v[3] = bf4hi(xq[u][1]) + gt2[3] * ys[3];
#pragma unroll
            for (int j = 0; j < 4; ++j) s += (v[j].x * v[j].x + v[j].y * v[j].y) + (v[j].z * v[j].z + v[j].w * v[j].w);
            const float rstd = 1.0f / sqrtf(wave_sum(s) * (1.0f / DM_) + 1e-6f);
            GAS f32x4* xw = (GAS f32x4*)(dst + (size_t)tk[u] * DM_) + 4 * lane;
            xw[0] = v[0] * rstd * gfp[0]; xw[1] = v[1] * rstd * gfp[1]; xw[2] = v[2] * rstd * gfp[2]; xw[3] = v[3] * rstd * gfp[3];
        }
    }
}

struct Args { const float* in[21]; float* out; unsigned char* ws; int ph_lo, ph_hi; };
__global__ void __launch_bounds__(NWAVES * 64, 2) mk_fwd(Args args) {
    extern __shared__ __attribute__((aligned(16))) unsigned char lds[];
    Frame F;
    F.lds = (LAS unsigned char*)lds; F.MISC = (volatile LAS unsigned*)(F.lds + MISC_OFF);
    F.wave = __builtin_amdgcn_readfirstlane(threadIdx.x >> 6);
    F.G = gridDim.x; { const int bx = blockIdx.x; F.vcu = (F.G % 8 == 0) ? (bx % 8) * (F.G / 8) + bx / 8 : bx; }
#pragma unroll
    for (int i = 0; i < 21; ++i) F.in[i] = args.in[i];
    F.out = args.out; F.ws = args.ws; F.ctl = (gu32*)(args.ws + WS_CTL);
    for (int u = threadIdx.x; u < (LDS_BYTES - LDSCTL_OFF) / 4; u += NWAVES * 64) ((LAS unsigned*)(F.lds + LDSCTL_OFF))[u] = 0u;
    __syncthreads();
    XcdBarrier bar; bar.bar = (unsigned*)(F.ctl + CW_BAR); bar.x = 0; bar.st = nullptr; bar.wv = F.wave;
    if (!MK_PER_PHASE) bar = xcd_barrier_post((unsigned*)(F.ctl + CW_BAR), F.MISC + 8);
    if (!MK_PER_PHASE && threadIdx.x == 0 && F.G == 256 && (int)xb_xcc_id() != (F.vcu >> 5)) __hip_atomic_fetch_or(F.ctl + CW_XOK, 1u, __ATOMIC_RELAXED, __HIP_MEMORY_SCOPE_AGENT);
    const int lo = args.ph_lo, hi = args.ph_hi;
#define IN(k) (lo <= (k) && (k) < hi)
#define SEAM(k) do { if (IN(k) && IN((k) + 1)) xcd_barrier(bar); } while (0)
#ifndef PROBE_DUP
#define PROBE_DUP 0
#endif
#define REPS(k) for (int rep_ = 0; rep_ < (((PROBE_DUP >> (k)) & 1) ? 2 : 1); ++rep_)
#define DUPBAR(k) do { if (((PROBE_DUP >> (k)) & 1) && rep_ == 0 && !MK_PER_PHASE) xcd_barrier(bar); } while (0)
    bf16* XN = (bf16*)(F.ws + WS_XN);
    if (IN(0)) REPS(0) { p0_prologue(F); p1_wqkv(F); DUPBAR(0); } SEAM(0);
    if (IN(1)) REPS(1) { p0_xhat(F); DUPBAR(1); } SEAM(1);
    if (IN(2)) REPS(2) {
        pg8::Gemm g{XN, (const bf16*)(F.ws + WS_WQKV), MROWS, QKVC, DM_}; pg8::QkvOrder S; S.init(MROWS, QKVC, F.G, (int)blockIdx.x);
        pg8::EpiQkv E{(bf16*)(F.ws + WS_QKV), F.in[8], F.in[9], (const float*)(F.ws + WS_ROPE), (const float*)(F.ws + WS_CB), F.ws + WS_QK8, F.ws + WS_V8, (unsigned*)(F.ctl + CW_NMAX)};
        pg8::gemm_phase<pg8::EpiQkv, pg8::QkvOrder, PG8_ALIGN, PG8_SP2, false, true>(F.lds + RING_OFF, g, S, E, F.wave); DUPBAR(2);
    } SEAM(2);
    if (IN(3)) REPS(3) { p3_attention(F, (char*)lds + RING_OFF); DUPBAR(3); } if (IN(3) && IN(5)) xcd_barrier(bar);
    const bool depok5 = !MK_PER_PHASE && PROBE_DUP == 0 && F.G == 256 && IN(5) && IN(6) && (__builtin_amdgcn_readfirstlane((int)__hip_atomic_load(F.ctl + CW_XOK, __ATOMIC_RELAXED, __HIP_MEMORY_SCOPE_AGENT)) == 0);
    if (IN(5)) REPS(5) {
        pg8::Gemm g{(const bf16*)(F.ws + WS_MIX), (const bf16*)(F.ws + WS_WO), NTOK, DM_, DM_}; pg8::WoOrder S; S.init(NTOK, DM_, F.G, (int)blockIdx.x); S.dep = (unsigned*)(F.ctl + CW_MT5); S.mode = depok5 ? 1 : 0;
        pg8::EpiWo E{F.in[0], (const float*)(F.ws + WS_MOD), (bf16*)(F.ws + WS_DT)};
        pg8::gemm_phase<pg8::EpiWo, pg8::WoOrder, PG8_ALIGN, PG8_SP2>(F.lds + RING_OFF, g, S, E, F.wave); DUPBAR(5);
    } if (!depok5) SEAM(5);
    if (IN(6)) REPS(6) { p6_router(F, depok5 ? (unsigned*)(F.ctl + CW_MT5) : nullptr); if (((PROBE_DUP >> 6) & 1) && rep_ == 0) { xcd_barrier(bar); if (blockIdx.x == 0 && threadIdx.x < 32) F.ctl[CW_CNT + threadIdx.x] = 0u; xcd_barrier(bar); } } SEAM(6);
    const bool depok = !MK_PER_PHASE && PROBE_DUP == 0 && F.G == 256 && IN(7) && IN(8) && (__builtin_amdgcn_readfirstlane((int)__hip_atomic_load(F.ctl + CW_XOK, __ATOMIC_RELAXED, __HIP_MEMORY_SCOPE_AGENT)) == 0);
    if (IN(7)) REPS(7) {
        build_tp(F);
        pg8::Gemm g{XN, (const bf16*)(F.ws + WS_WIN), 0, 0, DM_}; pg8::MoeOrder S{(const LAS int*)(F.lds + TP_OFF), (const LAS unsigned char*)(F.lds + TE_OFF), 8, F.G, F.vcu, (unsigned*)(F.ctl + CW_MT), depok ? 1 : 0, 0};
        pg8::EpiSwiglu E{(bf16*)(F.ws + WS_ACT), F.in[17]};
        pg8::gemm_phase<pg8::EpiSwiglu, pg8::MoeOrder, PG8_ALIGN, PG8_SP2, true, true>(F.lds + RING_OFF, g, S, E, F.wave, (const int*)(F.ws + WS_LTOK), (LAS unsigned*)(F.lds + IDBUF_OFF)); DUPBAR(7);
    } if (!depok) SEAM(7);
    if (IN(8)) REPS(8) {
        build_tp(F);
        pg8::Gemm g{(const bf16*)(F.ws + WS_ACT), (const bf16*)(F.ws + WS_WOUT), 0, 0, DM_}; pg8::MoeOrder S{(const LAS int*)(F.lds + TP_OFF), (const LAS unsigned char*)(F.lds + TE_OFF), 4, F.G, F.vcu, (unsigned*)(F.ctl + CW_MT), depok ? 2 : 0, 16};
        pg8::EpiMoeOut E{(bf16*)(F.ws + WS_Y), F.in[19], (const float*)(F.ws + WS_LGATE)};
        pg8::gemm_phase<pg8::EpiMoeOut, pg8::MoeOrder, PG8_ALIGN, PG8_SP2, false, true>(F.lds + RING_OFF, g, S, E, F.wave); DUPBAR(8);
    } SEAM(8);
    if (IN(9)) REPS(9) { build_tp(F); p9_final(F, (((PROBE_DUP >> 9) & 1) && rep_ == 0) ? (float*)(F.ws + WS_ACT) : F.out); DUPBAR(9); }
#undef IN
#undef SEAM
}

extern "C" void kernel_launch(void* const* d_in, const int* in_sizes, int n_in, void* d_out, int out_size, void* d_ws, size_t ws_size, hipStream_t stream) {
    static int grid = 0;
    if (grid == 0) {
        if (n_in != 21 || out_size != NTOK * DM_ || ws_size < WS_END) { fprintf(stderr, "kernel_launch: unexpected shapes (n_in %d, out %d, ws %zu); nothing launched\n", n_in, out_size, ws_size); grid = -1; return; }
        int dev = 0, cus = 0, per_cu = 0;
        if (hipGetDevice(&dev) != hipSuccess || hipDeviceGetAttribute(&cus, hipDeviceAttributeMultiprocessorCount, dev) != hipSuccess) { grid = -1; return; }
        if (hipFuncSetAttribute((const void*)mk_fwd, hipFuncAttributeMaxDynamicSharedMemorySize, LDS_BYTES) != hipSuccess) { fprintf(stderr, "kernel_launch: hipFuncSetAttribute failed\n"); grid = -1; return; }
        if (hipOccupancyMaxActiveBlocksPerMultiprocessor(&per_cu, (const void*)mk_fwd, NWAVES * 64, LDS_BYTES) != hipSuccess || per_cu < 1) { fprintf(stderr, "kernel_launch: occupancy query says %d blocks per CU\n", per_cu); }
        (void)hipGetLastError();
        grid = cus;
    }
    if (grid < 0) return;
    if (hipMemsetAsync((char*)d_ws + WS_CTL, 0, CTL_ZERO_BYTES, stream) != hipSuccess) return;
    Args a{};
    for (int i = 0; i < 21; ++i) a.in[i] = (const float*)d_in[i];
    a.out = (float*)d_out; a.ws = (unsigned char*)d_ws;
#if MK_PER_PHASE
    for (int p = 0; p < NPH; ++p) { a.ph_lo = p; a.ph_hi = p + 1; hipLaunchKernelGGL(mk_fwd, dim3(grid), dim3(NWAVES * 64), LDS_BYTES, stream, a); }
#else
    a.ph_lo = 0; a.ph_hi = NPH; hipLaunchKernelGGL(mk_fwd, dim3(grid), dim3(NWAVES * 64), LDS_BYTES, stream, a);
#endif
}
```

```cpp
#include <hip/hip_runtime.h>
#include <hip/hip_bf16.h>
#include <cstdio>
#include <cstdint>
#include <cmath>
__device__ __forceinline__ int lane_id_asm() { int l; asm volatile("v_mbcnt_lo_u32_b32 %0, -1, 0\n\tv_mbcnt_hi_u32_b32 %0, -1, %0" : "=v"(l)); return l; }
namespace pg8 {
#define PG8_LAS __attribute__((address_space(3)))
typedef unsigned short bf16_t;
typedef short bf16x8 __attribute__((ext_vector_type(8)));
typedef float f32x4 __attribute__((ext_vector_type(4)));
typedef unsigned u32x4 __attribute__((ext_vector_type(4)));
constexpr int BM = 256, BK = 64, HALF = 128, HTB = HALF * BK * 2  , STAGE_BYTES = 8 * HTB, NXCD = 8, WGM = 8;

__host__ __device__ __forceinline__ int lds_byte(int r, int c) { const int st = (r >> 4) * 2 + (c >> 5), rr = r & 15, cc = c & 31, ob = rr * 64 + cc * 2; return st * 1024 + (ob ^ (((ob >> 9) & 1) << 5)); }
__host__ __device__ __forceinline__ void stage_rc(int b, int& R, int& C) { const int st = b / 1024, sb = b % 1024, swz = sb ^ (((sb >> 9) & 1) << 5); R = (st >> 1) * 16 + swz / 64; C = (st & 1) * 32 + (swz % 64) / 2; }
__host__ __device__ __forceinline__ int perm32(int rho) { const int n = rho >> 4, i = rho & 15; return 8 * (i >> 2) + 4 * n + (i & 3); }

struct Unit { int pm, pn, e, mt, pnl, pad_; };
struct Gemm { const bf16_t* A; const bf16_t* Bt; int M, N, K; };

struct StaticOrder {
    int nM, nN, nwg, G, c;
    __host__ __device__ void init(int M, int N, int G_, int c_) { nM = M / BM; nN = N / BM; nwg = nM * nN; G = G_; c = c_; }
    __host__ __device__ bool next(int i, Unit& u) const {
        const long L = (long)i * G + c; if (L >= nwg) return false;
        int wgid = (int)L; { const int q = nwg / NXCD, r = nwg % NXCD, xcd = wgid % NXCD, off = wgid / NXCD; wgid = (xcd < r ? xcd * (q + 1) : r * (q + 1) + (xcd - r) * q) + off; }
        const int nig = WGM * nN, gid = wgid / nig, fm = gid * WGM, gsz = (nM - fm) < WGM ? (nM - fm) : WGM;
        u.pm = fm + ((wgid % nig) % gsz); u.pn = (wgid % nig) / gsz; return true;
    }
    __device__ __forceinline__ void poll_issue(const Unit&, PG8_LAS unsigned*) const {}
    __device__ __forceinline__ void a_ready(const Unit&, unsigned = 0u) const {}
    __device__ __forceinline__ void done(const Unit&, int = 0) const {}
};

__device__ __forceinline__ unsigned cvt_pk_bf16(float lo, float hi) { unsigned r; asm volatile("v_cvt_pk_bf16_f32 %0, %1, %2" : "=v"(r) : "v"(lo), "v"(hi)); return r; }
typedef float f32x2 __attribute__((ext_vector_type(2)));
typedef unsigned u32x2 __attribute__((ext_vector_type(2)));
typedef int v8i32 __attribute__((ext_vector_type(8)));
typedef int v4i32 __attribute__((ext_vector_type(4)));
__device__ __forceinline__ v8i32 cat8(bf16x8 lo, bf16x8 hi) { const v4i32 a = __builtin_bit_cast(v4i32, lo), b = __builtin_bit_cast(v4i32, hi); return __builtin_shufflevector(a, b, 0, 1, 2, 3, 4, 5, 6, 7); }
__device__ __forceinline__ unsigned pk4_fp8(float a, float b, float c, float d) { int r = __builtin_amdgcn_cvt_pk_fp8_f32(a, b, 0, false); r = __builtin_amdgcn_cvt_pk_fp8_f32(c, d, r, true); return (unsigned)r; }
constexpr float W8_SCALE = 16.0f, W8_INV = 1.0f / 16.0f;
constexpr int QKV_PITCH = 2304;
constexpr float ATT_C2 = 0.125f * 1.4426950408889634f;
constexpr float RMS_EPS = 1e-6f;

struct EpiQkv {
    static constexpr bool PERM = false, AFTER_DRAIN = false;
    bf16_t* O; const float* qn; const float* kn; const float* rope;
    const float* cb;
    unsigned char* qk8;
    unsigned char* v8;
    unsigned* nmax;
    __device__ __forceinline__ void operator()(const f32x4 (&acc)[2][2][4][2], const Unit& u, int wr, int wc, int fr_in, int fq_in) const {
        int fr = fr_in, fq = fq_in; asm volatile("" : "+v"(fr), "+v"(fq));
        const int s = u.pnl * 4 + wc;
        const bool isq = (s < 8) || (s >= 12 && s < 20), isk = (s >= 8 && s < 10) || (s >= 20 && s < 28);
        const bool donorm = s < 10; const float* gp = s < 8 ? qn : kn;
        const int tb = u.pm % 33;
        const int ax = fq >> 1, hc0 = 32 * ax + 8 * (fq & 1);
        const float* cbp = cb + (tb == 0 ? 2 : u.pm / 33) * QKV_PITCH + s * 64 + hc0;
        const bool dorope = (isq || isk) && tb != 0;
        const float sc = isq ? ATT_C2 * 4.0f : (isk ? 0.25f : 1.0f);
        const bool dobound = (s >= 12 && s < 28); float nmx = 0.f;
        f32x4 gv[2][2], cbv[2][2];
#pragma unroll
        for (int h = 0; h < 2; ++h)
#pragma unroll
            for (int n = 0; n < 2; ++n) { gv[h][n] = donorm ? *(const f32x4*)(gp + hc0 + 16 * h + 4 * n) : (f32x4){1.f, 1.f, 1.f, 1.f}; cbv[h][n] = (f32x4){0.f, 0.f, 0.f, 0.f}; }
        const int s26 = s < 10 ? s : s - 2;
#pragma unroll
        for (int ai = 0; ai < 2; ++ai)
#pragma unroll
            for (int m = 0; m < 4; ++m) {
                const int rl = ai * HALF + wr * 64 + m * 16 + fr;
                f32x4 v[2][2];
#pragma unroll
                for (int h = 0; h < 2; ++h)
#pragma unroll
                    for (int n = 0; n < 2; ++n) v[h][n] = acc[ai][h][m][n] * W8_INV + cbv[h][n];
                if (dobound || donorm) { float ss = 0.f;
#pragma unroll
                    for (int h = 0; h < 2; ++h)
#pragma unroll
                        for (int n = 0; n < 2; ++n) { const f32x4 x = v[h][n]; ss += (x[0] * x[0] + x[1] * x[1]) + (x[2] * x[2] + x[3] * x[3]); }
                    ss += __shfl_xor(ss, 16); ss += __shfl_xor(ss, 32);
                    if (dobound) nmx = fmaxf(nmx, ss);
                    if (donorm) { const float r = 1.0f / sqrtf(ss * (1.0f / 64.0f) + RMS_EPS);
#pragma unroll
                        for (int h = 0; h < 2; ++h)
#pragma unroll
                            for (int n = 0; n < 2; ++n) v[h][n] = v[h][n] * r * gv[h][n]; } }
                if (dorope) {
                    const int pos = ax ? (rl & 63) : ((tb - 1) * 4 + (rl >> 6));
#pragma unroll
                    for (int n = 0; n < 2; ++n) { const f32x4 cs = *(const f32x4*)(rope + pos * 16 + 8 * (fq & 1) + 4 * n), sn = *(const f32x4*)(rope + 2048 + pos * 16 + 8 * (fq & 1) + 4 * n);
                        const f32x4 x1 = v[0][n], x2 = v[1][n]; v[0][n] = x1 * cs - x2 * sn; v[1][n] = x2 * cs + x1 * sn; }
                }
                const size_t row = (size_t)(u.pm * BM + rl);
                if (isq || isk) { unsigned char* p8 = qk8 + row * 1664 + s26 * 64 + hc0;
                    u32x2 wv[2];
#pragma unroll
                    for (int h = 0; h < 2; ++h) { const f32x4 x0 = v[h][0] * sc, x1 = v[h][1] * sc; wv[h].x = pk4_fp8(x0[0], x0[1], x0[2], x0[3]); wv[h].y = pk4_fp8(x1[0], x1[1], x1[2], x1[3]); }
                    const auto rx = __builtin_amdgcn_permlane16_swap(wv[0].x, wv[1].x, false, false); const auto ry = __builtin_amdgcn_permlane16_swap(wv[0].y, wv[1].y, false, false);
                    u32x4 w4; w4.x = rx[0]; w4.y = ry[0]; w4.z = rx[1]; w4.w = ry[1]; *(u32x4*)(p8 + 8 * (fq & 1)) = w4; }
                else { bf16_t* rowp = O + row * QKV_PITCH + s * 64 + hc0;
                    { unsigned char* p8 = v8 + row * 640 + (s >= 28 ? 128 + (s - 28) * 64 : (s - 10) * 64) + hc0;
                        u32x2 wv[2];
#pragma unroll
                        for (int h = 0; h < 2; ++h) { const f32x4 x0 = v[h][0], x1 = v[h][1]; wv[h].x = pk4_fp8(x0[0], x0[1], x0[2], x0[3]); wv[h].y = pk4_fp8(x1[0], x1[1], x1[2], x1[3]); }
                        const auto rx = __builtin_amdgcn_permlane16_swap(wv[0].x, wv[1].x, false, false); const auto ry = __builtin_amdgcn_permlane16_swap(wv[0].y, wv[1].y, false, false);
                        u32x4 w4; w4.x = rx[0]; w4.y = ry[0]; w4.z = rx[1]; w4.w = ry[1]; *(u32x4*)(p8 + 8 * (fq & 1)) = w4; }
#pragma unroll
                    for (int h = 0; h < 2; ++h) { const f32x4 x0 = v[h][0], x1 = v[h][1]; u32x4 w; w.x = cvt_pk_bf16(x0[0], x0[1]); w.y = cvt_pk_bf16(x0[2], x0[3]); w.z = cvt_pk_bf16(x1[0], x1[1]); w.w = cvt_pk_bf16(x1[2], x1[3]); *(u32x4*)(rowp + 16 * h) = w; } }
            }
        if (dobound) {
#pragma unroll
            for (int o_ = 1; o_ < 16; o_ <<= 1) nmx = fmaxf(nmx, __shfl_xor(nmx, o_));
            if (fr == 0 && fq == 0) __hip_atomic_fetch_max(nmax + s, __float_as_uint(nmx), __ATOMIC_RELAXED, __HIP_MEMORY_SCOPE_AGENT); }
    }
};
struct EpiWo {
    static constexpr bool PERM = true, AFTER_DRAIN = false;
    const float* x; const float* mod; bf16_t* x1;
    __device__ __forceinline__ void operator()(const f32x4 (&acc)[2][2][4][2], const Unit& u, int wr, int wc, int fr_in, int fq_in) const {
        int fr = fr_in, fq = fq_in; asm volatile("" : "+v"(fr), "+v"(fq));
        const int b = u.pm >> 5; const float* gt = mod + b * 6144 + 2048;
        const int col0 = u.pn * BM + wc * 32 + 8 * fq, row0 = u.pm * BM + wr * 64 + fr;
        f32x4 g[2][2];
#pragma unroll
        for (int bj = 0; bj < 2; ++bj)
#pragma unroll
            for (int n = 0; n < 2; ++n) g[bj][n] = *(const f32x4*)(gt + col0 + bj * HALF + 4 * n);
#pragma unroll
        for (int ai = 0; ai < 2; ++ai)
#pragma unroll
            for (int m = 0; m < 4; ++m) { const size_t off = (size_t)(row0 + ai * HALF + m * 16) * 1024 + col0;
#pragma unroll
                for (int bj = 0; bj < 2; ++bj) { const f32x4 x0 = *(const f32x4*)(x + off + bj * HALF), x4 = *(const f32x4*)(x + off + bj * HALF + 4);
                    const f32x4 v0 = x0 + g[bj][0] * acc[ai][bj][m][0], v1 = x4 + g[bj][1] * acc[ai][bj][m][1];
                    u32x4 w; w.x = cvt_pk_bf16(v0[0], v0[1]); w.y = cvt_pk_bf16(v0[2], v0[3]); w.z = cvt_pk_bf16(v1[0], v1[1]); w.w = cvt_pk_bf16(v1[2], v1[3]);
                    *(u32x4*)(x1 + off + bj * HALF) = w; } }
    }
};
struct EpiSwiglu {
    static constexpr bool PERM = true, AFTER_DRAIN = false;
    bf16_t* act; const float* b_in;
    __device__ __forceinline__ void operator()(const f32x4 (&acc)[2][2][4][2], const Unit& u, int wr, int wc, int fr_in, int fq_in) const {
        int fr = fr_in, fq = fq_in; asm volatile("" : "+v"(fr), "+v"(fq));
        const int c0 = u.pnl * 128 + wc * 32 + 8 * fq; const float* bg = b_in + u.e * 2048 + c0; const float* bl = bg + 1024;
        constexpr float KP = 1.702f * 1.4426950408889634f, KI = 1.0f / KP;
        const f32x4 bgv[2] = {*(const f32x4*)bg * KP, *(const f32x4*)(bg + 4) * KP}, blv[2] = {(*(const f32x4*)bl + 1.0f) * KI, (*(const f32x4*)(bl + 4) + 1.0f) * KI};
#pragma unroll
        for (int ai = 0; ai < 2; ++ai)
#pragma unroll
            for (int mp = 0; mp < 2; ++mp) { u32x2 wv[2];
#pragma unroll
                for (int h = 0; h < 2; ++h) { const int m = 2 * mp + h; f32x4 a[2];
#pragma unroll
                    for (int n = 0; n < 2; ++n) { f32x4 g2 = acc[ai][0][m][n] * (W8_INV * KP) + bgv[n], l2 = acc[ai][1][m][n] * (W8_INV * KI) + blv[n], d;
#pragma unroll
                        for (int i = 0; i < 4; ++i) { g2[i] = fminf(g2[i], 7.0f * KP); l2[i] = __builtin_amdgcn_fmed3f(l2[i], -6.0f * KI, 8.0f * KI); d[i] = __builtin_amdgcn_exp2f(-g2[i]); }
                        d = d + 1.0f;
#pragma unroll
                        for (int i = 0; i < 4; ++i) d[i] = __builtin_amdgcn_rcpf(d[i]);
                        a[n] = g2 * d * l2; }
                    wv[h].x = pk4_fp8(a[0][0], a[0][1], a[0][2], a[0][3]); wv[h].y = pk4_fp8(a[1][0], a[1][1], a[1][2], a[1][3]); }
                const auto rx = __builtin_amdgcn_permlane16_swap(wv[0].x, wv[1].x, false, false); const auto ry = __builtin_amdgcn_permlane16_swap(wv[0].y, wv[1].y, false, false);
                const int odd = fq & 1; const size_t row = (size_t)u.pm * BM + ai * HALF + wr * 64 + (2 * mp + odd) * 16 + fr;
                u32x4 w4; w4.x = rx[0]; w4.y = ry[0]; w4.z = rx[1]; w4.w = ry[1];
                *(u32x4*)((unsigned char*)act + row * 1024 + c0 - 8 * odd) = w4; }
    }
};
struct EpiMoeOut {
    static constexpr bool PERM = true, AFTER_DRAIN = false;
    bf16_t* y; const float* b_out; const float* lgate;
    __device__ __forceinline__ void operator()(const f32x4 (&acc)[2][2][4][2], const Unit& u, int wr, int wc, int fr_in, int fq_in) const {
        int fr = fr_in, fq = fq_in; asm volatile("" : "+v"(fr), "+v"(fq));
        const int c0 = u.pnl * BM + wc * 64 + 8 * fq; const float* bp = b_out + u.e * 1024 + c0;
        f32x4 bv[2][2];
#pragma unroll
        for (int bj = 0; bj < 2; ++bj)
#pragma unroll
            for (int n = 0; n < 2; ++n) bv[bj][n] = *(const f32x4*)(bp + bj * 32 + 4 * n);
#pragma unroll
        for (int ai = 0; ai < 2; ++ai)
#pragma unroll
            for (int m = 0; m < 4; ++m) { const int rl = ai * HALF + wr * 64 + m * 16 + fr; const float gate = lgate[(size_t)u.e * 16384 + u.mt * BM + rl];
                unsigned char* rowp = (unsigned char*)y + ((size_t)u.pm * BM + rl) * 1024 + c0;
                u32x2 wv[2];
#pragma unroll
                for (int bj = 0; bj < 2; ++bj) { const f32x4 v0 = (acc[ai][bj][m][0] * W8_INV + bv[bj][0]) * gate, v1 = (acc[ai][bj][m][1] * W8_INV + bv[bj][1]) * gate;
                    wv[bj].x = pk4_fp8(v0[0], v0[1], v0[2], v0[3]); wv[bj].y = pk4_fp8(v1[0], v1[1], v1[2], v1[3]); }
                const auto rx = __builtin_amdgcn_permlane16_swap(wv[0].x, wv[1].x, false, false); const auto ry = __builtin_amdgcn_permlane16_swap(wv[0].y, wv[1].y, false, false);
                const int odd = fq & 1; u32x4 w4; w4.x = rx[0]; w4.y = ry[0]; w4.z = rx[1]; w4.w = ry[1];
                *(u32x4*)(rowp + (odd ? 32 - 8 : 0)) = w4; }
    }
};
struct WoOrder : StaticOrder {
    unsigned* dep; int mode;
    __device__ __forceinline__ void done(const Unit& u, int wid = 0) const { if (mode == 1) { if (wid == 0 && lane_id_asm() == 0) __hip_atomic_fetch_add(dep + u.pm, 1u, __ATOMIC_RELAXED, __HIP_MEMORY_SCOPE_AGENT); } }
};
struct QkvOrder : StaticOrder {
    int mode; unsigned* dep;
    __device__ __forceinline__ bool next(int i, Unit& u) const {
        if (mode == 0) { if (!StaticOrder::next(i, u)) return false; }
        else { const int x = c >> 5, j = c & 31, mlo = x < 2 ? 9 * x : 18 + 8 * (x - 2), cnt = x < 2 ? 9 : 8; const int L = i * 32 + j, nA = 7 * cnt; if (L >= 9 * cnt) return false;
            if (L < nA) { u.pm = mlo + L / 7; u.pn = L % 7; } else { u.pm = mlo + (L - nA) / 2; u.pn = 7 + (L - nA) % 2; } }
        u.pnl = u.pn;     u.e = 0; u.mt = 0; u.pad_ = 0; return true; }
    __device__ __forceinline__ void poll_issue(const Unit& u, PG8_LAS unsigned* slot) const { if (mode == 1) __builtin_amdgcn_global_load_lds((const unsigned*)(dep + u.pm), slot, 4, 0, 0); }
    __device__ __forceinline__ void a_ready(const Unit& u, unsigned seen = 0u) const { if (mode == 1 && seen < 32u) { while (__hip_atomic_load(dep + u.pm, __ATOMIC_RELAXED, __HIP_MEMORY_SCOPE_AGENT) < 32u) __builtin_amdgcn_s_sleep(4); asm volatile("" ::: "memory"); } }
};
struct MoeOrder {
    const PG8_LAS int* tp; const PG8_LAS unsigned char* te; int npn, G, c;
    unsigned* dep; int mode, joff;
    __device__ __forceinline__ bool next(int i, Unit& u) const {
        long L; int g;
        if (mode == 0) { L = (long)i * G + c; g = (int)(L / npn); }
        else { const int x = c >> 5, j = (c + joff) & 31; L = (long)i * 32 + j; const int T_ = __builtin_amdgcn_readfirstlane(tp[32]), per = (T_ + 7) >> 3, q = (int)(L / npn);
            if (q >= per) return false; g = x * per + q; }
        if (g >= __builtin_amdgcn_readfirstlane(tp[32])) return false;
        const int e = __builtin_amdgcn_readfirstlane((int)te[g]);
        u.e = e; u.mt = g - __builtin_amdgcn_readfirstlane(tp[e]); u.pnl = (int)(L % npn); u.pm = g; u.pn = e * npn + u.pnl; u.pad_ = 0; return true;
    }
    __device__ __forceinline__ void poll_issue(const Unit& u, PG8_LAS unsigned* slot) const { if (mode == 2) __builtin_amdgcn_global_load_lds((const unsigned*)(dep + u.pm), slot, 4, 0, 0); }
    __device__ __forceinline__ void a_ready(const Unit& u, unsigned seen = 0u) const { if (mode == 2 && seen < 8u) { while (__hip_atomic_load(dep + u.pm, __ATOMIC_RELAXED, __HIP_MEMORY_SCOPE_AGENT) < 8u) __builtin_amdgcn_s_sleep(4); asm volatile("" ::: "memory"); } }
    __device__ __forceinline__ void done(const Unit& u, int wid = 0) const { if (mode == 1) { if (wid == 0 && lane_id_asm() == 0) __hip_atomic_fetch_add(dep + u.pm, 1u, __ATOMIC_RELAXED, __HIP_MEMORY_SCOPE_AGENT); } }
};
template <class Epi, class Sched, bool ALIGN_EPI = false, bool SP2 = false, bool GATHER = false, bool F8 = false>
__device__ __forceinline__ void gemm_phase(PG8_LAS unsigned char* lds, const Gemm g, const Sched& S, const Epi& E, int wid_in, const int* glist = nullptr, PG8_LAS unsigned* idbuf = nullptr) {
    static_assert(!GATHER || SP2, "GATHER is written for the SP2 loop only");
    const int lane = lane_id_asm(), wid = wid_in, tid = wid * 64 + lane, wr = wid >> 2, wc = wid & 3, fr = lane & 15, fq = lane >> 4;
    constexpr int ES = F8 ? 1 : 2;
    const int K = g.K, nt = (K * ES) / (BK * 2);
    unsigned voffA[2], voffB[2]; int Rl[2]; unsigned Cb[2];
#pragma unroll
    for (int i = 0; i < 2; ++i) { int R, C; stage_rc(tid * 16 + i * 8192, R, C); const int Rb = Epi::PERM ? ((R & ~31) + perm32(R & 31)) : R;
        voffA[i] = (unsigned)(R * K * ES + C * 2); voffB[i] = (unsigned)(Rb * K * ES + C * 2); Rl[i] = R; Cb[i] = (unsigned)C * 2u; }
    unsigned cv[2][2] = {{0u, 0u}, {0u, 0u}}, nv[2][2] = {{0u, 0u}, {0u, 0u}};
    constexpr int GL_STRIDE = 16384;
    PG8_LAS unsigned* myid = idbuf + wid * 256;
#define PG8_FETCH_IDS(U) do { _Pragma("unroll") for (int h_ = 0; h_ < 2; ++h_) _Pragma("unroll") for (int i_ = 0; i_ < 2; ++i_) \
        __builtin_amdgcn_global_load_lds((const unsigned*)(glist + (size_t)(U).e * GL_STRIDE + (U).mt * BM + h_ * HALF + Rl[i_]), (PG8_LAS unsigned*)(myid + (h_ * 2 + i_) * 64), 4, 0, 0); } while (0)
#define PG8_READ_IDS(dst) do { _Pragma("unroll") for (int h_ = 0; h_ < 2; ++h_) _Pragma("unroll") for (int i_ = 0; i_ < 2; ++i_) dst[h_][i_] = myid[(h_ * 2 + i_) * 64 + lane] * (unsigned)(K * ES) + Cb[i_]; } while (0)
#define PG8_STAGE_A(bufoff, kbase, H, NX) do { if constexpr (GATHER) { unsigned v_[2]; v_[0] = (NX) ? nv[H][0] : cv[H][0]; v_[1] = (NX) ? nv[H][1] : cv[H][1]; PG8_STAGE(bufoff, kbase, v_); } \
        else { PG8_STAGE(bufoff, (kbase) + ((H) ? hstep : (size_t)0), voffA); } } while (0)
    const size_t kstep = (size_t)(BK * 2);
    const size_t hstep = (size_t)HALF * K * ES;
    const size_t tstep = 2 * hstep;
    const unsigned ldsw = (unsigned)wid * 1024u;
    const int aoff = lds_byte(wr * 64 + fr, fq * 8), boff = lds_byte(wc * 32 + fr, fq * 8);
#define PG8_SA(b, h) (((b) * 2 + (h)) * HTB)
#define PG8_SB(b, h) ((4 + (b) * 2 + (h)) * HTB)
#define PG8_STAGE(bufoff, gbase, voff) do { _Pragma("unroll") for (int _i = 0; _i < 2; ++_i) \
        __builtin_amdgcn_global_load_lds((const unsigned*)((const char*)(gbase) + (voff)[_i]), (PG8_LAS unsigned*)(lds + (bufoff) + ldsw + _i * 8192), 16, 0, 0); } while (0)
#define PG8_LDA(dst, b, h) do { if constexpr (F8) { _Pragma("unroll") for (int m = 0; m < 4; ++m) dst##8[m] = cat8(*(const PG8_LAS bf16x8*)(lds + PG8_SA(b, h) + aoff + m * 2048), *(const PG8_LAS bf16x8*)(lds + PG8_SA(b, h) + aoff + m * 2048 + 1024)); } \
        else { _Pragma("unroll") for (int m = 0; m < 4; ++m) _Pragma("unroll") for (int k = 0; k < 2; ++k) dst[m][k] = *(const PG8_LAS bf16x8*)(lds + PG8_SA(b, h) + aoff + m * 2048 + k * 1024); } } while (0)
#define PG8_LDB(dst, b, h) do { if constexpr (F8) { _Pragma("unroll") for (int n = 0; n < 2; ++n) dst##8[n] = cat8(*(const PG8_LAS bf16x8*)(lds + PG8_SB(b, h) + boff + n * 2048), *(const PG8_LAS bf16x8*)(lds + PG8_SB(b, h) + boff + n * 2048 + 1024)); } \
        else { _Pragma("unroll") for (int n = 0; n < 2; ++n) _Pragma("unroll") for (int k = 0; k < 2; ++k) dst[n][k] = *(const PG8_LAS bf16x8*)(lds + PG8_SB(b, h) + boff + n * 2048 + k * 1024); } } while (0)
#define PG8_MMA(ai, bj, At, Bt) do { __builtin_amdgcn_s_setprio(1); if constexpr (F8) { _Pragma("unroll") for (int m = 0; m < 4; ++m) _Pragma("unroll") for (int n = 0; n < 2; ++n) \
        asm volatile("s_nop 1\n\tv_mfma_f32_16x16x128_f8f6f4 %0, %1, %2, %0" : "+v"(acc[ai][bj][m][n]) : "v"(Bt##8[n]), "v"(At##8[m])); }     \
        else { _Pragma("unroll") for (int m = 0; m < 4; ++m) _Pragma("unroll") for (int n = 0; n < 2; ++n) _Pragma("unroll") for (int k = 0; k < 2; ++k) \
        acc[ai][bj][m][n] = __builtin_amdgcn_mfma_f32_16x16x32_bf16(Bt[n][k], At[m][k], acc[ai][bj][m][n], 0, 0, 0); } __builtin_amdgcn_s_setprio(0); } while (0)
#define PG8_WAIT_V(n) asm volatile("s_waitcnt vmcnt(" #n ")" ::: "memory")
#define PG8_WAIT_L(n) asm volatile("s_waitcnt lgkmcnt(" #n ")" ::: "memory")
#define PG8_BAR __builtin_amdgcn_s_barrier()
#define PG8_SCHED __builtin_amdgcn_sched_barrier(0)
    Unit cur, nxt, prv; int ui = 0; bool have_prv = false;
    if (!S.next(0, cur)) return;
    f32x4 acc[2][2][4][2];
#pragma unroll
    for (int a = 0; a < 2; ++a)
#pragma unroll
        for (int b = 0; b < 2; ++b)
#pragma unroll
            for (int m = 0; m < 4; ++m)
#pragma unroll
                for (int n = 0; n < 2; ++n) acc[a][b][m][n] = (f32x4){0.f, 0.f, 0.f, 0.f};
    bf16x8 At[4][2], B0[2][2], B1[2][2]; v8i32 At8[4], B08[2], B18[2];
    const char* cA = (const char*)g.A + (GATHER ? (size_t)0 : (size_t)cur.pm * tstep); const char* cB = (const char*)g.Bt + (size_t)cur.pn * tstep;
    S.a_ready(cur);
    if constexpr (GATHER) { PG8_FETCH_IDS(cur); asm volatile("s_waitcnt vmcnt(0)" ::: "memory"); PG8_READ_IDS(cv); }
    if constexpr (SP2) {
        PG8_STAGE(PG8_SB(0, 0), cB, voffB); PG8_STAGE(PG8_SB(0, 1), cB + hstep, voffB); PG8_STAGE_A(PG8_SA(0, 0), cA, 0, false); PG8_STAGE_A(PG8_SA(0, 1), cA, 1, false);
        if (wr == 1) PG8_BAR;
        PG8_WAIT_V(2); PG8_BAR;
        PG8_STAGE(PG8_SB(1, 0), cB + kstep, voffB); PG8_STAGE_A(PG8_SA(1, 0), cA + kstep, 0, false); PG8_STAGE(PG8_SB(1, 1), cB + hstep + kstep, voffB);
        PG8_WAIT_V(6); PG8_BAR;
    } else {
        PG8_STAGE(PG8_SB(0, 0), cB, voffB); PG8_STAGE(PG8_SA(0, 0), cA, voffA); PG8_STAGE(PG8_SB(0, 1), cB + hstep, voffB); PG8_STAGE(PG8_SA(0, 1), cA + hstep, voffA);
        if (wr == 1) PG8_BAR;
        PG8_WAIT_V(4); PG8_BAR;
        PG8_STAGE(PG8_SB(1, 0), cB + kstep, voffB); PG8_STAGE(PG8_SA(1, 0), cA + kstep, voffA); PG8_STAGE(PG8_SB(1, 1), cB + hstep + kstep, voffB);
        PG8_WAIT_V(6); PG8_BAR;
    }
    for (;;) {
        const bool has_next = S.next(ui + 1, nxt);
        const char* nA = (has_next && !GATHER) ? (const char*)g.A + (size_t)nxt.pm * tstep : cA; const char* nB = has_next ? (const char*)g.Bt + (size_t)nxt.pn * tstep : cB;
        if constexpr (GATHER) { if (has_next) PG8_FETCH_IDS(nxt); }
        if constexpr (!GATHER) { if (has_next) S.poll_issue(nxt, myid); }
        for (int t = 0; t < nt; t += 2) {
            const bool last = (t == nt - 2);
            if constexpr (GATHER) { if (last) { if (has_next) { PG8_READ_IDS(nv); } else { _Pragma("unroll") for (int h_ = 0; h_ < 2; ++h_) { nv[h_][0] = cv[h_][0]; nv[h_][1] = cv[h_][1]; } } } }
            const char* a1 = cA + (size_t)(t + 1) * kstep;
            const char* a2 = last ? nA : cA + (size_t)(t + 2) * kstep; const char* b2 = last ? nB : cB + (size_t)(t + 2) * kstep;
            const char* a3 = a2 + kstep; const char* b3 = b2 + kstep;
            if (last && has_next) { if constexpr (!GATHER) { const unsigned seen_ = __builtin_amdgcn_readfirstlane(myid[lane]); S.a_ready(nxt, seen_); } else { S.a_ready(nxt); } }
            if constexpr (SP2) {
            PG8_LDB(B0, 0, 0); PG8_LDB(B1, 0, 1); PG8_SCHED; PG8_LDA(At, 0, 0); PG8_STAGE_A(PG8_SA(1, 1), a1, 1, false);
            PG8_WAIT_V(8); PG8_WAIT_L(0); PG8_BAR; PG8_MMA(0, 0, At, B0); PG8_MMA(0, 1, At, B1); PG8_BAR; PG8_SCHED;
            PG8_LDA(At, 0, 1); PG8_STAGE(PG8_SB(0, 0), b2, voffB); PG8_STAGE(PG8_SB(0, 1), b2 + hstep, voffB); PG8_STAGE_A(PG8_SA(0, 0), a2, 0, last);
            PG8_WAIT_V(8); PG8_WAIT_L(0); PG8_BAR; PG8_MMA(1, 0, At, B0); PG8_MMA(1, 1, At, B1); PG8_BAR; PG8_SCHED;
            PG8_LDB(B0, 1, 0); PG8_LDB(B1, 1, 1); PG8_SCHED; PG8_LDA(At, 1, 0); PG8_STAGE_A(PG8_SA(0, 1), a2, 1, last);
            PG8_WAIT_V(8); PG8_WAIT_L(0); PG8_BAR; PG8_MMA(0, 0, At, B0); PG8_MMA(0, 1, At, B1); PG8_BAR; PG8_SCHED;
            PG8_LDA(At, 1, 1); PG8_STAGE(PG8_SB(1, 0), b3, voffB); PG8_STAGE(PG8_SB(1, 1), b3 + hstep, voffB); PG8_STAGE_A(PG8_SA(1, 0), a3, 0, last);
            PG8_WAIT_V(8); PG8_WAIT_L(0); PG8_BAR; PG8_MMA(1, 0, At, B0); PG8_MMA(1, 1, At, B1); PG8_BAR; PG8_SCHED;
            } else {
            PG8_LDB(B0, 0, 0); PG8_SCHED; PG8_LDA(At, 0, 0); PG8_STAGE(PG8_SA(1, 1), a1 + hstep, voffA);
            PG8_WAIT_L(8); PG8_BAR; PG8_WAIT_L(0); PG8_MMA(0, 0, At, B0); PG8_BAR; PG8_SCHED;
            PG8_LDB(B1, 0, 1); PG8_STAGE(PG8_SB(0, 0), b2, voffB);
            PG8_BAR; PG8_WAIT_L(0); PG8_MMA(0, 1, At, B1); PG8_BAR;
            PG8_LDA(At, 0, 1); PG8_STAGE(PG8_SA(0, 0), a2, voffA);
            PG8_BAR; PG8_WAIT_L(0); PG8_MMA(1, 0, At, B0); PG8_BAR; PG8_SCHED;
            PG8_STAGE(PG8_SB(0, 1), b2 + hstep, voffB);
            PG8_WAIT_V(6); PG8_BAR; PG8_MMA(1, 1, At, B1); PG8_BAR;
            PG8_LDB(B0, 1, 0); PG8_SCHED; PG8_LDA(At, 1, 0); PG8_STAGE(PG8_SA(0, 1), a2 + hstep, voffA);
            PG8_WAIT_L(8); PG8_BAR; PG8_WAIT_L(0); PG8_MMA(0, 0, At, B0); PG8_BAR; PG8_SCHED;
            PG8_LDB(B1, 1, 1); PG8_STAGE(PG8_SB(1, 0), b3, voffB);
            PG8_BAR; PG8_WAIT_L(0); PG8_MMA(0, 1, At, B1); PG8_BAR;
            PG8_LDA(At, 1, 1); PG8_STAGE(PG8_SA(1, 0), a3, voffA);
            PG8_BAR; PG8_WAIT_L(0); PG8_MMA(1, 0, At, B0); PG8_BAR; PG8_SCHED;
            PG8_STAGE(PG8_SB(1, 1), b3 + hstep, voffB);
            PG8_WAIT_V(6); PG8_BAR; PG8_MMA(1, 1, At, B1); PG8_BAR;
            }
        }
        if constexpr (ALIGN_EPI) { if (wr == 0) PG8_BAR; }
        if constexpr (F8) { asm volatile("s_nop 15\n\ts_nop 15" ::: "memory"); }
        if constexpr (!Epi::AFTER_DRAIN) { if (have_prv) S.done(prv, wid); E(acc, cur, wr, wc, fr, fq); prv = cur; have_prv = true; }
        if (!has_next) break;
#pragma unroll
        for (int a = 0; a < 2; ++a)
#pragma unroll
            for (int b = 0; b < 2; ++b)
#pragma unroll
                for (int m = 0; m < 4; ++m)
#pragma unroll
                    for (int n = 0; n < 2; ++n) acc[a][b][m][n] = (f32x4){0.f, 0.f, 0.f, 0.f};
        cur = nxt; cA = nA; cB = nB; ++ui;
        if constexpr (GATHER) { _Pragma("unroll") for (int h_ = 0; h_ < 2; ++h_) { cv[h_][0] = nv[h_][0]; cv[h_][1] = nv[h_][1]; } }
        if constexpr (ALIGN_EPI) { if (wr == 1) PG8_BAR; }
    }
    PG8_WAIT_V(0);
    if constexpr (!ALIGN_EPI) { if (wr == 0) PG8_BAR; }
    PG8_BAR;
    if constexpr (!Epi::AFTER_DRAIN) { if (have_prv) S.done(prv, wid); }
    if constexpr (Epi::AFTER_DRAIN) { E.fused(acc, cur, wr, wc, fr, fq, lds, wid, lane); S.done(cur, wid); }
#undef PG8_SA
#undef PG8_FETCH_IDS
#undef PG8_READ_IDS
#undef PG8_STAGE_A
#undef PG8_SB
#undef PG8_STAGE
#undef PG8_LDA
#undef PG8_LDB
#undef PG8_MMA
#undef PG8_WAIT_V
#undef PG8_WAIT_L
#undef PG8_BAR
#undef PG8_SCHED
}
}
#ifndef PG8_SP2
#define PG8_SP2 true
#endif
#ifndef PG8_ALIGN
#define PG8_ALIGN true
#endif
namespace attn_body {
using bf16=__hip_bfloat16;
using bf16x8=__attribute__((ext_vector_type(8)))short;
using s16x4=__attribute__((ext_vector_type(4)))short;
using f32x16=__attribute__((ext_vector_type(16)))float;
using u32x4=__attribute__((ext_vector_type(4)))unsigned;
constexpr int D=64,DM=2304;
constexpr int NW=8,QBLK=32,QB=QBLK*NW,KVBLK=64,NKEYS=8448,NT=NKEYS/KVBLK;
static_assert(NT%2==0&&NT>=6,"the 2-step loop needs an even tile count");
constexpr int ATTN_PITCH=DM, ATTN_UNIT_ROWS=QB;
__device__ __forceinline__ int crow(int r,int hi){return (r&3)+8*(r>>2)+4*hi;}
#define SBAR() __builtin_amdgcn_sched_barrier(0)
__device__ __forceinline__ void cmask(f32x16&p0,f32x16&p1,int jb,int qrel,int hi){
  const float NEG=-INFINITY; int kb=64*jb+4*hi;
  #pragma unroll
  for(int r=0;r<16;++r){int kv=kb+(r&3)+8*(r>>2); if(kv>qrel)p0[r]=NEG; if(kv+32>qrel)p1[r]=NEG;}
}

constexpr int NSLOT=3, SLOTB=8192;
constexpr int LDS_K=0, LDS_V=NSLOT*SLOTB, LDS_WS=2*NSLOT*SLOTB, LDS_OST=LDS_WS+NW*64*4, LDS_BYTES=LDS_OST+NW*4096;
constexpr float C2=0.125f*1.4426950408889634f;
__device__ __forceinline__ void glds16(const void*gsrc,unsigned lds_dst){unsigned keep;
  asm volatile("s_mov_b32 %0, m0\n\ts_mov_b32 m0, %2\n\ts_nop 0\n\tglobal_load_lds_dwordx4 %1, off\n\ts_mov_b32 m0, %0":"=&s"(keep):"v"(gsrc),"s"(lds_dst):"memory");}
__device__ __forceinline__ float max3f(float a,float b,float c){float r;asm("v_max3_f32 %0, %1, %2, %3":"=v"(r):"v"(a),"v"(b),"v"(c));return r;}
__device__ __forceinline__ float max2f(float a,float b){float r;asm("v_max_f32_e32 %0, %1, %2":"=v"(r):"v"(a),"v"(b));return r;}
__device__ __forceinline__ float fadd_s(float a,float b){float r;asm("v_add_f32_e32 %0, %1, %2":"=v"(r):"v"(a),"v"(b));return r;}
__device__ __forceinline__ float fsub_s(float a,float b){float r;asm("v_sub_f32_e32 %0, %1, %2":"=v"(r):"v"(a),"v"(b));return r;}
typedef float f32x2_t __attribute__((ext_vector_type(2))); typedef __bf16 bf16x2_t __attribute__((ext_vector_type(2)));
__device__ __forceinline__ unsigned cvtpk_s(float lo,float hi){f32x2_t v={lo,hi};bf16x2_t b=__builtin_convertvector(v,bf16x2_t);return __builtin_bit_cast(unsigned,b);}
#define WAIT_BAR(N) asm volatile("s_waitcnt vmcnt(" #N ") lgkmcnt(0)\n\ts_barrier":::"memory")

__device__ __forceinline__ void qkt(f32x16&p0,f32x16&p1,const char*Kslot,const bf16x8*qr,const f32x16&negm,int r32,int hi){
  const char*kb=Kslot+hi*1024+r32*16;
  #pragma unroll
  for(int d0=0;d0<4;++d0){
    const bf16x8 b0=*reinterpret_cast<const bf16x8*>(kb+d0*2048);
    const bf16x8 b1=*reinterpret_cast<const bf16x8*>(kb+d0*2048+512);
    if(d0==0){p0=__builtin_amdgcn_mfma_f32_32x32x16_bf16(b0,qr[0],negm,0,0,0);p1=__builtin_amdgcn_mfma_f32_32x32x16_bf16(b1,qr[0],negm,0,0,0);}
    else{p0=__builtin_amdgcn_mfma_f32_32x32x16_bf16(b0,qr[d0],p0,0,0,0);p1=__builtin_amdgcn_mfma_f32_32x32x16_bf16(b1,qr[d0],p1,0,0,0);}}
}
typedef __attribute__((address_space(3))) const char* lds_cptr;
typedef short v4i16_t __attribute__((ext_vector_type(4)));
__device__ __forceinline__ void kload8(bf16x8*kf,lds_cptr kp){
  kf[0]=*(const __attribute__((address_space(3))) bf16x8*)(kp);      kf[1]=*(const __attribute__((address_space(3))) bf16x8*)(kp+512);
  kf[2]=*(const __attribute__((address_space(3))) bf16x8*)(kp+2048); kf[3]=*(const __attribute__((address_space(3))) bf16x8*)(kp+2560);
  kf[4]=*(const __attribute__((address_space(3))) bf16x8*)(kp+4096); kf[5]=*(const __attribute__((address_space(3))) bf16x8*)(kp+4608);
  kf[6]=*(const __attribute__((address_space(3))) bf16x8*)(kp+6144); kf[7]=*(const __attribute__((address_space(3))) bf16x8*)(kp+6656);
}
__device__ __forceinline__ void kload2(bf16x8*kf,lds_cptr kp,int j){ kf[2*j]=*(const __attribute__((address_space(3))) bf16x8*)(kp+j*2048); kf[2*j+1]=*(const __attribute__((address_space(3))) bf16x8*)(kp+j*2048+512); }
__device__ __forceinline__ s16x4 vtr(lds_cptr p){ return __builtin_bit_cast(s16x4,__builtin_amdgcn_ds_read_tr16_b64_v4i16((__attribute__((address_space(3))) v4i16_t*)p)); }
__device__ __forceinline__ float rowmax(const f32x16&p0,const f32x16&p1){
  float a=max3f(p0[0],p0[1],p1[0]),b=max3f(p0[2],p0[3],p1[1]);a=max3f(a,p1[2],p1[3]);
  #pragma unroll
  for(int r=4;r<16;r+=4){a=max3f(a,p0[r],p0[r+1]);b=max3f(b,p0[r+2],p0[r+3]);a=max3f(a,p1[r],p1[r+1]);b=max3f(b,p1[r+2],p1[r+3]);}
  const float m=max2f(a,b);
  auto rr=__builtin_amdgcn_permlane32_swap(__float_as_uint(m),__float_as_uint(m),false,false);
  return max2f(__uint_as_float(rr[0]),__uint_as_float(rr[1]));
}
__device__ __forceinline__ void pv(f32x16*o,int vb,bf16x8 pa0,bf16x8 pa1,bf16x8 pa2,bf16x8 pa3){
  #pragma unroll
  for(int d0=0;d0<2;++d0){s16x4 lo[4],hi[4];
    #pragma unroll
    for(int ks=0;ks<4;++ks){
      asm volatile("ds_read_b64_tr_b16 %0,%1 offset:%c2":"=&v"(lo[ks]):"v"(vb),"i"(d0*4096+ks*1024):"memory");
      asm volatile("ds_read_b64_tr_b16 %0,%1 offset:%c2":"=&v"(hi[ks]):"v"(vb),"i"(d0*4096+ks*1024+512):"memory");}
    asm volatile("s_waitcnt lgkmcnt(0)":::"memory");SBAR();
    #define PK(k) (bf16x8){lo[k][0],lo[k][1],lo[k][2],lo[k][3],hi[k][0],hi[k][1],hi[k][2],hi[k][3]}
    o[d0]=__builtin_amdgcn_mfma_f32_32x32x16_bf16(pa0,PK(0),o[d0],0,0,0);
    o[d0]=__builtin_amdgcn_mfma_f32_32x32x16_bf16(pa1,PK(1),o[d0],0,0,0);
    o[d0]=__builtin_amdgcn_mfma_f32_32x32x16_bf16(pa2,PK(2),o[d0],0,0,0);
    o[d0]=__builtin_amdgcn_mfma_f32_32x32x16_bf16(pa3,PK(3),o[d0],0,0,0);
    #undef PK
  }
}

#ifndef ATTN_STORE16
#define ATTN_STORE16(p,v) (*(u32x4*)(p)=(v))
#endif
template<int THRL,bool FIXREF=false> __device__ __forceinline__ void attn_unit(const bf16*Qu,const bf16*__restrict__ Kb,const bf16*__restrict__ Vb,bf16*Ou,int opitch,char*shm,int wid){
  const int lane=lane_id_asm(),r32=lane&31,hi=lane>>5;
  const bf16*Qw=Qu+(long)(wid*QBLK)*DM;
  const bf16*Kh=Kb,*Vh=Vb;
  const unsigned lds0=(unsigned)(uintptr_t)shm;
  float*wsf=(float*)(shm+LDS_WS)+wid*64;
  const bf16*ksrc=Kh+(long)lane*DM+wid*8;
  const bf16*vsrc=Vh+(long)(16*(wid&3)+(lane>>2))*DM+(wid>>2)*32+(lane&3)*8;
  const unsigned kdst=lds0+LDS_K+wid*1024, vdst=lds0+LDS_V+wid*1024;
  #define DMA_K(t,slot) glds16(ksrc+(long)(t)*KVBLK*DM,(unsigned)__builtin_amdgcn_readfirstlane(kdst+(slot)))
  #define DMA_V(t,slot) glds16(vsrc+(long)(t)*KVBLK*DM,(unsigned)__builtin_amdgcn_readfirstlane(vdst+(slot)))
  const int vb0=(int)(lds0+LDS_V)+((lane>>4)&1)*32+(lane&3)*8+(4*hi+((lane&15)>>2))*64;
  const char*Kbase=shm+LDS_K; bf16x8 kf[8];
  const lds_cptr shm3=(lds_cptr)shm; const lds_cptr kp0=shm3+LDS_K+hi*1024+r32*16; const lds_cptr vp0=shm3+LDS_V+((lane>>4)&1)*32+(lane&3)*8+(4*hi+((lane&15)>>2))*64;
  DMA_K(0,0);DMA_V(0,0);DMA_K(1,SLOTB);
  bf16x8 qr[4];
  #pragma unroll
  for(int d0=0;d0<4;++d0)qr[d0]=*reinterpret_cast<const bf16x8*>(&Qw[(long)r32*DM+d0*16+hi*8]);
  float mhat=0.f,l_reg=0.f;f32x16 o[2];o[0]=f32x16{};o[1]=f32x16{};f32x16 negm=f32x16{};asm volatile("":"+v"(negm));
  #define CMASK(P0,P1,t) do{}while(0)
  bool resc=false;
  #define START(P0,P1) do{ resc=false; if constexpr(!FIXREF){ const float rm=rowmax(P0,P1); \
    { const float dl=rm; mhat=fadd_s(mhat,dl); \
      _Pragma("unroll") for(int r=0;r<16;++r){P0[r]=fsub_s(P0[r],dl);P1[r]=fsub_s(P1[r],dl);} \
      _Pragma("unroll") for(int r=0;r<16;++r)negm[r]=-mhat; asm volatile("":"+v"(negm)); } } \
    _Pragma("unroll") for(int r=0;r<16;++r)P0[r]=__builtin_amdgcn_exp2f(P0[r]); }while(0)
  #define RESC() do{ if(resc){ asm volatile("s_waitcnt lgkmcnt(0)":::"memory"); \
      _Pragma("unroll") for(int d_=0;d_<2;++d_) _Pragma("unroll") for(int r=0;r<16;++r)o[d_][r]*=wsf[crow(r,hi)]; } }while(0)
  f32x16 pA0,pA1,pB0,pB1;
  int sl_prev=0,sl_cur=0,sl_next=SLOTB;
  #define ROT() do{sl_prev=sl_cur;sl_cur=sl_next;sl_next=(sl_next==(NSLOT-1)*SLOTB)?0:sl_next+SLOTB;}while(0)
  DMA_K(2,2*SLOTB);
  WAIT_BAR(3);
  qkt(pA0,pA1,Kbase,qr,negm,r32,hi);asm volatile("s_nop 15\n\ts_nop 7":"+v"(pA0),"+v"(pA1));CMASK(pA0,pA1,0);
  START(pA0,pA1);
  _Pragma("unroll") for(int r=0;r<16;++r)pA1[r]=__builtin_amdgcn_exp2f(pA1[r]);
  WAIT_BAR(0);
  DMA_K(3,0);DMA_V(1,SLOTB);
  ROT();
  kload8(kf,kp0+sl_cur);
  WAIT_BAR(2);
  s16x4 vlo[8],vhi[8]; u32x4 pw0,pw1,pw2,pw3;
  #define PKW(P,B) cvtpk_s(P[B],P[B+1])
  #define PAF(k) __builtin_bit_cast(bf16x8,pw##k)
  #define VFR(i) (bf16x8){vlo[i][0],vlo[i][1],vlo[i][2],vlo[i][3],vhi[i][0],vhi[i][1],vhi[i][2],vhi[i][3]}
  #define PIN(x) asm volatile("":"+v"(x))
  #define MX3(a,b,c) __builtin_fmaxf(__builtin_fmaxf((a),(b)),(c))
  #define GAPA(MF,A0,A1,A2,A3,W0,W1,PW) do{ MF; sacc+=A0; sacc+=A1; sacc+=A2; sacc+=A3; PIN(sacc); W0; W1; PIN(PW); SBAR(); }while(0)
  #define EX(v) __builtin_amdgcn_exp2f(v)
  #define GAPB(MF,X,B) do{ MF; X[B]=EX(X[B]); X[B+1]=EX(X[B+1]); X[B+2]=EX(X[B+2]); X[B+3]=EX(X[B+3]); PIN(X); SBAR(); }while(0)
  #define VRD(i) do{ vlo[i]=vtr(vp_+(((i)>>2)*4096+((i)&3)*1024)); vhi[i]=vtr(vp_+(((i)>>2)*4096+((i)&3)*1024+512)); }while(0)
  #define KRD(G,j) do{ if(G){ kload2(kf,kp0+sl_next,j); SBAR(); } }while(0)
  #define STEP(C0,C1,P0,P1,t,GK,GV,GL) do{ SBAR(); \
    const lds_cptr vp_=vp0+sl_prev; \
    VRD(0); SBAR(); float sacc=(P0[0]+P0[1]); \
    GAPA(C0=__builtin_amdgcn_mfma_f32_32x32x16_bf16(kf[0],qr[0],negm,0,0,0), P0[2],P0[3],P0[4],P0[5],     pw0[0]=PKW(P0,0), pw0[1]=PKW(P0,2), pw0); \
    VRD(4); SBAR(); GAPA(C1=__builtin_amdgcn_mfma_f32_32x32x16_bf16(kf[1],qr[0],negm,0,0,0), P0[6],P0[7],P0[8],P0[9],     pw0[2]=PKW(P0,4), pw0[3]=PKW(P0,6), pw0); \
    VRD(1); SBAR(); GAPA(C0=__builtin_amdgcn_mfma_f32_32x32x16_bf16(kf[2],qr[1],C0,0,0,0),   P0[10],P0[11],P0[12],P0[13], pw1[0]=PKW(P0,8), pw1[1]=PKW(P0,10), pw1); \
    VRD(5); SBAR(); GAPA(C1=__builtin_amdgcn_mfma_f32_32x32x16_bf16(kf[3],qr[1],C1,0,0,0),   P0[14],P0[15],P1[0],P1[1],   pw1[2]=PKW(P0,12),pw1[3]=PKW(P0,14), pw1); \
    VRD(2); SBAR(); GAPA(C0=__builtin_amdgcn_mfma_f32_32x32x16_bf16(kf[4],qr[2],C0,0,0,0),   P1[2],P1[3],P1[4],P1[5],     pw2[0]=PKW(P1,0), pw2[1]=PKW(P1,2), pw2); \
    VRD(6); SBAR(); GAPA(C1=__builtin_amdgcn_mfma_f32_32x32x16_bf16(kf[5],qr[2],C1,0,0,0),   P1[6],P1[7],P1[8],P1[9],     pw2[2]=PKW(P1,4), pw2[3]=PKW(P1,6), pw2); \
    VRD(3); SBAR(); GAPA(C0=__builtin_amdgcn_mfma_f32_32x32x16_bf16(kf[6],qr[3],C0,0,0,0),   P1[10],P1[11],P1[12],P1[13], pw3[0]=PKW(P1,8), pw3[1]=PKW(P1,10), pw3); \
    VRD(7); SBAR(); GAPA(C1=__builtin_amdgcn_mfma_f32_32x32x16_bf16(kf[7],qr[3],C1,0,0,0),   P1[14],P1[15],0.f,0.f,       pw3[2]=PKW(P1,12),pw3[3]=PKW(P1,14), pw3); \
    l_reg+=sacc; \
    if(GK){DMA_K((t)+3,sl_cur);} if(GV){DMA_V((t)+1,sl_next);} \
    CMASK(C0,C1,t); \
    if constexpr(!FIXREF){ float a=MX3(C0[0],C0[1],C1[0]),b=MX3(C0[2],C0[3],C1[1]); a=MX3(a,C1[2],C1[3]); \
      _Pragma("unroll") for(int r=4;r<16;r+=4){a=MX3(a,C0[r],C0[r+1]);b=MX3(b,C0[r+2],C0[r+3]);a=MX3(a,C1[r],C1[r+1]);b=MX3(b,C1[r+2],C1[r+3]);} \
      float rm=__builtin_fmaxf(a,b); { auto rr=__builtin_amdgcn_permlane32_swap(__float_as_uint(rm),__float_as_uint(rm),false,false); rm=__builtin_fmaxf(__uint_as_float(rr[0]),__uint_as_float(rr[1])); } \
      resc=false; \
      if(__builtin_expect(__any(rm>(float)THRL),0)){ const float dl=__builtin_fmaxf(rm,0.f); mhat+=dl; \
        _Pragma("unroll") for(int r=0;r<16;++r){C0[r]-=dl;C1[r]-=dl;} \
        _Pragma("unroll") for(int r=0;r<16;++r)negm[r]=-mhat; asm volatile("":"+v"(negm)); \
        const float f=__builtin_amdgcn_exp2f(-dl); l_reg*=f; if(hi==0)wsf[r32]=f; resc=true; } } \
    SBAR(); \
    GAPB(o[0]=__builtin_amdgcn_mfma_f32_32x32x16_bf16(PAF(0),VFR(0),o[0],0,0,0), C0,0); \
    GAPB(o[1]=__builtin_amdgcn_mfma_f32_32x32x16_bf16(PAF(0),VFR(4),o[1],0,0,0), C0,4); \
    KRD(GL,0); GAPB(o[0]=__builtin_amdgcn_mfma_f32_32x32x16_bf16(PAF(1),VFR(1),o[0],0,0,0), C0,8); \
    KRD(GL,1); GAPB(o[1]=__builtin_amdgcn_mfma_f32_32x32x16_bf16(PAF(1),VFR(5),o[1],0,0,0), C0,12); \
    KRD(GL,2); GAPB(o[0]=__builtin_amdgcn_mfma_f32_32x32x16_bf16(PAF(2),VFR(2),o[0],0,0,0), C1,0); \
    KRD(GL,3); GAPB(o[1]=__builtin_amdgcn_mfma_f32_32x32x16_bf16(PAF(2),VFR(6),o[1],0,0,0), C1,4); \
    GAPB(o[0]=__builtin_amdgcn_mfma_f32_32x32x16_bf16(PAF(3),VFR(3),o[0],0,0,0), C1,8); \
    GAPB(o[1]=__builtin_amdgcn_mfma_f32_32x32x16_bf16(PAF(3),VFR(7),o[1],0,0,0), C1,12); \
    }while(0)
  int t=1;
  for(;t+5<NT;t+=2){
    STEP(pB0,pB1,pA0,pA1,t,true,true,true);     WAIT_BAR(2); RESC(); ROT();
    STEP(pA0,pA1,pB0,pB1,t+1,true,true,true);   WAIT_BAR(2); RESC(); ROT();
  }
  #define ENDW(tt) do{ if((tt)+3<NT){WAIT_BAR(2);} else if((tt)+2<NT){WAIT_BAR(1);} else {WAIT_BAR(0);} }while(0)
  for(;t+1<NT;t+=2){
    STEP(pB0,pB1,pA0,pA1,t,(t+3<NT),(t+1<NT),(t+1<NT));       ENDW(t);   RESC(); ROT();
    STEP(pA0,pA1,pB0,pB1,t+1,(t+4<NT),(t+2<NT),(t+2<NT));     ENDW(t+1); RESC(); ROT();
  }
  STEP(pB0,pB1,pA0,pA1,NT-1,false,false,false); RESC();
  { float sacc=pB0[0]+pB0[1]; _Pragma("unroll") for(int r=2;r<16;++r)sacc+=pB0[r]; _Pragma("unroll") for(int r=0;r<16;++r)sacc+=pB1[r]; l_reg+=sacc;
    pw0=(u32x4){PKW(pB0,0),PKW(pB0,2),PKW(pB0,4),PKW(pB0,6)};pw1=(u32x4){PKW(pB0,8),PKW(pB0,10),PKW(pB0,12),PKW(pB0,14)};pw2=(u32x4){PKW(pB1,0),PKW(pB1,2),PKW(pB1,4),PKW(pB1,6)};pw3=(u32x4){PKW(pB1,8),PKW(pB1,10),PKW(pB1,12),PKW(pB1,14)};
    SBAR(); pv(o,vb0+sl_cur,PAF(0),PAF(1),PAF(2),PAF(3)); }
  #undef PKW
  #undef PAF
  #undef VFR
  #undef PIN
  #undef MX3
  #undef GAPA
  #undef GAPB
  #undef EX
  #undef VRD
  #undef KRD
  #undef STEP
  #undef ENDW
  {auto rr=__builtin_amdgcn_permlane32_swap(__float_as_uint(l_reg),__float_as_uint(l_reg),false,false);l_reg=__uint_as_float(rr[0])+__uint_as_float(rr[1]);}
  if(hi==0)wsf[32+r32]=l_reg;asm volatile("s_waitcnt lgkmcnt(0)":::"memory");
  float rli[16];
  #pragma unroll
  for(int r=0;r<16;++r)rli[r]=__builtin_amdgcn_rcpf(wsf[32+crow(r,hi)]);
  bf16*Ow=Ou+(long)(wid*QBLK)*opitch;
  { bf16*stg=(bf16*)(shm+LDS_OST)+wid*2048;
    #pragma unroll
    for(int r=0;r<16;++r){const int orow=crow(r,hi);
      #pragma unroll
      for(int d0=0;d0<2;++d0)stg[orow*64+d0*32+r32]=__float2bfloat16(o[d0][r]*rli[r]);}
    asm volatile("s_waitcnt lgkmcnt(0)":::"memory");
    #pragma unroll
    for(int i=0;i<4;++i){const int row=i*8+(lane>>3),ch=lane&7; const u32x4 v=*(const u32x4*)(stg+row*64+ch*8); ATTN_STORE16(Ow+(long)row*opitch+ch*8,v);} }
  asm volatile("s_waitcnt lgkmcnt(0)\n\ts_barrier":::"memory");
  #undef DMA_K
  #undef DMA_V
  #undef CMASK
  #undef START
  #undef RESC
  #undef ROT
}
constexpr int SLOTV2=16384, LDS2_K=0, LDS2_V=NSLOT*SLOTB, LDS2_WS=LDS2_V+NSLOT*SLOTV2, LDS2_BYTES=LDS2_WS+NW*64*4;
__device__ __forceinline__ void pv128(f32x16*o,int vb,bf16x8 pa0,bf16x8 pa1,bf16x8 pa2,bf16x8 pa3){
  #pragma unroll
  for(int d0=0;d0<4;++d0){s16x4 lo[4],hi[4];
    #pragma unroll
    for(int ks=0;ks<4;++ks){
      asm volatile("ds_read_b64_tr_b16 %0,%1 offset:%c2":"=&v"(lo[ks]):"v"(vb),"i"(d0*4096+ks*1024):"memory");
      asm volatile("ds_read_b64_tr_b16 %0,%1 offset:%c2":"=&v"(hi[ks]):"v"(vb),"i"(d0*4096+ks*1024+512):"memory");}
    asm volatile("s_waitcnt lgkmcnt(0)":::"memory");SBAR();
    #define PK(k) (bf16x8){lo[k][0],lo[k][1],lo[k][2],lo[k][3],hi[k][0],hi[k][1],hi[k][2],hi[k][3]}
    o[d0]=__builtin_amdgcn_mfma_f32_32x32x16_bf16(pa0,PK(0),o[d0],0,0,0);
    o[d0]=__builtin_amdgcn_mfma_f32_32x32x16_bf16(pa1,PK(1),o[d0],0,0,0);
    o[d0]=__builtin_amdgcn_mfma_f32_32x32x16_bf16(pa2,PK(2),o[d0],0,0,0);
    o[d0]=__builtin_amdgcn_mfma_f32_32x32x16_bf16(pa3,PK(3),o[d0],0,0,0);
    #undef PK
  }
}
template<int THRL,bool FIXREF=false> __device__ __forceinline__ void attn_unit128(const bf16*Qu,const bf16*__restrict__ Kb,const bf16*__restrict__ Vb,bf16*Ou,int opitch,char*shm,int wid,float*stash,float lam,const float*subg){
  const int lane=lane_id_asm(),r32=lane&31,hi=lane>>5;
  const bf16*Vh=Vb;
 for(int cpass=0;cpass<2;++cpass){
  const int lane_p=lane_id_asm(),r32p=lane_p&31,hip=lane_p>>5;
  const bf16*Qw=Qu+(long)(wid*QBLK)*DM+cpass*64;
  const bf16*Kh=Kb+cpass*64;
  const unsigned lds0=(unsigned)(uintptr_t)shm;
  float*wsf=(float*)(shm+LDS2_WS)+wid*64;
  const bf16*ksrc=Kh+(long)lane_p*DM+wid*8;
  const bf16*vsrc=Vh+(long)(16*(wid&3)+(lane_p>>2))*DM+(wid>>2)*32+(lane_p&3)*8;
  const unsigned kdst=lds0+LDS2_K+wid*1024, vdst=lds0+LDS2_V+wid*1024;
  #define DMA_K(t,slot) glds16(ksrc+(long)(t)*KVBLK*DM,(unsigned)__builtin_amdgcn_readfirstlane(kdst+(slot)))
  #define DMA_V(t,slot) do{ glds16(vsrc+(long)(t)*KVBLK*DM,(unsigned)__builtin_amdgcn_readfirstlane(vdst+2*(slot))); glds16(vsrc+(long)(t)*KVBLK*DM+64,(unsigned)__builtin_amdgcn_readfirstlane(vdst+2*(slot)+8192)); }while(0)
  const int vb0=(int)(lds0+LDS2_V)+((lane_p>>4)&1)*32+(lane_p&3)*8+(4*hip+((lane_p&15)>>2))*64;
  const char*Kbase=shm+LDS2_K; bf16x8 kf[8];
  const lds_cptr shm3=(lds_cptr)shm; const lds_cptr kp0=shm3+LDS2_K+hip*1024+r32p*16; const lds_cptr vp0=shm3+LDS2_V+((lane_p>>4)&1)*32+(lane_p&3)*8+(4*hip+((lane_p&15)>>2))*64;
  DMA_K(0,0);DMA_V(0,0);DMA_K(1,SLOTB);
  bf16x8 qr[4];
  #pragma unroll
  for(int d0=0;d0<4;++d0)qr[d0]=*reinterpret_cast<const bf16x8*>(&Qw[(long)r32p*DM+d0*16+hip*8]);
  float zf_; asm volatile("v_mov_b32 %0, 0":"=v"(zf_));
  float mhat=0.f,l_reg=0.f;f32x16 o[4];
  #pragma unroll
  for(int r=0;r<16;++r){o[0][r]=zf_;o[1][r]=zf_;o[2][r]=zf_;o[3][r]=zf_;}
  f32x16 negm;
  #pragma unroll
  for(int r=0;r<16;++r)negm[r]=zf_;
  asm volatile("":"+v"(negm));
  #define CMASK(P0,P1,t) do{}while(0)
  bool resc=false;
  #define START(P0,P1) do{ resc=false; if constexpr(!FIXREF){ const float rm=rowmax(P0,P1); \
    { const float dl=rm; mhat=fadd_s(mhat,dl); \
      _Pragma("unroll") for(int r=0;r<16;++r){P0[r]=fsub_s(P0[r],dl);P1[r]=fsub_s(P1[r],dl);} \
      _Pragma("unroll") for(int r=0;r<16;++r)negm[r]=-mhat; asm volatile("":"+v"(negm)); } } \
    _Pragma("unroll") for(int r=0;r<16;++r)P0[r]=__builtin_amdgcn_exp2f(P0[r]); }while(0)
  #define RESC() do{ if(resc){ asm volatile("s_waitcnt lgkmcnt(0)":::"memory"); \
      _Pragma("unroll") for(int d_=0;d_<4;++d_) _Pragma("unroll") for(int r=0;r<16;++r)o[d_][r]*=wsf[crow(r,hi)]; } }while(0)
  f32x16 pA0,pA1,pB0,pB1;
  int sl_prev=0,sl_cur=0,sl_next=SLOTB;
  #define ROT() do{sl_prev=sl_cur;sl_cur=sl_next;sl_next=(sl_next==(NSLOT-1)*SLOTB)?0:sl_next+SLOTB;}while(0)
  DMA_K(2,2*SLOTB);
  WAIT_BAR(4);
  qkt(pA0,pA1,Kbase,qr,negm,r32,hi);asm volatile("s_nop 15\n\ts_nop 7":"+v"(pA0),"+v"(pA1));CMASK(pA0,pA1,0);
  START(pA0,pA1);
  _Pragma("unroll") for(int r=0;r<16;++r)pA1[r]=__builtin_amdgcn_exp2f(pA1[r]);
  WAIT_BAR(0);
  DMA_K(3,0);DMA_V(1,SLOTB);
  ROT();
  kload8(kf,kp0+sl_cur);
  WAIT_BAR(3);
  s16x4 vlo[9],vhi[9]; u32x4 pw0,pw1,pw2,pw3;
  #define PKW(P,B) cvtpk_s(P[B],P[B+1])
  #define PAF(k) __builtin_bit_cast(bf16x8,pw##k)
  #define VFR(i) (bf16x8){vlo[i][0],vlo[i][1],vlo[i][2],vlo[i][3],vhi[i][0],vhi[i][1],vhi[i][2],vhi[i][3]}
  #define PIN(x) asm volatile("":"+v"(x))
  #define MX3(a,b,c) __builtin_fmaxf(__builtin_fmaxf((a),(b)),(c))
  #define GAPA(MF,A0,A1,A2,A3,W0,W1,PW) do{ MF; sacc+=A0; sacc+=A1; sacc+=A2; sacc+=A3; PIN(sacc); W0; W1; PIN(PW); SBAR(); }while(0)
  #define EX(v) __builtin_amdgcn_exp2f(v)
  #define GAPB(MF,X,B) do{ MF; X[B]=EX(X[B]); X[B+1]=EX(X[B+1]); PIN(X); SBAR(); }while(0)
  #define VRD2(i,s) do{ vlo[s]=vtr(vp_+(8192+((i)>>2)*4096+((i)&3)*1024)); vhi[s]=vtr(vp_+(8192+((i)>>2)*4096+((i)&3)*1024+512)); }while(0)
  #define VRD(i) do{ vlo[i]=vtr(vp_+(((i)>>2)*4096+((i)&3)*1024)); vhi[i]=vtr(vp_+(((i)>>2)*4096+((i)&3)*1024+512)); }while(0)
  #define KRD(G,j) do{ if(G){ kload2(kf,kp0+sl_next,j); SBAR(); } }while(0)
  #define STEP(C0,C1,P0,P1,t,GK,GV,GL) do{ SBAR(); \
    const lds_cptr vp_=vp0+2*sl_prev; \
    VRD(0); SBAR(); float sacc=(P0[0]+P0[1]); \
    GAPA(C0=__builtin_amdgcn_mfma_f32_32x32x16_bf16(kf[0],qr[0],negm,0,0,0), P0[2],P0[3],P0[4],P0[5],     pw0[0]=PKW(P0,0), pw0[1]=PKW(P0,2), pw0); \
    VRD(4); SBAR(); GAPA(C1=__builtin_amdgcn_mfma_f32_32x32x16_bf16(kf[1],qr[0],negm,0,0,0), P0[6],P0[7],P0[8],P0[9],     pw0[2]=PKW(P0,4), pw0[3]=PKW(P0,6), pw0); \
    VRD(1); SBAR(); GAPA(C0=__builtin_amdgcn_mfma_f32_32x32x16_bf16(kf[2],qr[1],C0,0,0,0),   P0[10],P0[11],P0[12],P0[13], pw1[0]=PKW(P0,8), pw1[1]=PKW(P0,10), pw1); \
    VRD(5); SBAR(); GAPA(C1=__builtin_amdgcn_mfma_f32_32x32x16_bf16(kf[3],qr[1],C1,0,0,0),   P0[14],P0[15],P1[0],P1[1],   pw1[2]=PKW(P0,12),pw1[3]=PKW(P0,14), pw1); \
    VRD(2); SBAR(); GAPA(C0=__builtin_amdgcn_mfma_f32_32x32x16_bf16(kf[4],qr[2],C0,0,0,0),   P1[2],P1[3],P1[4],P1[5],     pw2[0]=PKW(P1,0), pw2[1]=PKW(P1,2), pw2); \
    VRD(6); SBAR(); GAPA(C1=__builtin_amdgcn_mfma_f32_32x32x16_bf16(kf[5],qr[2],C1,0,0,0),   P1[6],P1[7],P1[8],P1[9],     pw2[2]=PKW(P1,4), pw2[3]=PKW(P1,6), pw2); \
    VRD(3); SBAR(); GAPA(C0=__builtin_amdgcn_mfma_f32_32x32x16_bf16(kf[6],qr[3],C0,0,0,0),   P1[10],P1[11],P1[12],P1[13], pw3[0]=PKW(P1,8), pw3[1]=PKW(P1,10), pw3); \
    VRD(7); SBAR(); GAPA(C1=__builtin_amdgcn_mfma_f32_32x32x16_bf16(kf[7],qr[3],C1,0,0,0),   P1[14],P1[15],0.f,0.f,       pw3[2]=PKW(P1,12),pw3[3]=PKW(P1,14), pw3); \
    l_reg+=sacc; \
    if(GK){DMA_K((t)+3,sl_cur);} if(GV){DMA_V((t)+1,sl_next);} \
    CMASK(C0,C1,t); \
    if constexpr(!FIXREF){ float a=MX3(C0[0],C0[1],C1[0]),b=MX3(C0[2],C0[3],C1[1]); a=MX3(a,C1[2],C1[3]); \
      _Pragma("unroll") for(int r=4;r<16;r+=4){a=MX3(a,C0[r],C0[r+1]);b=MX3(b,C0[r+2],C0[r+3]);a=MX3(a,C1[r],C1[r+1]);b=MX3(b,C1[r+2],C1[r+3]);} \
      float rm=__builtin_fmaxf(a,b); { auto rr=__builtin_amdgcn_permlane32_swap(__float_as_uint(rm),__float_as_uint(rm),false,false); rm=__builtin_fmaxf(__uint_as_float(rr[0]),__uint_as_float(rr[1])); } \
      resc=false; \
      if(__builtin_expect(__any(rm>(float)THRL),0)){ const float dl=__builtin_fmaxf(rm,0.f); mhat+=dl; \
        _Pragma("unroll") for(int r=0;r<16;++r){C0[r]-=dl;C1[r]-=dl;} \
        _Pragma("unroll") for(int r=0;r<16;++r)negm[r]=-mhat; asm volatile("":"+v"(negm)); \
        const float f=__builtin_amdgcn_exp2f(-dl); l_reg*=f; { const int l2_=lane_id_asm(); if((l2_>>5)==0)wsf[l2_&31]=f; } resc=true; } } \
    SBAR(); \
    VRD2(0,8); SBAR(); GAPB(o[0]=__builtin_amdgcn_mfma_f32_32x32x16_bf16(PAF(0),VFR(0),o[0],0,0,0), C0,0); \
    VRD2(4,0); SBAR(); GAPB(o[1]=__builtin_amdgcn_mfma_f32_32x32x16_bf16(PAF(0),VFR(4),o[1],0,0,0), C0,2); \
    VRD2(1,4); SBAR(); GAPB(o[0]=__builtin_amdgcn_mfma_f32_32x32x16_bf16(PAF(1),VFR(1),o[0],0,0,0), C0,4); \
    VRD2(5,1); SBAR(); GAPB(o[1]=__builtin_amdgcn_mfma_f32_32x32x16_bf16(PAF(1),VFR(5),o[1],0,0,0), C0,6); \
    VRD2(2,5); SBAR(); GAPB(o[0]=__builtin_amdgcn_mfma_f32_32x32x16_bf16(PAF(2),VFR(2),o[0],0,0,0), C0,8); \
    VRD2(6,2); SBAR(); GAPB(o[1]=__builtin_amdgcn_mfma_f32_32x32x16_bf16(PAF(2),VFR(6),o[1],0,0,0), C0,10); \
    VRD2(3,6); SBAR(); GAPB(o[0]=__builtin_amdgcn_mfma_f32_32x32x16_bf16(PAF(3),VFR(3),o[0],0,0,0), C0,12); \
    VRD2(7,3); SBAR(); GAPB(o[1]=__builtin_amdgcn_mfma_f32_32x32x16_bf16(PAF(3),VFR(7),o[1],0,0,0), C0,14); \
    KRD(GL,0); GAPB(o[2]=__builtin_amdgcn_mfma_f32_32x32x16_bf16(PAF(0),VFR(8),o[2],0,0,0), C1,0); \
    KRD(GL,1); GAPB(o[3]=__builtin_amdgcn_mfma_f32_32x32x16_bf16(PAF(0),VFR(0),o[3],0,0,0), C1,2); \
    KRD(GL,2); GAPB(o[2]=__builtin_amdgcn_mfma_f32_32x32x16_bf16(PAF(1),VFR(4),o[2],0,0,0), C1,4); \
    KRD(GL,3); GAPB(o[3]=__builtin_amdgcn_mfma_f32_32x32x16_bf16(PAF(1),VFR(1),o[3],0,0,0), C1,6); \
    GAPB(o[2]=__builtin_amdgcn_mfma_f32_32x32x16_bf16(PAF(2),VFR(5),o[2],0,0,0), C1,8); \
    GAPB(o[3]=__builtin_amdgcn_mfma_f32_32x32x16_bf16(PAF(2),VFR(2),o[3],0,0,0), C1,10); \
    GAPB(o[2]=__builtin_amdgcn_mfma_f32_32x32x16_bf16(PAF(3),VFR(6),o[2],0,0,0), C1,12); \
    GAPB(o[3]=__builtin_amdgcn_mfma_f32_32x32x16_bf16(PAF(3),VFR(3),o[3],0,0,0), C1,14); \
    }while(0)
  int t=1;
  for(;t+5<NT;t+=2){
    STEP(pB0,pB1,pA0,pA1,t,true,true,true);     WAIT_BAR(3); RESC(); ROT();
    STEP(pA0,pA1,pB0,pB1,t+1,true,true,true);   WAIT_BAR(3); RESC(); ROT();
  }
  #define ENDW(tt) do{ if((tt)+3<NT){WAIT_BAR(3);} else if((tt)+2<NT){WAIT_BAR(2);} else {WAIT_BAR(0);} }while(0)
  for(;t+1<NT;t+=2){
    STEP(pB0,pB1,pA0,pA1,t,(t+3<NT),(t+1<NT),(t+1<NT));       ENDW(t);   RESC(); ROT();
    STEP(pA0,pA1,pB0,pB1,t+1,(t+4<NT),(t+2<NT),(t+2<NT));     ENDW(t+1); RESC(); ROT();
  }
  STEP(pB0,pB1,pA0,pA1,NT-1,false,false,false); RESC();
  { float sacc=pB0[0]+pB0[1]; _Pragma("unroll") for(int r=2;r<16;++r)sacc+=pB0[r]; _Pragma("unroll") for(int r=0;r<16;++r)sacc+=pB1[r]; l_reg+=sacc;
    pw0=(u32x4){PKW(pB0,0),PKW(pB0,2),PKW(pB0,4),PKW(pB0,6)};pw1=(u32x4){PKW(pB0,8),PKW(pB0,10),PKW(pB0,12),PKW(pB0,14)};pw2=(u32x4){PKW(pB1,0),PKW(pB1,2),PKW(pB1,4),PKW(pB1,6)};pw3=(u32x4){PKW(pB1,8),PKW(pB1,10),PKW(pB1,12),PKW(pB1,14)};
    SBAR(); pv128(o,vb0+2*sl_cur,PAF(0),PAF(1),PAF(2),PAF(3)); }
  #undef PKW
  #undef PAF
  #undef VFR
  #undef VRD2
  #undef PIN
  #undef MX3
  #undef GAPA
  #undef GAPB
  #undef EX
  #undef VRD
  #undef KRD
  #undef STEP
  #undef ENDW
  {auto rr=__builtin_amdgcn_permlane32_swap(__float_as_uint(l_reg),__float_as_uint(l_reg),false,false);l_reg=__uint_as_float(rr[0])+__uint_as_float(rr[1]);}
  const int lane_e=lane_id_asm(),r32e=lane_e&31,hie=lane_e>>5;
  if(hie==0)wsf[32+r32e]=l_reg;asm volatile("s_waitcnt lgkmcnt(0)":::"memory");
  float rli[16];
  #pragma unroll
  for(int r=0;r<16;++r)rli[r]=__builtin_amdgcn_rcpf(wsf[32+crow(r,hie)]);
  float*st=stash+(size_t)wid*4096+lane_e*4;
  if(cpass==0){
    #pragma unroll
    for(int d0=0;d0<4;++d0)
      #pragma unroll
      for(int q4=0;q4<4;++q4){ typedef float f32x4_t __attribute__((ext_vector_type(4)));
        const f32x4_t v={o[d0][4*q4]*rli[4*q4],o[d0][4*q4+1]*rli[4*q4+1],o[d0][4*q4+2]*rli[4*q4+2],o[d0][4*q4+3]*rli[4*q4+3]};
        *(f32x4_t*)(st+(d0*4+q4)*256)=v; }
  } else {
    typedef float f32x4_t __attribute__((ext_vector_type(4)));
    float ss[16];
    #pragma unroll
    for(int r=0;r<16;++r)ss[r]=0.f;
    #pragma unroll
    for(int d0=0;d0<4;++d0)
      #pragma unroll
      for(int q4=0;q4<4;++q4){ const f32x4_t a=*(const f32x4_t*)(st+(d0*4+q4)*256);
        #pragma unroll
        for(int i=0;i<4;++i){ const int r=4*q4+i; const float v=a[i]-lam*(o[d0][r]*rli[r]); o[d0][r]=v; ss[r]+=v*v; } if(q4==3)asm volatile("":::"memory"); }
    #pragma unroll
    for(int r=0;r<16;++r){ float s=ss[r]; s+=__shfl_xor(s,1); s+=__shfl_xor(s,2); s+=__shfl_xor(s,4); s+=__shfl_xor(s,8); s+=__shfl_xor(s,16); ss[r]=0.8f/sqrtf(s*(1.0f/128.0f)+1e-6f); }
    float gsub[4];
    #pragma unroll
    for(int d0=0;d0<4;++d0)gsub[d0]=subg[d0*32+r32e];
    asm volatile("s_waitcnt lgkmcnt(0)\n\ts_barrier":::"memory");
    bf16*Ow=Ou+(long)(wid*QBLK)*opitch;
    bf16*stg=(bf16*)shm+wid*4096;
    #pragma unroll
    for(int r=0;r<16;++r){const int orow=crow(r,hie);
      #pragma unroll
      for(int d0=0;d0<4;++d0)stg[orow*128+d0*32+r32e]=__float2bfloat16(o[d0][r]*ss[r]*gsub[d0]);}
    asm volatile("s_waitcnt lgkmcnt(0)":::"memory");
    #pragma unroll
    for(int i=0;i<8;++i){const int row=i*4+(lane_e>>4),ch=lane_e&15; const u32x4 v=*(const u32x4*)(stg+row*128+ch*8); ATTN_STORE16(Ow+(long)row*opitch+ch*8,v);}
  }
  asm volatile("s_waitcnt lgkmcnt(0)\n\ts_barrier":::"memory");
 }
  #undef DMA_K
  #undef DMA_V
  #undef CMASK
  #undef START
  #undef RESC
  #undef ROT
}

typedef int v8i32_t __attribute__((ext_vector_type(8))); typedef int v4i32_t __attribute__((ext_vector_type(4)));
constexpr int P8=1664;
#define MFMA8(a,b,c) __builtin_amdgcn_mfma_scale_f32_32x32x64_f8f6f4(a,b,c,0,0,0,0,0,0)
__device__ __forceinline__ v8i32_t cat8v(v4i32_t a,v4i32_t b){ return __builtin_shufflevector(a,b,0,1,2,3,4,5,6,7); }
__device__ __forceinline__ v8i32_t kfrag8(lds_cptr kp){ return cat8v(*(const __attribute__((address_space(3))) v4i32_t*)(kp),*(const __attribute__((address_space(3))) v4i32_t*)(kp+1024)); }
__device__ __forceinline__ void qkt8(f32x16&p0,f32x16&p1,lds_cptr kp,v8i32_t q8,const f32x16&negm){ const v8i32_t a=kfrag8(kp),b=kfrag8(kp+512); p0=MFMA8(a,q8,negm); p1=MFMA8(b,q8,negm); }
constexpr int SLOTK8=4096;
constexpr int L8A_K=0, L8A_V=NSLOT*SLOTK8, L8A_WS=L8A_V+NSLOT*8192, L8A_OST=L8A_WS+NW*64*4, L8A_BYTES=L8A_OST+NW*4096;
constexpr int L8B_K=0, L8B_V=NSLOT*SLOTK8, L8B_WS=65536, L8B_BYTES=L8B_WS+NW*64*4;
template<int THRL,bool FIXREF=false> __device__ __forceinline__ void attn_unit_q8(const unsigned char*Qu8,const unsigned char*__restrict__ Kb8,const bf16*__restrict__ Vb,bf16*Ou,int opitch,char*shm,int wid){
  const int lane=lane_id_asm(),r32=lane&31,hi=lane>>5;
  const unsigned char*Qw8=Qu8+(long)(wid*QBLK)*P8;
  const unsigned char*Kh8=Kb8; const bf16*Vh=Vb;
  const unsigned lds0=(unsigned)(uintptr_t)shm;
  float*wsf=(float*)(shm+L8A_WS)+wid*64;
  const unsigned char*ksrc=Kh8+(long)lane*P8+(wid&3)*16;
  const bf16*vsrc=Vh+(long)(16*(wid&3)+(lane>>2))*DM+(wid>>2)*32+(lane&3)*8;
  const unsigned kdst=lds0+L8A_K+(wid&3)*1024, vdst=lds0+L8A_V+wid*1024;
  #define DMA_K(t,slot) glds16(ksrc+(long)(t)*KVBLK*P8,(unsigned)__builtin_amdgcn_readfirstlane(kdst+(slot)))
  #define DMA_V(t,slot) glds16(vsrc+(long)(t)*KVBLK*DM,(unsigned)__builtin_amdgcn_readfirstlane(vdst+2*(slot)))
  const int vb0=(int)(lds0+L8A_V)+((lane>>4)&1)*32+(lane&3)*8+(4*hi+((lane&15)>>2))*64;
  v8i32_t kf8[2];
  const lds_cptr shm3=(lds_cptr)shm; const lds_cptr kp0=shm3+L8A_K+hi*2048+r32*16; const lds_cptr vp0=shm3+L8A_V+((lane>>4)&1)*32+(lane&3)*8+(4*hi+((lane&15)>>2))*64;
  DMA_K(0,0);DMA_V(0,0);DMA_K(1,SLOTK8);
  const v8i32_t q8=*reinterpret_cast<const v8i32_t*>(Qw8+(long)r32*P8+hi*32);
  float mhat=0.f,l_reg=0.f;f32x16 o[2];o[0]=f32x16{};o[1]=f32x16{};f32x16 negm=f32x16{};asm volatile("":"+v"(negm));
  #define CMASK(P0,P1,t) do{}while(0)
  bool resc=false;
  #define START(P0,P1) do{ resc=false; if constexpr(!FIXREF){ const float rm=rowmax(P0,P1); \
    { const float dl=rm; mhat=fadd_s(mhat,dl); \
      _Pragma("unroll") for(int r=0;r<16;++r){P0[r]=fsub_s(P0[r],dl);P1[r]=fsub_s(P1[r],dl);} \
      _Pragma("unroll") for(int r=0;r<16;++r)negm[r]=-mhat; asm volatile("":"+v"(negm)); } } \
    _Pragma("unroll") for(int r=0;r<16;++r)P0[r]=__builtin_amdgcn_exp2f(P0[r]); }while(0)
  #define RESC() do{ if(resc){ asm volatile("s_waitcnt lgkmcnt(0)":::"memory"); \
      _Pragma("unroll") for(int d_=0;d_<2;++d_) _Pragma("unroll") for(int r=0;r<16;++r)o[d_][r]*=wsf[crow(r,hi)]; } }while(0)
  f32x16 pA0,pA1,pB0,pB1;
  int sl_prev=0,sl_cur=0,sl_next=SLOTK8;
  #define ROT() do{sl_prev=sl_cur;sl_cur=sl_next;sl_next=(sl_next==(NSLOT-1)*SLOTK8)?0:sl_next+SLOTK8;}while(0)
  DMA_K(2,2*SLOTK8);
  WAIT_BAR(3);
  qkt8(pA0,pA1,kp0,q8,negm);asm volatile("s_nop 15\n\ts_nop 7":"+v"(pA0),"+v"(pA1));CMASK(pA0,pA1,0);
  START(pA0,pA1);
  _Pragma("unroll") for(int r=0;r<16;++r)pA1[r]=__builtin_amdgcn_exp2f(pA1[r]);
  WAIT_BAR(0);
  DMA_K(3,0);DMA_V(1,SLOTK8);
  ROT();
  kf8[0]=kfrag8(kp0+sl_cur); kf8[1]=kfrag8(kp0+sl_cur+512);
  WAIT_BAR(2);
  s16x4 vlo[8],vhi[8]; u32x4 pw0,pw1,pw2,pw3;
  #define PKW(P,B) cvtpk_s(P[B],P[B+1])
  #define PAF(k) __builtin_bit_cast(bf16x8,pw##k)
  #define VFR(i) (bf16x8){vlo[i][0],vlo[i][1],vlo[i][2],vlo[i][3],vhi[i][0],vhi[i][1],vhi[i][2],vhi[i][3]}
  #define PIN(x) asm volatile("":"+v"(x))
  #define MX3(a,b,c) __builtin_fmaxf(__builtin_fmaxf((a),(b)),(c))
  #define GAPA(MF,A0,A1,A2,A3,W0,W1,PW) do{ MF; sacc+=A0; sacc+=A1; sacc+=A2; sacc+=A3; PIN(sacc); W0; W1; PIN(PW); SBAR(); }while(0)
  #define EX(v) __builtin_amdgcn_exp2f(v)
  #define GAPB(MF,X,B) do{ MF; X[B]=EX(X[B]); X[B+1]=EX(X[B+1]); X[B+2]=EX(X[B+2]); X[B+3]=EX(X[B+3]); PIN(X); SBAR(); }while(0)
  #define VRD(i) do{ vlo[i]=vtr(vp_+(((i)>>2)*4096+((i)&3)*1024)); vhi[i]=vtr(vp_+(((i)>>2)*4096+((i)&3)*1024+512)); }while(0)
  #define KRD(G,j) do{ if(G){ kf8[j]=kfrag8(kp0+sl_next+(j)*512); SBAR(); } }while(0)
  #define STEP(C0,C1,P0,P1,t,GK,GV,GL) do{ SBAR(); \
    const lds_cptr vp_=vp0+2*sl_prev; \
    VRD(0); SBAR(); float sacc=(P0[0]+P0[1]); \
    C0=MFMA8(kf8[0],q8,negm); \
    sacc+=P0[2];sacc+=P0[3];sacc+=P0[4];sacc+=P0[5];sacc+=P0[6];sacc+=P0[7]; PIN(sacc); pw0[0]=PKW(P0,0); pw0[1]=PKW(P0,2); pw0[2]=PKW(P0,4); pw0[3]=PKW(P0,6); PIN(pw0); SBAR(); \
    VRD(4); SBAR(); \
    sacc+=P0[8];sacc+=P0[9];sacc+=P0[10];sacc+=P0[11];sacc+=P0[12];sacc+=P0[13];sacc+=P0[14];sacc+=P0[15]; PIN(sacc); pw1[0]=PKW(P0,8); pw1[1]=PKW(P0,10); pw1[2]=PKW(P0,12); pw1[3]=PKW(P0,14); PIN(pw1); SBAR(); \
    VRD(1); VRD(5); SBAR(); \
    C1=MFMA8(kf8[1],q8,negm); \
    sacc+=P1[0];sacc+=P1[1];sacc+=P1[2];sacc+=P1[3];sacc+=P1[4];sacc+=P1[5];sacc+=P1[6];sacc+=P1[7]; PIN(sacc); pw2[0]=PKW(P1,0); pw2[1]=PKW(P1,2); pw2[2]=PKW(P1,4); pw2[3]=PKW(P1,6); PIN(pw2); SBAR(); \
    VRD(2); VRD(6); SBAR(); \
    sacc+=P1[8];sacc+=P1[9];sacc+=P1[10];sacc+=P1[11];sacc+=P1[12];sacc+=P1[13];sacc+=P1[14];sacc+=P1[15]; PIN(sacc); pw3[0]=PKW(P1,8); pw3[1]=PKW(P1,10); pw3[2]=PKW(P1,12); pw3[3]=PKW(P1,14); PIN(pw3); SBAR(); \
    VRD(3); VRD(7); SBAR(); \
    l_reg+=sacc; \
    if(GK){DMA_K((t)+3,sl_cur);} if(GV){DMA_V((t)+1,sl_next);} \
    CMASK(C0,C1,t); \
    if constexpr(!FIXREF){ float a=MX3(C0[0],C0[1],C1[0]),b=MX3(C0[2],C0[3],C1[1]); a=MX3(a,C1[2],C1[3]); \
      _Pragma("unroll") for(int r=4;r<16;r+=4){a=MX3(a,C0[r],C0[r+1]);b=MX3(b,C0[r+2],C0[r+3]);a=MX3(a,C1[r],C1[r+1]);b=MX3(b,C1[r+2],C1[r+3]);} \
      float rm=__builtin_fmaxf(a,b); { auto rr=__builtin_amdgcn_permlane32_swap(__float_as_uint(rm),__float_as_uint(rm),false,false); rm=__builtin_fmaxf(__uint_as_float(rr[0]),__uint_as_float(rr[1])); } \
      resc=false; \
      if(__builtin_expect(__any(rm>(float)THRL),0)){ const float dl=__builtin_fmaxf(rm,0.f); mhat+=dl; \
        _Pragma("unroll") for(int r=0;r<16;++r){C0[r]-=dl;C1[r]-=dl;} \
        _Pragma("unroll") for(int r=0;r<16;++r)negm[r]=-mhat; asm volatile("":"+v"(negm)); \
        const float f=__builtin_amdgcn_exp2f(-dl); l_reg*=f; if(hi==0)wsf[r32]=f; resc=true; } } \
    SBAR(); \
    GAPB(o[0]=__builtin_amdgcn_mfma_f32_32x32x16_bf16(PAF(0),VFR(0),o[0],0,0,0), C0,0); \
    GAPB(o[1]=__builtin_amdgcn_mfma_f32_32x32x16_bf16(PAF(0),VFR(4),o[1],0,0,0), C0,4); \
    KRD(GL,0); GAPB(o[0]=__builtin_amdgcn_mfma_f32_32x32x16_bf16(PAF(1),VFR(1),o[0],0,0,0), C0,8); \
    KRD(GL,1); GAPB(o[1]=__builtin_amdgcn_mfma_f32_32x32x16_bf16(PAF(1),VFR(5),o[1],0,0,0), C0,12); \
    GAPB(o[0]=__builtin_amdgcn_mfma_f32_32x32x16_bf16(PAF(2),VFR(2),o[0],0,0,0), C1,0); \
    GAPB(o[1]=__builtin_amdgcn_mfma_f32_32x32x16_bf16(PAF(2),VFR(6),o[1],0,0,0), C1,4); \
    GAPB(o[0]=__builtin_amdgcn_mfma_f32_32x32x16_bf16(PAF(3),VFR(3),o[0],0,0,0), C1,8); \
    GAPB(o[1]=__builtin_amdgcn_mfma_f32_32x32x16_bf16(PAF(3),VFR(7),o[1],0,0,0), C1,12); \
    }while(0)
  int t=1;
  for(;t+5<NT;t+=2){
    STEP(pB0,pB1,pA0,pA1,t,true,true,true);     WAIT_BAR(2); RESC(); ROT();
    STEP(pA0,pA1,pB0,pB1,t+1,true,true,true);   WAIT_BAR(2); RESC(); ROT();
  }
  #define ENDW(tt) do{ if((tt)+3<NT){WAIT_BAR(2);} else if((tt)+2<NT){WAIT_BAR(1);} else {WAIT_BAR(0);} }while(0)
  for(;t+1<NT;t+=2){
    STEP(pB0,pB1,pA0,pA1,t,(t+3<NT),(t+1<NT),(t+1<NT));       ENDW(t);   RESC(); ROT();
    STEP(pA0,pA1,pB0,pB1,t+1,(t+4<NT),(t+2<NT),(t+2<NT));     ENDW(t+1); RESC(); ROT();
  }
  STEP(pB0,pB1,pA0,pA1,NT-1,false,false,false); RESC();
  { float sacc=pB0[0]+pB0[1]; _Pragma("unroll") for(int r=2;r<16;++r)sacc+=pB0[r]; _Pragma("unroll") for(int r=0;r<16;++r)sacc+=pB1[r]; l_reg+=sacc;
    pw0=(u32x4){PKW(pB0,0),PKW(pB0,2),PKW(pB0,4),PKW(pB0,6)};pw1=(u32x4){PKW(pB0,8),PKW(pB0,10),PKW(pB0,12),PKW(pB0,14)};pw2=(u32x4){PKW(pB1,0),PKW(pB1,2),PKW(pB1,4),PKW(pB1,6)};pw3=(u32x4){PKW(pB1,8),PKW(pB1,10),PKW(pB1,12),PKW(pB1,14)};
    SBAR(); pv(o,vb0+2*sl_cur,PAF(0),PAF(1),PAF(2),PAF(3)); }
  #undef PKW
  #undef PAF
  #undef VFR
  #undef PIN
  #undef MX3
  #undef GAPA
  #undef GAPB
  #undef EX
  #undef VRD
  #undef KRD
  #undef STEP
  #undef ENDW
  {auto rr=__builtin_amdgcn_permlane32_swap(__float_as_uint(l_reg),__float_as_uint(l_reg),false,false);l_reg=__uint_as_float(rr[0])+__uint_as_float(rr[1]);}
  if(hi==0)wsf[32+r32]=l_reg;asm volatile("s_waitcnt lgkmcnt(0)":::"memory");
  float rli[16];
  #pragma unroll
  for(int r=0;r<16;++r)rli[r]=__builtin_amdgcn_rcpf(wsf[32+crow(r,hi)]);
  bf16*Ow=Ou+(long)(wid*QBLK)*opitch;
  { bf16*stg=(bf16*)(shm+L8A_OST)+wid*2048;
    #pragma unroll
    for(int r=0;r<16;++r){const int orow=crow(r,hi);
      #pragma unroll
      for(int d0=0;d0<2;++d0)stg[orow*64+d0*32+r32]=__float2bfloat16(o[d0][r]*rli[r]);}
    asm volatile("s_waitcnt lgkmcnt(0)":::"memory");
    #pragma unroll
    for(int i=0;i<4;++i){const int row=i*8+(lane>>3),ch=lane&7; const u32x4 v=*(const u32x4*)(stg+row*64+ch*8); ATTN_STORE16(Ow+(long)row*opitch+ch*8,v);} }
  asm volatile("s_waitcnt lgkmcnt(0)\n\ts_barrier":::"memory");
  #undef DMA_K
  #undef DMA_V
  #undef CMASK
  #undef START
  #undef RESC
  #undef ROT
}
typedef int v2i32_t __attribute__((ext_vector_type(2)));
constexpr int PV8=640;
constexpr int L9A_K=0, L9A_V=4*SLOTK8, L9A_WS=7*SLOTK8, L9A_OST=L9A_WS+NW*64*4, L9A_BYTES=L9A_OST+NW*4096;
template<int THRL,bool FIXREF=false> __device__ __forceinline__ void attn_unit_q8v(const unsigned char*Qu8,const unsigned char*__restrict__ Kb8,const unsigned char*__restrict__ Vb8,bf16*Ou,int opitch,char*shm,int wid){
  const int lane=lane_id_asm(),r32=lane&31,hi=lane>>5;
  const unsigned char*Qw8=Qu8+(long)(wid*QBLK)*P8;
  const unsigned char*Kh8=Kb8; const bool kw=wid<4;
  const unsigned lds0=(unsigned)(uintptr_t)shm;
  float*wsf=(float*)(shm+L9A_WS)+wid*64;
  const unsigned char*ksrc=Kh8+(long)lane*P8+(wid&3)*16;
  const int vkey_=16*(wid&3)+(lane>>2), vc_=(lane&3)^(((vkey_>>3)&1)<<1);
  const unsigned char*vsrc=Vb8+(long)vkey_*PV8+vc_*16;
  const unsigned kdst=lds0+L9A_K+(wid&3)*1024, vdst=lds0+L9A_V+(wid&3)*1024;
  #define DMA_K(t,slot) glds16(ksrc+(long)(t)*KVBLK*P8,(unsigned)__builtin_amdgcn_readfirstlane(kdst+(slot)))
  #define DMA_V(t,slot) glds16(vsrc+(long)(t)*KVBLK*PV8,(unsigned)__builtin_amdgcn_readfirstlane(vdst+(slot)))
  v8i32_t kf8[2];
  const lds_cptr shm3=(lds_cptr)shm; const lds_cptr kp0=shm3+L9A_K+hi*2048+r32*16;
  const int vq_=(lane&15)>>1, vkey0_=(vq_&3)+8*(vq_>>2)+4*hi, vsw_=(vq_>>2)<<1;
  const lds_cptr vpA=shm3+L9A_V+vkey0_*64+((((lane>>4)&1))^vsw_)*16+(lane&1)*8, vpB=shm3+L9A_V+vkey0_*64+((2+((lane>>4)&1))^vsw_)*16+(lane&1)*8;
  if(kw){DMA_K(0,0);DMA_K(1,SLOTK8);}else{DMA_V(0,0);}
  const v8i32_t q8=*reinterpret_cast<const v8i32_t*>(Qw8+(long)r32*P8+hi*32);
  float mhat=0.f,l_reg=0.f;f32x16 o[2];o[0]=f32x16{};o[1]=f32x16{};f32x16 negm=f32x16{};asm volatile("":"+v"(negm));
  #define CMASK(P0,P1,t) do{}while(0)
  bool resc=false;
  #define START(P0,P1) do{ resc=false; if constexpr(!FIXREF){ const float rm=rowmax(P0,P1); \
    { const float dl=rm; mhat=fadd_s(mhat,dl); \
      _Pragma("unroll") for(int r=0;r<16;++r){P0[r]=fsub_s(P0[r],dl);P1[r]=fsub_s(P1[r],dl);} \
      _Pragma("unroll") for(int r=0;r<16;++r)negm[r]=-mhat; asm volatile("":"+v"(negm)); } } \
    _Pragma("unroll") for(int r=0;r<16;++r)P0[r]=__builtin_amdgcn_exp2f(P0[r]); }while(0)
  #define RESC() do{ if(resc){ asm volatile("s_waitcnt lgkmcnt(0)":::"memory"); \
      _Pragma("unroll") for(int d_=0;d_<2;++d_) _Pragma("unroll") for(int r=0;r<16;++r)o[d_][r]*=wsf[crow(r,hi)]; } }while(0)
  f32x16 pA0,pA1,pB0,pB1;
  int sl_prev=0,sl_cur=0,sl_next=SLOTK8;
  int kq_prev=0,kq_cur=0,kq_next=SLOTK8;
  #define ROT() do{sl_prev=sl_cur;sl_cur=sl_next;sl_next=(sl_next==(NSLOT-1)*SLOTK8)?0:sl_next+SLOTK8; kq_prev=kq_cur;kq_cur=kq_next;kq_next=(kq_next==3*SLOTK8)?0:kq_next+SLOTK8;}while(0)
  if(kw){DMA_K(2,2*SLOTK8);}
  WAIT_BAR(2);
  qkt8(pA0,pA1,kp0,q8,negm);asm volatile("s_nop 15\n\ts_nop 7":"+v"(pA0),"+v"(pA1));CMASK(pA0,pA1,0);
  START(pA0,pA1);
  _Pragma("unroll") for(int r=0;r<16;++r)pA1[r]=__builtin_amdgcn_exp2f(pA1[r]);
  WAIT_BAR(0);
  if(kw){DMA_K(3,3*SLOTK8);}else{DMA_V(1,SLOTK8);}
  ROT();
  kf8[0]=kfrag8(kp0+kq_cur); kf8[1]=kfrag8(kp0+kq_cur+512);
  WAIT_BAR(1);
  v2i32_t vA0,vA1,vA2,vA3,vB0,vB1,vB2,vB3; v8i32_t pw8=v8i32_t{}; static_assert(FIXREF,"constant reference only (the row sums are not rescaled)");
  v8i32_t ones8; { int o1_; asm volatile("v_mov_b32 %0, 0x38383838":"=v"(o1_)); ones8=(v8i32_t){o1_,o1_,o1_,o1_,o1_,o1_,o1_,o1_}; } f32x16 ls=f32x16{};
  #define PK4(P,B) (int)pg8::pk4_fp8(P[B],P[B+1],P[B+2],P[B+3])
  #define PK4I(D,P,B) do{ D=__builtin_amdgcn_cvt_pk_fp8_f32(P[B],P[B+1],D,false); D=__builtin_amdgcn_cvt_pk_fp8_f32(P[B+2],P[B+3],D,true); }while(0)
  #define VT8(p) __builtin_amdgcn_ds_read_tr8_b64_v2i32((__attribute__((address_space(3))) v2i32_t*)(p))
  #define V8A() (v8i32_t){vA0[0],vA0[1],vA1[0],vA1[1],vA2[0],vA2[1],vA3[0],vA3[1]}
  #define V8B() (v8i32_t){vB0[0],vB0[1],vB1[0],vB1[1],vB2[0],vB2[1],vB3[0],vB3[1]}
  #define PIN(x) asm volatile("":"+v"(x))
  #define MX3(a,b,c) __builtin_fmaxf(__builtin_fmaxf((a),(b)),(c))
  #define EX(v) __builtin_amdgcn_exp2f(v)
  #define EX4(X,B) do{ X[B]=EX(X[B]); X[B+1]=EX(X[B+1]); X[B+2]=EX(X[B+2]); X[B+3]=EX(X[B+3]); PIN(X); SBAR(); }while(0)
  #define KRD(G,j,KS) do{ if(G){ kf8[j]=kfrag8(kp0+(KS)+(j)*512); SBAR(); } }while(0)
  #define STEPA(C0,C1,P0,P1) do{ SBAR(); \
    const lds_cptr va_=vpA+sl_prev, vb_=vpB+sl_prev; \
    vA0=VT8(va_); vA1=VT8(va_+1024); SBAR(); \
    C0=MFMA8(kf8[0],q8,negm); \
    PK4I(pw8[0],P0,0); PK4I(pw8[1],P0,4); PIN(pw8); SBAR(); \
    vA2=VT8(va_+2048); vA3=VT8(va_+3072); SBAR(); \
    PK4I(pw8[2],P0,8); PK4I(pw8[3],P0,12); PIN(pw8); SBAR(); \
    vB0=VT8(vb_); vB1=VT8(vb_+1024); SBAR(); \
    C1=MFMA8(kf8[1],q8,negm); \
    PK4I(pw8[4],P1,0); PK4I(pw8[5],P1,4); PIN(pw8); SBAR(); \
    vB2=VT8(vb_+2048); vB3=VT8(vb_+3072); SBAR(); \
    PK4I(pw8[6],P1,8); PK4I(pw8[7],P1,12); PIN(pw8); SBAR(); \
    }while(0)
  #define STEPB(C0,C1,GL,KS) do{ SBAR(); \
    ls=MFMA8(pw8,ones8,ls); o[0]=MFMA8(pw8,V8A(),o[0]); SBAR(); \
    EX4(C0,0); EX4(C0,4); KRD(GL,0,KS); EX4(C0,8); EX4(C0,12); \
    o[1]=MFMA8(pw8,V8B(),o[1]); SBAR(); \
    EX4(C1,0); KRD(GL,1,KS); EX4(C1,4); EX4(C1,8); EX4(C1,12); \
    }while(0)
  #define ENDW(tt) do{ if((tt)+3<NT){WAIT_BAR(1);} else {WAIT_BAR(0);} }while(0)
  if(kw){
    int t=1;
    for(;t+1<NT;t+=2){
      STEPA(pB0,pB1,pA0,pA1); if(t+3<NT){DMA_K(t+3,kq_prev);} STEPB(pB0,pB1,true,kq_next); ENDW(t); ROT();
      STEPA(pA0,pA1,pB0,pB1); if(t+4<NT){DMA_K(t+4,kq_prev);} STEPB(pA0,pA1,(t+2<NT),kq_next); ENDW(t+1); ROT();
    }
    STEPA(pB0,pB1,pA0,pA1); STEPB(pB0,pB1,false,0);
  } else {
    int t=1;
    DMA_V(2,sl_next); STEPA(pB0,pB1,pA0,pA1); ENDW(1); ROT(); t=2;
    for(;t+3<NT;t+=2){
      DMA_V(t+1,sl_next); STEPB(pB0,pB1,true,kq_cur); STEPA(pA0,pA1,pB0,pB1); ENDW(t); ROT();
      DMA_V(t+2,sl_next); STEPB(pA0,pA1,true,kq_cur); STEPA(pB0,pB1,pA0,pA1); ENDW(t+1); ROT();
    }
    DMA_V(t+1,sl_next); STEPB(pB0,pB1,true,kq_cur); STEPA(pA0,pA1,pB0,pB1); ENDW(t); ROT();
    STEPB(pA0,pA1,true,kq_cur); STEPA(pB0,pB1,pA0,pA1);
    STEPB(pB0,pB1,false,0);
  }
  {
    pw8=(v8i32_t){PK4(pB0,0),PK4(pB0,4),PK4(pB0,8),PK4(pB0,12),PK4(pB1,0),PK4(pB1,4),PK4(pB1,8),PK4(pB1,12)};
    const lds_cptr va_=vpA+sl_cur, vb_=vpB+sl_cur;
    vA0=VT8(va_); vA1=VT8(va_+1024); vA2=VT8(va_+2048); vA3=VT8(va_+3072); vB0=VT8(vb_); vB1=VT8(vb_+1024); vB2=VT8(vb_+2048); vB3=VT8(vb_+3072);
    SBAR(); ls=MFMA8(pw8,ones8,ls); o[0]=MFMA8(pw8,V8A(),o[0]); o[1]=MFMA8(pw8,V8B(),o[1]); }
  #undef PK4
  #undef PK4I
  #undef VT8
  #undef V8A
  #undef V8B
  #undef PIN
  #undef MX3
  #undef EX
  #undef EX4
  #undef KRD
  #undef STEPA
  #undef STEPB
  #undef STEP
  #undef ENDW
  {auto rr=__builtin_amdgcn_permlane32_swap(__float_as_uint(l_reg),__float_as_uint(l_reg),false,false);l_reg=__uint_as_float(rr[0])+__uint_as_float(rr[1]);}
  if(hi==0)wsf[32+r32]=l_reg;asm volatile("s_waitcnt lgkmcnt(0)":::"memory");
  float rli[16];
  #pragma unroll
  for(int r=0;r<16;++r)rli[r]=__builtin_amdgcn_rcpf(ls[r]);
  bf16*Ow=Ou+(long)(wid*QBLK)*opitch;
  { bf16*stg=(bf16*)(shm+L9A_OST)+wid*2048;
    #pragma unroll
    for(int r=0;r<16;++r){const int orow=crow(r,hi);
      #pragma unroll
      for(int d0=0;d0<2;++d0)stg[orow*64+d0*32+r32]=__float2bfloat16(o[d0][r]*rli[r]);}
    asm volatile("s_waitcnt lgkmcnt(0)":::"memory");
    #pragma unroll
    for(int i=0;i<4;++i){const int row=i*8+(lane>>3),ch=lane&7; const u32x4 v=*(const u32x4*)(stg+row*64+ch*8); ATTN_STORE16(Ow+(long)row*opitch+ch*8,v);} }
  asm volatile("s_waitcnt lgkmcnt(0)\n\ts_barrier":::"memory");
  #undef DMA_K
  #undef DMA_V
  #undef CMASK
  #undef START
  #undef RESC
  #undef ROT
}
template<int THRL,bool FIXREF=false> __device__ __forceinline__ void attn_unit128_q8(const unsigned char*Qu8,const unsigned char*__restrict__ Kb8,const bf16*__restrict__ Vb,bf16*Ou,int opitch,char*shm,int wid,float*stash,float lam,const float*subg,int pass_lo,int pass_hi){
  const int lane=lane_id_asm(),r32=lane&31,hi=lane>>5;
  const bf16*Vh=Vb;
 for(int cpass=pass_lo;cpass<pass_hi;++cpass){
  const int lane_p=lane_id_asm(),r32p=lane_p&31,hip=lane_p>>5;
  const unsigned char*Qw8=Qu8+(long)(wid*QBLK)*P8+cpass*64;
  const unsigned char*Kh8=Kb8+cpass*64;
  const unsigned lds0=(unsigned)(uintptr_t)shm;
  float*wsf=(float*)(shm+L8B_WS)+wid*64;
  const unsigned char*ksrc=Kh8+(long)lane_p*P8+(wid&3)*16;
  const bf16*vsrc=Vh+(long)(16*(wid&3)+(lane_p>>2))*DM+(wid>>2)*32+(lane_p&3)*8;
  const unsigned kdst=lds0+L8B_K+(wid&3)*1024, vdst=lds0+L8B_V+wid*1024;
  #define DMA_K(t,slot) glds16(ksrc+(long)(t)*KVBLK*P8,(unsigned)__builtin_amdgcn_readfirstlane(kdst+(slot)))
  #define DMA_V(t,slot) do{ glds16(vsrc+(long)(t)*KVBLK*DM,(unsigned)__builtin_amdgcn_readfirstlane(vdst+4*(slot))); glds16(vsrc+(long)(t)*KVBLK*DM+64,(unsigned)__builtin_amdgcn_readfirstlane(vdst+4*(slot)+8192)); }while(0)
  const int vb0=(int)(lds0+L8B_V)+((lane_p>>4)&1)*32+(lane_p&3)*8+(4*hip+((lane_p&15)>>2))*64;
  v8i32_t kf8[2];
  const lds_cptr shm3=(lds_cptr)shm; const lds_cptr kp0=shm3+L8B_K+hip*2048+r32p*16; const lds_cptr vp0=shm3+L8B_V+((lane_p>>4)&1)*32+(lane_p&3)*8+(4*hip+((lane_p&15)>>2))*64;
  DMA_K(0,0);DMA_V(0,0);DMA_K(1,SLOTK8);
  const v8i32_t q8=*reinterpret_cast<const v8i32_t*>(Qw8+(long)r32p*P8+hip*32);
  float zf_; asm volatile("v_mov_b32 %0, 0":"=v"(zf_));
  float mhat=0.f,l_reg=0.f;f32x16 o[4];
  #pragma unroll
  for(int r=0;r<16;++r){o[0][r]=zf_;o[1][r]=zf_;o[2][r]=zf_;o[3][r]=zf_;}
  f32x16 negm;
  #pragma unroll
  for(int r=0;r<16;++r)negm[r]=zf_;
  asm volatile("":"+v"(negm));
  #define CMASK(P0,P1,t) do{}while(0)
  bool resc=false;
  #define START(P0,P1) do{ resc=false; if constexpr(!FIXREF){ const float rm=rowmax(P0,P1); \
    { const float dl=rm; mhat=fadd_s(mhat,dl); \
      _Pragma("unroll") for(int r=0;r<16;++r){P0[r]=fsub_s(P0[r],dl);P1[r]=fsub_s(P1[r],dl);} \
      _Pragma("unroll") for(int r=0;r<16;++r)negm[r]=-mhat; asm volatile("":"+v"(negm)); } } \
    _Pragma("unroll") for(int r=0;r<16;++r)P0[r]=__builtin_amdgcn_exp2f(P0[r]); }while(0)
  #define RESC() do{ if(resc){ asm volatile("s_waitcnt lgkmcnt(0)":::"memory"); \
      _Pragma("unroll") for(int d_=0;d_<4;++d_) _Pragma("unroll") for(int r=0;r<16;++r)o[d_][r]*=wsf[crow(r,hi)]; } }while(0)
  f32x16 pA0,pA1,pB0,pB1;
  int sl_prev=0,sl_cur=0,sl_next=SLOTK8;
  #define ROT() do{sl_prev=sl_cur;sl_cur=sl_next;sl_next=(sl_next==(NSLOT-1)*SLOTK8)?0:sl_next+SLOTK8;}while(0)
  DMA_K(2,2*SLOTK8);
  WAIT_BAR(4);
  qkt8(pA0,pA1,kp0,q8,negm);asm volatile("s_nop 15\n\ts_nop 7":"+v"(pA0),"+v"(pA1));CMASK(pA0,pA1,0);
  START(pA0,pA1);
  _Pragma("unroll") for(int r=0;r<16;++r)pA1[r]=__builtin_amdgcn_exp2f(pA1[r]);
  WAIT_BAR(0);
  DMA_K(3,0);DMA_V(1,SLOTK8);
  ROT();
  kf8[0]=kfrag8(kp0+sl_cur); kf8[1]=kfrag8(kp0+sl_cur+512);
  WAIT_BAR(3);
  s16x4 vlo[9],vhi[9]; u32x4 pw0,pw1,pw2,pw3;
  #define PKW(P,B) cvtpk_s(P[B],P[B+1])
  #define PAF(k) __builtin_bit_cast(bf16x8,pw##k)
  #define VFR(i) (bf16x8){vlo[i][0],vlo[i][1],vlo[i][2],vlo[i][3],vhi[i][0],vhi[i][1],vhi[i][2],vhi[i][3]}
  #define PIN(x) asm volatile("":"+v"(x))
  #define MX3(a,b,c) __builtin_fmaxf(__builtin_fmaxf((a),(b)),(c))
  #define GAPA(MF,A0,A1,A2,A3,W0,W1,PW) do{ MF; sacc+=A0; sacc+=A1; sacc+=A2; sacc+=A3; PIN(sacc); W0; W1; PIN(PW); SBAR(); }while(0)
  #define EX(v) __builtin_amdgcn_exp2f(v)
  #define GAPB(MF,X,B) do{ MF; X[B]=EX(X[B]); X[B+1]=EX(X[B+1]); PIN(X); SBAR(); }while(0)
  #define VRD2(i,s) do{ vlo[s]=vtr(vp_+(8192+((i)>>2)*4096+((i)&3)*1024)); vhi[s]=vtr(vp_+(8192+((i)>>2)*4096+((i)&3)*1024+512)); }while(0)
  #define VRD(i) do{ vlo[i]=vtr(vp_+(((i)>>2)*4096+((i)&3)*1024)); vhi[i]=vtr(vp_+(((i)>>2)*4096+((i)&3)*1024+512)); }while(0)
  #define KRD(G,j) do{ if(G){ kf8[j]=kfrag8(kp0+sl_next+(j)*512); SBAR(); } }while(0)
  #define STEP(C0,C1,P0,P1,t,GK,GV,GL) do{ SBAR(); \
    const lds_cptr vp_=vp0+4*sl_prev; \
    VRD(0); SBAR(); float sacc=(P0[0]+P0[1]); \
    C0=MFMA8(kf8[0],q8,negm); \
    sacc+=P0[2];sacc+=P0[3];sacc+=P0[4];sacc+=P0[5];sacc+=P0[6];sacc+=P0[7]; PIN(sacc); pw0[0]=PKW(P0,0); pw0[1]=PKW(P0,2); pw0[2]=PKW(P0,4); pw0[3]=PKW(P0,6); PIN(pw0); SBAR(); \
    VRD(4); SBAR(); \
    sacc+=P0[8];sacc+=P0[9];sacc+=P0[10];sacc+=P0[11];sacc+=P0[12];sacc+=P0[13];sacc+=P0[14];sacc+=P0[15]; PIN(sacc); pw1[0]=PKW(P0,8); pw1[1]=PKW(P0,10); pw1[2]=PKW(P0,12); pw1[3]=PKW(P0,14); PIN(pw1); SBAR(); \
    VRD(1); VRD(5); SBAR(); \
    C1=MFMA8(kf8[1],q8,negm); \
    sacc+=P1[0];sacc+=P1[1];sacc+=P1[2];sacc+=P1[3];sacc+=P1[4];sacc+=P1[5];sacc+=P1[6];sacc+=P1[7]; PIN(sacc); pw2[0]=PKW(P1,0); pw2[1]=PKW(P1,2); pw2[2]=PKW(P1,4); pw2[3]=PKW(P1,6); PIN(pw2); SBAR(); \
    VRD(2); VRD(6); SBAR(); \
    sacc+=P1[8];sacc+=P1[9];sacc+=P1[10];sacc+=P1[11];sacc+=P1[12];sacc+=P1[13];sacc+=P1[14];sacc+=P1[15]; PIN(sacc); pw3[0]=PKW(P1,8); pw3[1]=PKW(P1,10); pw3[2]=PKW(P1,12); pw3[3]=PKW(P1,14); PIN(pw3); SBAR(); \
    VRD(3); VRD(7); SBAR(); \
    l_reg+=sacc; \
    if(GK){DMA_K((t)+3,sl_cur);} if(GV){DMA_V((t)+1,sl_next);} \
    CMASK(C0,C1,t); \
    if constexpr(!FIXREF){ float a=MX3(C0[0],C0[1],C1[0]),b=MX3(C0[2],C0[3],C1[1]); a=MX3(a,C1[2],C1[3]); \
      _Pragma("unroll") for(int r=4;r<16;r+=4){a=MX3(a,C0[r],C0[r+1]);b=MX3(b,C0[r+2],C0[r+3]);a=MX3(a,C1[r],C1[r+1]);b=MX3(b,C1[r+2],C1[r+3]);} \
      float rm=__builtin_fmaxf(a,b); { auto rr=__builtin_amdgcn_permlane32_swap(__float_as_uint(rm),__float_as_uint(rm),false,false); rm=__builtin_fmaxf(__uint_as_float(rr[0]),__uint_as_float(rr[1])); } \
      resc=false; \
      if(__builtin_expect(__any(rm>(float)THRL),0)){ const float dl=__builtin_fmaxf(rm,0.f); mhat+=dl; \
        _Pragma("unroll") for(int r=0;r<16;++r){C0[r]-=dl;C1[r]-=dl;} \
        _Pragma("unroll") for(int r=0;r<16;++r)negm[r]=-mhat; asm volatile("":"+v"(negm)); \
        const float f=__builtin_amdgcn_exp2f(-dl); l_reg*=f; { const int l2_=lane_id_asm(); if((l2_>>5)==0)wsf[l2_&31]=f; } resc=true; } } \
    SBAR(); \
    VRD2(0,8); SBAR(); GAPB(o[0]=__builtin_amdgcn_mfma_f32_32x32x16_bf16(PAF(0),VFR(0),o[0],0,0,0), C0,0); \
    VRD2(4,0); SBAR(); GAPB(o[1]=__builtin_amdgcn_mfma_f32_32x32x16_bf16(PAF(0),VFR(4),o[1],0,0,0), C0,2); \
    VRD2(1,4); SBAR(); GAPB(o[0]=__builtin_amdgcn_mfma_f32_32x32x16_bf16(PAF(1),VFR(1),o[0],0,0,0), C0,4); \
    VRD2(5,1); SBAR(); GAPB(o[1]=__builtin_amdgcn_mfma_f32_32x32x16_bf16(PAF(1),VFR(5),o[1],0,0,0), C0,6); \
    VRD2(2,5); SBAR(); GAPB(o[0]=__builtin_amdgcn_mfma_f32_32x32x16_bf16(PAF(2),VFR(2),o[0],0,0,0), C0,8); \
    VRD2(6,2); SBAR(); GAPB(o[1]=__builtin_amdgcn_mfma_f32_32x32x16_bf16(PAF(2),VFR(6),o[1],0,0,0), C0,10); \
    VRD2(3,6); SBAR(); GAPB(o[0]=__builtin_amdgcn_mfma_f32_32x32x16_bf16(PAF(3),VFR(3),o[0],0,0,0), C0,12); \
    VRD2(7,3); SBAR(); GAPB(o[1]=__builtin_amdgcn_mfma_f32_32x32x16_bf16(PAF(3),VFR(7),o[1],0,0,0), C0,14); \
    KRD(GL,0); GAPB(o[2]=__builtin_amdgcn_mfma_f32_32x32x16_bf16(PAF(0),VFR(8),o[2],0,0,0), C1,0); \
    KRD(GL,1); GAPB(o[3]=__builtin_amdgcn_mfma_f32_32x32x16_bf16(PAF(0),VFR(0),o[3],0,0,0), C1,2); \
    GAPB(o[2]=__builtin_amdgcn_mfma_f32_32x32x16_bf16(PAF(1),VFR(4),o[2],0,0,0), C1,4); \
    GAPB(o[3]=__builtin_amdgcn_mfma_f32_32x32x16_bf16(PAF(1),VFR(1),o[3],0,0,0), C1,6); \
    GAPB(o[2]=__builtin_amdgcn_mfma_f32_32x32x16_bf16(PAF(2),VFR(5),o[2],0,0,0), C1,8); \
    GAPB(o[3]=__builtin_amdgcn_mfma_f32_32x32x16_bf16(PAF(2),VFR(2),o[3],0,0,0), C1,10); \
    GAPB(o[2]=__builtin_amdgcn_mfma_f32_32x32x16_bf16(PAF(3),VFR(6),o[2],0,0,0), C1,12); \
    GAPB(o[3]=__builtin_amdgcn_mfma_f32_32x32x16_bf16(PAF(3),VFR(3),o[3],0,0,0), C1,14); \
    }while(0)
  int t=1;
  for(;t+5<NT;t+=2){
    STEP(pB0,pB1,pA0,pA1,t,true,true,true);     WAIT_BAR(3); RESC(); ROT();
    STEP(pA0,pA1,pB0,pB1,t+1,true,true,true);   WAIT_BAR(3); RESC(); ROT();
  }
  #define ENDW(tt) do{ if((tt)+3<NT){WAIT_BAR(3);} else if((tt)+2<NT){WAIT_BAR(2);} else {WAIT_BAR(0);} }while(0)
  for(;t+1<NT;t+=2){
    STEP(pB0,pB1,pA0,pA1,t,(t+3<NT),(t+1<NT),(t+1<NT));       ENDW(t);   RESC(); ROT();
    STEP(pA0,pA1,pB0,pB1,t+1,(t+4<NT),(t+2<NT),(t+2<NT));     ENDW(t+1); RESC(); ROT();
  }
  STEP(pB0,pB1,pA0,pA1,NT-1,false,false,false); RESC();
  { float sacc=pB0[0]+pB0[1]; _Pragma("unroll") for(int r=2;r<16;++r)sacc+=pB0[r]; _Pragma("unroll") for(int r=0;r<16;++r)sacc+=pB1[r]; l_reg+=sacc;
    pw0=(u32x4){PKW(pB0,0),PKW(pB0,2),PKW(pB0,4),PKW(pB0,6)};pw1=(u32x4){PKW(pB0,8),PKW(pB0,10),PKW(pB0,12),PKW(pB0,14)};pw2=(u32x4){PKW(pB1,0),PKW(pB1,2),PKW(pB1,4),PKW(pB1,6)};pw3=(u32x4){PKW(pB1,8),PKW(pB1,10),PKW(pB1,12),PKW(pB1,14)};
    SBAR(); pv128(o,vb0+4*sl_cur,PAF(0),PAF(1),PAF(2),PAF(3)); }
  #undef PKW
  #undef PAF
  #undef VFR
  #undef VRD2
  #undef PIN
  #undef MX3
  #undef GAPA
  #undef GAPB
  #undef EX
  #undef VRD
  #undef KRD
  #undef STEP
  #undef ENDW
  {auto rr=__builtin_amdgcn_permlane32_swap(__float_as_uint(l_reg),__float_as_uint(l_reg),false,false);l_reg=__uint_as_float(rr[0])+__uint_as_float(rr[1]);}
  const int lane_e=lane_id_asm(),r32e=lane_e&31,hie=lane_e>>5;
  if(hie==0)wsf[32+r32e]=l_reg;asm volatile("s_waitcnt lgkmcnt(0)":::"memory");
  float rli[16];
  #pragma unroll
  for(int r=0;r<16;++r)rli[r]=__builtin_amdgcn_rcpf(wsf[32+crow(r,hie)]);
  float*st=stash+(size_t)wid*4096+lane_e*4;
  if(cpass==0){
    #pragma unroll
    for(int d0=0;d0<4;++d0)
      #pragma unroll
      for(int q4=0;q4<4;++q4){ typedef float f32x4_t __attribute__((ext_vector_type(4)));
        const f32x4_t v={o[d0][4*q4]*rli[4*q4],o[d0][4*q4+1]*rli[4*q4+1],o[d0][4*q4+2]*rli[4*q4+2],o[d0][4*q4+3]*rli[4*q4+3]};
        *(f32x4_t*)(st+(d0*4+q4)*256)=v; }
  } else {
    typedef float f32x4_t __attribute__((ext_vector_type(4)));
    float ss[16];
    #pragma unroll
    for(int r=0;r<16;++r)ss[r]=0.f;
    #pragma unroll
    for(int d0=0;d0<4;++d0)
      #pragma unroll
      for(int q4=0;q4<4;++q4){ const f32x4_t a=*(const f32x4_t*)(st+(d0*4+q4)*256);
        #pragma unroll
        for(int i=0;i<4;++i){ const int r=4*q4+i; const float v=a[i]-lam*(o[d0][r]*rli[r]); o[d0][r]=v; ss[r]+=v*v; } if(q4==3)asm volatile("":::"memory"); }
    #pragma unroll
    for(int r=0;r<16;++r){ float s=ss[r]; s+=__shfl_xor(s,1); s+=__shfl_xor(s,2); s+=__shfl_xor(s,4); s+=__shfl_xor(s,8); s+=__shfl_xor(s,16); ss[r]=0.8f/sqrtf(s*(1.0f/128.0f)+1e-6f); }
    float gsub[4];
    #pragma unroll
    for(int d0=0;d0<4;++d0)gsub[d0]=subg[d0*32+r32e];
    asm volatile("s_waitcnt lgkmcnt(0)\n\ts_barrier":::"memory");
    bf16*Ow=Ou+(long)(wid*QBLK)*opitch;
    bf16*stg=(bf16*)shm+wid*4096;
    #pragma unroll
    for(int r=0;r<16;++r){const int orow=crow(r,hie);
      #pragma unroll
      for(int d0=0;d0<4;++d0)stg[orow*128+d0*32+r32e]=__float2bfloat16(o[d0][r]*ss[r]*gsub[d0]);}
    asm volatile("s_waitcnt lgkmcnt(0)":::"memory");
    #pragma unroll
    for(int i=0;i<8;++i){const int row=i*4+(lane_e>>4),ch=lane_e&15; const u32x4 v=*(const u32x4*)(stg+row*128+ch*8); ATTN_STORE16(Ow+(long)row*opitch+ch*8,v);}
  }
  asm volatile("s_waitcnt lgkmcnt(0)\n\ts_barrier":::"memory");
 }
  #undef DMA_K
  #undef DMA_V
  #undef CMASK
  #undef START
  #undef RESC
  #undef ROT
}
constexpr float REFOFF=3.0f, LMIN=8.0f; constexpr int L9B_K=0, L9B_V=NSLOT*SLOTK8, L9B_WS=65536, L9B_FLAG=L9B_WS+NW*64*4, L9B_BYTES=L9B_FLAG+64;
template<int THRL,bool FIXREF=false> __device__ __forceinline__ bool attn_unit128_q8v(const unsigned char*Qu8,const unsigned char*__restrict__ Kb8,const unsigned char*__restrict__ Vb8,bf16*Ou,int opitch,char*shm,int wid,float*stash,float lam,const float*subg,int pass_lo,int pass_hi,float ref){
  static_assert(FIXREF,"constant reference only"); bool bad_any=false;
  const int lane=lane_id_asm(),r32=lane&31,hi=lane>>5;
  const bool kw=wid<4;
 for(int cpass=pass_lo;cpass<pass_hi;++cpass){
  const int lane_p=lane_id_asm(),r32p=lane_p&31,hip=lane_p>>5;
  const unsigned char*Qw8=Qu8+(long)(wid*QBLK)*P8+cpass*64;
  const unsigned char*Kh8=Kb8+cpass*64;
  const unsigned lds0=(unsigned)(uintptr_t)shm;
  float*wsf=(float*)(shm+L9B_WS)+wid*64;
  const unsigned char*ksrc=Kh8+(long)lane_p*P8+(wid&3)*16;
  const int vkey_=8*wid+(lane_p>>3), vc_=(lane_p&7)^((((vkey_>>1)&1)<<1)|(((vkey_>>3)&1)<<2));
  const unsigned char*vsrc=Vb8+(long)vkey_*PV8+vc_*16;
  const unsigned kdst=lds0+L9B_K+(wid&3)*1024, vdst=lds0+L9B_V+wid*1024;
  #define DMA_K(t,slot) glds16(ksrc+(long)(t)*KVBLK*P8,(unsigned)__builtin_amdgcn_readfirstlane(kdst+(slot)))
  #define DMA_V(t,slot) glds16(vsrc+(long)(t)*KVBLK*PV8,(unsigned)__builtin_amdgcn_readfirstlane(vdst+2*(slot)))
  #define WAITB(nk,nv) do{ if(kw){WAIT_BAR(nk);}else{WAIT_BAR(nv);} }while(0)
  v8i32_t kf8[2];
  const lds_cptr shm3=(lds_cptr)shm; const lds_cptr kp0=shm3+L9B_K+hip*2048+r32p*16;
  const int vq_=(lane_p&15)>>1, vkey0_=(vq_&3)+8*(vq_>>2)+4*hip, vsw_=(((vq_>>1)&1)<<1)|(((vq_>>2)&1)<<2), vg_=(lane_p>>4)&1;
  const lds_cptr vq0=shm3+L9B_V+vkey0_*128+(lane_p&1)*8;
  const lds_cptr vp0_=vq0+((0+vg_)^vsw_)*16, vp1_=vq0+((2+vg_)^vsw_)*16, vp2_=vq0+((4+vg_)^vsw_)*16, vp3_=vq0+((6+vg_)^vsw_)*16;
  if(kw){DMA_K(0,0);} DMA_V(0,0); if(kw){DMA_K(1,SLOTK8);}
  const v8i32_t q8=*reinterpret_cast<const v8i32_t*>(Qw8+(long)r32p*P8+hip*32);
  float zf_; asm volatile("v_mov_b32 %0, 0":"=v"(zf_));
  float mhat=0.f,l_reg=0.f,smax=0.f;f32x16 o[4];
  #pragma unroll
  for(int r=0;r<16;++r){o[0][r]=zf_;o[1][r]=zf_;o[2][r]=zf_;o[3][r]=zf_;}
  f32x16 negm;
  #pragma unroll
  for(int r=0;r<16;++r)negm[r]=zf_-ref;
  asm volatile("":"+v"(negm));
  #define CMASK(P0,P1,t) do{}while(0)
  bool resc=false;
  #define START(P0,P1) do{ resc=false; if constexpr(!FIXREF){ const float rm=rowmax(P0,P1); \
    { const float dl=rm-REFOFF; mhat=fadd_s(mhat,dl);     \
      _Pragma("unroll") for(int r=0;r<16;++r){P0[r]=fsub_s(P0[r],dl);P1[r]=fsub_s(P1[r],dl);} \
      _Pragma("unroll") for(int r=0;r<16;++r)negm[r]=-mhat; asm volatile("":"+v"(negm)); } } \
    _Pragma("unroll") for(int r=0;r<16;++r)P0[r]=__builtin_amdgcn_exp2f(P0[r]); }while(0)
  #define RESC() do{ if(resc){ asm volatile("s_waitcnt lgkmcnt(0)":::"memory"); \
      _Pragma("unroll") for(int d_=0;d_<4;++d_) _Pragma("unroll") for(int r=0;r<16;++r)o[d_][r]*=wsf[crow(r,hi)]; } }while(0)
  f32x16 pA0,pA1,pB0,pB1;
  int sl_prev=0,sl_cur=0,sl_next=SLOTK8;
  #define ROT() do{sl_prev=sl_cur;sl_cur=sl_next;sl_next=(sl_next==(NSLOT-1)*SLOTK8)?0:sl_next+SLOTK8;}while(0)
  if(kw){DMA_K(2,2*SLOTK8);}
  WAITB(3,2);
  qkt8(pA0,pA1,kp0,q8,negm);asm volatile("s_nop 15\n\ts_nop 7":"+v"(pA0),"+v"(pA1));CMASK(pA0,pA1,0);
  START(pA0,pA1);
  _Pragma("unroll") for(int r=0;r<16;++r)pA1[r]=__builtin_amdgcn_exp2f(pA1[r]);
  WAIT_BAR(0);
  if(kw){DMA_K(3,0);} DMA_V(1,SLOTK8);
  ROT();
  kf8[0]=kfrag8(kp0+sl_cur); kf8[1]=kfrag8(kp0+sl_cur+512);
  WAITB(2,1);
  v2i32_t vA0,vA1,vA2,vA3,vB0,vB1,vB2,vB3; v8i32_t pw8=v8i32_t{};
  v8i32_t ones8; { int o1_; asm volatile("v_mov_b32 %0, 0x38383838":"=v"(o1_)); ones8=(v8i32_t){o1_,o1_,o1_,o1_,o1_,o1_,o1_,o1_}; } f32x16 ls; _Pragma("unroll") for(int r=0;r<16;++r)ls[r]=zf_;
  #define PK4(P,B) __builtin_amdgcn_cvt_pk_bf8_f32(P[B+2],P[B+3],__builtin_amdgcn_cvt_pk_bf8_f32(P[B],P[B+1],0,false),true)
  #define PK4I(D,P,B) do{ D=__builtin_amdgcn_cvt_pk_bf8_f32(P[B],P[B+1],D,false); D=__builtin_amdgcn_cvt_pk_bf8_f32(P[B+2],P[B+3],D,true); }while(0)
  #define MFMAP(a,b,c) __builtin_amdgcn_mfma_scale_f32_32x32x64_f8f6f4(a,b,c,1,0,0,0,0,0)
  #define VT8(p) __builtin_amdgcn_ds_read_tr8_b64_v2i32((__attribute__((address_space(3))) v2i32_t*)(p))
  #define V8A() (v8i32_t){vA0[0],vA0[1],vA1[0],vA1[1],vA2[0],vA2[1],vA3[0],vA3[1]}
  #define V8B() (v8i32_t){vB0[0],vB0[1],vB1[0],vB1[1],vB2[0],vB2[1],vB3[0],vB3[1]}
  #define RDA(vp) do{ const lds_cptr p_=(vp)+2*sl_prev; vA0=VT8(p_); vA1=VT8(p_+2048); vA2=VT8(p_+4096); vA3=VT8(p_+6144); }while(0)
  #define RDB(vp) do{ const lds_cptr p_=(vp)+2*sl_prev; vB0=VT8(p_); vB1=VT8(p_+2048); vB2=VT8(p_+4096); vB3=VT8(p_+6144); }while(0)
  #define PIN(x) asm volatile("":"+v"(x))
  #define MX3(a,b,c) __builtin_fmaxf(__builtin_fmaxf((a),(b)),(c))
  #define EX(v) __builtin_amdgcn_exp2f(v)
  #define EX4(X,B) do{ X[B]=EX(X[B]); X[B+1]=EX(X[B+1]); X[B+2]=EX(X[B+2]); X[B+3]=EX(X[B+3]); PIN(X); SBAR(); }while(0)
  #define KRD(G,j) do{ if(G){ kf8[j]=kfrag8(kp0+sl_next+(j)*512); SBAR(); } }while(0)
  #define STEP(C0,C1,P0,P1,t,GK,GV,GL) do{ SBAR(); \
    { const lds_cptr p_=vp0_+2*sl_prev; vA0=VT8(p_); vA1=VT8(p_+2048); } SBAR(); \
    C0=MFMA8(kf8[0],q8,negm); \
    PK4I(pw8[0],P0,0); PK4I(pw8[1],P0,4); PIN(pw8); SBAR(); \
    { const lds_cptr p_=vp0_+2*sl_prev; vA2=VT8(p_+4096); vA3=VT8(p_+6144); } SBAR(); \
    PK4I(pw8[2],P0,8); PK4I(pw8[3],P0,12); PIN(pw8); SBAR(); \
    { const lds_cptr p_=vp1_+2*sl_prev; vB0=VT8(p_); vB1=VT8(p_+2048); } SBAR(); \
    C1=MFMA8(kf8[1],q8,negm); \
    PK4I(pw8[4],P1,0); PK4I(pw8[5],P1,4); PIN(pw8); SBAR(); \
    { const lds_cptr p_=vp1_+2*sl_prev; vB2=VT8(p_+4096); vB3=VT8(p_+6144); } SBAR(); \
    PK4I(pw8[6],P1,8); PK4I(pw8[7],P1,12); PIN(pw8); SBAR(); \
    if(GK){ if(kw){DMA_K((t)+3,sl_cur);} } if(GV){DMA_V((t)+1,sl_next);} \
    CMASK(C0,C1,t); \
    SBAR(); \
    ls=MFMAP(pw8,ones8,ls); o[0]=MFMAP(pw8,V8A(),o[0]); SBAR(); RDA(vp2_); SBAR(); EX4(C0,0); EX4(C0,4); \
    o[1]=MFMAP(pw8,V8B(),o[1]); SBAR(); RDB(vp3_); SBAR(); EX4(C0,8); EX4(C0,12); \
    KRD(GL,0); \
    o[2]=MFMAP(pw8,V8A(),o[2]); SBAR(); EX4(C1,0); EX4(C1,4); \
    KRD(GL,1); \
    o[3]=MFMAP(pw8,V8B(),o[3]); SBAR(); EX4(C1,8); EX4(C1,12); \
    }while(0)
  int t=1;
  for(;t+5<NT;t+=2){
    STEP(pB0,pB1,pA0,pA1,t,true,true,true);     WAITB(2,1); RESC(); ROT();
    STEP(pA0,pA1,pB0,pB1,t+1,true,true,true);   WAITB(2,1); RESC(); ROT();
  }
  #define ENDW(tt) do{ if((tt)+3<NT){WAITB(2,1);} else if((tt)+2<NT){WAIT_BAR(1);} else {WAIT_BAR(0);} }while(0)
  for(;t+1<NT;t+=2){
    STEP(pB0,pB1,pA0,pA1,t,(t+3<NT),(t+1<NT),(t+1<NT));       ENDW(t);   RESC(); ROT();
    STEP(pA0,pA1,pB0,pB1,t+1,(t+4<NT),(t+2<NT),(t+2<NT));     ENDW(t+1); RESC(); ROT();
  }
  STEP(pB0,pB1,pA0,pA1,NT-1,false,false,false); RESC();
  {
    pw8=(v8i32_t){PK4(pB0,0),PK4(pB0,4),PK4(pB0,8),PK4(pB0,12),PK4(pB1,0),PK4(pB1,4),PK4(pB1,8),PK4(pB1,12)};
    const int sl_keep=sl_prev; sl_prev=sl_cur;
    RDA(vp0_); RDB(vp1_); SBAR(); ls=MFMAP(pw8,ones8,ls); o[0]=MFMAP(pw8,V8A(),o[0]); o[1]=MFMAP(pw8,V8B(),o[1]); SBAR();
    RDA(vp2_); RDB(vp3_); SBAR(); o[2]=MFMAP(pw8,V8A(),o[2]); o[3]=MFMAP(pw8,V8B(),o[3]); sl_prev=sl_keep; }
  #undef PK4
  #undef PK4I
  #undef MFMAP
  #undef VT8
  #undef V8A
  #undef V8B
  #undef RDA
  #undef RDB
  #undef PIN
  #undef MX3
  #undef EX
  #undef EX4
  #undef KRD
  #undef STEP
  #undef ENDW
  {auto rr=__builtin_amdgcn_permlane32_swap(__float_as_uint(l_reg),__float_as_uint(l_reg),false,false);l_reg=__uint_as_float(rr[0])+__uint_as_float(rr[1]);}
  const int lane_e=lane_id_asm(),r32e=lane_e&31,hie=lane_e>>5;
  { float nz_=0.f; _Pragma("unroll") for(int d_=0;d_<4;++d_) _Pragma("unroll") for(int r=0;r<16;++r)nz_=__builtin_fmaf(o[d_][r],0.0f,nz_);     float lmin_=ls[0]; _Pragma("unroll") for(int r=1;r<16;++r)lmin_=__builtin_fminf(lmin_,ls[r]); const bool badl=!(nz_==0.0f)||!(lmin_>=LMIN); const int lf_=lane_id_asm(); if(__any(badl)&&lf_==0)((volatile float*)(shm+L9B_FLAG))[wid]=1.0f; else if(lf_==0)((volatile float*)(shm+L9B_FLAG))[wid]=0.0f; }
  if(hie==0)wsf[32+r32e]=l_reg;asm volatile("s_waitcnt lgkmcnt(0)":::"memory");
  float rli[16];
  #pragma unroll
  for(int r=0;r<16;++r)rli[r]=__builtin_amdgcn_rcpf(ls[r]);
  float*st=stash+(size_t)wid*4096+lane_e*4;
  if(cpass==0){
    #pragma unroll
    for(int d0=0;d0<4;++d0)
      #pragma unroll
      for(int q4=0;q4<4;++q4){ typedef float f32x4_t __attribute__((ext_vector_type(4)));
        const f32x4_t v={o[d0][4*q4]*rli[4*q4],o[d0][4*q4+1]*rli[4*q4+1],o[d0][4*q4+2]*rli[4*q4+2],o[d0][4*q4+3]*rli[4*q4+3]};
        *(f32x4_t*)(st+(d0*4+q4)*256)=v; }
  } else {
    typedef float f32x4_t __attribute__((ext_vector_type(4)));
    float ss[16];
    #pragma unroll
    for(int r=0;r<16;++r)ss[r]=0.f;
    #pragma unroll
    for(int d0=0;d0<4;++d0)
      #pragma unroll
      for(int q4=0;q4<4;++q4){ const f32x4_t a=*(const f32x4_t*)(st+(d0*4+q4)*256);
        #pragma unroll
        for(int i=0;i<4;++i){ const int r=4*q4+i; const float v=a[i]-lam*(o[d0][r]*rli[r]); o[d0][r]=v; ss[r]+=v*v; } if(q4==3)asm volatile("":::"memory"); }
    #pragma unroll
    for(int r=0;r<16;++r){ float s=ss[r]; s+=__shfl_xor(s,1); s+=__shfl_xor(s,2); s+=__shfl_xor(s,4); s+=__shfl_xor(s,8); s+=__shfl_xor(s,16); ss[r]=0.8f/sqrtf(s*(1.0f/128.0f)+1e-6f); }
    float gsub[4];
    #pragma unroll
    for(int d0=0;d0<4;++d0)gsub[d0]=subg[d0*32+r32e];
    asm volatile("s_waitcnt lgkmcnt(0)\n\ts_barrier":::"memory");
    bf16*Ow=Ou+(long)(wid*QBLK)*opitch;
    bf16*stg=(bf16*)shm+wid*4096;
    #pragma unroll
    for(int r=0;r<16;++r){const int orow=crow(r,hie);
      #pragma unroll
      for(int d0=0;d0<4;++d0)stg[orow*128+d0*32+r32e]=__float2bfloat16(o[d0][r]*ss[r]*gsub[d0]);}
    asm volatile("s_waitcnt lgkmcnt(0)":::"memory");
    #pragma unroll
    for(int i=0;i<8;++i){const int row=i*4+(lane_e>>4),ch=lane_e&15; const u32x4 v=*(const u32x4*)(stg+row*128+ch*8); ATTN_STORE16(Ow+(long)row*opitch+ch*8,v);}
  }
  asm volatile("s_waitcnt lgkmcnt(0)\n\ts_barrier":::"memory");
  { const float*fl_=(const float*)(shm+L9B_FLAG); float fs_=0.f; _Pragma("unroll") for(int w_=0;w_<NW;++w_)fs_+=fl_[w_]; bad_any=bad_any||(__builtin_amdgcn_readfirstlane(__float_as_uint(fs_))!=0u); }
 }
  return bad_any;
  #undef DMA_K
  #undef DMA_V
  #undef WAITB
  #undef CMASK
  #undef START
  #undef RESC
  #undef ROT
}
constexpr int ATTN_LDS_BYTES=LDS_BYTES;
#undef SBAR
#undef WAIT_BAR
}
#define GAS __attribute__((address_space(1)))
#define LAS __attribute__((address_space(3)))
typedef unsigned short bf16;
typedef unsigned v4u __attribute__((ext_vector_type(4)));
typedef float f32x4 __attribute__((ext_vector_type(4)));
typedef short bf16x8 __attribute__((ext_vector_type(8)));
typedef GAS unsigned gu32;
typedef GAS unsigned long long gu64;
#define RLX_AGENT __ATOMIC_RELAXED, __HIP_MEMORY_SCOPE_AGENT
#define LDS_WAIT() asm volatile("s_waitcnt lgkmcnt(0)" ::: "memory")
#define VM_WAIT() asm volatile("s_waitcnt vmcnt(0)" ::: "memory")
__device__ __forceinline__ unsigned long long rt() { return __builtin_amdgcn_s_memrealtime(); }
__device__ __forceinline__ unsigned f2bf(float f) { unsigned u = __builtin_bit_cast(unsigned, f); return (u + 0x7fffu + ((u >> 16) & 1u)) >> 16; }
__device__ __forceinline__ unsigned pk2(float lo, float hi) { return f2bf(lo) | (f2bf(hi) << 16); }

#define XB_TMO      128
#define XB_XCNT(j)  (256  + 64 * (j))
#define XB_XSUB(j)  (1280 + 64 * (j))
#define XB_XGEN(j)  (2304 + 64 * (j))
#define XB_TOP      3328
#define XB_TOPGEN   3392
#define XCD_BAR_WORDS 3456
#define XB_SPIN_CAP (1u << 18)

__device__ __forceinline__ unsigned xb_ld(unsigned* p)              { return __hip_atomic_load(p, __ATOMIC_RELAXED, __HIP_MEMORY_SCOPE_AGENT); }
__device__ __forceinline__ unsigned xb_add(unsigned* p, unsigned v) { return __hip_atomic_fetch_add(p, v, __ATOMIC_RELAXED, __HIP_MEMORY_SCOPE_AGENT); }
__device__ __forceinline__ unsigned xb_xcc_id() { return (unsigned)__builtin_amdgcn_s_getreg((3 << 11) | 20) & 0xFu; }
#define XB_SPIN(cond, bar) do { unsigned _sp = 0; while (cond) { __builtin_amdgcn_s_sleep(1); \
    if ((++_sp & 255u) == 0u) { if (xb_ld(&(bar)[XB_TMO])) break; if (_sp > XB_SPIN_CAP) { atomicAdd(&(bar)[XB_TMO], 1u); break; } } } } while (0)

struct XcdBarrier {
    unsigned* bar; unsigned x;
    int wv;
    volatile LAS unsigned* st;
};

__device__ __forceinline__ XcdBarrier xcd_barrier_post(unsigned* bar, volatile LAS unsigned* st) {
    XcdBarrier b; b.bar = bar; b.x = xb_xcc_id(); b.st = st; b.wv = __builtin_amdgcn_readfirstlane(threadIdx.x >> 6);
    if (threadIdx.x == 0) (void)xb_add(&bar[XB_XCNT(b.x)], 1u);
    return b;
}
__device__ __forceinline__ void xcd_barrier_complete(unsigned* bar, unsigned x, unsigned& nloc, unsigned& nx) {
    const unsigned G = gridDim.x * gridDim.y * gridDim.z;
    unsigned sum, cnt, mine, sp = 0u;
    for (;;) {
        sum = 0u; cnt = 0u; mine = 0u;
#pragma unroll
        for (unsigned j = 0; j < 16; ++j) { const unsigned c = xb_ld(&bar[XB_XCNT(j)]); sum += c; cnt += (c > 0u) ? 1u : 0u; mine = (j == x) ? c : mine; }
        if (sum == G) break;
        __builtin_amdgcn_s_sleep(1);
        if ((++sp & 255u) == 0u) { if (xb_ld(&bar[XB_TMO])) break; if (sp > XB_SPIN_CAP) { atomicAdd(&bar[XB_TMO], 1u); break; } }
    }
    nloc = mine > 0u ? mine : 1u; nx = cnt > 0u ? cnt : 1u;
}

__device__ __forceinline__ void xcd_barrier(const XcdBarrier& b) {
    asm volatile("s_waitcnt vmcnt(0)" ::: "memory");
    __syncthreads();
    if (b.wv == 0 && lane_id_asm() == 0) {
        unsigned* bar = b.bar;
        __builtin_amdgcn_s_waitcnt(0);
        unsigned nloc = b.st[0], nx = b.st[1];
        if (nloc == 0u) { xcd_barrier_complete(bar, b.x, nloc, nx); b.st[0] = nloc; b.st[1] = nx; }
        const unsigned old = xb_add(&bar[XB_XSUB(b.x)], 1u);
        const unsigned gen = old / nloc;
        if (old + 1u == (gen + 1u) * nloc) {
            __builtin_amdgcn_fence(__ATOMIC_RELEASE, "agent");
            asm volatile("s_waitcnt vmcnt(0)" ::: "memory");
            const unsigned og = xb_add(&bar[XB_TOP], 1u);
            const unsigned tg = og / nx;
            if (og + 1u == (tg + 1u) * nx) xb_add(&bar[XB_TOPGEN], 1u);
            else XB_SPIN(xb_ld(&bar[XB_TOPGEN]) == tg, bar);
            __builtin_amdgcn_fence(__ATOMIC_ACQUIRE, "agent");
            xb_add(&bar[XB_XGEN(b.x)], 1u);
            asm volatile("s_waitcnt vmcnt(0)" ::: "memory");
        } else {
            XB_SPIN(xb_ld(&bar[XB_XGEN(b.x)]) == gen, bar);
            __builtin_amdgcn_fence(__ATOMIC_ACQUIRE, "agent");
            asm volatile("s_waitcnt vmcnt(0)" ::: "memory");
        }
    }
    __syncthreads();
}
__device__ __forceinline__ float wave_sum(float v) {
#pragma unroll
    for (int o = 1; o < 64; o <<= 1) v += __shfl_xor(v, o);
    return v;
}
constexpr int NWAVES = 8;
#ifndef MK_PER_PHASE
#define MK_PER_PHASE 0
#endif
constexpr int NPH = 10;
constexpr int DM_ = 1024, NB_ = 2, T_ = 8192, CTXL = 256, KEYS = CTXL + T_  , MROWS = NB_ * KEYS  , NTOK = NB_ * T_, QKVC = 2304, NE = 32, NMOD = 6 * DM_;
constexpr int SORT_ROWS = NTOK * 4 + NE * 256;
constexpr size_t MiB = 1u << 20;
constexpr size_t WS_CTL = 0, CTL_ZERO_BYTES = 64 * 1024;
constexpr size_t WS_MOD = 1 * MiB;
constexpr size_t WS_ROPE = WS_MOD + 3 * NMOD * 4;
constexpr size_t WS_SE = 2 * MiB;
constexpr size_t WS_SP = WS_SE + (size_t)NTOK * 4 * 4;
constexpr size_t WS_LTOK = 3 * MiB;
constexpr size_t WS_LGATE = 5 * MiB;
constexpr size_t WS_WQKV = 8 * MiB;
constexpr size_t WS_CB = 1 * MiB + 128 * 1024;
constexpr size_t WS_WO = 669 * MiB;
constexpr size_t WS_WIN = 16 * MiB;
constexpr size_t WS_WOUT = 144 * MiB;
constexpr size_t WS_XN = 208 * MiB;
constexpr size_t WS_QKV = 242 * MiB;
constexpr size_t WS_DT = 317 * MiB;
constexpr size_t WS_MIX = 349 * MiB;
constexpr size_t WS_ACT = 381 * MiB;
constexpr size_t WS_Y = 525 * MiB;
constexpr size_t WS_QK8 = 671 * MiB;
constexpr size_t WS_V8 = 96 * MiB;
constexpr size_t WS_END = 699 * MiB;
static_assert(WS_XN + (size_t)MROWS * 1024 * 2 <= WS_QKV && WS_QKV + (size_t)MROWS * QKVC * 2 <= WS_DT && WS_ACT + (size_t)SORT_ROWS * 1024 * 2 <= WS_Y && WS_Y + (size_t)SORT_ROWS * 1024 * 2 <= WS_END, "d_ws map");
constexpr int CW_CNT = 64;
constexpr int CW_MT = 8192;
constexpr int CW_MT5 = 9216;
constexpr int CW_MT2 = 9344;
constexpr int CW_XOK = 99;
constexpr int CW_NMAX = 128;
static_assert(true, ""); constexpr int CW_BAR = 4096;
constexpr int RING_OFF = 0, RING_BYTES = 131072;
constexpr int LDSCTL_OFF = RING_BYTES, MISC_OFF = LDSCTL_OFF + 320;
constexpr int IDBUF_OFF = RING_BYTES + 1024;
constexpr int TP_OFF = RING_BYTES + 9216;
constexpr int TE_OFF = TP_OFF + 256;
constexpr int XSCR_OFF = RING_BYTES + 10240;
constexpr int LDS_BYTES = 147456;
static_assert(XSCR_OFF + 4096 <= LDS_BYTES, "LDS map");

struct Frame {
    LAS unsigned char* lds; volatile LAS unsigned* MISC; gu32* ctl;
    int wave, vcu, G;
    const float* in[21]; float* out; unsigned char* ws;
};
__device__ __forceinline__ void build_tp(Frame& F) {
    LAS int* tp = (LAS int*)(F.lds + TP_OFF); const int lane = lane_id_asm();
    __syncthreads();
    if (F.wave == 0) {
        const int t = lane < NE ? (((int)__hip_atomic_load(F.ctl + CW_CNT + lane, RLX_AGENT) + 255) >> 8) : 0; int s = t;
#pragma unroll
        for (int o = 1; o < 32; o <<= 1) { const int u = __shfl_up(s, o); if (lane >= o) s += u; }
        if (lane < NE) { tp[lane] = s - t; LAS unsigned char* te = (LAS unsigned char*)(F.lds + TE_OFF); for (int g_ = s - t; g_ < s; ++g_) te[g_] = (unsigned char)lane; }
        if (lane == NE - 1) tp[NE] = s;
    }
    __syncthreads();
}
__device__ __forceinline__ void transpose_item(const float* W, int K, int N, bf16* WT, int k0, int n0, int wt_row0, LAS float* scr, int lane) {
    float t_[32];
#pragma unroll
    for (int i = 0; i < 32; ++i) t_[i] = W[(size_t)(k0 + 2 * i + (lane >> 5)) * N + n0 + (lane & 31)];
#pragma unroll
    for (int i = 0; i < 32; ++i) scr[(2 * i + (lane >> 5)) * 33 + (lane & 31)] = t_[i];
    LDS_WAIT(); asm volatile("" ::: "memory");
    const int c = lane & 7;
#pragma unroll
    for (int j = 0; j < 4; ++j) { const int n = (lane >> 3) + 8 * j; const LAS float* s = scr + (8 * c) * 33 + n;
        v4u o; o.x = pk2(s[0 * 33], s[1 * 33]); o.y = pk2(s[2 * 33], s[3 * 33]); o.z = pk2(s[4 * 33], s[5 * 33]); o.w = pk2(s[6 * 33], s[7 * 33]);
        *(GAS v4u*)(WT + (size_t)(wt_row0 + n) * K + k0 + 8 * c) = o; }
    LDS_WAIT(); asm volatile("" ::: "memory");
}
__device__ __forceinline__ void transpose_item_f8(const float* W, int K, int N, unsigned char* WT, int k0, int n0, int wt_row0, LAS float* scr, int lane, const float* kmul = nullptr, const float* kadd1 = nullptr, bool qmap = false) {
    float t_[32];
#pragma unroll
    for (int i = 0; i < 32; ++i) t_[i] = W[(size_t)(k0 + 2 * i + (lane >> 5)) * N + n0 + (lane & 31)];
    if (kmul) {
#pragma unroll
        for (int i = 0; i < 32; ++i) { const int k = k0 + 2 * i + (lane >> 5); t_[i] *= kmul[k] * (1.0f + kadd1[k]); } }
#pragma unroll
    for (int i = 0; i < 32; ++i) scr[(2 * i + (lane >> 5)) * 33 + (lane & 31)] = t_[i];
    LDS_WAIT(); asm volatile("" ::: "memory");
    const int c = lane & 3;
#pragma unroll
    for (int j = 0; j < 2; ++j) { const int n = (lane >> 2) + 16 * j; const LAS float* s = scr + (16 * c) * 33 + n;
        const int wrow = qmap ? wt_row0 + 128 * (n >> 4) + 16 * ((n & 7) >> 2) + 4 * ((n >> 3) & 1) + (n & 3) : wt_row0 + n;
        v4u o; o.x = pg8::pk4_fp8(s[0 * 33] * pg8::W8_SCALE, s[1 * 33] * pg8::W8_SCALE, s[2 * 33] * pg8::W8_SCALE, s[3 * 33] * pg8::W8_SCALE); o.y = pg8::pk4_fp8(s[4 * 33] * pg8::W8_SCALE, s[5 * 33] * pg8::W8_SCALE, s[6 * 33] * pg8::W8_SCALE, s[7 * 33] * pg8::W8_SCALE);
        o.z = pg8::pk4_fp8(s[8 * 33] * pg8::W8_SCALE, s[9 * 33] * pg8::W8_SCALE, s[10 * 33] * pg8::W8_SCALE, s[11 * 33] * pg8::W8_SCALE); o.w = pg8::pk4_fp8(s[12 * 33] * pg8::W8_SCALE, s[13 * 33] * pg8::W8_SCALE, s[14 * 33] * pg8::W8_SCALE, s[15 * 33] * pg8::W8_SCALE);
        *(GAS v4u*)(WT + (size_t)wrow * K + k0 + 16 * c) = o; }
    LDS_WAIT(); asm volatile("" ::: "memory");
}
constexpr int I_QKV = 16 * 72, I_WO = 16 * 32, I_IN = 16 * 64, I_OUT = 16 * 32;
constexpr int CONV_DENSE = I_WO, CONV_ALL = I_WO + NE * I_IN + NE * I_OUT;
__device__ __forceinline__ void conv_items(Frame& F, int first, int count, LAS float* scr, int lane) {
    const int gw = F.vcu * NWAVES + F.wave, NGW = F.G * NWAVES;
    for (int it = first + gw; it < first + count; it += NGW) {
        int r = it;
        if (r < I_WO) { const int kb = r / 32, nb = r % 32; transpose_item(F.in[12], DM_, DM_, (bf16*)(F.ws + WS_WO), 64 * kb, 32 * nb, 32 * nb, scr, lane); continue; } r -= I_WO;
        if (r < NE * I_IN) { const int e = r / I_IN, q = r % I_IN, kb = q / 64, nb = q % 64; const int grp = nb < 32 ? ((nb >> 2) * 8 + (nb & 3)) : (((nb - 32) >> 2) * 8 + 4 + ((nb - 32) & 3));
            transpose_item_f8(F.in[16] + (size_t)e * DM_ * 2048, DM_, 2048, F.ws + WS_WIN + (size_t)e * 2048 * DM_, 64 * kb, 32 * nb, 32 * grp, scr, lane); continue; } r -= NE * I_IN;
        { const int e = r / I_OUT, q = r % I_OUT, kb = q / 32, nb = q % 32;
            transpose_item_f8(F.in[18] + (size_t)e * DM_ * DM_, DM_, DM_, F.ws + WS_WOUT + (size_t)e * DM_ * DM_, 64 * kb, 32 * nb, 32 * nb, scr, lane); }
    }
}
__device__ __forceinline__ void cx_desc(const Frame& F, int it, const float*& src, int& N, unsigned char*& dst) {
    int r = it - I_WO;
    if (r < NE * I_IN) { const int e = r / I_IN, q = r % I_IN, kb = q / 64, nb = q % 64; const int grp = nb < 32 ? ((nb >> 2) * 8 + (nb & 3)) : (((nb - 32) >> 2) * 8 + 4 + ((nb - 32) & 3));
        N = 2048; src = F.in[16] + (size_t)e * DM_ * 2048 + (size_t)(64 * kb) * 2048 + 32 * nb; dst = F.ws + WS_WIN + (size_t)e * 2048 * DM_ + (size_t)(32 * grp) * DM_ + 64 * kb; }
    else { r -= NE * I_IN; const int e = r / I_OUT, q = r % I_OUT, kb = q / 32, nb = q % 32;
        const int nbp = (nb & ~7) | ((nb & 1) << 2) | ((nb & 7) >> 1);
        N = DM_; src = F.in[18] + (size_t)e * DM_ * DM_ + (size_t)(64 * kb) * DM_ + 32 * nb; dst = F.ws + WS_WOUT + (size_t)e * DM_ * DM_ + (size_t)(32 * nbp) * DM_ + 64 * kb; }
}
__device__ __forceinline__ void cx_ld(const Frame& F, int it, int lane, f32x4 (&t_)[8]) {
    const float* src; int N; unsigned char* dst; cx_desc(F, it, src, N, dst);
    const float* p = src + (size_t)(4 * (lane >> 3)) * N + 4 * (lane & 7);
#pragma unroll
    for (int i = 0; i < 8; ++i) t_[i] = *(const f32x4*)(p + (size_t)(32 * (i >> 2) + (i & 3)) * N);
}
__device__ __forceinline__ void cx_st(const Frame& F, int it, int lane, const f32x4 (&t_)[8], LAS float* scr) {
    const float* src; int N; unsigned char* dst; cx_desc(F, it, src, N, dst);
    LAS unsigned* sc = (LAS unsigned*)scr; const int cn = lane & 7, r = lane >> 3;
#pragma unroll
    for (int h = 0; h < 2; ++h)
#pragma unroll
        for (int c = 0; c < 4; ++c)
            sc[(4 * cn + c) * 18 + 8 * h + r] = pg8::pk4_fp8(t_[4 * h][c] * pg8::W8_SCALE, t_[4 * h + 1][c] * pg8::W8_SCALE, t_[4 * h + 2][c] * pg8::W8_SCALE, t_[4 * h + 3][c] * pg8::W8_SCALE);
    LDS_WAIT(); asm volatile("" ::: "memory");
    const int c2 = lane & 3;
#pragma unroll
    for (int j = 0; j < 2; ++j) { const int n = (lane >> 2) + 16 * j; const LAS unsigned* s_ = sc + n * 18 + 4 * c2;
        const pg8::u32x2 lo = *(const LAS pg8::u32x2*)s_, hi = *(const LAS pg8::u32x2*)(s_ + 2);
        v4u o; o.x = lo.x; o.y = lo.y; o.z = hi.x; o.w = hi.y;
        *(GAS v4u*)(dst + (size_t)n * DM_ + 16 * c2) = o; }
    LDS_WAIT(); asm volatile("" ::: "memory");
}
__device__ __forceinline__ void conv_experts(Frame& F, LAS float* scr, int lane) {
    const int cvu = (F.G % 8 == 0) ? ((F.vcu & ~7) | ((F.vcu + (F.vcu >> 3)) & 7)) : F.vcu;
    const int gw = cvu * NWAVES + F.wave, NGW = F.G * NWAVES, end = CONV_ALL;
    int it = CONV_DENSE + gw;
    f32x4 A_[8], B_[8], C_[8];
    if (it + 2 * NGW < end) {
        cx_ld(F, it, lane, A_); cx_ld(F, it + NGW, lane, B_);
        while (it + 4 * NGW < end) {
            cx_ld(F, it + 2 * NGW, lane, C_); cx_st(F, it, lane, A_, scr);
            cx_ld(F, it + 3 * NGW, lane, A_); cx_st(F, it + NGW, lane, B_, scr);
            cx_ld(F, it + 4 * NGW, lane, B_); cx_st(F, it + 2 * NGW, lane, C_, scr);
            it += 3 * NGW;
        }
        cx_st(F, it, lane, A_, scr); cx_st(F, it + NGW, lane, B_, scr); it += 2 * NGW;
    }
    for (; it < end; it += NGW) { cx_ld(F, it, lane, A_); cx_st(F, it, lane, A_, scr); }
}
__device__ __forceinline__ void p0_prologue(Frame& F) {
    const float* c = F.in[1]; const float* cctx = F.in[3]; const float* w_ada = F.in[4]; const float* b_ada = F.in[5];
    float* mod = (float*)(F.ws + WS_MOD); float* rope = (float*)(F.ws + WS_ROPE);
    LAS float* scr = (LAS float*)(F.lds + RING_OFF + F.wave * 16384);
    const int lane = lane_id_asm(), w = F.wave, tid = w * 64 + lane;
    for (int cg = F.vcu; cg < 192; cg += F.G) {
        for (int i = lane; i < 384; i += 64) { const int v = i >> 7, kk = i & 127; const float s = (v < 2 ? c[v * DM_ + 128 * w + kk] : cctx[128 * w + kk]); scr[i] = s / (1.0f + expf(-s)); }
        LDS_WAIT(); asm volatile("" ::: "memory");
        const int kh = lane >> 5, col = 32 * cg + (lane & 31); float a0 = 0.f, a1 = 0.f, a2 = 0.f;
        float wl_[64];
#pragma unroll
        for (int j = 0; j < 64; ++j) wl_[j] = w_ada[(size_t)(128 * w + 2 * j + kh) * NMOD + col];
#pragma unroll
        for (int j = 0; j < 64; ++j) { const int kk = 2 * j + kh; a0 += scr[kk] * wl_[j]; a1 += scr[128 + kk] * wl_[j]; a2 += scr[256 + kk] * wl_[j]; }
        a0 += __shfl_xor(a0, 32); a1 += __shfl_xor(a1, 32); a2 += __shfl_xor(a2, 32);
        LAS float* xs = (LAS float*)(F.lds + XSCR_OFF);
        if (lane < 32) { xs[w * 96 + lane] = a0; xs[w * 96 + 32 + lane] = a1; xs[w * 96 + 64 + lane] = a2; }
        __syncthreads();
        if (tid < 96) { float s = 0.f; for (int ww = 0; ww < 8; ++ww) s += xs[ww * 96 + tid]; const int v = tid >> 5, cc = 32 * cg + (tid & 31); mod[v * NMOD + cc] = s + b_ada[cc]; }
        __syncthreads();
    }
    for (int i = F.vcu * 8 + tid; i < 2048 && tid < 8; i += F.G * 8) { const int p = i >> 4, f = i & 15; const float invf = (float)pow(10000.0, -(double)f / 16.0); const float ang = (float)p * invf;
        rope[i] = (float)cos((double)ang); rope[2048 + i] = (float)sin((double)ang); }
    { GAS v4u* lt = (GAS v4u*)(F.ws + WS_LTOK); const int n16 = NE * 16384 * 4 / 16; for (int i = F.vcu * NWAVES * 64 + tid; i < n16; i += F.G * NWAVES * 64) lt[i] = (v4u){0u, 0u, 0u, 0u}; }
    conv_items(F, 0, CONV_DENSE, scr, lane);
}
__device__ __forceinline__ void p0_xhat(Frame& F, unsigned* dep = nullptr) {
    const float* x = F.in[0]; const float* ctx = F.in[2]; bf16* XN = (bf16*)(F.ws + WS_XN); const float* g1 = F.in[6]; const float* mod = (const float*)(F.ws + WS_MOD);
    const int gw = F.vcu * NWAVES + F.wave, NGW = F.G * NWAVES, lane = lane_id_asm();
    const int xl = F.vcu >> 5, wl = (F.vcu & 31) * NWAVES + F.wave, mlo = xl < 2 ? 9 * xl : 18 + 8 * (xl - 2), mcnt = xl < 2 ? 9 : 8;
    const int nit = dep ? (mcnt + 1) / 2 : (MROWS - gw + 2 * NGW - 1) / (2 * NGW);
    int pend0 = -1, pend1 = -1;
    for (int it = 0; it < nit; ++it) {
        f32x4 v[2][4]; int mm[2];
#pragma unroll
        for (int u = 0; u < 2; ++u) { int m;
            if (dep) { const int k = 2 * it + u; m = (mlo + (k < mcnt ? k : 2 * it)) * 256 + wl; }
            else { const int m0 = gw + it * 2 * NGW; m = (m0 + u * NGW < MROWS) ? m0 + u * NGW : m0; }
            mm[u] = m; const int b = m / KEYS, i = m % KEYS;
            const float* src = (i < CTXL) ? ctx + ((size_t)b * CTXL + i) * DM_ : x + ((size_t)b * T_ + (i - CTXL)) * DM_;
            const GAS f32x4* xr = (const GAS f32x4*)src + lane;
#pragma unroll
            for (int j = 0; j < 4; ++j) v[u][j] = xr[64 * j]; }
#pragma unroll
        for (int u = 0; u < 2; ++u) { float s = 0.f;
#pragma unroll
            for (int j = 0; j < 4; ++j) s += (v[u][j].x * v[u][j].x + v[u][j].y * v[u][j].y) + (v[u][j].z * v[u][j].z + v[u][j].w * v[u][j].w);
            const float rstd = 1.0f / sqrtf(wave_sum(s) * (1.0f / DM_) + 1e-6f);
            if (dep && u == 0) {
                asm volatile("s_waitcnt vmcnt(0)" :: "v"(rstd) : "memory");
                __syncthreads();
                if (F.wave == 0 && lane == 0) { if (pend0 >= 0) __hip_atomic_fetch_add(dep + pend0, 1u, __ATOMIC_RELAXED, __HIP_MEMORY_SCOPE_AGENT); if (pend1 >= 0) __hip_atomic_fetch_add(dep + pend1, 1u, __ATOMIC_RELAXED, __HIP_MEMORY_SCOPE_AGENT); }
                pend0 = mm[0] >> 8; pend1 = (2 * it + 1 < mcnt) ? (mm[1] >> 8) : -1; }
            GAS unsigned* o4 = (GAS unsigned*)((unsigned char*)XN + (size_t)mm[u] * DM_) + lane;
            const float* md = mod + (((mm[u] % KEYS) < CTXL) ? 2 : mm[u] / KEYS) * NMOD;
#pragma unroll
            for (int j = 0; j < 4; ++j) { const int cc = 4 * (lane + 64 * j); const f32x4 o = v[u][j] * rstd * (*(const f32x4*)(g1 + cc) * (*(const f32x4*)(md + DM_ + cc) + 1.0f)) + *(const f32x4*)(md + cc);
                o4[64 * j] = pg8::pk4_fp8(o.x, o.y, o.z, o.w); } }
    }
    if (dep) { asm volatile("s_waitcnt vmcnt(0)" ::: "memory");
        __syncthreads();
        if (F.wave == 0 && lane == 0) { if (pend0 >= 0) __hip_atomic_fetch_add(dep + pend0, 1u, __ATOMIC_RELAXED, __HIP_MEMORY_SCOPE_AGENT); if (pend1 >= 0) __hip_atomic_fetch_add(dep + pend1, 1u, __ATOMIC_RELAXED, __HIP_MEMORY_SCOPE_AGENT); } }
}
__device__ __forceinline__ void p1_wqkv(Frame& F) {
    const float* w = F.in[7];
    LAS float* scr = (LAS float*)(F.lds + RING_OFF + F.wave * 16384);
    const int lane = lane_id_asm(), wv = F.wave;
    const int gw = F.vcu * NWAVES + wv, NGW = F.G * NWAVES;
    for (int it = gw; it < I_QKV; it += NGW) { const int r = it, kb = r / 72, nb = r % 72, pn = nb >> 3, wc = (nb & 7) >> 1, ax = nb & 1;
        transpose_item_f8(w, DM_, QKVC, F.ws + WS_WQKV, 64 * kb, 32 * nb, 256 * pn + 32 * wc + 8 * ax, scr, lane, nullptr, nullptr, true); }
}
__device__ __forceinline__ float bf2f(unsigned short h) { return __builtin_bit_cast(float, (unsigned)h << 16); }
__device__ __forceinline__ void p3_attention(Frame& F, char* lds) {
    using abf = attn_body::bf16;
    const abf* QKV = (const abf*)(F.ws + WS_QKV); abf* MIX = (abf*)(F.ws + WS_MIX);
    const int ordB = (F.vcu >> 5) & 1; const int v8 = F.vcu & 7; const int cpos = v8 == 0 ? 0 : v8 < 3 ? 1 : v8 < 5 ? 2 : v8 < 7 ? 3 : 4; int pos = 0; bool cdone = false;
    bool fixref; { const int l_ = lane_id_asm(); float gq = fabsf(F.in[8][l_]), gk = fabsf(F.in[9][l_]);
#pragma unroll
        for (int o_ = 1; o_ < 64; o_ <<= 1) { gq = fmaxf(gq, __shfl_xor(gq, o_)); gk = fmaxf(gk, __shfl_xor(gk, o_)); }
        fixref = __builtin_amdgcn_readfirstlane((gq * gk <= 8.0f) ? 1 : 0) != 0; }
#define CONV_AT() do { if (!cdone && pos == cpos) { conv_experts(F, (LAS float*)(F.lds + RING_OFF + F.wave * 16384), lane_id_asm()); __syncthreads(); cdone = true; } ++pos; } while (0)
    CONV_AT();
    const float* lamp = F.in[10];
    float lam; { const int lane = lane_id_asm(); lam = expf(wave_sum(lamp[lane] * lamp[64 + lane])) - expf(wave_sum(lamp[128 + lane] * lamp[192 + lane])) + 0.2f; }
#pragma nounroll
    for (int seg = 0; seg < 2; ++seg) {
      if ((seg == 0) != (ordB != 0)) {
        for (int L = F.vcu; L < 16 * 32; L += F.G) {
            const int run = L >> 5, qb = L & 31, b = run >> 3, h = run & 7;
            const abf* kb = QKV + (size_t)b * KEYS * QKVC;
            const unsigned char* k8 = F.ws + WS_QK8 + (size_t)b * KEYS * 1664;
            if (fixref) attn_body::attn_unit_q8v<8, true>(k8 + (size_t)(CTXL + qb * 256) * 1664 + h * 64, k8 + (8 + (h >> 2)) * 64, F.ws + WS_V8 + (size_t)b * KEYS * 640 + (h >> 2) * 64, MIX + ((size_t)b * T_ + qb * 256) * DM_ + h * 64, DM_, lds, F.wave);
            else attn_body::attn_unit_q8<8, false>(k8 + (size_t)(CTXL + qb * 256) * 1664 + h * 64, k8 + (8 + (h >> 2)) * 64, kb + 640 + (h >> 2) * 64, MIX + ((size_t)b * T_ + qb * 256) * DM_ + h * 64, DM_, lds, F.wave);
            CONV_AT();
        }
      } else {
        for (int L = F.vcu; L < 8 * 32; L += F.G) {
            const int bh = L >> 5, qb = L & 31, b = bh >> 2, h = bh & 3;
            const abf* kb = QKV + (size_t)b * KEYS * QKVC;
            const float nq = fmaxf(__uint_as_float(__hip_atomic_load(F.ctl + CW_NMAX + 12 + 2 * h, RLX_AGENT)), __uint_as_float(__hip_atomic_load(F.ctl + CW_NMAX + 13 + 2 * h, RLX_AGENT)));
            const float nk = fmaxf(__uint_as_float(__hip_atomic_load(F.ctl + CW_NMAX + 20 + 2 * h, RLX_AGENT)), __uint_as_float(__hip_atomic_load(F.ctl + CW_NMAX + 21 + 2 * h, RLX_AGENT)));
            const float bound = sqrtf(nq * nk) * pg8::ATT_C2;
            const float ref8 = fmaxf(0.55f * bound - 15.0f, 0.0f);
            const unsigned char* k8 = F.ws + WS_QK8 + (size_t)b * KEYS * 1664;
#pragma nounroll
            for (int pp = 0; pp < 2; ++pp) {
                const bool redo = attn_body::attn_unit128_q8v<8, true>(k8 + (size_t)(CTXL + qb * 256) * 1664 + (10 + 2 * h) * 64, k8 + (18 + 2 * h) * 64, F.ws + WS_V8 + (size_t)b * KEYS * 640 + 128 + h * 128, MIX + ((size_t)b * T_ + qb * 256) * DM_ + 512 + h * 128, DM_, lds, F.wave,
                                           (float*)(F.ws + WS_DT) + (size_t)F.vcu * 32768, lam, F.in[11], pp, pp + 1, ref8);
                if (redo) attn_body::attn_unit128_q8<8, false>(k8 + (size_t)(CTXL + qb * 256) * 1664 + (10 + 2 * h) * 64, k8 + (18 + 2 * h) * 64, kb + 1792 + h * 128, MIX + ((size_t)b * T_ + qb * 256) * DM_ + 512 + h * 128, DM_, lds, F.wave,
                                           (float*)(F.ws + WS_DT) + (size_t)F.vcu * 32768, lam, F.in[11], pp, pp + 1);
                CONV_AT();
            }
        }
      }
    }
    if (!cdone) { conv_experts(F, (LAS float*)(F.lds + RING_OFF + F.wave * 16384), lane_id_asm()); __syncthreads(); }
#undef CONV_AT
}
__device__ __forceinline__ f32x4 bf4lo(v4u q); __device__ __forceinline__ f32x4 bf4hi(v4u q);
typedef short p6_bf16x8 __attribute__((ext_vector_type(8)));
typedef float p6_f32x16 __attribute__((ext_vector_type(16)));
__device__ __forceinline__ void p6_split8(const float (&v)[8], p6_bf16x8& hi, p6_bf16x8& lo) {
    unsigned h[4], l[4];
#pragma unroll
    for (int j = 0; j < 4; ++j) { h[j] = pg8::cvt_pk_bf16(v[2 * j], v[2 * j + 1]);
        const float r0 = v[2 * j] - __builtin_bit_cast(float, h[j] << 16), r1 = v[2 * j + 1] - __builtin_bit_cast(float, h[j] & 0xffff0000u); l[j] = pg8::cvt_pk_bf16(r0, r1); }
    hi = __builtin_bit_cast(p6_bf16x8, (v4u){h[0], h[1], h[2], h[3]}); lo = __builtin_bit_cast(p6_bf16x8, (v4u){l[0], l[1], l[2], l[3]});
}
__device__ __forceinline__ void p6_router(Frame& F, unsigned* dep5 = nullptr) {
    const bf16* x1 = (const bf16*)(F.ws + WS_DT); const float* g = F.in[13]; const float* wr = F.in[14]; const float* br = F.in[15]; const float* mod = (const float*)(F.ws + WS_MOD);
    bf16* H2 = (bf16*)(F.ws + WS_XN); int* se = (int*)(F.ws + WS_SE); int* sp = (int*)(F.ws + WS_SP); int* ltok = (int*)(F.ws + WS_LTOK); float* lgate = (float*)(F.ws + WS_LGATE);
    LAS float* rstdb = (LAS float*)(F.lds + RING_OFF);
    LAS float* part = (LAS float*)(F.lds + RING_OFF + 1024);
    LAS float* lgb = (LAS float*)(F.lds + RING_OFF + 1024 + 65536);
    LAS float* selb = (LAS float*)(F.lds + RING_OFF + 1024 + 65536 + 8192);
    LAS unsigned* lcount = (LAS unsigned*)(F.lds + RING_OFF + 1024 + 65536 + 8192 + 1024);
    LAS unsigned* lbase = lcount + 32;
    LAS unsigned* recE = lbase + 32;
    LAS float* recG = (LAS float*)(recE + 256);
    const int lane = lane_id_asm(), w = F.wave, e = lane & 31, hh = lane >> 5, tid = w * 64 + lane;
    p6_bf16x8 wh[8], wl[8];
#pragma unroll
    for (int st = 0; st < 8; ++st) { float t[8];
#pragma unroll
        for (int j = 0; j < 8; ++j) t[j] = wr[(size_t)(128 * w + 16 * st + 8 * hh + j) * NE + e];
        p6_split8(t, wh[st], wl[st]); }
    const float bre = br[e];
    for (int chunk = F.vcu; chunk < NTOK / 64; chunk += F.G) {
        if (dep5) { while (__hip_atomic_load(dep5 + (chunk >> 2), __ATOMIC_RELAXED, __HIP_MEMORY_SCOPE_AGENT) < 4u) __builtin_amdgcn_s_sleep(4); asm volatile("" ::: "memory"); }
        const int tokc = chunk * 64, b = tokc / T_; const float* md = mod + b * NMOD;
        if (tid < 32) lcount[tid] = 0u;
        { f32x4 ga[4], sh[4];
#pragma unroll
            for (int j = 0; j < 4; ++j) { const int cc = 4 * (lane + 64 * j); ga[j] = *(const f32x4*)(g + cc) * (*(const f32x4*)(md + 4 * DM_ + cc) + 1.0f); sh[j] = *(const f32x4*)(md + 3 * DM_ + cc); }
#pragma unroll 1
            for (int hb = 0; hb < 2; ++hb) { const int tokw = tokc + 8 * w + 4 * hb;
                unsigned long long q_[4][4];
#pragma unroll
                for (int r = 0; r < 4; ++r) { const GAS unsigned long long* xr = (const GAS unsigned long long*)(x1 + (size_t)(tokw + r) * DM_) + lane;
#pragma unroll
                    for (int j = 0; j < 4; ++j) q_[r][j] = xr[64 * j]; }
                float rs_[4];
#pragma unroll
                for (int r = 0; r < 4; ++r) { float s = 0.f;
#pragma unroll
                    for (int j = 0; j < 4; ++j) { const unsigned lo = (unsigned)q_[r][j], hi = (unsigned)(q_[r][j] >> 32); const float a0 = bf2f(lo & 0xffff), a1 = bf2f(lo >> 16), a2 = bf2f(hi & 0xffff), a3 = bf2f(hi >> 16); s += (a0 * a0 + a1 * a1) + (a2 * a2 + a3 * a3); }
                    rs_[r] = 1.0f / sqrtf(wave_sum(s) * (1.0f / DM_) + 1e-6f); }
                if (lane == 0) {
#pragma unroll
                    for (int r = 0; r < 4; ++r) rstdb[8 * w + 4 * hb + r] = rs_[r]; }
#pragma unroll
                for (int r = 0; r < 4; ++r)
#pragma unroll
                    for (int j = 0; j < 4; ++j) { asm volatile("" : "+v"(q_[r][j])); const unsigned lo = (unsigned)q_[r][j], hi = (unsigned)(q_[r][j] >> 32); const f32x4 v = (f32x4){bf2f(lo & 0xffff), bf2f(lo >> 16), bf2f(hi & 0xffff), bf2f(hi >> 16)};
                        const f32x4 o = v * rs_[r] * ga[j] + sh[j];
                        *((GAS unsigned*)((unsigned char*)H2 + (size_t)(tokw + r) * DM_) + lane + 64 * j) = pg8::pk4_fp8(o.x, o.y, o.z, o.w); }
            }
        }
        __syncthreads();
        { p6_f32x16 acc[2]; acc[0] = p6_f32x16{}; acc[1] = p6_f32x16{};
            const float rs0 = rstdb[e], rs1 = rstdb[32 + e];
#pragma unroll
            for (int st = 0; st < 8; ++st) { const int k0 = 128 * w + 16 * st + 8 * hh;
                const f32x4 g0 = *(const f32x4*)(g + k0), g1 = *(const f32x4*)(g + k0 + 4), c0 = *(const f32x4*)(md + 4 * DM_ + k0), c1 = *(const f32x4*)(md + 4 * DM_ + k0 + 4), h0 = *(const f32x4*)(md + 3 * DM_ + k0), h1 = *(const f32x4*)(md + 3 * DM_ + k0 + 4);
                const f32x4 a0 = g0 * (c0 + 1.0f), a1 = g1 * (c1 + 1.0f);
#pragma unroll
                for (int rb = 0; rb < 2; ++rb) { const v4u q = *(const GAS v4u*)(x1 + (size_t)(tokc + 32 * rb + e) * DM_ + k0); const float rs = rb ? rs1 : rs0;
                    const f32x4 xl = bf4lo(q), xh = bf4hi(q); const f32x4 vl = xl * rs * a0 + h0, vh = xh * rs * a1 + h1;
                    const float vv[8] = {vl.x, vl.y, vl.z, vl.w, vh.x, vh.y, vh.z, vh.w}; p6_bf16x8 ahi, alo; p6_split8(vv, ahi, alo);
                    acc[rb] = __builtin_amdgcn_mfma_f32_32x32x16_bf16(ahi, wh[st], acc[rb], 0, 0, 0);
                    acc[rb] = __builtin_amdgcn_mfma_f32_32x32x16_bf16(ahi, wl[st], acc[rb], 0, 0, 0);
                    acc[rb] = __builtin_amdgcn_mfma_f32_32x32x16_bf16(alo, wh[st], acc[rb], 0, 0, 0); } }
#pragma unroll
            for (int rb = 0; rb < 2; ++rb)
#pragma unroll
                for (int r = 0; r < 16; ++r) part[(w * 64 + 32 * rb + (r & 3) + 8 * (r >> 2) + 4 * hh) * 32 + e] = acc[rb][r]; }
        __syncthreads();
        { const int row = tid >> 3, e4 = (tid & 7) * 4; f32x4 sacc = *(const f32x4*)(br + e4);
#pragma unroll
            for (int ww = 0; ww < 8; ++ww) sacc += *(const LAS f32x4*)(part + (ww * 64 + row) * 32 + e4);
            *(LAS f32x4*)(lgb + row * 32 + e4) = sacc; }
        __syncthreads();
#pragma unroll 2
        for (int r = 0; r < 8; ++r) { const int row = 8 * w + r; const float lg = lgb[row * 32 + e];
            int rank = 0;
#pragma unroll
            for (int q = 0; q < 32; ++q) { const float o = lgb[row * 32 + q]; rank += (o > lg || (o == lg && q < e)) ? 1 : 0; }
            if (lane < 32 && rank < 4) selb[row * 4 + rank] = lg;
            LDS_WAIT(); asm volatile("" ::: "memory");
            const float m0 = selb[row * 4], den = 1.0f + expf(selb[row * 4 + 1] - m0) + expf(selb[row * 4 + 2] - m0) + expf(selb[row * 4 + 3] - m0);
            if (lane < 32 && rank < 4) { const unsigned lpos = __hip_atomic_fetch_add(lcount + e, 1u, __ATOMIC_RELAXED, __HIP_MEMORY_SCOPE_WORKGROUP);
                recE[row * 4 + rank] = (unsigned)e | (lpos << 8); recG[row * 4 + rank] = expf(lg - m0) / den; }
        }
        (void)bre;
        __syncthreads();
        if (tid < 32) lbase[tid] = __hip_atomic_fetch_add(F.ctl + CW_CNT + tid, lcount[tid], RLX_AGENT);
        __syncthreads();
        if (tid < 256) { const unsigned rc = recE[tid]; const int ee = (int)(rc & 255u), pos = (int)(lbase[ee] + (rc >> 8)), tok = tokc + (tid >> 2);
            ltok[ee * 16384 + pos] = tok; lgate[ee * 16384 + pos] = recG[tid]; se[tok * 4 + (tid & 3)] = ee; sp[tok * 4 + (tid & 3)] = pos; }
        __syncthreads();
    }
}
__device__ __forceinline__ f32x4 bf4lo(v4u q) { return (f32x4){bf2f(q.x & 0xffff), bf2f(q.x >> 16), bf2f(q.y & 0xffff), bf2f(q.y >> 16)}; }
__device__ __forceinline__ f32x4 bf4hi(v4u q) { return (f32x4){bf2f(q.z & 0xffff), bf2f(q.z >> 16), bf2f(q.w & 0xffff), bf2f(q.w >> 16)}; }
__device__ __forceinline__ f32x4 f8x4(unsigned w) { return (f32x4){__builtin_amdgcn_cvt_f32_fp8((int)w, 0), __builtin_amdgcn_cvt_f32_fp8((int)w, 1), __builtin_amdgcn_cvt_f32_fp8((int)w, 2), __builtin_amdgcn_cvt_f32_fp8((int)w, 3)}; }
__device__ __forceinline__ void p9_final(Frame& F, float* dst) {
    const bf16* xo = (const bf16*)(F.ws + WS_DT); const float* gf = F.in[20]; const float* mod = (const float*)(F.ws + WS_MOD); const unsigned char* Y = F.ws + WS_Y;
    const int* se = (const int*)(F.ws + WS_SE); const int* sp = (const int*)(F.ws + WS_SP); const LAS int* tp = (const LAS int*)(F.lds + TP_OFF);
    const int gw = F.vcu * NWAVES + F.wave, NGW = F.G * NWAVES, lane = lane_id_asm();
    constexpr int NU = 2;
    for (int t0 = gw; t0 < NTOK; t0 += NU * NGW) {
        int tk[NU];
#pragma unroll
        for (int u = 0; u < NU; ++u) tk[u] = (t0 + u * NGW < NTOK) ? t0 + u * NGW : t0;
        int ee[NU][4], pp[NU][4];
#pragma unroll
        for (int u = 0; u < NU; ++u)
#pragma unroll
            for (int k = 0; k < 4; ++k) { ee[u][k] = se[tk[u] * 4 + k]; pp[u][k] = sp[tk[u] * 4 + k]; }
        v4u yq[NU][4]; v4u xq[NU][2];
#pragma unroll
        for (int u = 0; u < NU; ++u) {
#pragma unroll
            for (int k = 0; k < 4; ++k) yq[u][k] = *((const GAS v4u*)(Y + ((size_t)tp[ee[u][k]] * 256 + pp[u][k]) * DM_) + lane);
            const GAS v4u* xr = (const GAS v4u*)(xo + (size_t)tk[u] * DM_) + 2 * lane; xq[u][0] = xr[0]; xq[u][1] = xr[1];
        }
#pragma unroll
        for (int u = 0; u < NU; ++u) {
            const int b = tk[u] / T_; const GAS f32x4* gt2 = (const GAS f32x4*)(mod + b * NMOD + 5 * DM_) + 4 * lane; const GAS f32x4* gfp = (const GAS f32x4*)gf + 4 * lane;
            f32x4 ys[4] = {(f32x4){0.f, 0.f, 0.f, 0.f}, (f32x4){0.f, 0.f, 0.f, 0.f}, (f32x4){0.f, 0.f, 0.f, 0.f}, (f32x4){0.f, 0.f, 0.f, 0.f}};
#pragma unroll
            for (int k = 0; k < 4; ++k) { ys[0] += f8x4(yq[u][k].x); ys[1] += f8x4(yq[u][k].y); ys[2] += f8x4(yq[u][k].z); ys[3] += f8x4(yq[u][k].w); }
            f32x4 v[4]; float s = 0.f;
            v[0] = bf4lo(xq[u][0]) + gt2[0] * ys[0]; v[1] = bf4hi(xq[u][0]) + gt2[1] * ys[1]; v[2] = bf4lo(xq[u][1]) + gt2[2] * ys[2]; v[3] = bf4hi(xq[u][1]) + gt2[3] * ys[3];
#pragma unroll
            for (int j = 0; j < 4; ++j) s += (v[j].x * v[j].x + v[j].y * v[j].y) + (v[j].z * v[j].z + v[j].w * v[j].w);
            const float rstd = 1.0f / sqrtf(wave_sum(s) * (1.0f / DM_) + 1e-6f);
            GAS f32x4* xw = (GAS f32x4*)(dst + (size_t)tk[u] * DM_) + 4 * lane;
            { LAS f32x4* stg = (LAS f32x4*)(F.lds + RING_OFF) + F.wave * 256;
                stg[4 * lane] = v[0] * rstd * gfp[0]; stg[4 * lane + 1] = v[1] * rstd * gfp[1]; stg[4 * lane + 2] = v[2] * rstd * gfp[2]; stg[4 * lane + 3] = v[3] * rstd * gfp[3];
                LDS_WAIT(); asm volatile("" ::: "memory");
                GAS f32x4* xo4 = (GAS f32x4*)(dst + (size_t)tk[u] * DM_) + lane;
                const f32x4 w0 = stg[lane], w1 = stg[64 + lane], w2 = stg[128 + lane], w3 = stg[192 + lane];
                xo4[0] = w0; xo4[64] = w1; xo4[128] = w2; xo4[192] = w3;
                LDS_WAIT(); asm volatile("" ::: "memory"); }
        }
    }
}

struct Args { const float* in[21]; float* out; unsigned char* ws; int ph_lo, ph_hi; };
__global__ void __launch_bounds__(NWAVES * 64, 2) mk_fwd(Args args) {
    extern __shared__ __attribute__((aligned(16))) unsigned char lds[];
    Frame F;
    F.lds = (LAS unsigned char*)lds; F.MISC = (volatile LAS unsigned*)(F.lds + MISC_OFF);
    F.wave = __builtin_amdgcn_readfirstlane(threadIdx.x >> 6);
    F.G = gridDim.x; { const int bx = blockIdx.x; F.vcu = (F.G % 8 == 0) ? (bx % 8) * (F.G / 8) + bx / 8 : bx; }
#pragma unroll
    for (int i = 0; i < 21; ++i) F.in[i] = args.in[i];
    F.out = args.out; F.ws = args.ws; F.ctl = (gu32*)(args.ws + WS_CTL);
    for (int u = threadIdx.x; u < (LDS_BYTES - LDSCTL_OFF) / 4; u += NWAVES * 64) ((LAS unsigned*)(F.lds + LDSCTL_OFF))[u] = 0u;
    __syncthreads();
    XcdBarrier bar; bar.bar = (unsigned*)(F.ctl + CW_BAR); bar.x = 0; bar.st = nullptr; bar.wv = F.wave;
    if (!MK_PER_PHASE) bar = xcd_barrier_post((unsigned*)(F.ctl + CW_BAR), F.MISC + 8);
    if (!MK_PER_PHASE && threadIdx.x == 0 && F.G == 256 && (int)xb_xcc_id() != (F.vcu >> 5)) __hip_atomic_fetch_or(F.ctl + CW_XOK, 1u, __ATOMIC_RELAXED, __HIP_MEMORY_SCOPE_AGENT);
    const int lo = args.ph_lo, hi = args.ph_hi;
#define IN(k) (lo <= (k) && (k) < hi)
#define SEAM(k) do { if (IN(k) && IN((k) + 1)) xcd_barrier(bar); } while (0)
#ifndef PROBE_DUP
#define PROBE_DUP 0
#endif
#define REPS(k) for (int rep_ = 0; rep_ < (((PROBE_DUP >> (k)) & 1) ? 2 : 1); ++rep_)
#define DUPBAR(k) do { if (((PROBE_DUP >> (k)) & 1) && rep_ == 0 && !MK_PER_PHASE) xcd_barrier(bar); } while (0)
    bf16* XN = (bf16*)(F.ws + WS_XN);
    if (IN(0)) REPS(0) { p0_prologue(F); p1_wqkv(F); DUPBAR(0); } SEAM(0);
    const bool depok1 = !MK_PER_PHASE && PROBE_DUP == 0 && F.G == 256 && IN(1) && IN(2) && (__builtin_amdgcn_readfirstlane((int)__hip_atomic_load(F.ctl + CW_XOK, __ATOMIC_RELAXED, __HIP_MEMORY_SCOPE_AGENT)) == 0);
    if (IN(1)) REPS(1) { p0_xhat(F, depok1 ? (unsigned*)(F.ctl + CW_MT2) : nullptr); DUPBAR(1); } if (!depok1) SEAM(1);
    if (IN(2)) REPS(2) {
        pg8::Gemm g{XN, (const bf16*)(F.ws + WS_WQKV), MROWS, QKVC, DM_}; pg8::QkvOrder S; S.init(MROWS, QKVC, F.G, depok1 ? F.vcu : (int)blockIdx.x); S.mode = depok1 ? 1 : 0; S.dep = (unsigned*)(F.ctl + CW_MT2);
        pg8::EpiQkv E{(bf16*)(F.ws + WS_QKV), F.in[8], F.in[9], (const float*)(F.ws + WS_ROPE), (const float*)(F.ws + WS_CB), F.ws + WS_QK8, F.ws + WS_V8, (unsigned*)(F.ctl + CW_NMAX)};
        pg8::gemm_phase<pg8::EpiQkv, pg8::QkvOrder, PG8_ALIGN, PG8_SP2, false, true>(F.lds + RING_OFF, g, S, E, F.wave, nullptr, (LAS unsigned*)(F.lds + IDBUF_OFF)); DUPBAR(2);
    } SEAM(2);
    if (IN(3)) REPS(3) { p3_attention(F, (char*)lds + RING_OFF); DUPBAR(3); } if (IN(3) && IN(5)) xcd_barrier(bar);
    const bool depok5 = !MK_PER_PHASE && PROBE_DUP == 0 && F.G == 256 && IN(5) && IN(6) && (__builtin_amdgcn_readfirstlane((int)__hip_atomic_load(F.ctl + CW_XOK, __ATOMIC_RELAXED, __HIP_MEMORY_SCOPE_AGENT)) == 0);
    if (IN(5)) REPS(5) {
        pg8::Gemm g{(const bf16*)(F.ws + WS_MIX), (const bf16*)(F.ws + WS_WO), NTOK, DM_, DM_}; pg8::WoOrder S; S.init(NTOK, DM_, F.G, (int)blockIdx.x); S.dep = (unsigned*)(F.ctl + CW_MT5); S.mode = depok5 ? 1 : 0;
        pg8::EpiWo E{F.in[0], (const float*)(F.ws + WS_MOD), (bf16*)(F.ws + WS_DT)};
        pg8::gemm_phase<pg8::EpiWo, pg8::WoOrder, PG8_ALIGN, PG8_SP2>(F.lds + RING_OFF, g, S, E, F.wave); DUPBAR(5);
    } if (!depok5) SEAM(5);
    if (IN(6)) REPS(6) { p6_router(F, depok5 ? (unsigned*)(F.ctl + CW_MT5) : nullptr); if (((PROBE_DUP >> 6) & 1) && rep_ == 0) { xcd_barrier(bar); if (blockIdx.x == 0 && threadIdx.x < 32) F.ctl[CW_CNT + threadIdx.x] = 0u; xcd_barrier(bar); } } SEAM(6);
    const bool depok = !MK_PER_PHASE && PROBE_DUP == 0 && F.G == 256 && IN(7) && IN(8) && (__builtin_amdgcn_readfirstlane((int)__hip_atomic_load(F.ctl + CW_XOK, __ATOMIC_RELAXED, __HIP_MEMORY_SCOPE_AGENT)) == 0);
    if (IN(7)) REPS(7) {
        build_tp(F);
        pg8::Gemm g{XN, (const bf16*)(F.ws + WS_WIN), 0, 0, DM_}; pg8::MoeOrder S{(const LAS int*)(F.lds + TP_OFF), (const LAS unsigned char*)(F.lds + TE_OFF), 8, F.G, F.vcu, (unsigned*)(F.ctl + CW_MT), depok ? 1 : 0, 0};
        pg8::EpiSwiglu E{(bf16*)(F.ws + WS_ACT), F.in[17]};
        pg8::gemm_phase<pg8::EpiSwiglu, pg8::MoeOrder, PG8_ALIGN, PG8_SP2, true, true>(F.lds + RING_OFF, g, S, E, F.wave, (const int*)(F.ws + WS_LTOK), (LAS unsigned*)(F.lds + IDBUF_OFF)); DUPBAR(7);
    } if (!depok) SEAM(7);
    if (IN(8)) REPS(8) {
        if (!IN(7)) build_tp(F);
        pg8::Gemm g{(const bf16*)(F.ws + WS_ACT), (const bf16*)(F.ws + WS_WOUT), 0, 0, DM_}; pg8::MoeOrder S{(const LAS int*)(F.lds + TP_OFF), (const LAS unsigned char*)(F.lds + TE_OFF), 4, F.G, F.vcu, (unsigned*)(F.ctl + CW_MT), depok ? 2 : 0, 16};
        pg8::EpiMoeOut E{(bf16*)(F.ws + WS_Y), F.in[19], (const float*)(F.ws + WS_LGATE)};
        pg8::gemm_phase<pg8::EpiMoeOut, pg8::MoeOrder, PG8_ALIGN, PG8_SP2, false, true>(F.lds + RING_OFF, g, S, E, F.wave, nullptr, (LAS unsigned*)(F.lds + IDBUF_OFF)); DUPBAR(8);
    } SEAM(8);
    if (IN(9)) REPS(9) { if (!IN(7)) build_tp(F); p9_final(F, (((PROBE_DUP >> 9) & 1) && rep_ == 0) ? (float*)(F.ws + WS_ACT) : F.out); DUPBAR(9); }
#undef IN
#undef SEAM
}

extern "C" void kernel_launch(void* const* d_in, const int* in_sizes, int n_in, void* d_out, int out_size, void* d_ws, size_t ws_size, hipStream_t stream) {
    static int grid = 0;
    if (grid == 0) {
        if (n_in != 21 || out_size != NTOK * DM_ || ws_size < WS_END) { fprintf(stderr, "kernel_launch: unexpected shapes (n_in %d, out %d, ws %zu); nothing launched\n", n_in, out_size, ws_size); grid = -1; return; }
        int dev = 0, cus = 0, per_cu = 0;
        if (hipGetDevice(&dev) != hipSuccess || hipDeviceGetAttribute(&cus, hipDeviceAttributeMultiprocessorCount, dev) != hipSuccess) { grid = -1; return; }
        if (hipFuncSetAttribute((const void*)mk_fwd, hipFuncAttributeMaxDynamicSharedMemorySize, LDS_BYTES) != hipSuccess) { fprintf(stderr, "kernel_launch: hipFuncSetAttribute failed\n"); grid = -1; return; }
        if (hipOccupancyMaxActiveBlocksPerMultiprocessor(&per_cu, (const void*)mk_fwd, NWAVES * 64, LDS_BYTES) != hipSuccess || per_cu < 1) { fprintf(stderr, "kernel_launch: occupancy query says %d blocks per CU\n", per_cu); }
        (void)hipGetLastError();
        grid = cus;
    }
    if (grid < 0) return;
    if (hipMemsetAsync((char*)d_ws + WS_CTL, 0, CTL_ZERO_BYTES, stream) != hipSuccess) return;
    Args a{};
    for (int i = 0; i < 21; ++i) a.in[i] = (const float*)d_in[i];
    a.out = (float*)d_out; a.ws = (unsigned char*)d_ws;
#if MK_PER_PHASE
    for (int p = 0; p < NPH; ++p) { a.ph_lo = p; a.ph_hi = p + 1; hipLaunchKernelGGL(mk_fwd, dim3(grid), dim3(NWAVES * 64), LDS_BYTES, stream, a); }
#else
    a.ph_lo = 0; a.ph_hi = NPH; hipLaunchKernelGGL(mk_fwd, dim3(grid), dim3(NWAVES * 64), LDS_BYTES, stream, a);
#endif
}
```
